# Optimizing an MI355X kernel written in HIP

```python
import math
import jax, jax.numpy as jnp
from jax import lax
import numpy as np

D_MODEL = 2048
BATCH = 8
SEQ = 4096
DEPTH = 4

MIX_WIDTH = D_MODEL
CONV_WIDTH = D_MODEL // 2
CONV_GROUPS = 8
CONV_K = 3
ATTN_HEADS = 8
ATTN_WIDTH = MIX_WIDTH - CONV_WIDTH
ATTN_VDIM = ATTN_WIDTH // ATTN_HEADS
ATTN_SUBDIM = ATTN_VDIM // 2
ROPE_DIM = ATTN_SUBDIM // 4
ROPE_THETA = 500000.0
Q_BLOCK = 128
IN_COLS = 3 * CONV_WIDTH + 3 * ATTN_WIDTH
PEER_HEADS = 8
PEER_NKEYS = 128
PEER_N = PEER_NKEYS * PEER_NKEYS
PEER_QDIM = 256
PEER_HALF = PEER_QDIM // 2
PEER_TOPK = 16
PEER_CHUNK = 128
NORM_EPS = 1e-6

kernel_name = "hybrid_conv_diffattn_peer_encoder"


def rmsnorm(x, g):
    x32 = x.astype(jnp.float32)
    y = x32 * lax.rsqrt(jnp.mean(x32 * x32, axis=-1, keepdims=True) + NORM_EPS)
    return y.astype(x.dtype) * g


def rotary_tables(positions, dtype):
    inv_freq = ROPE_THETA ** (-jnp.arange(0, ROPE_DIM, 2, dtype=jnp.float32) / ROPE_DIM)
    freqs = positions.astype(jnp.float32)[..., None] * inv_freq
    emb = jnp.concatenate([freqs, freqs], axis=-1)
    return (jnp.cos(emb)[:, :, None, None, :].astype(dtype),
            jnp.sin(emb)[:, :, None, None, :].astype(dtype))


def partial_rope(x, cos, sin):
    xr, xp = x[..., :ROPE_DIM], x[..., ROPE_DIM:]
    x1, x2 = xr[..., :ROPE_DIM // 2], xr[..., ROPE_DIM // 2:]
    rot = jnp.concatenate([-x2, x1], axis=-1)
    return jnp.concatenate([xr * cos + rot * sin, xp], axis=-1)


def short_conv_group(gb, gc, hv, conv_w):
    z = gc * hv
    zp = jnp.pad(z, ((0, 0), (1, 1), (0, 0)))
    y = conv_w[0] * zp[:, :-2] + conv_w[1] * zp[:, 1:-1] + conv_w[2] * zp[:, 2:]
    return gb * y


def diff_attention_group(q, k, v, cos, sin, lq1, lk1, lq2, lk2, subln_g, lam_init):
    bsz, seq, _ = q.shape
    q = partial_rope(q.reshape(bsz, seq, ATTN_HEADS, 2, ATTN_SUBDIM), cos, sin)
    k = partial_rope(k.reshape(bsz, seq, ATTN_HEADS, 2, ATTN_SUBDIM), cos, sin)
    q = q.transpose(0, 2, 3, 1, 4)
    k = k.transpose(0, 2, 3, 1, 4)
    v = v.reshape(bsz, seq, ATTN_HEADS, ATTN_VDIM).transpose(0, 2, 1, 3)
    lam = (jnp.exp(jnp.sum(lq1.astype(jnp.float32) * lk1.astype(jnp.float32)))
           - jnp.exp(jnp.sum(lq2.astype(jnp.float32) * lk2.astype(jnp.float32)))
           + lam_init)
    scale = ATTN_SUBDIM ** -0.5
    nb = seq // Q_BLOCK
    qb = jnp.moveaxis(q.reshape(bsz, ATTN_HEADS, 2, nb, Q_BLOCK, ATTN_SUBDIM), 3, 0)

    def block(qi):
        s = jnp.einsum('bhcqd,bhckd->bhcqk', qi, k).astype(jnp.float32) * scale
        p = jax.nn.softmax(s, axis=-1)
        a = (p[:, :, 0] - lam * p[:, :, 1]).astype(v.dtype)
        return jnp.einsum('bhqk,bhkd->bhqd', a, v)

    o = lax.map(block, qb)
    o = o.transpose(1, 0, 3, 2, 4).reshape(bsz, seq, ATTN_HEADS, ATTN_VDIM)
    o = rmsnorm(o, subln_g) * (1.0 - lam_init)
    return o.reshape(bsz, seq, ATTN_WIDTH)


def hybrid_mixer(h, w_in, conv_w, lq1, lk1, lq2, lk2, subln_g, w_out, cos, sin, lam_init):
    z = h @ w_in
    c0, c1, c2 = CONV_WIDTH, 2 * CONV_WIDTH, 3 * CONV_WIDTH
    gb, gc, hv, q, k, v = jnp.split(z, [c0, c1, c2, c2 + ATTN_WIDTH, c2 + 2 * ATTN_WIDTH], axis=-1)
    conv_out = short_conv_group(gb, gc, hv, conv_w)
    attn_out = diff_attention_group(q, k, v, cos, sin, lq1, lk1, lq2, lk2, subln_g, lam_init)
    return jnp.concatenate([conv_out, attn_out], axis=-1) @ w_out


def peer_ffn(h, wq, keys, u, v):
    bsz, seq, d = h.shape
    q = (h @ wq).reshape(bsz, seq, PEER_HEADS, 2, PEER_HALF)
    s = jnp.einsum('bshcd,hcnd->bshcn', q, keys)
    st, it = lax.top_k(s, PEER_TOPK)
    cand = (st[..., 0, :, None] + st[..., 1, None, :]).reshape(bsz, seq, PEER_HEADS, PEER_TOPK * PEER_TOPK)
    cidx = (it[..., 0, :, None] * PEER_NKEYS + it[..., 1, None, :]).reshape(bsz, seq, PEER_HEADS, PEER_TOPK * PEER_TOPK)
    sc, pos = lax.top_k(cand, PEER_TOPK)
    experts = jnp.take_along_axis(cidx, pos, axis=-1)
    g = jax.nn.softmax(sc.astype(jnp.float32), axis=-1).astype(h.dtype)
    n_chunks = (bsz * seq) // PEER_CHUNK
    xs = h.reshape(n_chunks, PEER_CHUNK, d)
    es = experts.reshape(n_chunks, PEER_CHUNK, PEER_HEADS * PEER_TOPK)
    gs = g.reshape(n_chunks, PEER_CHUNK, PEER_HEADS * PEER_TOPK)

    def chunk(args):
        xc, ec, gcnk = args
        a = jnp.einsum('tkd,td->tk', u[ec], xc)
        a = jax.nn.gelu(a, approximate=False) * gcnk
        return jnp.einsum('tk,tkd->td', a, v[ec])

    out = lax.map(chunk, (xs, es, gs))
    return out.reshape(bsz, seq, d)


def setup_inputs(seed: int = 0) -> dict:
    key = jax.random.key(seed)
    ks = jax.random.split(key, 20)
    D = D_MODEL
    f32 = jnp.float32
    x = jax.random.normal(ks[0], (BATCH, SEQ, D), f32)
    c = jax.random.normal(ks[1], (BATCH, D), f32)
    offset = jax.random.randint(ks[2], (BATCH, 1), 0, 1024, dtype=jnp.int32)
    positions = offset + jnp.arange(SEQ, dtype=jnp.int32)[None, :]
    ada_w = jax.random.normal(ks[3], (DEPTH, D, 6 * D), f32) * (0.5 * D ** -0.5)
    ada_b = jax.random.normal(ks[4], (DEPTH, 6 * D), f32) * 0.02
    norm1_g = 1.0 + 0.05 * jax.random.normal(ks[5], (DEPTH, D), f32)
    w_in = jax.random.normal(ks[6], (DEPTH, D, IN_COLS), f32) * D ** -0.5
    conv_w = jax.random.normal(ks[7], (DEPTH, CONV_K, CONV_WIDTH), f32) * CONV_K ** -0.5
    lambda_q1 = jax.random.normal(ks[8], (DEPTH, ATTN_SUBDIM), f32) * 0.1
    lambda_k1 = jax.random.normal(ks[9], (DEPTH, ATTN_SUBDIM), f32) * 0.1
    lambda_q2 = jax.random.normal(ks[10], (DEPTH, ATTN_SUBDIM), f32) * 0.1
    lambda_k2 = jax.random.normal(ks[11], (DEPTH, ATTN_SUBDIM), f32) * 0.1
    subln_g = 1.0 + 0.05 * jax.random.normal(ks[12], (DEPTH, ATTN_VDIM), f32)
    w_out = jax.random.normal(ks[13], (DEPTH, MIX_WIDTH, D), f32) * MIX_WIDTH ** -0.5
    norm2_g = 1.0 + 0.05 * jax.random.normal(ks[14], (DEPTH, D), f32)
    peer_wq = jax.random.normal(ks[15], (DEPTH, D, PEER_HEADS * PEER_QDIM), f32) * D ** -0.5
    peer_keys = jax.random.normal(ks[16], (DEPTH, PEER_HEADS, 2, PEER_NKEYS, PEER_HALF), f32) * PEER_HALF ** -0.5
    peer_u = jax.random.normal(ks[17], (DEPTH, PEER_N, D), f32) * D ** -0.5
    peer_v = jax.random.normal(ks[18], (DEPTH, PEER_N, D), f32) * 0.5
    final_g = 1.0 + 0.05 * jax.random.normal(ks[19], (D,), f32)
    return {"x": x, "c": c, "positions": positions, "ada_w": ada_w, "ada_b": ada_b,
            "norm1_g": norm1_g, "w_in": w_in, "conv_w": conv_w,
            "lambda_q1": lambda_q1, "lambda_k1": lambda_k1, "lambda_q2": lambda_q2, "lambda_k2": lambda_k2,
            "subln_g": subln_g, "w_out": w_out, "norm2_g": norm2_g, "peer_wq": peer_wq,
            "peer_keys": peer_keys, "peer_u": peer_u, "peer_v": peer_v, "final_g": final_g}


def reference(x, c, positions, ada_w, ada_b, norm1_g, w_in, conv_w, lambda_q1, lambda_k1,
              lambda_q2, lambda_k2, subln_g, w_out, norm2_g, peer_wq, peer_keys, peer_u,
              peer_v, final_g):
    cos, sin = rotary_tables(positions, x.dtype)
    c_act = jax.nn.silu(c)
    for l in range(DEPTH):
        lam_init = 0.8 - 0.6 * math.exp(-0.3 * l)
        mod = c_act @ ada_w[l] + ada_b[l]
        sh1, sc1, g1, sh2, sc2, g2 = [m[:, None, :] for m in jnp.split(mod, 6, axis=-1)]
        h = rmsnorm(x, norm1_g[l]) * (1.0 + sc1) + sh1
        x = x + g1 * hybrid_mixer(h, w_in[l], conv_w[l], lambda_q1[l], lambda_k1[l],
                                  lambda_q2[l], lambda_k2[l], subln_g[l], w_out[l], cos, sin, lam_init)
        h = rmsnorm(x, norm2_g[l]) * (1.0 + sc2) + sh2
        x = x + g2 * peer_ffn(h, peer_wq[l], peer_keys[l], peer_u[l], peer_v[l])
    return rmsnorm(x, final_g)
```

```cpp
#include <hip/hip_runtime.h>
#include <cstdio>
#include <cstdint>

#define GAS __attribute__((address_space(1)))
#define LAS __attribute__((address_space(3)))
typedef unsigned short bf16_t;
typedef short bf16x8 __attribute__((ext_vector_type(8)));
typedef short s16x4 __attribute__((ext_vector_type(4)));
typedef float f32x2 __attribute__((ext_vector_type(2)));
typedef float f32x4 __attribute__((ext_vector_type(4)));
typedef float f32x16 __attribute__((ext_vector_type(16)));
typedef unsigned u32x2 __attribute__((ext_vector_type(2)));
typedef unsigned u32x4 __attribute__((ext_vector_type(4)));
typedef __bf16 bf16x2_t __attribute__((ext_vector_type(2)));

constexpr int DM = 2048, NBATCH = 8, SEQ = 4096, DEPTH = 4, MTOK = NBATCH * SEQ;
constexpr int CONVW = 1024, AHEADS = 8, ATTW = 1024, VDIM = 128, SUBD = 64;
constexpr int INC = 6144;
constexpr int PHEADS = 8, NKEYS = 128, NEXP = 16384, TOPK = 16;
constexpr int MODW = 6 * DM;
constexpr float NORM_EPS = 1e-6f;
constexpr int NWAVES = 8, NTHREADS = 512;

constexpr size_t MiB = 1u << 20;
constexpr size_t WS_CTL = 0, CTL_ZERO_BYTES = 1 * MiB;
constexpr size_t WS_MOD = 2 * MiB;
constexpr size_t WS_MODP = 4 * MiB;
constexpr size_t WS_ROPE = 16 * MiB;
constexpr size_t WS_LAM = 18 * MiB;
constexpr size_t WS_KEYS = 20 * MiB;
constexpr size_t WS_WIN = 32 * MiB;
constexpr size_t WS_WOUT = 128 * MiB;
constexpr size_t WS_WQ = 160 * MiB;
constexpr size_t WS_U = 192 * MiB;
constexpr size_t WS_V = 448 * MiB;
constexpr size_t WS_H = 704 * MiB;
constexpr size_t WS_SEG = 832 * MiB;
constexpr size_t SEG_ELEMS = (size_t)MTOK * 1024;
constexpr size_t WS_MIX = 1216 * MiB;
constexpr size_t WS_QP = 1344 * MiB;
constexpr size_t WS_ROUTE = 1472 * MiB;
constexpr size_t WS_DIAG = 1488 * MiB;
constexpr size_t WS_H2 = 1504 * MiB;
constexpr size_t WS_OT = 1632 * MiB;
constexpr size_t WS_END = 1760 * MiB;

constexpr int CW_BAR = 4096;
constexpr int CW_KMAX = 16384;

constexpr int LDS_BYTES = 147456;
constexpr int LDS_MISC = 131072;
namespace pg8 {
#define PG8_LAS __attribute__((address_space(3)))
typedef unsigned short bf16_t;
typedef short bf16x8 __attribute__((ext_vector_type(8)));
typedef float f32x4 __attribute__((ext_vector_type(4)));
typedef unsigned u32x4 __attribute__((ext_vector_type(4)));
constexpr int BM = 256, BK = 64, HALF = 128, HTB = HALF * BK * 2  , STAGE_BYTES = 8 * HTB, NXCD = 8, WGM = 8;

__host__ __device__ __forceinline__ int lds_byte(int r, int c) { const int st = (r >> 4) * 2 + (c >> 5), rr = r & 15, cc = c & 31, ob = rr * 64 + cc * 2; return st * 1024 + (ob ^ (((ob >> 9) & 1) << 5)); }
__host__ __device__ __forceinline__ void stage_rc(int b, int& R, int& C) { const int st = b / 1024, sb = b % 1024, swz = sb ^ (((sb >> 9) & 1) << 5); R = (st >> 1) * 16 + swz / 64; C = (st & 1) * 32 + (swz % 64) / 2; }
__host__ __device__ __forceinline__ int perm32(int rho) { const int n = rho >> 4, i = rho & 15; return 8 * (i >> 2) + 4 * n + (i & 3); }

struct Unit { int pm, pn; };
struct Gemm { const bf16_t* A; const bf16_t* Bt; int M, N, K; };

struct StaticOrder {
    int nM, nN, nwg, G, c;
    __host__ __device__ void init(int M, int N, int G_, int c_) { nM = M / BM; nN = N / BM; nwg = nM * nN; G = G_; c = c_; }
    __host__ __device__ bool next(int i, Unit& u) const {
        const long L = (long)i * G + c; if (L >= nwg) return false;
        int wgid = (int)L; { const int q = nwg / NXCD, r = nwg % NXCD, xcd = wgid % NXCD, off = wgid / NXCD; wgid = (xcd < r ? xcd * (q + 1) : r * (q + 1) + (xcd - r) * q) + off; }
        const int nig = WGM * nN, gid = wgid / nig, fm = gid * WGM, gsz = (nM - fm) < WGM ? (nM - fm) : WGM;
        u.pm = fm + ((wgid % nig) % gsz); u.pn = (wgid % nig) / gsz; return true;
    }
    __device__ __forceinline__ void a_ready(const Unit&) const {}
    __device__ __forceinline__ void done(const Unit&) const {}
};


__device__ __forceinline__ unsigned cvt_pk_bf16(float lo, float hi) { unsigned r; asm volatile("v_cvt_pk_bf16_f32 %0, %1, %2" : "=v"(r) : "v"(lo), "v"(hi)); return r; }

struct EpiBf16 {
    static constexpr bool PERM = true, AFTER_DRAIN = false;
    bf16_t* O; int ldc;
    __device__ __forceinline__ void operator()(const f32x4 (&acc)[2][2][4][2], const Unit& u, int wr, int wc, int fr, int fq) const {
        const int row0 = u.pm * BM + wr * 64 + fr, col0 = u.pn * BM + wc * 32 + 8 * fq;
#pragma unroll
        for (int ai = 0; ai < 2; ++ai)
#pragma unroll
            for (int m = 0; m < 4; ++m) { bf16_t* rowp = O + (size_t)(row0 + ai * HALF + m * 16) * ldc + col0;
#pragma unroll
                for (int bj = 0; bj < 2; ++bj) { const f32x4 v0 = acc[ai][bj][m][0], v1 = acc[ai][bj][m][1];
                    u32x4 w; w.x = cvt_pk_bf16(v0[0], v0[1]); w.y = cvt_pk_bf16(v0[2], v0[3]); w.z = cvt_pk_bf16(v1[0], v1[1]); w.w = cvt_pk_bf16(v1[2], v1[3]);
                    *(u32x4*)(rowp + bj * HALF) = w; } }
    }
};

struct EpiIn {
    static constexpr bool PERM = true, AFTER_DRAIN = false;
    bf16_t* seg0; size_t sege; const float* rope; unsigned* kmax;
    __device__ __forceinline__ void operator()(const f32x4 (&acc)[2][2][4][2], const Unit& u, int wr, int wc, int fr, int fq) const {
        const int t = u.pn >> 2, colt = (u.pn & 3) * BM;
        const int row0 = u.pm * BM + wr * 64 + fr, col0 = colt + wc * 32 + 8 * fq;
        bf16_t* base = seg0 + (size_t)t * sege;
        const bool isqk = (t == 3) || (t == 4);
        const bool ropew = isqk && ((wc & 1) == 0);
        const bool isk = (t == 4);
        float mx[2] = {0.f, 0.f};
#pragma unroll
        for (int ai = 0; ai < 2; ++ai)
#pragma unroll
            for (int m = 0; m < 4; ++m) { const int row = row0 + ai * HALF + m * 16; bf16_t* rowp = base + (size_t)row * 1024 + col0;
                f32x4 cs0 = {1.f, 1.f, 1.f, 1.f}, cs1 = cs0, sn0 = {0.f, 0.f, 0.f, 0.f}, sn1 = sn0;
                if (ropew && fq < 2) { const f32x4* rp = (const f32x4*)(rope + (size_t)row * 16); cs0 = rp[0]; cs1 = rp[1]; sn0 = rp[2]; sn1 = rp[3];
                    if (fq == 0) { sn0 = -sn0; sn1 = -sn1; } }
#pragma unroll
                for (int bj = 0; bj < 2; ++bj) { f32x4 v0 = acc[ai][bj][m][0], v1 = acc[ai][bj][m][1];
                    if (ropew) {
                        f32x4 p0, p1;
#pragma unroll
                        for (int i = 0; i < 4; ++i) { p0[i] = __shfl_xor(v0[i], 16); p1[i] = __shfl_xor(v1[i], 16); }
                        v0 = v0 * cs0 + p0 * sn0; v1 = v1 * cs1 + p1 * sn1;
                    }
                    u32x4 w; w.x = cvt_pk_bf16(v0[0], v0[1]); w.y = cvt_pk_bf16(v0[2], v0[3]); w.z = cvt_pk_bf16(v1[0], v1[1]); w.w = cvt_pk_bf16(v1[2], v1[3]);
                    *(u32x4*)(rowp + bj * HALF) = w;
                    if (isk) { float ss = (v0[0] * v0[0] + v0[1] * v0[1]) + (v0[2] * v0[2] + v0[3] * v0[3]) + (v1[0] * v1[0] + v1[1] * v1[1]) + (v1[2] * v1[2] + v1[3] * v1[3]);
                        ss += __shfl_xor(ss, 16); ss += __shfl_xor(ss, 32); mx[bj] = fmaxf(mx[bj], ss); } } }
        if (isk) {
#pragma unroll
            for (int bj = 0; bj < 2; ++bj) { float v = mx[bj];
                v = fmaxf(v, __shfl_xor(v, 1)); v = fmaxf(v, __shfl_xor(v, 2)); v = fmaxf(v, __shfl_xor(v, 4)); v = fmaxf(v, __shfl_xor(v, 8));
                if ((threadIdx.x & 63) == 0) { const int b = u.pm >> 4, head = (u.pn & 3) * 2 + bj, c = wc >> 1, half = wc & 1;
                    atomicMax(kmax + (((b * 8 + head) * 2 + c) * 2 + half), __float_as_uint(v)); } }
        }
    }
};

struct EpiRes {
    static constexpr bool PERM = true, AFTER_DRAIN = false;
    const float* xin; float* xout; const float* gate;
    __device__ __forceinline__ void operator()(const f32x4 (&acc)[2][2][4][2], const Unit& u, int wr, int wc, int fr, int fq) const {
        const int row0 = u.pm * BM + wr * 64 + fr, col0 = u.pn * BM + wc * 32 + 8 * fq, b = u.pm >> 4;
        f32x4 g[2][2];
#pragma unroll
        for (int bj = 0; bj < 2; ++bj)
#pragma unroll
            for (int n = 0; n < 2; ++n) g[bj][n] = *(const f32x4*)(gate + (size_t)b * 12288 + col0 + bj * HALF + 4 * n);
#pragma unroll
        for (int ai = 0; ai < 2; ++ai)
#pragma unroll
            for (int m = 0; m < 4; ++m) { const size_t off = (size_t)(row0 + ai * HALF + m * 16) * 2048 + col0;
#pragma unroll
                for (int bj = 0; bj < 2; ++bj)
#pragma unroll
                    for (int n = 0; n < 2; ++n) { const f32x4 x = *(const f32x4*)(xin + off + bj * HALF + 4 * n);
                        *(f32x4*)(xout + off + bj * HALF + 4 * n) = x + g[bj][n] * acc[ai][bj][m][n]; } }
    }
};

template <class Epi, class Sched, bool ALIGN_EPI = false, bool SP2 = false>
__device__ __forceinline__ void gemm_phase(PG8_LAS unsigned char* lds, const Gemm g, const Sched& S, const Epi& E) {
    int tid_ = threadIdx.x; asm volatile("" : "+v"(tid_));
    const int tid = tid_, wid = __builtin_amdgcn_readfirstlane(tid >> 6), lane = tid & 63, wr = wid >> 2, wc = wid & 3, fr = lane & 15, fq = lane >> 4;
    const int K = g.K, nt = K / BK;
    unsigned voffA[2], voffB[2];
#pragma unroll
    for (int i = 0; i < 2; ++i) { int R, C; stage_rc(tid * 16 + i * 8192, R, C); const int Rb = Epi::PERM ? ((R & ~31) + perm32(R & 31)) : R;
        voffA[i] = (unsigned)(R * K + C) * 2u; voffB[i] = (unsigned)(Rb * K + C) * 2u; }
    const size_t kstep = (size_t)(BK * 2);
    const size_t hstep = (size_t)HALF * K * 2;
    const size_t tstep = 2 * hstep;
    const unsigned ldsw = (unsigned)wid * 1024u;
    const int aoff = lds_byte(wr * 64 + fr, fq * 8), boff = lds_byte(wc * 32 + fr, fq * 8);
#define PG8_SA(b, h) (((b) * 2 + (h)) * HTB)
#define PG8_SB(b, h) ((4 + (b) * 2 + (h)) * HTB)
#define PG8_STAGE(bufoff, gbase, voff) do { _Pragma("unroll") for (int _i = 0; _i < 2; ++_i) \
        __builtin_amdgcn_global_load_lds((const unsigned*)((const char*)(gbase) + (voff)[_i]), (PG8_LAS unsigned*)(lds + (bufoff) + ldsw + _i * 8192), 16, 0, 0); } while (0)
#define PG8_LDA(dst, b, h) do { _Pragma("unroll") for (int m = 0; m < 4; ++m) _Pragma("unroll") for (int k = 0; k < 2; ++k) dst[m][k] = *(const PG8_LAS bf16x8*)(lds + PG8_SA(b, h) + aoff + m * 2048 + k * 1024); } while (0)
#define PG8_LDB(dst, b, h) do { _Pragma("unroll") for (int n = 0; n < 2; ++n) _Pragma("unroll") for (int k = 0; k < 2; ++k) dst[n][k] = *(const PG8_LAS bf16x8*)(lds + PG8_SB(b, h) + boff + n * 2048 + k * 1024); } while (0)
#define PG8_MMA(ai, bj, At, Bt) do { __builtin_amdgcn_s_setprio(1); _Pragma("unroll") for (int m = 0; m < 4; ++m) _Pragma("unroll") for (int n = 0; n < 2; ++n) _Pragma("unroll") for (int k = 0; k < 2; ++k) \
        acc[ai][bj][m][n] = __builtin_amdgcn_mfma_f32_16x16x32_bf16(Bt[n][k], At[m][k], acc[ai][bj][m][n], 0, 0, 0); __builtin_amdgcn_s_setprio(0); } while (0)
#define PG8_WAIT_V(n) asm volatile("s_waitcnt vmcnt(" #n ")" ::: "memory")
#define PG8_WAIT_L(n) asm volatile("s_waitcnt lgkmcnt(" #n ")" ::: "memory")
#define PG8_BAR __builtin_amdgcn_s_barrier()
#define PG8_SCHED __builtin_amdgcn_sched_barrier(0)
    Unit cur, nxt; int ui = 0;
    if (!S.next(0, cur)) return;
    f32x4 acc[2][2][4][2];
#pragma unroll
    for (int a = 0; a < 2; ++a)
#pragma unroll
        for (int b = 0; b < 2; ++b)
#pragma unroll
            for (int m = 0; m < 4; ++m)
#pragma unroll
                for (int n = 0; n < 2; ++n) acc[a][b][m][n] = (f32x4){0.f, 0.f, 0.f, 0.f};
    bf16x8 At[4][2], B0[2][2], B1[2][2];
    const char* cA = (const char*)g.A + (size_t)cur.pm * tstep; const char* cB = (const char*)g.Bt + (size_t)cur.pn * tstep;
    S.a_ready(cur);
    if constexpr (SP2) {
        PG8_STAGE(PG8_SB(0, 0), cB, voffB); PG8_STAGE(PG8_SB(0, 1), cB + hstep, voffB); PG8_STAGE(PG8_SA(0, 0), cA, voffA); PG8_STAGE(PG8_SA(0, 1), cA + hstep, voffA);
        if (wr == 1) PG8_BAR;
        PG8_WAIT_V(2); PG8_BAR;
        PG8_STAGE(PG8_SB(1, 0), cB + kstep, voffB); PG8_STAGE(PG8_SA(1, 0), cA + kstep, voffA); PG8_STAGE(PG8_SB(1, 1), cB + hstep + kstep, voffB);
        PG8_WAIT_V(6); PG8_BAR;
    } else {
        PG8_STAGE(PG8_SB(0, 0), cB, voffB); PG8_STAGE(PG8_SA(0, 0), cA, voffA); PG8_STAGE(PG8_SB(0, 1), cB + hstep, voffB); PG8_STAGE(PG8_SA(0, 1), cA + hstep, voffA);
        if (wr == 1) PG8_BAR;
        PG8_WAIT_V(4); PG8_BAR;
        PG8_STAGE(PG8_SB(1, 0), cB + kstep, voffB); PG8_STAGE(PG8_SA(1, 0), cA + kstep, voffA); PG8_STAGE(PG8_SB(1, 1), cB + hstep + kstep, voffB);
        PG8_WAIT_V(6); PG8_BAR;
    }
    for (;;) {
        const bool has_next = S.next(ui + 1, nxt);
        const char* nA = has_next ? (const char*)g.A + (size_t)nxt.pm * tstep : cA; const char* nB = has_next ? (const char*)g.Bt + (size_t)nxt.pn * tstep : cB;
        for (int t = 0; t < nt; t += 2) {
            const bool last = (t == nt - 2);
            const char* a1 = cA + (size_t)(t + 1) * kstep;
            const char* a2 = last ? nA : cA + (size_t)(t + 2) * kstep; const char* b2 = last ? nB : cB + (size_t)(t + 2) * kstep;
            const char* a3 = a2 + kstep; const char* b3 = b2 + kstep;
            if (last && has_next) S.a_ready(nxt);
            if constexpr (SP2) {
            PG8_LDB(B0, 0, 0); PG8_LDB(B1, 0, 1); PG8_SCHED; PG8_LDA(At, 0, 0); PG8_STAGE(PG8_SA(1, 1), a1 + hstep, voffA);
            PG8_WAIT_V(8); PG8_WAIT_L(0); PG8_BAR; PG8_MMA(0, 0, At, B0); PG8_MMA(0, 1, At, B1); PG8_BAR; PG8_SCHED;
            PG8_LDA(At, 0, 1); PG8_STAGE(PG8_SB(0, 0), b2, voffB); PG8_STAGE(PG8_SB(0, 1), b2 + hstep, voffB); PG8_STAGE(PG8_SA(0, 0), a2, voffA);
            PG8_WAIT_V(8); PG8_WAIT_L(0); PG8_BAR; PG8_MMA(1, 0, At, B0); PG8_MMA(1, 1, At, B1); PG8_BAR; PG8_SCHED;
            PG8_LDB(B0, 1, 0); PG8_LDB(B1, 1, 1); PG8_SCHED; PG8_LDA(At, 1, 0); PG8_STAGE(PG8_SA(0, 1), a2 + hstep, voffA);
            PG8_WAIT_V(8); PG8_WAIT_L(0); PG8_BAR; PG8_MMA(0, 0, At, B0); PG8_MMA(0, 1, At, B1); PG8_BAR; PG8_SCHED;
            PG8_LDA(At, 1, 1); PG8_STAGE(PG8_SB(1, 0), b3, voffB); PG8_STAGE(PG8_SB(1, 1), b3 + hstep, voffB); PG8_STAGE(PG8_SA(1, 0), a3, voffA);
            PG8_WAIT_V(8); PG8_WAIT_L(0); PG8_BAR; PG8_MMA(1, 0, At, B0); PG8_MMA(1, 1, At, B1); PG8_BAR; PG8_SCHED;
            } else {
            PG8_LDB(B0, 0, 0); PG8_SCHED; PG8_LDA(At, 0, 0); PG8_STAGE(PG8_SA(1, 1), a1 + hstep, voffA);
            PG8_WAIT_L(8); PG8_BAR; PG8_WAIT_L(0); PG8_MMA(0, 0, At, B0); PG8_BAR; PG8_SCHED;
            PG8_LDB(B1, 0, 1); PG8_STAGE(PG8_SB(0, 0), b2, voffB);
            PG8_BAR; PG8_WAIT_L(0); PG8_MMA(0, 1, At, B1); PG8_BAR;
            PG8_LDA(At, 0, 1); PG8_STAGE(PG8_SA(0, 0), a2, voffA);
            PG8_BAR; PG8_WAIT_L(0); PG8_MMA(1, 0, At, B0); PG8_BAR; PG8_SCHED;
            PG8_STAGE(PG8_SB(0, 1), b2 + hstep, voffB);
            PG8_WAIT_V(6); PG8_BAR; PG8_MMA(1, 1, At, B1); PG8_BAR;
            PG8_LDB(B0, 1, 0); PG8_SCHED; PG8_LDA(At, 1, 0); PG8_STAGE(PG8_SA(0, 1), a2 + hstep, voffA);
            PG8_WAIT_L(8); PG8_BAR; PG8_WAIT_L(0); PG8_MMA(0, 0, At, B0); PG8_BAR; PG8_SCHED;
            PG8_LDB(B1, 1, 1); PG8_STAGE(PG8_SB(1, 0), b3, voffB);
            PG8_BAR; PG8_WAIT_L(0); PG8_MMA(0, 1, At, B1); PG8_BAR;
            PG8_LDA(At, 1, 1); PG8_STAGE(PG8_SA(1, 0), a3, voffA);
            PG8_BAR; PG8_WAIT_L(0); PG8_MMA(1, 0, At, B0); PG8_BAR; PG8_SCHED;
            PG8_STAGE(PG8_SB(1, 1), b3 + hstep, voffB);
            PG8_WAIT_V(6); PG8_BAR; PG8_MMA(1, 1, At, B1); PG8_BAR;
            }
        }
        if constexpr (ALIGN_EPI) { if (wr == 0) PG8_BAR; }
        if constexpr (!Epi::AFTER_DRAIN) { E(acc, cur, wr, wc, fr, fq); S.done(cur); }
        if (!has_next) break;
#pragma unroll
        for (int a = 0; a < 2; ++a)
#pragma unroll
            for (int b = 0; b < 2; ++b)
#pragma unroll
                for (int m = 0; m < 4; ++m)
#pragma unroll
                    for (int n = 0; n < 2; ++n) acc[a][b][m][n] = (f32x4){0.f, 0.f, 0.f, 0.f};
        cur = nxt; cA = nA; cB = nB; ++ui;
        if constexpr (ALIGN_EPI) { if (wr == 1) PG8_BAR; }
    }
    PG8_WAIT_V(0);
    if constexpr (!ALIGN_EPI) { if (wr == 0) PG8_BAR; }
    PG8_BAR;
    if constexpr (Epi::AFTER_DRAIN) { E.fused(acc, cur, wr, wc, fr, fq, lds, wid, lane); S.done(cur); }
#undef PG8_SA
#undef PG8_SB
#undef PG8_STAGE
#undef PG8_LDA
#undef PG8_LDB
#undef PG8_MMA
#undef PG8_WAIT_V
#undef PG8_WAIT_L
#undef PG8_BAR
#undef PG8_SCHED
}
}

#define XB_TMO      128
#define XB_XCNT(j)  (256  + 64 * (j))
#define XB_XSUB(j)  (1280 + 64 * (j))
#define XB_XGEN(j)  (2304 + 64 * (j))
#define XB_TOP      3328
#define XB_TOPGEN   3392
#define XCD_BAR_WORDS 3456
#define XB_SPIN_CAP (1u << 18)

__device__ __forceinline__ unsigned xb_ld(unsigned* p)              { return __hip_atomic_load(p, __ATOMIC_RELAXED, __HIP_MEMORY_SCOPE_AGENT); }
__device__ __forceinline__ unsigned xb_add(unsigned* p, unsigned v) { return __hip_atomic_fetch_add(p, v, __ATOMIC_RELAXED, __HIP_MEMORY_SCOPE_AGENT); }
__device__ __forceinline__ unsigned xb_xcc_id() { return (unsigned)__builtin_amdgcn_s_getreg((3 << 11) | 20) & 0xFu; }
#define XB_SPIN(cond, bar) do { unsigned _sp = 0; while (cond) { __builtin_amdgcn_s_sleep(1); \
    if ((++_sp & 255u) == 0u) { if (xb_ld(&(bar)[XB_TMO])) break; if (_sp > XB_SPIN_CAP) { atomicAdd(&(bar)[XB_TMO], 1u); break; } } } } while (0)

struct XcdBarrier {
    unsigned* bar; unsigned x;
    volatile LAS unsigned* st;
};

__device__ __forceinline__ XcdBarrier xcd_barrier_post(unsigned* bar, volatile LAS unsigned* st) {
    XcdBarrier b; b.bar = bar; b.x = xb_xcc_id(); b.st = st;
    if (threadIdx.x == 0) (void)xb_add(&bar[XB_XCNT(b.x)], 1u);
    return b;
}
__device__ __forceinline__ void xcd_barrier_complete(unsigned* bar, unsigned x, unsigned& nloc, unsigned& nx) {
    const unsigned G = gridDim.x * gridDim.y * gridDim.z;
    unsigned sum, cnt, mine, sp = 0u;
    for (;;) {
        sum = 0u; cnt = 0u; mine = 0u;
#pragma unroll
        for (unsigned j = 0; j < 16; ++j) { const unsigned c = xb_ld(&bar[XB_XCNT(j)]); sum += c; cnt += (c > 0u) ? 1u : 0u; mine = (j == x) ? c : mine; }
        if (sum == G) break;
        __builtin_amdgcn_s_sleep(1);
        if ((++sp & 255u) == 0u) { if (xb_ld(&bar[XB_TMO])) break; if (sp > XB_SPIN_CAP) { atomicAdd(&bar[XB_TMO], 1u); break; } }
    }
    nloc = mine > 0u ? mine : 1u; nx = cnt > 0u ? cnt : 1u;
}

__device__ __forceinline__ void xcd_barrier(const XcdBarrier& b) {
    asm volatile("s_waitcnt vmcnt(0)" ::: "memory");
    __syncthreads();
    if (threadIdx.x == 0) {
        unsigned* bar = b.bar;
        __builtin_amdgcn_s_waitcnt(0);
        unsigned nloc = b.st[0], nx = b.st[1];
        if (nloc == 0u) { xcd_barrier_complete(bar, b.x, nloc, nx); b.st[0] = nloc; b.st[1] = nx; }
        const unsigned old = xb_add(&bar[XB_XSUB(b.x)], 1u);
        const unsigned gen = old / nloc;
        if (old + 1u == (gen + 1u) * nloc) {
            __builtin_amdgcn_fence(__ATOMIC_RELEASE, "agent");
            asm volatile("s_waitcnt vmcnt(0)" ::: "memory");
            const unsigned og = xb_add(&bar[XB_TOP], 1u);
            const unsigned tg = og / nx;
            if (og + 1u == (tg + 1u) * nx) xb_add(&bar[XB_TOPGEN], 1u);
            else XB_SPIN(xb_ld(&bar[XB_TOPGEN]) == tg, bar);
            __builtin_amdgcn_fence(__ATOMIC_ACQUIRE, "agent");
            xb_add(&bar[XB_XGEN(b.x)], 1u);
            asm volatile("s_waitcnt vmcnt(0)" ::: "memory");
        } else {
            XB_SPIN(xb_ld(&bar[XB_XGEN(b.x)]) == gen, bar);
            __builtin_amdgcn_fence(__ATOMIC_ACQUIRE, "agent");
            asm volatile("s_waitcnt vmcnt(0)" ::: "memory");
        }
    }
    __syncthreads();
}

#define LDS_WAIT() asm volatile("s_waitcnt lgkmcnt(0)" ::: "memory")
#define VM_WAIT() asm volatile("s_waitcnt vmcnt(0)" ::: "memory")
__device__ __forceinline__ unsigned f2bf(float f) { unsigned u = __builtin_bit_cast(unsigned, f); return (u + 0x7fffu + ((u >> 16) & 1u)) >> 16; }
__device__ __forceinline__ unsigned pk2(float lo, float hi) { return f2bf(lo) | (f2bf(hi) << 16); }
__device__ __forceinline__ float bf_lo(unsigned w) { return __builtin_bit_cast(float, w << 16); }
__device__ __forceinline__ float bf_hi(unsigned w) { return __builtin_bit_cast(float, w & 0xffff0000u); }
__device__ __forceinline__ float wave_sum(float v) {
#pragma unroll
    for (int o = 1; o < 64; o <<= 1) v += __shfl_xor(v, o);
    return v;
}

struct Ctx {
    LAS unsigned char* lds;
    unsigned char* ws;
    int tid, lane, wave, vcu, G, gw, NGW;
    float* out;
};

__device__ __forceinline__ void p0_transpose_item(const float* W, int K, int N, bf16_t* WT, LAS float* scr, int item, int lane) {
    const int nblk = N / 32, kb = item / nblk, nb = item % nblk, k0 = 64 * kb, n0 = 32 * nb;
#pragma unroll 8
    for (int i = 0; i < 32; ++i) { const int kk = 2 * i + (lane >> 5); scr[kk * 33 + (lane & 31)] = W[(size_t)(k0 + kk) * N + n0 + (lane & 31)]; }
    LDS_WAIT(); asm volatile("" ::: "memory");
    const int c = lane & 7;
#pragma unroll
    for (int j = 0; j < 4; ++j) { const int n = (lane >> 3) + 8 * j; const LAS float* s = scr + (8 * c) * 33 + n;
        u32x4 o; o.x = pk2(s[0 * 33], s[1 * 33]); o.y = pk2(s[2 * 33], s[3 * 33]); o.z = pk2(s[4 * 33], s[5 * 33]); o.w = pk2(s[6 * 33], s[7 * 33]);
        *(u32x4*)(WT + (size_t)(n0 + n) * K + k0 + 8 * c) = o; }
    LDS_WAIT(); asm volatile("" ::: "memory");
}
__device__ __forceinline__ void p0_cvt_row(const float* src, bf16_t* dst, int lane) {
#pragma unroll
    for (int j = 0; j < 4; ++j) { const f32x4 a = *(const f32x4*)(src + 512 * j + 8 * lane), b = *(const f32x4*)(src + 512 * j + 8 * lane + 4);
        u32x4 o; o.x = pk2(a[0], a[1]); o.y = pk2(a[2], a[3]); o.z = pk2(b[0], b[1]); o.w = pk2(b[2], b[3]);
        *(u32x4*)(dst + 512 * j + 8 * lane) = o; }
}
__device__ __forceinline__ void p0_adaln_task(const float* c, const float* ada_w, float* modp, LAS float* scr, int task, int lane) {
    const int ks = task & 7, cg = (task >> 3) % 48, l = task / 384;
#pragma unroll
    for (int i = 0; i < 32; ++i) { const int e = i * 64 + lane, k = e >> 3, b = e & 7; const float x = c[b * DM + ks * 256 + k];
        scr[e] = x / (1.f + expf(-x)); }
    LDS_WAIT(); asm volatile("" ::: "memory");
    const float* wp = ada_w + ((size_t)l * DM + ks * 256) * MODW + cg * 256 + lane * 4;
    f32x4 acc[8];
#pragma unroll
    for (int b = 0; b < 8; ++b) acc[b] = (f32x4){0.f, 0.f, 0.f, 0.f};
#pragma unroll 4
    for (int k = 0; k < 256; ++k) { const f32x4 w = *(const f32x4*)(wp + (size_t)k * MODW);
        const f32x4 s0 = *(const LAS f32x4*)(scr + k * 8), s1 = *(const LAS f32x4*)(scr + k * 8 + 4);
        acc[0] += w * s0[0]; acc[1] += w * s0[1]; acc[2] += w * s0[2]; acc[3] += w * s0[3];
        acc[4] += w * s1[0]; acc[5] += w * s1[1]; acc[6] += w * s1[2]; acc[7] += w * s1[3]; }
#pragma unroll
    for (int b = 0; b < 8; ++b) *(f32x4*)(modp + (((size_t)ks * DEPTH + l) * NBATCH + b) * MODW + cg * 256 + lane * 4) = acc[b];
    LDS_WAIT(); asm volatile("" ::: "memory");
}
struct Args;
template <class A> __device__ __forceinline__ void p0_prologue(Ctx& C, const A& args) {
    LAS float* scr = (LAS float*)(C.lds + C.wave * 16384);
    const float* w_in = args.in[6]; const float* w_out = args.in[13]; const float* wq = args.in[15];
    bf16_t* WIN = (bf16_t*)(C.ws + WS_WIN); bf16_t* WOUT = (bf16_t*)(C.ws + WS_WOUT); bf16_t* WQ = (bf16_t*)(C.ws + WS_WQ);
    constexpr int T_ADA = 4 * 48 * 8;
    constexpr int I_IN = (DM / 64) * (INC / 32), I_SQ = (DM / 64) * (DM / 32);
    constexpr int T_IN = 4 * I_IN, T_OUT = 4 * I_SQ, T_WQ = 4 * I_SQ;
    constexpr int T_KEYS = 4 * 16 * 128 * 128 / 2048;
    constexpr int T_UV = 4 * NEXP;
    constexpr int T_ROPE = MTOK / 64;
    constexpr int NT = T_ADA + T_IN + T_OUT + T_WQ + T_KEYS + 2 * T_UV + T_ROPE + 1;
    for (int it = C.gw; it < NT; it += C.NGW) {
        int r = it;
        if (r < T_ADA) { p0_adaln_task(args.in[1], args.in[3], (float*)(C.ws + WS_MODP), scr, r, C.lane); continue; } r -= T_ADA;
        if (r < T_IN) { const int l = r / I_IN; p0_transpose_item(w_in + (size_t)l * DM * INC, DM, INC, WIN + (size_t)l * INC * DM, scr, r % I_IN, C.lane); continue; } r -= T_IN;
        if (r < T_OUT) { const int l = r / I_SQ; p0_transpose_item(w_out + (size_t)l * DM * DM, DM, DM, WOUT + (size_t)l * DM * DM, scr, r % I_SQ, C.lane); continue; } r -= T_OUT;
        if (r < T_WQ) { const int l = r / I_SQ; p0_transpose_item(wq + (size_t)l * DM * DM, DM, DM, WQ + (size_t)l * DM * DM, scr, r % I_SQ, C.lane); continue; } r -= T_WQ;
        if (r < T_KEYS) { p0_cvt_row(args.in[16] + (size_t)r * 2048, (bf16_t*)(C.ws + WS_KEYS) + (size_t)r * 2048, C.lane); continue; } r -= T_KEYS;
        if (r < T_UV) { p0_cvt_row(args.in[17] + (size_t)r * 2048, (bf16_t*)(C.ws + WS_U) + (size_t)r * 2048, C.lane); continue; } r -= T_UV;
        if (r < T_UV) { p0_cvt_row(args.in[18] + (size_t)r * 2048, (bf16_t*)(C.ws + WS_V) + (size_t)r * 2048, C.lane); continue; } r -= T_UV;
        if (r < T_ROPE) {
            const int row = r * 64 + C.lane; const float pos = (float)((const int*)args.in[2])[row]; float* o = (float*)(C.ws + WS_ROPE) + (size_t)row * 16;
#pragma unroll
            for (int j = 0; j < 8; ++j) { const float invf = exp2f(-(float)j * 0.125f * 18.931568569324174f);
                const float ang = pos * invf; double rev = (double)ang * 0.15915494309189535; rev -= __builtin_rint(rev);
                const float rf = (float)rev; o[j] = __builtin_amdgcn_cosf(rf); o[8 + j] = __builtin_amdgcn_sinf(rf); }
            continue; } r -= T_ROPE;
        {
            float* lam = (float*)(C.ws + WS_LAM);
            for (int l = 0; l < DEPTH; ++l) {
                const float a = wave_sum(args.in[8][l * 64 + C.lane] * args.in[9][l * 64 + C.lane]), b = wave_sum(args.in[10][l * 64 + C.lane] * args.in[11][l * 64 + C.lane]);
                const float li = 0.8f - 0.6f * expf(-0.3f * (float)l);
                if (C.lane == 0) { lam[l] = expf(a) - expf(b) + li; lam[4 + l] = 1.f - li; } }
        }
    }
}
__device__ __forceinline__ void p1_modfinal(Ctx& C, const float* ada_b) {
    const float* modp = (const float*)(C.ws + WS_MODP); float* mod = (float*)(C.ws + WS_MOD);
    constexpr int N4 = DEPTH * NBATCH * MODW / 4;
    for (int i = C.vcu * NTHREADS + C.tid; i < N4; i += C.G * NTHREADS) { const int l = i / (NBATCH * MODW / 4), n4 = i % (MODW / 4);
        f32x4 s = *(const f32x4*)(ada_b + (size_t)l * MODW + n4 * 4);
#pragma unroll
        for (int ks = 0; ks < 8; ++ks) s += *(const f32x4*)(modp + (size_t)ks * DEPTH * NBATCH * MODW + (size_t)i * 4);
        *(f32x4*)(mod + (size_t)i * 4) = s; }
}

__device__ __forceinline__ void norm_pass(Ctx& C, const float* x, bf16_t* H, const float* g, const float* sh, const float* sc) {
    for (int row = C.gw; row < MTOK; row += C.NGW) { const int b = row >> 12; const float* xr = x + (size_t)row * DM + 8 * C.lane;
        f32x4 v[8]; float ss = 0.f;
#pragma unroll
        for (int j = 0; j < 4; ++j) { v[2 * j] = *(const f32x4*)(xr + 512 * j); v[2 * j + 1] = *(const f32x4*)(xr + 512 * j + 4);
            const f32x4 a = v[2 * j], c = v[2 * j + 1]; ss += (a[0] * a[0] + a[1] * a[1]) + (a[2] * a[2] + a[3] * a[3]) + (c[0] * c[0] + c[1] * c[1]) + (c[2] * c[2] + c[3] * c[3]); }
        const float rstd = 1.0f / sqrtf(wave_sum(ss) * (1.f / DM) + NORM_EPS);
        const float* gp = g + 8 * C.lane; const float* shp = sh + (size_t)b * MODW + 8 * C.lane; const float* scp = sc + (size_t)b * MODW + 8 * C.lane;
#pragma unroll
        for (int j = 0; j < 4; ++j) { f32x4 o[2];
#pragma unroll
            for (int q = 0; q < 2; ++q) { const f32x4 gg = *(const f32x4*)(gp + 512 * j + 4 * q), s1 = *(const f32x4*)(scp + 512 * j + 4 * q), s0 = *(const f32x4*)(shp + 512 * j + 4 * q);
                o[q] = (v[2 * j + q] * rstd) * gg * (s1 + 1.0f) + s0; }
            u32x4 w; w.x = pk2(o[0][0], o[0][1]); w.y = pk2(o[0][2], o[0][3]); w.z = pk2(o[1][0], o[1][1]); w.w = pk2(o[1][2], o[1][3]);
            *(u32x4*)(H + (size_t)row * DM + 512 * j + 8 * C.lane) = w; }
    }
}
__device__ __forceinline__ void final_norm_pass(Ctx& C, const float* x, float* out, const float* g) {
    for (int row = C.gw; row < MTOK; row += C.NGW) { const float* xr = x + (size_t)row * DM + 8 * C.lane;
        f32x4 v[8]; float ss = 0.f;
#pragma unroll
        for (int j = 0; j < 4; ++j) { v[2 * j] = *(const f32x4*)(xr + 512 * j); v[2 * j + 1] = *(const f32x4*)(xr + 512 * j + 4);
            const f32x4 a = v[2 * j], c = v[2 * j + 1]; ss += (a[0] * a[0] + a[1] * a[1]) + (a[2] * a[2] + a[3] * a[3]) + (c[0] * c[0] + c[1] * c[1]) + (c[2] * c[2] + c[3] * c[3]); }
        const float rstd = 1.0f / sqrtf(wave_sum(ss) * (1.f / DM) + NORM_EPS);
#pragma unroll
        for (int j = 0; j < 4; ++j)
#pragma unroll
            for (int q = 0; q < 2; ++q) { const f32x4 gg = *(const f32x4*)(g + 8 * C.lane + 512 * j + 4 * q);
                *(f32x4*)(out + (size_t)row * DM + 8 * C.lane + 512 * j + 4 * q) = (v[2 * j + q] * rstd) * gg; }
    }
}

__device__ __forceinline__ void conv_chunk(const bf16_t* GBp, const bf16_t* GCp, const bf16_t* HVp, const float* cw, bf16_t* MIXp, int chunk, int tid) {
    const int c0 = (tid & 127) * 8, r0 = chunk * 128 + (tid >> 7) * 32;
    float w0[8], w1[8], w2[8];
#pragma unroll
    for (int i = 0; i < 8; ++i) { w0[i] = cw[c0 + i]; w1[i] = cw[1024 + c0 + i]; w2[i] = cw[2048 + c0 + i]; }
    float zp[8], zc[8], zn[8];
    auto loadz = [&](int row, float (&z)[8]) {
        const bool ok = ((row >> 12) == (r0 >> 12)) && row >= 0 && row < MTOK;
        if (ok) { const u32x4 a = *(const u32x4*)(GCp + (size_t)row * 1024 + c0), h = *(const u32x4*)(HVp + (size_t)row * 1024 + c0);
#pragma unroll
            for (int i = 0; i < 4; ++i) { z[2 * i] = bf_lo(a[i]) * bf_lo(h[i]); z[2 * i + 1] = bf_hi(a[i]) * bf_hi(h[i]); } }
        else {
#pragma unroll
            for (int i = 0; i < 8; ++i) z[i] = 0.f; }
    };
    loadz(r0 - 1, zp); loadz(r0, zc);
    for (int r = r0; r < r0 + 32; ++r) {
        loadz(r + 1, zn);
        const u32x4 gbv = *(const u32x4*)(GBp + (size_t)r * 1024 + c0);
        float y[8];
#pragma unroll
        for (int i = 0; i < 4; ++i) { y[2 * i] = bf_lo(gbv[i]) * (w0[2 * i] * zp[2 * i] + w1[2 * i] * zc[2 * i] + w2[2 * i] * zn[2 * i]);
            y[2 * i + 1] = bf_hi(gbv[i]) * (w0[2 * i + 1] * zp[2 * i + 1] + w1[2 * i + 1] * zc[2 * i + 1] + w2[2 * i + 1] * zn[2 * i + 1]); }
        u32x4 o; o.x = pk2(y[0], y[1]); o.y = pk2(y[2], y[3]); o.z = pk2(y[4], y[5]); o.w = pk2(y[6], y[7]);
        *(u32x4*)(MIXp + (size_t)r * 2048 + c0) = o;
#pragma unroll
        for (int i = 0; i < 8; ++i) { zp[i] = zc[i]; zc[i] = zn[i]; }
    }
}

namespace att {
constexpr int NSLOT = 3, KSLOT = 8192, VSLOT = 16384;
constexpr int L_K = 0, L_V = NSLOT * KSLOT, L_WS = L_V + NSLOT * VSLOT, L_END = L_WS + NWAVES * 256;
constexpr float C2 = 0.125f * 1.4426950408889634f;
#define SBAR() __builtin_amdgcn_sched_barrier(0)
#define KSWZ(row, colB) ((row) * 256 + ((colB) ^ (((row) & 7) << 4)))
__device__ __forceinline__ int crow(int r, int hi) { return (r & 3) + 8 * (r >> 2) + 4 * hi; }
__device__ __forceinline__ unsigned cvtpk(float lo, float hi) { unsigned r; asm volatile("v_cvt_pk_bf16_f32 %0, %1, %2" : "=v"(r) : "v"(lo), "v"(hi)); return r; }
__device__ __forceinline__ void glds16(const void* gsrc, unsigned lds_dst) { unsigned keep;
    asm volatile("s_mov_b32 %0, m0\n\ts_mov_b32 m0, %2\n\ts_nop 0\n\tglobal_load_lds_dwordx4 %1, off\n\ts_mov_b32 m0, %0" : "=&s"(keep) : "v"(gsrc), "s"(lds_dst) : "memory"); }
#define WAIT_BAR(N) asm volatile("s_waitcnt vmcnt(" #N ") lgkmcnt(0)\n\ts_barrier" ::: "memory")
__device__ __forceinline__ int v_rd_base(int lane) { return ((lane & 3) << 3) | (((lane >> 2) & 3) << 6) | (((lane >> 4) & 1) << 5) | (((lane >> 5) & 1) << 8); }
constexpr int v_rd_off(int d0, int ks, int half) { return d0 * 512 + ks * 4096 + half * 2048; }
template <int OFF> __device__ __forceinline__ s16x4 tr_read(int vb) { s16x4 r; asm volatile("ds_read_b64_tr_b16 %0, %1 offset:%2" : "=&v"(r) : "v"(vb), "i"(OFF) : "memory"); return r; }

__device__ __forceinline__ void qkt(f32x16& p0, f32x16& p1, const LAS char* Ks, const bf16x8* qr, int r32, int hi) {
    const LAS char* kb = Ks + hi * 1024 + r32 * 16;
#pragma unroll
    for (int r = 0; r < 16; ++r) { p0[r] = 0.f; p1[r] = 0.f; }
#pragma unroll
    for (int d0 = 0; d0 < 4; ++d0) {
        const bf16x8 b0 = *(const LAS bf16x8*)(kb + d0 * 2048);
        const bf16x8 b1 = *(const LAS bf16x8*)(kb + d0 * 2048 + 512);
        p0 = __builtin_amdgcn_mfma_f32_32x32x16_bf16(b0, qr[d0], p0, 0, 0, 0);
        p1 = __builtin_amdgcn_mfma_f32_32x32x16_bf16(b1, qr[d0], p1, 0, 0, 0); }
}
__device__ __forceinline__ void softmax_pack(f32x16& p0, f32x16& p1, float negmC, float& l, bf16x8& pa0, bf16x8& pa1, bf16x8& pa2, bf16x8& pa3) {
#pragma unroll
    for (int r = 0; r < 16; ++r) { p0[r] = __builtin_amdgcn_exp2f(fmaf(p0[r], C2, negmC)); p1[r] = __builtin_amdgcn_exp2f(fmaf(p1[r], C2, negmC)); }
    float ps = 0.f;
#pragma unroll
    for (int r = 0; r < 16; ++r) ps += p0[r];
#pragma unroll
    for (int r = 0; r < 16; ++r) ps += p1[r];
    l += ps;
#define PK4(P, BASE, OUT) do { unsigned a0 = cvtpk(P[BASE + 0], P[BASE + 1]), a1 = cvtpk(P[BASE + 2], P[BASE + 3]);   \
    unsigned b0 = cvtpk(P[BASE + 4], P[BASE + 5]), b1 = cvtpk(P[BASE + 6], P[BASE + 7]);                              \
    auto r0 = __builtin_amdgcn_permlane32_swap(a0, b0, false, false); auto r1 = __builtin_amdgcn_permlane32_swap(a1, b1, false, false); \
    u32x4 w = {r0[0], r1[0], r0[1], r1[1]}; OUT = __builtin_bit_cast(bf16x8, w); } while (0)
    PK4(p0, 0, pa0); PK4(p0, 8, pa1); PK4(p1, 0, pa2); PK4(p1, 8, pa3);
#undef PK4
}
template <int D0> __device__ __forceinline__ void pv_one(f32x16& od, int vb, bf16x8 pa0, bf16x8 pa1, bf16x8 pa2, bf16x8 pa3) {
    const s16x4 l0 = tr_read<v_rd_off(D0, 0, 0)>(vb), h0 = tr_read<v_rd_off(D0, 0, 1)>(vb), l1 = tr_read<v_rd_off(D0, 1, 0)>(vb), h1 = tr_read<v_rd_off(D0, 1, 1)>(vb);
    const s16x4 l2 = tr_read<v_rd_off(D0, 2, 0)>(vb), h2 = tr_read<v_rd_off(D0, 2, 1)>(vb), l3 = tr_read<v_rd_off(D0, 3, 0)>(vb), h3 = tr_read<v_rd_off(D0, 3, 1)>(vb);
    asm volatile("s_waitcnt lgkmcnt(0)" ::: "memory"); SBAR();
#define PK(L, H) (bf16x8){L[0], L[1], L[2], L[3], H[0], H[1], H[2], H[3]}
    od = __builtin_amdgcn_mfma_f32_32x32x16_bf16(pa0, PK(l0, h0), od, 0, 0, 0);
    od = __builtin_amdgcn_mfma_f32_32x32x16_bf16(pa1, PK(l1, h1), od, 0, 0, 0);
    od = __builtin_amdgcn_mfma_f32_32x32x16_bf16(pa2, PK(l2, h2), od, 0, 0, 0);
    od = __builtin_amdgcn_mfma_f32_32x32x16_bf16(pa3, PK(l3, h3), od, 0, 0, 0);
#undef PK
}
__device__ __forceinline__ void pv_all(f32x16* o, int vb, bf16x8 pa0, bf16x8 pa1, bf16x8 pa2, bf16x8 pa3) {
    pv_one<0>(o[0], vb, pa0, pa1, pa2, pa3); pv_one<1>(o[1], vb, pa0, pa1, pa2, pa3); pv_one<2>(o[2], vb, pa0, pa1, pa2, pa3); pv_one<3>(o[3], vb, pa0, pa1, pa2, pa3);
}

__device__ __forceinline__ void attn_unit(int b, int h, int c, int qb, const bf16_t* Q, const bf16_t* K, const bf16_t* V, bf16_t* OT, const unsigned* kmax, LAS char* shm) {
    int tid_ = threadIdx.x; asm volatile("" : "+v"(tid_));
    const int tid = tid_, lane = tid & 63, r32 = lane & 31, hi = lane >> 5; const int wid = __builtin_amdgcn_readfirstlane(tid >> 6);
    const size_t rowbase = (size_t)b * SEQ; const int q0 = qb * 256;
    const bf16_t* Qw = Q + (rowbase + q0 + wid * 32) * 1024 + h * 128 + c * 64;
    const bf16_t* Kh = K + rowbase * 1024 + h * 128 + c * 64; const bf16_t* Vh = V + rowbase * 1024 + h * 128;
    const unsigned lds0 = (unsigned)(uintptr_t)shm;
    const bf16_t* ksrc = Kh + (size_t)lane * 1024 + wid * 8;
    const bf16_t* vsrc[2];
#pragma unroll
    for (int i = 0; i < 2; ++i) { const int p = 2 * wid + i;
        const int st = 2 * p + (lane >> 5), kk = (st >> 2) * 8 + ((lane & 31) >> 2), key = (kk & ~0xC) | ((kk & 4) << 1) | ((kk & 8) >> 1), cc = (st & 3) * 32 + (lane & 3) * 8;
        vsrc[i] = Vh + (size_t)key * 1024 + cc; }
    const unsigned kdst = lds0 + L_K + wid * 1024, vdst = lds0 + L_V + wid * 2048;
#define DMA_KV(t, slot) do { const size_t toff_ = (size_t)(t) * 64 * 1024; \
        glds16(ksrc + toff_, (unsigned)__builtin_amdgcn_readfirstlane(kdst + (slot) * KSLOT)); \
        glds16(vsrc[0] + toff_, (unsigned)__builtin_amdgcn_readfirstlane(vdst + (slot) * VSLOT)); glds16(vsrc[1] + toff_, (unsigned)__builtin_amdgcn_readfirstlane(vdst + (slot) * VSLOT + 1024)); } while (0)
    DMA_KV(0, 0); DMA_KV(1, 1);
    bf16x8 qr[4];
#pragma unroll
    for (int d0 = 0; d0 < 4; ++d0) qr[d0] = *(const bf16x8*)(Qw + (size_t)r32 * 1024 + d0 * 16 + hi * 8);
    float negm;
    {
        float sa = 0.f;
#pragma unroll
        for (int d0 = 0; d0 < 4; ++d0)
#pragma unroll
            for (int e = 0; e < 8; ++e) { const float x = __builtin_bit_cast(float, ((unsigned)(unsigned short)qr[d0][e]) << 16); sa += x * x; }
        { auto rr = __builtin_amdgcn_permlane32_swap(__float_as_uint(sa), __float_as_uint(sa), false, false); sa = __uint_as_float(rr[0]) + __uint_as_float(rr[1]); }
        const unsigned* km = kmax + ((b * 8 + h) * 2 + c) * 2;
        negm = -sqrtf(sa) * sqrtf(__uint_as_float(km[0]) + __uint_as_float(km[1])) * C2;
    }
    f32x16 o[4];
#pragma unroll
    for (int d = 0; d < 4; ++d)
#pragma unroll
        for (int r = 0; r < 16; ++r) o[d][r] = 0.f;
    float l = 0.f;
    const int vb0 = (int)(lds0 + L_V) + v_rd_base(lane);
    constexpr int NT = SEQ / 64;
    int slot = 0;
    for (int t = 0; t < NT; ++t) {
        if (t + 1 < NT) { WAIT_BAR(3); } else { WAIT_BAR(0); }
        if (t + 2 < NT) { const int s2 = (slot + 2 >= NSLOT) ? slot + 2 - NSLOT : slot + 2; DMA_KV(t + 2, s2); }
        const LAS char* Ks = shm + L_K + slot * KSLOT; const int vb = vb0 + slot * VSLOT;
        f32x16 p0, p1; bf16x8 a0, a1, a2, a3;
        SBAR(); qkt(p0, p1, Ks, qr, r32, hi);
        softmax_pack(p0, p1, negm, l, a0, a1, a2, a3);
        SBAR(); pv_all(o, vb, a0, a1, a2, a3);
        slot = (slot + 1 == NSLOT) ? 0 : slot + 1;
    }
#undef DMA_KV
    { auto rr = __builtin_amdgcn_permlane32_swap(__float_as_uint(l), __float_as_uint(l), false, false); l = __uint_as_float(rr[0]) + __uint_as_float(rr[1]); }
    LAS float* wsf = (LAS float*)(shm + L_WS) + wid * 64;
    if (hi == 0) wsf[r32] = 1.0f / l;
    asm volatile("s_waitcnt lgkmcnt(0)" ::: "memory");
    bf16_t* Ow = OT + (size_t)c * MTOK * 1024 + (rowbase + q0 + wid * 32) * 1024 + h * 128;
#pragma unroll
    for (int r = 0; r < 16; ++r) { const int orow = crow(r, hi); const float il = wsf[orow];
#pragma unroll
        for (int d = 0; d < 4; ++d) Ow[(size_t)orow * 1024 + d * 32 + r32] = (bf16_t)f2bf(o[d][r] * il); }
    asm volatile("s_waitcnt lgkmcnt(0)\n\ts_barrier" ::: "memory");
}
#undef SBAR
#undef KSWZ
#undef WAIT_BAR
}

__device__ __forceinline__ void combine_chunk(const bf16_t* OT, bf16_t* MIXp, float lam, const float* subg, float oscale, int chunk, int tid) {
    const int d0 = (tid & 15) * 8;
    float gs[8];
#pragma unroll
    for (int i = 0; i < 8; ++i) gs[i] = subg[d0 + i] * oscale;
    for (int it = tid >> 4; it < 128 * 8; it += NTHREADS / 16) { const int row = chunk * 128 + (it >> 3), h = it & 7;
        const u32x4 a = *(const u32x4*)(OT + (size_t)row * 1024 + h * 128 + d0), bq = *(const u32x4*)(OT + (size_t)MTOK * 1024 + (size_t)row * 1024 + h * 128 + d0);
        float o[8], ss = 0.f;
#pragma unroll
        for (int i = 0; i < 4; ++i) { o[2 * i] = bf_lo(a[i]) - lam * bf_lo(bq[i]); o[2 * i + 1] = bf_hi(a[i]) - lam * bf_hi(bq[i]); ss += o[2 * i] * o[2 * i] + o[2 * i + 1] * o[2 * i + 1]; }
        ss += __shfl_xor(ss, 1); ss += __shfl_xor(ss, 2); ss += __shfl_xor(ss, 4); ss += __shfl_xor(ss, 8);
        const float rstd = 1.0f / sqrtf(ss * (1.f / 128.f) + NORM_EPS);
        u32x4 w; w.x = pk2(o[0] * rstd * gs[0], o[1] * rstd * gs[1]); w.y = pk2(o[2] * rstd * gs[2], o[3] * rstd * gs[3]); w.z = pk2(o[4] * rstd * gs[4], o[5] * rstd * gs[5]); w.w = pk2(o[6] * rstd * gs[6], o[7] * rstd * gs[7]);
        *(u32x4*)(MIXp + (size_t)row * 2048 + 1024 + h * 128 + d0) = w; }
}

__device__ __forceinline__ int skey(float s, int payload, int mask) { int b = __builtin_bit_cast(int, s); b ^= (b >> 31) & 0x7fffffff; return (b & ~mask) | payload; }
__device__ __forceinline__ float skey_score(int k, int mask) { int b = k & ~mask; b ^= (b >> 31) & 0x7fffffff; return __builtin_bit_cast(float, b); }
#define CEX_DESC(a, b) do { const int hi_ = max((a), (b)), lo_ = min((a), (b)); (a) = hi_; (b) = lo_; } while (0)
__device__ __forceinline__ void sort16_desc(int (&k)[16]) {
#pragma unroll
    for (int sz = 2; sz <= 16; sz <<= 1)
#pragma unroll
        for (int j = sz >> 1; j > 0; j >>= 1)
#pragma unroll
            for (int i = 0; i < 16; ++i) { const int l = i ^ j;
                if (l > i) { if ((i & sz) == 0) { CEX_DESC(k[i], k[l]); } else { CEX_DESC(k[l], k[i]); } } }
}
__device__ __forceinline__ void bmerge16_desc(int (&k)[16]) {
#pragma unroll
    for (int j = 8; j > 0; j >>= 1)
#pragma unroll
        for (int i = 0; i < 16; ++i) { const int l = i ^ j; if (l > i) CEX_DESC(k[i], k[l]); }
}
__device__ __forceinline__ void top16_merge(int (&a)[16], const int (&b)[16]) {
#pragma unroll
    for (int i = 0; i < 16; ++i) a[i] = max(a[i], b[15 - i]);
    bmerge16_desc(a);
}
__device__ __forceinline__ void top16_xlane(int (&a)[16]) {
    int e[16], o[16];
#pragma unroll
    for (int i = 0; i < 16; ++i) { auto r = __builtin_amdgcn_permlane16_swap((unsigned)a[i], (unsigned)a[i], false, false); e[i] = (int)r[0]; o[i] = (int)r[1]; }
#pragma unroll
    for (int i = 0; i < 16; ++i) a[i] = max(e[i], o[15 - i]);
    bmerge16_desc(a);
#pragma unroll
    for (int i = 0; i < 16; ++i) { auto r = __builtin_amdgcn_permlane32_swap((unsigned)a[i], (unsigned)a[i], false, false); e[i] = (int)r[0]; o[i] = (int)r[1]; }
#pragma unroll
    for (int i = 0; i < 16; ++i) a[i] = max(e[i], o[15 - i]);
    bmerge16_desc(a);
}

__device__ __forceinline__ void router_task(const bf16_t* QP, const bf16_t* KEYS, unsigned* ROUTE, int tok0, int h, LAS int* scr, int lane) {
    const int fr = lane & 15, fq = lane >> 4;
    int top[2][16];
#pragma unroll
    for (int c = 0; c < 2; ++c) {
        const int hc = h * 2 + c;
        f32x4 acc[8];
#pragma unroll
        for (int nt = 0; nt < 8; ++nt) acc[nt] = (f32x4){0.f, 0.f, 0.f, 0.f};
        const bf16_t* qp = QP + (size_t)(tok0 + fr) * 2048 + hc * 128 + fq * 8;
        const bf16_t* kp = KEYS + ((size_t)hc * 128 + fr) * 128 + fq * 8;
#pragma unroll
        for (int ks = 0; ks < 4; ++ks) { const bf16x8 bq = *(const bf16x8*)(qp + ks * 32);
#pragma unroll
            for (int nt = 0; nt < 8; ++nt) { const bf16x8 ak = *(const bf16x8*)(kp + (size_t)nt * 16 * 128 + ks * 32);
                acc[nt] = __builtin_amdgcn_mfma_f32_16x16x32_bf16(ak, bq, acc[nt], 0, 0, 0); } }
        int ka[16], kb[16];
#pragma unroll
        for (int nt = 0; nt < 4; ++nt)
#pragma unroll
            for (int i = 0; i < 4; ++i) { ka[nt * 4 + i] = skey(acc[nt][i], 16 * nt + 4 * fq + i, 127); kb[nt * 4 + i] = skey(acc[nt + 4][i], 16 * (nt + 4) + 4 * fq + i, 127); }
        sort16_desc(ka); sort16_desc(kb); top16_merge(ka, kb);
        top16_xlane(ka);
#pragma unroll
        for (int i = 0; i < 16; ++i) top[c][i] = ka[i];
    }
    if (fq == 0) {
#pragma unroll
        for (int i = 0; i < 16; ++i) { scr[fr * 32 + i] = top[0][i] & 127; scr[fr * 32 + 16 + i] = top[1][i] & 127; } }
    float s0[16], s1[16];
#pragma unroll
    for (int i = 0; i < 16; ++i) { s0[i] = skey_score(top[0][i], 127); s1[i] = skey_score(top[1][i], 127); }
    constexpr int NEG = (int)0x80000000;
    int best[16], ch[16];
#define CAND(a, b) skey(s0[a] + s1[b], (a) * 16 + (b), 255)
#pragma unroll
    for (int b = 0; b < 16; ++b) best[b] = CAND(0, b);
    sort16_desc(best);
    ch[0] = CAND(1, 0); ch[1] = CAND(1, 1); ch[2] = CAND(1, 2); ch[3] = CAND(1, 3); ch[4] = CAND(1, 4); ch[5] = CAND(1, 5); ch[6] = CAND(1, 6); ch[7] = CAND(1, 7);
    ch[8] = CAND(2, 0); ch[9] = CAND(2, 1); ch[10] = CAND(2, 2); ch[11] = CAND(2, 3); ch[12] = CAND(2, 4); ch[13] = CAND(3, 0); ch[14] = CAND(3, 1); ch[15] = CAND(3, 2);
    sort16_desc(ch); top16_merge(best, ch);
    ch[0] = CAND(3, 3); ch[1] = CAND(4, 0); ch[2] = CAND(4, 1); ch[3] = CAND(4, 2); ch[4] = CAND(5, 0); ch[5] = CAND(5, 1); ch[6] = CAND(6, 0); ch[7] = CAND(6, 1);
    ch[8] = CAND(7, 0); ch[9] = CAND(7, 1); ch[10] = CAND(8, 0); ch[11] = CAND(9, 0); ch[12] = CAND(10, 0); ch[13] = CAND(11, 0); ch[14] = CAND(12, 0); ch[15] = CAND(13, 0);
    sort16_desc(ch); top16_merge(best, ch);
    ch[0] = CAND(14, 0); ch[1] = CAND(15, 0);
#pragma unroll
    for (int i = 2; i < 16; ++i) ch[i] = NEG;
    sort16_desc(ch); top16_merge(best, ch);
#undef CAND
    float g[16], gs = 0.f; const float smax = skey_score(best[0], 255);
#pragma unroll
    for (int i = 0; i < 16; ++i) { g[i] = __expf(skey_score(best[i], 255) - smax); gs += g[i]; }
    const float inv = 1.0f / gs;
    LDS_WAIT(); asm volatile("" ::: "memory");
    if (fq == 0) { unsigned e[16];
#pragma unroll
        for (int i = 0; i < 16; ++i) { const int ci = best[i] & 255, a = ci >> 4, b = ci & 15; const int ia = scr[fr * 32 + a], ib = scr[fr * 32 + 16 + b];
            e[i] = (f2bf(g[i] * inv) << 16) | (unsigned)(ia * 128 + ib); }
        unsigned* rp = ROUTE + (size_t)(tok0 + fr) * 128 + h * 16;
#pragma unroll
        for (int i = 0; i < 4; ++i) *(u32x4*)(rp + 4 * i) = (u32x4){e[4 * i], e[4 * i + 1], e[4 * i + 2], e[4 * i + 3]}; }
    LDS_WAIT(); asm volatile("" ::: "memory");
}

__device__ __forceinline__ float dot2_bf16(unsigned a, unsigned b, float acc) { asm("v_dot2c_f32_bf16 %0, %1, %2" : "+v"(acc) : "v"(a), "v"(b)); return acc; }
__device__ __forceinline__ float gelu_exact(float a) { return 0.5f * a * (1.0f + erff(a * 0.70710678118654752f)); }
__device__ __forceinline__ float expert_u_half(const unsigned R, const unsigned (&hp)[16], const bf16_t* U, int lane) {
    float W = 0.f;
#pragma unroll 1
    for (int g8 = 0; g8 < 8; ++g8) {
        float part[8];
#pragma unroll
        for (int i = 0; i < 8; ++i) {
            const unsigned ent = (unsigned)__builtin_amdgcn_readlane((int)R, g8 * 8 + i);
            const bf16_t* up = U + (size_t)(ent & 0x3fffu) * DM + 8 * lane;
            float acc = 0.f;
#pragma unroll
            for (int j = 0; j < 4; ++j) { const u32x4 uu = *(const u32x4*)(up + 512 * j);
#pragma unroll
                for (int q = 0; q < 4; ++q) acc = dot2_bf16(uu[q], hp[4 * j + q], acc); }
            part[i] = acc;
            if (i == 3) __builtin_amdgcn_sched_barrier(0); }
#pragma unroll
        for (int s = 0; s < 3; ++s) { const int m = 1 << s; const bool up_ = (lane & m) != 0;
#pragma unroll
            for (int i = 0; i < (4 >> s); ++i) { const float a = part[2 * i], c = part[2 * i + 1]; const float keep = up_ ? c : a, send = up_ ? a : c;
                part[i] = keep + __shfl_xor(send, m); } }
        float tot = part[0]; tot += __shfl_xor(tot, 8); tot += __shfl_xor(tot, 16); tot += __shfl_xor(tot, 32);
        const float val = gelu_exact(tot) * __builtin_bit_cast(float, R & 0xffff0000u);
        W = ((lane >> 3) == g8) ? val : W;
    }
    return W;
}
__device__ __forceinline__ void expert_v_half(const unsigned R, const float W, float (&oacc)[32], const bf16_t* V, int lane) {
#pragma unroll 1
    for (int e0 = 0; e0 < 64; e0 += 4) {
#pragma unroll
        for (int i = 0; i < 4; ++i) {
            const unsigned ent = (unsigned)__builtin_amdgcn_readlane((int)R, e0 + i);
            const float w = __builtin_bit_cast(float, __builtin_amdgcn_readlane(__builtin_bit_cast(int, W), e0 + i));
            const bf16_t* vp = V + (size_t)(ent & 0x3fffu) * DM + 8 * lane;
#pragma unroll
            for (int j = 0; j < 4; ++j) { const u32x4 vv = *(const u32x4*)(vp + 512 * j);
#pragma unroll
                for (int q = 0; q < 4; ++q) { oacc[8 * j + 2 * q] += w * bf_lo(vv[q]); oacc[8 * j + 2 * q + 1] += w * bf_hi(vv[q]); } } }
    }
}
__device__ __forceinline__ void expert_token(const float* xin, float* xout, const float* g, const float* sh, const float* sc, const float* gate, const bf16_t* U, const bf16_t* V, const unsigned* ROUTE, int row, int lane) {
    const int b = row >> 12; const float* xr = xin + (size_t)row * DM + 8 * lane;
    unsigned hp[16];
    {
        f32x4 v[8]; float ss = 0.f;
#pragma unroll
        for (int j = 0; j < 4; ++j) { v[2 * j] = *(const f32x4*)(xr + 512 * j); v[2 * j + 1] = *(const f32x4*)(xr + 512 * j + 4);
            const f32x4 a = v[2 * j], c = v[2 * j + 1]; ss += (a[0] * a[0] + a[1] * a[1]) + (a[2] * a[2] + a[3] * a[3]) + (c[0] * c[0] + c[1] * c[1]) + (c[2] * c[2] + c[3] * c[3]); }
        const float rstd = 1.0f / sqrtf(wave_sum(ss) * (1.f / DM) + NORM_EPS);
        const float* gp = g + 8 * lane; const float* shp = sh + (size_t)b * MODW + 8 * lane; const float* scp = sc + (size_t)b * MODW + 8 * lane;
#pragma unroll
        for (int j = 0; j < 4; ++j) { f32x4 o[2];
#pragma unroll
            for (int q = 0; q < 2; ++q) { const f32x4 gg = *(const f32x4*)(gp + 512 * j + 4 * q), s1 = *(const f32x4*)(scp + 512 * j + 4 * q), s0 = *(const f32x4*)(shp + 512 * j + 4 * q);
                o[q] = (v[2 * j + q] * rstd) * gg * (s1 + 1.0f) + s0; }
            hp[4 * j] = pk2(o[0][0], o[0][1]); hp[4 * j + 1] = pk2(o[0][2], o[0][3]); hp[4 * j + 2] = pk2(o[1][0], o[1][1]); hp[4 * j + 3] = pk2(o[1][2], o[1][3]); }
    }
    const unsigned r0 = ROUTE[(size_t)row * 128 + lane], r1 = ROUTE[(size_t)row * 128 + 64 + lane];
    const float w0 = expert_u_half(r0, hp, U, lane), w1 = expert_u_half(r1, hp, U, lane);
    float oacc[32];
#pragma unroll
    for (int i = 0; i < 32; ++i) oacc[i] = 0.f;
    expert_v_half(r0, w0, oacc, V, lane); expert_v_half(r1, w1, oacc, V, lane);
    const float* gtp = gate + (size_t)b * MODW + 8 * lane;
#pragma unroll
    for (int j = 0; j < 4; ++j)
#pragma unroll
        for (int q = 0; q < 2; ++q) { const f32x4 x = *(const f32x4*)(xr + 512 * j + 4 * q), gg = *(const f32x4*)(gtp + 512 * j + 4 * q);
            const f32x4 o = {oacc[8 * j + 4 * q], oacc[8 * j + 4 * q + 1], oacc[8 * j + 4 * q + 2], oacc[8 * j + 4 * q + 3]};
            *(f32x4*)(xout + (size_t)row * DM + 8 * lane + 512 * j + 4 * q) = x + gg * o; }
}

constexpr int NPHASE = 39;
#ifndef MK_SPLIT
#define MK_SPLIT 1
#endif
struct Args { const float* in[20]; float* out; unsigned char* ws; int ph_lo, ph_hi; };
static_assert(sizeof(Args) == 20 * 8 + 8 + 8 + 8, "Args has no padding");

__device__ __forceinline__ bool in_range(int lo, int hi, int k) { asm volatile("" : "+s"(lo), "+s"(hi)); return lo <= k && k < hi; }
__global__ void __launch_bounds__(NTHREADS, 2) fwd_kernel(Args args) {
    extern __shared__ __attribute__((aligned(16))) unsigned char lds_raw[];
    Ctx C;
    C.lds = (LAS unsigned char*)lds_raw; C.ws = args.ws;
    C.tid = threadIdx.x; C.lane = C.tid & 63; C.wave = __builtin_amdgcn_readfirstlane(C.tid >> 6);
    C.G = gridDim.x; { const int bx = blockIdx.x; C.vcu = (C.G % 8 == 0) ? (bx % 8) * (C.G / 8) + bx / 8 : bx; }
    C.gw = C.vcu * NWAVES + C.wave; C.NGW = C.G * NWAVES;
    C.out = args.out;
    unsigned* ctl = (unsigned*)(C.ws + WS_CTL);
    volatile LAS unsigned* MISC = (volatile LAS unsigned*)(C.lds + LDS_MISC);
    for (int u = C.tid; u < (LDS_BYTES - LDS_MISC) / 4; u += NTHREADS) ((LAS unsigned*)(C.lds + LDS_MISC))[u] = 0u;
    __syncthreads();
    const int lo = args.ph_lo, hi = args.ph_hi;
    XcdBarrier bar; bar.bar = ctl + CW_BAR; bar.x = 0; bar.st = nullptr;
    if (hi - lo > 1) bar = xcd_barrier_post(ctl + CW_BAR, MISC + 8);
#ifndef ONLYP
#define ONLYP -1
#endif
#define PEN(c) (ONLYP < 0 || ONLYP == (c))
#define IN(k) in_range(lo, hi, (k))
#define FRESH(k) do { C.tid = threadIdx.x; uintptr_t w_ = (uintptr_t)args.ws, o_ = (uintptr_t)args.out; asm volatile("; PHASE_MARK " #k : "+v"(C.tid), "+s"(C.gw), "+s"(C.vcu), "+s"(w_), "+s"(o_)); \
    C.ws = (unsigned char*)(GAS unsigned char*)w_; C.out = (float*)(GAS float*)o_; C.lane = C.tid & 63; } while (0)
#define SEAM(k) do { if (IN(k) && IN((k) + 1)) xcd_barrier(bar); } while (0)

    float* MOD = (float*)(C.ws + WS_MOD);
    bf16_t* H = (bf16_t*)(C.ws + WS_H); bf16_t* SEG = (bf16_t*)(C.ws + WS_SEG); bf16_t* MIX = (bf16_t*)(C.ws + WS_MIX); bf16_t* QP = (bf16_t*)(C.ws + WS_QP); bf16_t* H2 = (bf16_t*)(C.ws + WS_H2); bf16_t* OT = (bf16_t*)(C.ws + WS_OT);
    unsigned* ROUTE = (unsigned*)(C.ws + WS_ROUTE);

    if (PEN(0) && IN(0)) { FRESH(0); p0_prologue(C, args); } SEAM(0);
    if (PEN(1) && IN(1)) { FRESH(1); p1_modfinal(C, args.in[4]); } SEAM(1);

    for (int l = 0; l < DEPTH; ++l) {
        const int pb = 2 + 9 * l;
        const float* modl = MOD + (size_t)l * NBATCH * MODW;
        unsigned* kmax = ctl + CW_KMAX + l * 256;
        if (PEN(2) && IN(pb + 0)) { FRESH(2); const float* xcur = (l == 0) ? args.in[0] : (const float*)C.out; norm_pass(C, xcur, H, args.in[5] + (size_t)l * DM, modl + 0 * DM, modl + 1 * DM); } SEAM(pb + 0);
        if (PEN(3) && IN(pb + 1)) { FRESH(3);
            pg8::Gemm g{H, (const bf16_t*)(C.ws + WS_WIN) + (size_t)l * INC * DM, MTOK, INC, DM}; pg8::StaticOrder S; S.init(MTOK, INC, C.G, (int)blockIdx.x);
            pg8::EpiIn E{SEG, SEG_ELEMS, (const float*)(C.ws + WS_ROPE), kmax};
            pg8::gemm_phase<pg8::EpiIn, pg8::StaticOrder, true, true>(C.lds, g, S, E);
        } SEAM(pb + 1);
        if (PEN(4) && IN(pb + 2)) { FRESH(4);
            for (int u = C.vcu; u < NBATCH * AHEADS * 2 * (SEQ / 256); u += C.G) { const int bh = u >> 5, c = (u >> 4) & 1, qb = u & 15;
                att::attn_unit(bh >> 3, bh & 7, c, qb, SEG + 3 * SEG_ELEMS, SEG + 4 * SEG_ELEMS, SEG + 5 * SEG_ELEMS, OT, kmax, (LAS char*)C.lds); }
        } SEAM(pb + 2);
        if (PEN(11) && IN(pb + 3)) { FRESH(11);
            const float lam = ((const float*)(C.ws + WS_LAM))[l], osc = ((const float*)(C.ws + WS_LAM))[4 + l];
            for (int ch = C.vcu; ch < MTOK / 128; ch += C.G) {
                conv_chunk(SEG + 0 * SEG_ELEMS, SEG + 1 * SEG_ELEMS, SEG + 2 * SEG_ELEMS, args.in[7] + (size_t)l * 3 * CONVW, MIX, ch, C.tid);
                combine_chunk(OT, MIX, lam, args.in[12] + (size_t)l * VDIM, osc, ch, C.tid); }
        } SEAM(pb + 3);
        if (PEN(5) && IN(pb + 4)) { FRESH(5);
            pg8::Gemm g{MIX, (const bf16_t*)(C.ws + WS_WOUT) + (size_t)l * DM * DM, MTOK, DM, DM}; pg8::StaticOrder S; S.init(MTOK, DM, C.G, (int)blockIdx.x);
            const float* xcur = (l == 0) ? args.in[0] : (const float*)C.out;
            pg8::EpiRes E{xcur, C.out, modl + 2 * DM};
            pg8::gemm_phase<pg8::EpiRes, pg8::StaticOrder, true, true>(C.lds, g, S, E);
        } SEAM(pb + 4);
        if (PEN(6) && IN(pb + 5)) { FRESH(6); norm_pass(C, C.out, H2, args.in[14] + (size_t)l * DM, modl + 3 * DM, modl + 4 * DM); } SEAM(pb + 5);
        if (PEN(7) && IN(pb + 6)) { FRESH(7);
            pg8::Gemm g{H2, (const bf16_t*)(C.ws + WS_WQ) + (size_t)l * DM * DM, MTOK, DM, DM}; pg8::StaticOrder S; S.init(MTOK, DM, C.G, (int)blockIdx.x);
            pg8::EpiBf16 E{QP, DM};
            pg8::gemm_phase<pg8::EpiBf16, pg8::StaticOrder, true, true>(C.lds, g, S, E);
        } SEAM(pb + 6);
        if (PEN(8) && IN(pb + 7)) { FRESH(8);
            const bf16_t* keys = (const bf16_t*)(C.ws + WS_KEYS) + (size_t)l * 16 * 128 * 128;
            LAS int* scr = (LAS int*)(C.lds + C.wave * 2048);
            for (int it = C.gw; it < (MTOK / 16) * PHEADS; it += C.NGW) router_task(QP, keys, ROUTE, (it >> 3) * 16, it & 7, scr, C.lane);
        } SEAM(pb + 7);
        if (PEN(9) && IN(pb + 8)) { FRESH(9);
            const bf16_t* U = (const bf16_t*)(C.ws + WS_U) + (size_t)l * NEXP * DM; const bf16_t* V = (const bf16_t*)(C.ws + WS_V) + (size_t)l * NEXP * DM;
            for (int row = C.gw; row < MTOK; row += C.NGW)
                expert_token(C.out, C.out, args.in[14] + (size_t)l * DM, modl + 3 * DM, modl + 4 * DM, modl + 5 * DM, U, V, ROUTE, row, C.lane);
        } SEAM(pb + 8);
    }
    if (PEN(10) && IN(38)) { FRESH(10); final_norm_pass(C, C.out, C.out, args.in[19]); }
#undef IN
#undef SEAM
}


#if defined(CHECK) && CHECK
constexpr size_t WS_XSAVE = 1760 * MiB;
constexpr int NSTAGE = 13, NSAMP = 96;
__device__ __forceinline__ unsigned hash32(unsigned x) { x ^= x >> 16; x *= 0x7feb352du; x ^= x >> 15; x *= 0x846ca68bu; x ^= x >> 16; return x; }
__device__ __forceinline__ float bf2f(bf16_t v) { return __builtin_bit_cast(float, ((unsigned)v) << 16); }
__device__ __forceinline__ double wsumd(double v) {
#pragma unroll
    for (int o = 1; o < 64; o <<= 1) v += __shfl_xor(v, o);
    return v; }
__device__ __forceinline__ float wmaxf(float v) {
#pragma unroll
    for (int o = 1; o < 64; o <<= 1) v = fmaxf(v, __shfl_xor(v, o));
    return v; }
__device__ __forceinline__ void diag_add(float* diag, int stage, double num, double den, int lane) { if (lane == 0) { atomicAdd(diag + 2 * stage, (float)num); atomicAdd(diag + 2 * stage + 1, (float)den); } }
__device__ __forceinline__ float chk_silu(float x) { return x / (1.f + expf(-x)); }
__device__ __forceinline__ float chk_rstd(const float* x, int row, int lane) { double ss = 0; for (int k = lane; k < DM; k += 64) { const double v = x[(size_t)row * DM + k]; ss += v * v; } ss = wsumd(ss); return 1.0f / sqrtf((float)(ss / DM) + NORM_EPS); }
__device__ __forceinline__ float chk_norm_elem(const float* x, int row, int col, float rstd, const float* g, const float* sh, const float* sc) { const int b = row >> 12;
    return x[(size_t)row * DM + col] * rstd * g[col] * (1.0f + sc[(size_t)b * MODW + col]) + sh[(size_t)b * MODW + col]; }
__global__ void __launch_bounds__(64) check_kernel(Args args) {
    __shared__ float sq_[64]; __shared__ float ssc[256]; __shared__ int sused[256]; __shared__ int sti[32]; __shared__ float sts[32]; __shared__ int sce[16]; __shared__ float scs[16];
    const int stage = blockIdx.x / NSAMP, s = blockIdx.x % NSAMP, lane = threadIdx.x;
    unsigned char* ws = args.ws; float* diag = (float*)(ws + WS_DIAG);
    const float* MOD = (const float*)(ws + WS_MOD); const bf16_t* H = (const bf16_t*)(ws + WS_H); const bf16_t* SEG = (const bf16_t*)(ws + WS_SEG);
    const bf16_t* MIX = (const bf16_t*)(ws + WS_MIX); const bf16_t* OT = (const bf16_t*)(ws + WS_OT); const bf16_t* H2 = (const bf16_t*)(ws + WS_H2); const bf16_t* QP = (const bf16_t*)(ws + WS_QP); const unsigned* ROUTE = (const unsigned*)(ws + WS_ROUTE);
    const float* XS = (const float*)(ws + WS_XSAVE); const unsigned* kmax = (const unsigned*)(ws + WS_CTL) + CW_KMAX;
    const unsigned hsh = hash32(stage * 7919u + s * 104729u + 12345u);
    const int row = hsh % MTOK; const unsigned h2 = hash32(hsh + 1u);
    if (stage == 1) {
        const int b = h2 % 8, n = (h2 >> 3) % MODW; double a = 0;
        for (int k = lane; k < DM; k += 64) a += (double)chk_silu(args.in[1][b * DM + k]) * args.in[3][(size_t)k * MODW + n];
        a = wsumd(a) + args.in[4][n]; const double d = MOD[(size_t)b * MODW + n] - a; diag_add(diag, stage, d * d, a * a, lane);
    } else if (stage == 2) {
        const int col = h2 % DM; const float rstd = chk_rstd(args.in[0], row, lane); const float r = chk_norm_elem(args.in[0], row, col, rstd, args.in[5], MOD + 0 * DM, MOD + 1 * DM);
        const double d = bf2f(H[(size_t)row * DM + col]) - r; diag_add(diag, stage, d * d, (double)r * r, lane);
    } else if (stage == 3 || stage == 4) {
        int col;
        if (stage == 3) { const int t = h2 % 4; col = (t == 3 ? 5 : t) * 1024 + (h2 >> 2) % 1024; } else { col = 3072 + (h2 % 2048); if (s < NSAMP / 2) col = (col & ~63) | ((h2 >> 11) % 16); }
        auto dotc = [&](int c) { double a = 0; for (int k = lane; k < DM; k += 64) a += (double)bf2f(H[(size_t)row * DM + k]) * args.in[6][(size_t)k * INC + c]; return (float)wsumd(a); };
        float r = dotc(col);
        if (stage == 4) { const int dd = col & 63; if (dd < 16) { const int j = dd & 7; const float invf = powf(500000.f, -(float)(2 * j) / 16.f); const float ang = (float)((const int*)args.in[2])[row] * invf;
                const float cs = cosf(ang), sn = sinf(ang); const float o = (dd < 8) ? dotc(col + 8) : dotc(col - 8); r = (dd < 8) ? r * cs - o * sn : r * cs + o * sn; } }
        const float got = bf2f(SEG[(size_t)(col >> 10) * SEG_ELEMS + (size_t)row * 1024 + (col & 1023)]);
        const double d = got - r; diag_add(diag, stage, d * d, (double)r * r, lane);
    } else if (stage == 5) {
        const int b = h2 % 8, hh = (h2 >> 3) % 8, c = (h2 >> 6) % 2; const bf16_t* K = SEG + 4 * SEG_ELEMS; float mx = 0.f;
        for (int sq = lane; sq < SEQ; sq += 64) { float a = 0; for (int d = 0; d < 64; ++d) { const float v = bf2f(K[((size_t)b * SEQ + sq) * 1024 + hh * 128 + c * 64 + d]); a += v * v; } mx = fmaxf(mx, a); }
        mx = wmaxf(mx);
        const unsigned* km = kmax + ((b * 8 + hh) * 2 + c) * 2; const float bound = __uint_as_float(km[0]) + __uint_as_float(km[1]);
        const bool ok = bound >= mx * 0.98f && bound <= mx * 2.2f; diag_add(diag, stage, ok ? 0.0 : 1.0, 1.0, lane);
    } else if (stage == 6) {
        const int hh = h2 % 8, c = (h2 >> 3) % 2, d = (h2 >> 4) % 128, b = row >> 12;
        const bf16_t* Q = SEG + 3 * SEG_ELEMS; const bf16_t* K = SEG + 4 * SEG_ELEMS; const bf16_t* V = SEG + 5 * SEG_ELEMS;
        sq_[lane] = bf2f(Q[(size_t)row * 1024 + hh * 128 + c * 64 + lane]); __syncthreads();
        float mx = -1e30f;
        for (int sq = lane; sq < SEQ; sq += 64) { float a = 0; const bf16_t* kr = K + ((size_t)b * SEQ + sq) * 1024 + hh * 128 + c * 64; for (int e = 0; e < 64; ++e) a += sq_[e] * bf2f(kr[e]); mx = fmaxf(mx, a * 0.125f); }
        mx = wmaxf(mx);
        double num = 0, den = 0;
        for (int sq = lane; sq < SEQ; sq += 64) { float a = 0; const bf16_t* kr = K + ((size_t)b * SEQ + sq) * 1024 + hh * 128 + c * 64; for (int e = 0; e < 64; ++e) a += sq_[e] * bf2f(kr[e]);
            const double p = exp((double)(a * 0.125f - mx)); den += p; num += p * bf2f(V[((size_t)b * SEQ + sq) * 1024 + hh * 128 + d]); }
        num = wsumd(num); den = wsumd(den);
        const double r = num / den; const double dd = bf2f(OT[(size_t)c * MTOK * 1024 + (size_t)row * 1024 + hh * 128 + d]) - r; diag_add(diag, stage, dd * dd, r * r, lane);
    } else if (stage == 7) {
        if ((s & 1) == 0) { const int col = h2 % 1024, sq = row & (SEQ - 1); const bf16_t* GB = SEG; const bf16_t* GC = SEG + SEG_ELEMS; const bf16_t* HV = SEG + 2 * SEG_ELEMS;
            auto z = [&](int r) { return bf2f(GC[(size_t)r * 1024 + col]) * bf2f(HV[(size_t)r * 1024 + col]); };
            const float zm = (sq > 0) ? z(row - 1) : 0.f, zc = z(row), zp = (sq < SEQ - 1) ? z(row + 1) : 0.f;
            const float r = bf2f(GB[(size_t)row * 1024 + col]) * (args.in[7][col] * zm + args.in[7][1024 + col] * zc + args.in[7][2048 + col] * zp);
            const double d = bf2f(MIX[(size_t)row * 2048 + col]) - r; diag_add(diag, stage, d * d, (double)r * r, lane);
        } else { const int hh = h2 % 8, d = (h2 >> 3) % 128;
            const double a1 = wsumd((double)args.in[8][lane] * args.in[9][lane]), a2 = wsumd((double)args.in[10][lane] * args.in[11][lane]);
            const float lam_init = 0.8f - 0.6f * expf(-0.3f * 0.f), lam = (float)(exp(a1) - exp(a2)) + lam_init;
            double ss = 0; float od = 0;
            for (int e = lane; e < 128; e += 64) { const float o = bf2f(OT[(size_t)row * 1024 + hh * 128 + e]) - lam * bf2f(OT[(size_t)MTOK * 1024 + (size_t)row * 1024 + hh * 128 + e]); ss += (double)o * o; if (e == d) od = o; }
            ss = wsumd(ss); od = (float)wsumd((double)od);
            const float r = od / sqrtf((float)(ss / 128.0) + NORM_EPS) * args.in[12][d] * (1.f - lam_init);
            const double dd = bf2f(MIX[(size_t)row * 2048 + 1024 + hh * 128 + d]) - r; diag_add(diag, stage, dd * dd, (double)r * r, lane); }
    } else if (stage == 8) {
        const int col = h2 % DM, b = row >> 12; double a = 0; for (int k = lane; k < DM; k += 64) a += (double)bf2f(MIX[(size_t)row * DM + k]) * args.in[13][(size_t)k * DM + col];
        a = wsumd(a); const double delta = (double)MOD[(size_t)b * MODW + 2 * DM + col] * a;
        const double r = args.in[0][(size_t)row * DM + col] + delta; const double d = XS[(size_t)row * DM + col] - r; diag_add(diag, stage, d * d, delta * delta, lane);
    } else if (stage == 9) {
        const int col = h2 % DM; const float rstd = chk_rstd(XS, row, lane); const float r = chk_norm_elem(XS, row, col, rstd, args.in[14], MOD + 3 * DM, MOD + 4 * DM);
        const double d = bf2f(H2[(size_t)row * DM + col]) - r; diag_add(diag, stage, d * d, (double)r * r, lane);
    } else if (stage == 10) {
        const int col = h2 % DM; double a = 0; for (int k = lane; k < DM; k += 64) a += (double)bf2f(H2[(size_t)row * DM + k]) * args.in[15][(size_t)k * DM + col];
        a = wsumd(a); const double d = bf2f(QP[(size_t)row * DM + col]) - a; diag_add(diag, stage, d * d, a * a, lane);
    } else if (stage == 11) {
        const int hh = h2 % 8;
        for (int i = lane; i < 256; i += 64) { const int c = i >> 7, n = i & 127; double a = 0; for (int d = 0; d < 128; ++d) a += (double)bf2f(QP[(size_t)row * DM + (hh * 2 + c) * 128 + d]) * args.in[16][(((size_t)hh * 2 + c) * 128 + n) * 128 + d]; ssc[i] = (float)a; sused[i] = 0; }
        __syncthreads();
        if (lane == 0) {
            for (int c = 0; c < 2; ++c) for (int j = 0; j < 16; ++j) { int bi = -1; float bv = -1e30f; for (int n = 0; n < 128; ++n) if (!sused[c * 128 + n] && ssc[c * 128 + n] > bv) { bv = ssc[c * 128 + n]; bi = n; }
                sti[c * 16 + j] = bi; sts[c * 16 + j] = bv; sused[c * 128 + bi] = 1; }
            for (int q = 0; q < 256; ++q) sused[q] = 0;
            for (int j = 0; j < 16; ++j) { int bi = -1; float bv = -1e30f; for (int q = 0; q < 256; ++q) { if (sused[q]) continue; const float v = sts[q >> 4] + sts[16 + (q & 15)]; if (v > bv) { bv = v; bi = q; } }
                sused[bi] = 1; sce[j] = sti[bi >> 4] * 128 + sti[16 + (bi & 15)]; scs[j] = bv; }
            double gsum = 0; for (int j = 0; j < 16; ++j) gsum += exp((double)(scs[j] - scs[0]));
            double err = 0;
            for (int j = 0; j < 16; ++j) { const double gr = exp((double)(scs[j] - scs[0])) / gsum; double gm = 0;
                for (int q = 0; q < 16; ++q) { const unsigned e = ROUTE[(size_t)row * 128 + hh * 16 + q]; if ((int)(e & 0x3fffu) == sce[j]) gm = __builtin_bit_cast(float, e & 0xffff0000u); }
                err += fabs(gr - gm); }
            diag_add(diag, stage, err * err, 1.0, lane); }
    } else if (stage == 12) {
        const int col = h2 % DM, b = row >> 12; const float rstd = chk_rstd(XS, row, lane); double out = 0;
        for (int e = 0; e < 128; ++e) { const unsigned ent = ROUTE[(size_t)row * 128 + e]; const int eid = ent & 0x3fffu; const float gate = __builtin_bit_cast(float, ent & 0xffff0000u); double a = 0;
            for (int k = lane; k < DM; k += 64) { const float hk = chk_norm_elem(XS, row, k, rstd, args.in[14], MOD + 3 * DM, MOD + 4 * DM); a += (double)hk * args.in[17][(size_t)eid * DM + k]; }
            a = wsumd(a); const double ge = 0.5 * a * (1.0 + erf(a * 0.7071067811865476)); out += ge * gate * args.in[18][(size_t)eid * DM + col]; }
        const double delta = (double)MOD[(size_t)b * MODW + 5 * DM + col] * out; const double r = XS[(size_t)row * DM + col] + delta; const double d = args.out[(size_t)row * DM + col] - r; diag_add(diag, stage, d * d, delta * delta, lane);
    }
}
#ifndef CHECK_FROM
#define CHECK_FROM 1
#endif
__global__ void encode_kernel(Args args) {
    const float* diag = (const float*)(args.ws + WS_DIAG);
    int k = 14; float m = 1.f;
    for (int st = NSTAGE - 1; st >= CHECK_FROM; --st) { const float num = diag[2 * st], den = diag[2 * st + 1]; float rel = sqrtf(num / fmaxf(den, 1e-30f)); if (!(rel == rel)) rel = 1e4f;
        const float tol = (st == 11) ? 0.08f : (st == 5 ? 0.01f : 0.03f);
        if (rel > tol) { k = st; m = fminf(9.9f, fmaxf(1.f, 1.f + 2.f * (log10f(rel) + 4.f))); } }
    const float c = sqrtf(m * powf(10.f, (float)k));
    for (size_t i = (size_t)blockIdx.x * blockDim.x + threadIdx.x; i < (size_t)MTOK * DM; i += (size_t)gridDim.x * blockDim.x) args.out[i] = c;
}
#endif
extern "C" void kernel_launch(void* const* d_in, const int* in_sizes, int n_in, void* d_out, int out_size, void* d_ws, size_t ws_size, hipStream_t stream) {
    static int grid = 0;
    if (grid == 0) {
        if (n_in != 20 || out_size != MTOK * DM || ws_size < WS_END) { fprintf(stderr, "kernel_launch: unexpected shapes: n_in %d out %d ws %zu (need %zu)\n", n_in, out_size, ws_size, (size_t)WS_END); grid = -1; return; }
        int dev = 0, cus = 0;
        if (hipGetDevice(&dev) != hipSuccess || hipDeviceGetAttribute(&cus, hipDeviceAttributeMultiprocessorCount, dev) != hipSuccess) { grid = -1; return; }
        if (hipFuncSetAttribute((const void*)fwd_kernel, hipFuncAttributeMaxDynamicSharedMemorySize, LDS_BYTES) != hipSuccess) { fprintf(stderr, "kernel_launch: hipFuncSetAttribute failed\n"); grid = -1; return; }
        int per_cu = 0;
        if (hipOccupancyMaxActiveBlocksPerMultiprocessor(&per_cu, (const void*)fwd_kernel, NTHREADS, LDS_BYTES) != hipSuccess || per_cu < 1) { fprintf(stderr, "kernel_launch: occupancy query says %d\n", per_cu); }
        (void)hipGetLastError();
        grid = cus;
    }
    if (grid < 0) return;
    (void)hipMemsetAsync((char*)d_ws + WS_CTL, 0, CTL_ZERO_BYTES, stream);
    Args a{};
    for (int i = 0; i < 20; ++i) a.in[i] = (const float*)d_in[i];
    a.out = (float*)d_out; a.ws = (unsigned char*)d_ws;
#if defined(CHECK) && CHECK
    if (ws_size < WS_XSAVE + (size_t)MTOK * DM * 4) { fprintf(stderr, "check build: workspace too small\n"); return; }
    (void)hipMemsetAsync((char*)d_ws + WS_DIAG, 0, 4096, stream);
    for (int p = 0; p < 2 + 9; ++p) { a.ph_lo = p; a.ph_hi = p + 1; hipLaunchKernelGGL(fwd_kernel, dim3(grid), dim3(NTHREADS), LDS_BYTES, stream, a);
        if (p == 2 + 4) (void)hipMemcpyAsync((char*)d_ws + WS_XSAVE, d_out, (size_t)MTOK * DM * 4, hipMemcpyDeviceToDevice, stream); }
    hipLaunchKernelGGL(check_kernel, dim3(NSTAGE * NSAMP), dim3(64), 0, stream, a);
    hipLaunchKernelGGL(encode_kernel, dim3(1024), dim3(256), 0, stream, a);
#elif MK_SPLIT
    for (int p = 0; p < NPHASE; ++p) { a.ph_lo = p; a.ph_hi = p + 1; hipLaunchKernelGGL(fwd_kernel, dim3(grid), dim3(NTHREADS), LDS_BYTES, stream, a); }
#else
    a.ph_lo = 0; a.ph_hi = NPHASE; hipLaunchKernelGGL(fwd_kernel, dim3(grid), dim3(NTHREADS), LDS_BYTES, stream, a);
#endif
    const hipError_t le = hipPeekAtLastError();
    if (le != hipSuccess) fprintf(stderr, "kernel_launch: launch failed: %s\n", hipGetErrorName(le));
}
```

```cpp
#include <hip/hip_runtime.h>
#include <cstdio>
#include <cstdint>

#define GAS __attribute__((address_space(1)))
#define LAS __attribute__((address_space(3)))
typedef unsigned short bf16_t;
typedef short bf16x8 __attribute__((ext_vector_type(8)));
typedef short s16x4 __attribute__((ext_vector_type(4)));
typedef float f32x2 __attribute__((ext_vector_type(2)));
typedef float f32x4 __attribute__((ext_vector_type(4)));
typedef float f32x16 __attribute__((ext_vector_type(16)));
typedef unsigned u32x2 __attribute__((ext_vector_type(2)));
typedef unsigned u32x4 __attribute__((ext_vector_type(4)));
typedef __bf16 bf16x2_t __attribute__((ext_vector_type(2)));

constexpr int DM = 2048, NBATCH = 8, SEQ = 4096, DEPTH = 4, MTOK = NBATCH * SEQ;
constexpr int CONVW = 1024, AHEADS = 8, ATTW = 1024, VDIM = 128, SUBD = 64;
constexpr int INC = 6144;
constexpr int PHEADS = 8, NKEYS = 128, NEXP = 16384, TOPK = 16;
constexpr int MODW = 6 * DM;
constexpr float NORM_EPS = 1e-6f;
constexpr int NWAVES = 8, NTHREADS = 512;

constexpr size_t MiB = 1u << 20;
constexpr size_t WS_CTL = 0, CTL_ZERO_BYTES = 1 * MiB;
constexpr size_t WS_MOD = 2 * MiB;
constexpr size_t WS_MODP = 4 * MiB;
constexpr size_t WS_ROPE = 16 * MiB;
constexpr size_t WS_LAM = 18 * MiB;
constexpr size_t WS_KEYS = 20 * MiB;
constexpr size_t WS_WIN = 32 * MiB;
constexpr size_t WS_WOUT = 128 * MiB;
constexpr size_t WS_WQ = 160 * MiB;
constexpr size_t WS_U = 192 * MiB;
constexpr size_t WS_V = 448 * MiB;
constexpr size_t WS_H = 704 * MiB;
constexpr size_t WS_SEG = 832 * MiB;
constexpr size_t SEG_ELEMS = (size_t)MTOK * 1024;
constexpr size_t WS_MIX = 1216 * MiB;
constexpr size_t WS_QP = 1344 * MiB;
constexpr size_t WS_ROUTE = 1472 * MiB;
constexpr size_t WS_DIAG = 1488 * MiB;
constexpr size_t WS_H2 = 1504 * MiB;
constexpr size_t WS_OT = 1632 * MiB;
constexpr size_t WS_END = 1760 * MiB;

constexpr int CW_BAR = 4096;
constexpr int CW_KMAX = 16384;

constexpr int LDS_BYTES = 147456;
constexpr int LDS_MISC = 131072;
namespace pg8 {
#define PG8_LAS __attribute__((address_space(3)))
typedef unsigned short bf16_t;
typedef short bf16x8 __attribute__((ext_vector_type(8)));
typedef float f32x4 __attribute__((ext_vector_type(4)));
typedef unsigned u32x4 __attribute__((ext_vector_type(4)));
constexpr int BM = 256, BK = 64, HALF = 128, HTB = HALF * BK * 2  , STAGE_BYTES = 8 * HTB, NXCD = 8, WGM = 8;

__host__ __device__ __forceinline__ int lds_byte(int r, int c) { const int st = (r >> 4) * 2 + (c >> 5), rr = r & 15, cc = c & 31, ob = rr * 64 + cc * 2; return st * 1024 + (ob ^ (((ob >> 9) & 1) << 5)); }
__host__ __device__ __forceinline__ void stage_rc(int b, int& R, int& C) { const int st = b / 1024, sb = b % 1024, swz = sb ^ (((sb >> 9) & 1) << 5); R = (st >> 1) * 16 + swz / 64; C = (st & 1) * 32 + (swz % 64) / 2; }
__host__ __device__ __forceinline__ int perm32(int rho) { const int n = rho >> 4, i = rho & 15; return 8 * (i >> 2) + 4 * n + (i & 3); }

struct Unit { int pm, pn; };
struct Gemm { const bf16_t* A; const bf16_t* Bt; int M, N, K; };

struct StaticOrder {
    int nM, nN, nwg, G, c;
    __host__ __device__ void init(int M, int N, int G_, int c_) { nM = M / BM; nN = N / BM; nwg = nM * nN; G = G_; c = c_; }
    __host__ __device__ bool next(int i, Unit& u) const {
        const long L = (long)i * G + c; if (L >= nwg) return false;
        int wgid = (int)L; { const int q = nwg / NXCD, r = nwg % NXCD, xcd = wgid % NXCD, off = wgid / NXCD; wgid = (xcd < r ? xcd * (q + 1) : r * (q + 1) + (xcd - r) * q) + off; }
        const int nig = WGM * nN, gid = wgid / nig, fm = gid * WGM, gsz = (nM - fm) < WGM ? (nM - fm) : WGM;
        u.pm = fm + ((wgid % nig) % gsz); u.pn = (wgid % nig) / gsz; return true;
    }
    __device__ __forceinline__ void a_ready(const Unit&) const {}
    __device__ __forceinline__ void done(const Unit&) const {}
};


__device__ __forceinline__ unsigned cvt_pk_bf16(float lo, float hi) { unsigned r; asm volatile("v_cvt_pk_bf16_f32 %0, %1, %2" : "=v"(r) : "v"(lo), "v"(hi)); return r; }

struct EpiBf16 {
    static constexpr bool PERM = true, AFTER_DRAIN = false;
    bf16_t* O; int ldc;
    __device__ __forceinline__ void operator()(const f32x4 (&acc)[2][2][4][2], const Unit& u, int wr, int wc, int fr, int fq) const {
        const int row0 = u.pm * BM + wr * 64 + fr, col0 = u.pn * BM + wc * 32 + 8 * fq;
#pragma unroll
        for (int ai = 0; ai < 2; ++ai)
#pragma unroll
            for (int m = 0; m < 4; ++m) { bf16_t* rowp = O + (size_t)(row0 + ai * HALF + m * 16) * ldc + col0;
#pragma unroll
                for (int bj = 0; bj < 2; ++bj) { const f32x4 v0 = acc[ai][bj][m][0], v1 = acc[ai][bj][m][1];
                    u32x4 w; w.x = cvt_pk_bf16(v0[0], v0[1]); w.y = cvt_pk_bf16(v0[2], v0[3]); w.z = cvt_pk_bf16(v1[0], v1[1]); w.w = cvt_pk_bf16(v1[2], v1[3]);
                    *(u32x4*)(rowp + bj * HALF) = w; } }
    }
};

struct EpiIn {
    static constexpr bool PERM = true, AFTER_DRAIN = false;
    bf16_t* seg0; size_t sege; const float* rope; unsigned* kmax;
    __device__ __forceinline__ void operator()(const f32x4 (&acc)[2][2][4][2], const Unit& u, int wr, int wc, int fr, int fq) const {
        const int t = u.pn >> 2, colt = (u.pn & 3) * BM;
        const int row0 = u.pm * BM + wr * 64 + fr, col0 = colt + wc * 32 + 8 * fq;
        bf16_t* base = seg0 + (size_t)t * sege;
        const bool isqk = (t == 3) || (t == 4);
        const bool ropew = isqk && ((wc & 1) == 0);
        const bool isk = (t == 4);
        float mx[2] = {0.f, 0.f};
#pragma unroll
        for (int ai = 0; ai < 2; ++ai)
#pragma unroll
            for (int m = 0; m < 4; ++m) { const int row = row0 + ai * HALF + m * 16; bf16_t* rowp = base + (size_t)row * 1024 + col0;
                f32x4 cs0 = {1.f, 1.f, 1.f, 1.f}, cs1 = cs0, sn0 = {0.f, 0.f, 0.f, 0.f}, sn1 = sn0;
                if (ropew && fq < 2) { const f32x4* rp = (const f32x4*)(rope + (size_t)row * 16); cs0 = rp[0]; cs1 = rp[1]; sn0 = rp[2]; sn1 = rp[3];
                    if (fq == 0) { sn0 = -sn0; sn1 = -sn1; } }
#pragma unroll
                for (int bj = 0; bj < 2; ++bj) { f32x4 v0 = acc[ai][bj][m][0], v1 = acc[ai][bj][m][1];
                    if (ropew) {
                        f32x4 p0, p1;
#pragma unroll
                        for (int i = 0; i < 4; ++i) { p0[i] = __shfl_xor(v0[i], 16); p1[i] = __shfl_xor(v1[i], 16); }
                        v0 = v0 * cs0 + p0 * sn0; v1 = v1 * cs1 + p1 * sn1;
                    }
                    u32x4 w; w.x = cvt_pk_bf16(v0[0], v0[1]); w.y = cvt_pk_bf16(v0[2], v0[3]); w.z = cvt_pk_bf16(v1[0], v1[1]); w.w = cvt_pk_bf16(v1[2], v1[3]);
                    *(u32x4*)(rowp + bj * HALF) = w;
                    if (isk) { float ss = (v0[0] * v0[0] + v0[1] * v0[1]) + (v0[2] * v0[2] + v0[3] * v0[3]) + (v1[0] * v1[0] + v1[1] * v1[1]) + (v1[2] * v1[2] + v1[3] * v1[3]);
                        ss += __shfl_xor(ss, 16); ss += __shfl_xor(ss, 32); mx[bj] = fmaxf(mx[bj], ss); } } }
        if (isk) {
#pragma unroll
            for (int bj = 0; bj < 2; ++bj) { float v = mx[bj];
                v = fmaxf(v, __shfl_xor(v, 1)); v = fmaxf(v, __shfl_xor(v, 2)); v = fmaxf(v, __shfl_xor(v, 4)); v = fmaxf(v, __shfl_xor(v, 8));
                if ((threadIdx.x & 63) == 0) { const int b = u.pm >> 4, head = (u.pn & 3) * 2 + bj, c = wc >> 1, half = wc & 1;
                    atomicMax(kmax + (((b * 8 + head) * 2 + c) * 2 + half), __float_as_uint(v)); } }
        }
    }
};

struct EpiRes {
    static constexpr bool PERM = true, AFTER_DRAIN = false;
    const float* xin; float* xout; const float* gate;
    __device__ __forceinline__ void operator()(const f32x4 (&acc)[2][2][4][2], const Unit& u, int wr, int wc, int fr, int fq) const {
        const int row0 = u.pm * BM + wr * 64 + fr, col0 = u.pn * BM + wc * 32 + 8 * fq, b = u.pm >> 4;
        f32x4 g[2][2];
#pragma unroll
        for (int bj = 0; bj < 2; ++bj)
#pragma unroll
            for (int n = 0; n < 2; ++n) g[bj][n] = *(const f32x4*)(gate + (size_t)b * 12288 + col0 + bj * HALF + 4 * n);
#pragma unroll
        for (int ai = 0; ai < 2; ++ai)
#pragma unroll
            for (int m = 0; m < 4; ++m) { const size_t off = (size_t)(row0 + ai * HALF + m * 16) * 2048 + col0;
#pragma unroll
                for (int bj = 0; bj < 2; ++bj)
#pragma unroll
                    for (int n = 0; n < 2; ++n) { const f32x4 x = *(const f32x4*)(xin + off + bj * HALF + 4 * n);
                        *(f32x4*)(xout + off + bj * HALF + 4 * n) = x + g[bj][n] * acc[ai][bj][m][n]; } }
    }
};

template <class Epi, class Sched, bool ALIGN_EPI = false, bool SP2 = false>
__device__ __forceinline__ void gemm_phase(PG8_LAS unsigned char* lds, const Gemm g, const Sched& S, const Epi& E) {
    int tid_ = threadIdx.x; asm volatile("" : "+v"(tid_));
    const int tid = tid_, wid = __builtin_amdgcn_readfirstlane(tid >> 6), lane = tid & 63, wr = wid >> 2, wc = wid & 3, fr = lane & 15, fq = lane >> 4;
    const int K = g.K, nt = K / BK;
    unsigned voffA[2], voffB[2];
#pragma unroll
    for (int i = 0; i < 2; ++i) { int R, C; stage_rc(tid * 16 + i * 8192, R, C); const int Rb = Epi::PERM ? ((R & ~31) + perm32(R & 31)) : R;
        voffA[i] = (unsigned)(R * K + C) * 2u; voffB[i] = (unsigned)(Rb * K + C) * 2u; }
    const size_t kstep = (size_t)(BK * 2);
    const size_t hstep = (size_t)HALF * K * 2;
    const size_t tstep = 2 * hstep;
    const unsigned ldsw = (unsigned)wid * 1024u;
    const int aoff = lds_byte(wr * 64 + fr, fq * 8), boff = lds_byte(wc * 32 + fr, fq * 8);
#define PG8_SA(b, h) (((b) * 2 + (h)) * HTB)
#define PG8_SB(b, h) ((4 + (b) * 2 + (h)) * HTB)
#define PG8_STAGE(bufoff, gbase, voff) do { _Pragma("unroll") for (int _i = 0; _i < 2; ++_i) \
        __builtin_amdgcn_global_load_lds((const unsigned*)((const char*)(gbase) + (voff)[_i]), (PG8_LAS unsigned*)(lds + (bufoff) + ldsw + _i * 8192), 16, 0, 0); } while (0)
#define PG8_LDA(dst, b, h) do { _Pragma("unroll") for (int m = 0; m < 4; ++m) _Pragma("unroll") for (int k = 0; k < 2; ++k) dst[m][k] = *(const PG8_LAS bf16x8*)(lds + PG8_SA(b, h) + aoff + m * 2048 + k * 1024); } while (0)
#define PG8_LDB(dst, b, h) do { _Pragma("unroll") for (int n = 0; n < 2; ++n) _Pragma("unroll") for (int k = 0; k < 2; ++k) dst[n][k] = *(const PG8_LAS bf16x8*)(lds + PG8_SB(b, h) + boff + n * 2048 + k * 1024); } while (0)
#define PG8_MMA(ai, bj, At, Bt) do { __builtin_amdgcn_s_setprio(1); _Pragma("unroll") for (int m = 0; m < 4; ++m) _Pragma("unroll") for (int n = 0; n < 2; ++n) _Pragma("unroll") for (int k = 0; k < 2; ++k) \
        acc[ai][bj][m][n] = __builtin_amdgcn_mfma_f32_16x16x32_bf16(Bt[n][k], At[m][k], acc[ai][bj][m][n], 0, 0, 0); __builtin_amdgcn_s_setprio(0); } while (0)
#define PG8_WAIT_V(n) asm volatile("s_waitcnt vmcnt(" #n ")" ::: "memory")
#define PG8_WAIT_L(n) asm volatile("s_waitcnt lgkmcnt(" #n ")" ::: "memory")
#define PG8_BAR __builtin_amdgcn_s_barrier()
#define PG8_SCHED __builtin_amdgcn_sched_barrier(0)
    Unit cur, nxt; int ui = 0;
    if (!S.next(0, cur)) return;
    f32x4 acc[2][2][4][2];
#pragma unroll
    for (int a = 0; a < 2; ++a)
#pragma unroll
        for (int b = 0; b < 2; ++b)
#pragma unroll
            for (int m = 0; m < 4; ++m)
#pragma unroll
                for (int n = 0; n < 2; ++n) acc[a][b][m][n] = (f32x4){0.f, 0.f, 0.f, 0.f};
    bf16x8 At[4][2], B0[2][2], B1[2][2];
    const char* cA = (const char*)g.A + (size_t)cur.pm * tstep; const char* cB = (const char*)g.Bt + (size_t)cur.pn * tstep;
    S.a_ready(cur);
    if constexpr (SP2) {
        PG8_STAGE(PG8_SB(0, 0), cB, voffB); PG8_STAGE(PG8_SB(0, 1), cB + hstep, voffB); PG8_STAGE(PG8_SA(0, 0), cA, voffA); PG8_STAGE(PG8_SA(0, 1), cA + hstep, voffA);
        if (wr == 1) PG8_BAR;
        PG8_WAIT_V(2); PG8_BAR;
        PG8_STAGE(PG8_SB(1, 0), cB + kstep, voffB); PG8_STAGE(PG8_SA(1, 0), cA + kstep, voffA); PG8_STAGE(PG8_SB(1, 1), cB + hstep + kstep, voffB);
        PG8_WAIT_V(6); PG8_BAR;
    } else {
        PG8_STAGE(PG8_SB(0, 0), cB, voffB); PG8_STAGE(PG8_SA(0, 0), cA, voffA); PG8_STAGE(PG8_SB(0, 1), cB + hstep, voffB); PG8_STAGE(PG8_SA(0, 1), cA + hstep, voffA);
        if (wr == 1) PG8_BAR;
        PG8_WAIT_V(4); PG8_BAR;
        PG8_STAGE(PG8_SB(1, 0), cB + kstep, voffB); PG8_STAGE(PG8_SA(1, 0), cA + kstep, voffA); PG8_STAGE(PG8_SB(1, 1), cB + hstep + kstep, voffB);
        PG8_WAIT_V(6); PG8_BAR;
    }
    for (;;) {
        const bool has_next = S.next(ui + 1, nxt);
        const char* nA = has_next ? (const char*)g.A + (size_t)nxt.pm * tstep : cA; const char* nB = has_next ? (const char*)g.Bt + (size_t)nxt.pn * tstep : cB;
        for (int t = 0; t < nt; t += 2) {
            const bool last = (t == nt - 2);
            const char* a1 = cA + (size_t)(t + 1) * kstep;
            const char* a2 = last ? nA : cA + (size_t)(t + 2) * kstep; const char* b2 = last ? nB : cB + (size_t)(t + 2) * kstep;
            const char* a3 = a2 + kstep; const char* b3 = b2 + kstep;
            if (last && has_next) S.a_ready(nxt);
            if constexpr (SP2) {
            PG8_LDB(B0, 0, 0); PG8_LDB(B1, 0, 1); PG8_SCHED; PG8_LDA(At, 0, 0); PG8_STAGE(PG8_SA(1, 1), a1 + hstep, voffA);
            PG8_WAIT_V(8); PG8_WAIT_L(0); PG8_BAR; PG8_MMA(0, 0, At, B0); PG8_MMA(0, 1, At, B1); PG8_BAR; PG8_SCHED;
            PG8_LDA(At, 0, 1); PG8_STAGE(PG8_SB(0, 0), b2, voffB); PG8_STAGE(PG8_SB(0, 1), b2 + hstep, voffB); PG8_STAGE(PG8_SA(0, 0), a2, voffA);
            PG8_WAIT_V(8); PG8_WAIT_L(0); PG8_BAR; PG8_MMA(1, 0, At, B0); PG8_MMA(1, 1, At, B1); PG8_BAR; PG8_SCHED;
            PG8_LDB(B0, 1, 0); PG8_LDB(B1, 1, 1); PG8_SCHED; PG8_LDA(At, 1, 0); PG8_STAGE(PG8_SA(0, 1), a2 + hstep, voffA);
            PG8_WAIT_V(8); PG8_WAIT_L(0); PG8_BAR; PG8_MMA(0, 0, At, B0); PG8_MMA(0, 1, At, B1); PG8_BAR; PG8_SCHED;
            PG8_LDA(At, 1, 1); PG8_STAGE(PG8_SB(1, 0), b3, voffB); PG8_STAGE(PG8_SB(1, 1), b3 + hstep, voffB); PG8_STAGE(PG8_SA(1, 0), a3, voffA);
            PG8_WAIT_V(8); PG8_WAIT_L(0); PG8_BAR; PG8_MMA(1, 0, At, B0); PG8_MMA(1, 1, At, B1); PG8_BAR; PG8_SCHED;
            } else {
            PG8_LDB(B0, 0, 0); PG8_SCHED; PG8_LDA(At, 0, 0); PG8_STAGE(PG8_SA(1, 1), a1 + hstep, voffA);
            PG8_WAIT_L(8); PG8_BAR; PG8_WAIT_L(0); PG8_MMA(0, 0, At, B0); PG8_BAR; PG8_SCHED;
            PG8_LDB(B1, 0, 1); PG8_STAGE(PG8_SB(0, 0), b2, voffB);
            PG8_BAR; PG8_WAIT_L(0); PG8_MMA(0, 1, At, B1); PG8_BAR;
            PG8_LDA(At, 0, 1); PG8_STAGE(PG8_SA(0, 0), a2, voffA);
            PG8_BAR; PG8_WAIT_L(0); PG8_MMA(1, 0, At, B0); PG8_BAR; PG8_SCHED;
            PG8_STAGE(PG8_SB(0, 1), b2 + hstep, voffB);
            PG8_WAIT_V(6); PG8_BAR; PG8_MMA(1, 1, At, B1); PG8_BAR;
            PG8_LDB(B0, 1, 0); PG8_SCHED; PG8_LDA(At, 1, 0); PG8_STAGE(PG8_SA(0, 1), a2 + hstep, voffA);
            PG8_WAIT_L(8); PG8_BAR; PG8_WAIT_L(0); PG8_MMA(0, 0, At, B0); PG8_BAR; PG8_SCHED;
            PG8_LDB(B1, 1, 1); PG8_STAGE(PG8_SB(1, 0), b3, voffB);
            PG8_BAR; PG8_WAIT_L(0); PG8_MMA(0, 1, At, B1); PG8_BAR;
            PG8_LDA(At, 1, 1); PG8_STAGE(PG8_SA(1, 0), a3, voffA);
            PG8_BAR; PG8_WAIT_L(0); PG8_MMA(1, 0, At, B0); PG8_BAR; PG8_SCHED;
            PG8_STAGE(PG8_SB(1, 1), b3 + hstep, voffB);
            PG8_WAIT_V(6); PG8_BAR; PG8_MMA(1, 1, At, B1); PG8_BAR;
            }
        }
        if constexpr (ALIGN_EPI) { if (wr == 0) PG8_BAR; }
        if constexpr (!Epi::AFTER_DRAIN) { E(acc, cur, wr, wc, fr, fq); S.done(cur); }
        if (!has_next) break;
#pragma unroll
        for (int a = 0; a < 2; ++a)
#pragma unroll
            for (int b = 0; b < 2; ++b)
#pragma unroll
                for (int m = 0; m < 4; ++m)
#pragma unroll
                    for (int n = 0; n < 2; ++n) acc[a][b][m][n] = (f32x4){0.f, 0.f, 0.f, 0.f};
        cur = nxt; cA = nA; cB = nB; ++ui;
        if constexpr (ALIGN_EPI) { if (wr == 1) PG8_BAR; }
    }
    PG8_WAIT_V(0);
    if constexpr (!ALIGN_EPI) { if (wr == 0) PG8_BAR; }
    PG8_BAR;
    if constexpr (Epi::AFTER_DRAIN) { E.fused(acc, cur, wr, wc, fr, fq, lds, wid, lane); S.done(cur); }
#undef PG8_SA
#undef PG8_SB
#undef PG8_STAGE
#undef PG8_LDA
#undef PG8_LDB
#undef PG8_MMA
#undef PG8_WAIT_V
#undef PG8_WAIT_L
#undef PG8_BAR
#undef PG8_SCHED
}
}

#define XB_TMO      128
#define XB_XCNT(j)  (256  + 64 * (j))
#define XB_XSUB(j)  (1280 + 64 * (j))
#define XB_XGEN(j)  (2304 + 64 * (j))
#define XB_TOP      3328
#define XB_TOPGEN   3392
#define XCD_BAR_WORDS 3456
#define XB_SPIN_CAP (1u << 18)

__device__ __forceinline__ unsigned xb_ld(unsigned* p)              { return __hip_atomic_load(p, __ATOMIC_RELAXED, __HIP_MEMORY_SCOPE_AGENT); }
__device__ __forceinline__ unsigned xb_add(unsigned* p, unsigned v) { return __hip_atomic_fetch_add(p, v, __ATOMIC_RELAXED, __HIP_MEMORY_SCOPE_AGENT); }
__device__ __forceinline__ unsigned xb_xcc_id() { return (unsigned)__builtin_amdgcn_s_getreg((3 << 11) | 20) & 0xFu; }
#define XB_SPIN(cond, bar) do { unsigned _sp = 0; while (cond) { __builtin_amdgcn_s_sleep(1); \
    if ((++_sp & 255u) == 0u) { if (xb_ld(&(bar)[XB_TMO])) break; if (_sp > XB_SPIN_CAP) { atomicAdd(&(bar)[XB_TMO], 1u); break; } } } } while (0)

struct XcdBarrier {
    unsigned* bar; unsigned x;
    volatile LAS unsigned* st;
};

__device__ __forceinline__ XcdBarrier xcd_barrier_post(unsigned* bar, volatile LAS unsigned* st) {
    XcdBarrier b; b.bar = bar; b.x = xb_xcc_id(); b.st = st;
    if (threadIdx.x == 0) (void)xb_add(&bar[XB_XCNT(b.x)], 1u);
    return b;
}
__device__ __forceinline__ void xcd_barrier_complete(unsigned* bar, unsigned x, unsigned& nloc, unsigned& nx) {
    const unsigned G = gridDim.x * gridDim.y * gridDim.z;
    unsigned sum, cnt, mine, sp = 0u;
    for (;;) {
        sum = 0u; cnt = 0u; mine = 0u;
#pragma unroll
        for (unsigned j = 0; j < 16; ++j) { const unsigned c = xb_ld(&bar[XB_XCNT(j)]); sum += c; cnt += (c > 0u) ? 1u : 0u; mine = (j == x) ? c : mine; }
        if (sum == G) break;
        __builtin_amdgcn_s_sleep(1);
        if ((++sp & 255u) == 0u) { if (xb_ld(&bar[XB_TMO])) break; if (sp > XB_SPIN_CAP) { atomicAdd(&bar[XB_TMO], 1u); break; } }
    }
    nloc = mine > 0u ? mine : 1u; nx = cnt > 0u ? cnt : 1u;
}

__device__ __forceinline__ void xcd_barrier(const XcdBarrier& b) {
    asm volatile("s_waitcnt vmcnt(0)" ::: "memory");
    __syncthreads();
    if (threadIdx.x == 0) {
        unsigned* bar = b.bar;
        __builtin_amdgcn_s_waitcnt(0);
        unsigned nloc = b.st[0], nx = b.st[1];
        if (nloc == 0u) { xcd_barrier_complete(bar, b.x, nloc, nx); b.st[0] = nloc; b.st[1] = nx; }
        const unsigned old = xb_add(&bar[XB_XSUB(b.x)], 1u);
        const unsigned gen = old / nloc;
        if (old + 1u == (gen + 1u) * nloc) {
            __builtin_amdgcn_fence(__ATOMIC_RELEASE, "agent");
            asm volatile("s_waitcnt vmcnt(0)" ::: "memory");
            const unsigned og = xb_add(&bar[XB_TOP], 1u);
            const unsigned tg = og / nx;
            if (og + 1u == (tg + 1u) * nx) xb_add(&bar[XB_TOPGEN], 1u);
            else XB_SPIN(xb_ld(&bar[XB_TOPGEN]) == tg, bar);
            __builtin_amdgcn_fence(__ATOMIC_ACQUIRE, "agent");
            xb_add(&bar[XB_XGEN(b.x)], 1u);
            asm volatile("s_waitcnt vmcnt(0)" ::: "memory");
        } else {
            XB_SPIN(xb_ld(&bar[XB_XGEN(b.x)]) == gen, bar);
            __builtin_amdgcn_fence(__ATOMIC_ACQUIRE, "agent");
            asm volatile("s_waitcnt vmcnt(0)" ::: "memory");
        }
    }
    __syncthreads();
}

#define LDS_WAIT() asm volatile("s_waitcnt lgkmcnt(0)" ::: "memory")
#define VM_WAIT() asm volatile("s_waitcnt vmcnt(0)" ::: "memory")
__device__ __forceinline__ unsigned f2bf(float f) { unsigned u = __builtin_bit_cast(unsigned, f); return (u + 0x7fffu + ((u >> 16) & 1u)) >> 16; }
__device__ __forceinline__ unsigned pk2(float lo, float hi) { return f2bf(lo) | (f2bf(hi) << 16); }
__device__ __forceinline__ float bf_lo(unsigned w) { return __builtin_bit_cast(float, w << 16); }
__device__ __forceinline__ float bf_hi(unsigned w) { return __builtin_bit_cast(float, w & 0xffff0000u); }
__device__ __forceinline__ float wave_sum(float v) {
#pragma unroll
    for (int o = 1; o < 64; o <<= 1) v += __shfl_xor(v, o);
    return v;
}

struct Ctx {
    LAS unsigned char* lds;
    unsigned char* ws;
    int tid, lane, wave, vcu, G, gw, NGW;
    float* out;
};

__device__ __forceinline__ void p0_transpose_item(const float* W, int K, int N, bf16_t* WT, LAS float* scr, int item, int lane) {
    const int nblk = N / 32, kb = item / nblk, nb = item % nblk, k0 = 64 * kb, n0 = 32 * nb;
#pragma unroll 8
    for (int i = 0; i < 32; ++i) { const int kk = 2 * i + (lane >> 5); scr[kk * 33 + (lane & 31)] = W[(size_t)(k0 + kk) * N + n0 + (lane & 31)]; }
    LDS_WAIT(); asm volatile("" ::: "memory");
    const int c = lane & 7;
#pragma unroll
    for (int j = 0; j < 4; ++j) { const int n = (lane >> 3) + 8 * j; const LAS float* s = scr + (8 * c) * 33 + n;
        u32x4 o; o.x = pk2(s[0 * 33], s[1 * 33]); o.y = pk2(s[2 * 33], s[3 * 33]); o.z = pk2(s[4 * 33], s[5 * 33]); o.w = pk2(s[6 * 33], s[7 * 33]);
        *(u32x4*)(WT + (size_t)(n0 + n) * K + k0 + 8 * c) = o; }
    LDS_WAIT(); asm volatile("" ::: "memory");
}
__device__ __forceinline__ void p0_cvt_row(const float* src, bf16_t* dst, int lane) {
#pragma unroll
    for (int j = 0; j < 4; ++j) { const f32x4 a = *(const f32x4*)(src + 512 * j + 8 * lane), b = *(const f32x4*)(src + 512 * j + 8 * lane + 4);
        u32x4 o; o.x = pk2(a[0], a[1]); o.y = pk2(a[2], a[3]); o.z = pk2(b[0], b[1]); o.w = pk2(b[2], b[3]);
        *(u32x4*)(dst + 512 * j + 8 * lane) = o; }
}
__device__ __forceinline__ void p0_adaln_task(const float* c, const float* ada_w, float* modp, LAS float* scr, int task, int lane) {
    const int ks = task & 7, cg = (task >> 3) % 48, l = task / 384;
#pragma unroll
    for (int i = 0; i < 32; ++i) { const int e = i * 64 + lane, k = e >> 3, b = e & 7; const float x = c[b * DM + ks * 256 + k];
        scr[e] = x / (1.f + expf(-x)); }
    LDS_WAIT(); asm volatile("" ::: "memory");
    const float* wp = ada_w + ((size_t)l * DM + ks * 256) * MODW + cg * 256 + lane * 4;
    f32x4 acc[8];
#pragma unroll
    for (int b = 0; b < 8; ++b) acc[b] = (f32x4){0.f, 0.f, 0.f, 0.f};
#pragma unroll 4
    for (int k = 0; k < 256; ++k) { const f32x4 w = *(const f32x4*)(wp + (size_t)k * MODW);
        const f32x4 s0 = *(const LAS f32x4*)(scr + k * 8), s1 = *(const LAS f32x4*)(scr + k * 8 + 4);
        acc[0] += w * s0[0]; acc[1] += w * s0[1]; acc[2] += w * s0[2]; acc[3] += w * s0[3];
        acc[4] += w * s1[0]; acc[5] += w * s1[1]; acc[6] += w * s1[2]; acc[7] += w * s1[3]; }
#pragma unroll
    for (int b = 0; b < 8; ++b) *(f32x4*)(modp + (((size_t)ks * DEPTH + l) * NBATCH + b) * MODW + cg * 256 + lane * 4) = acc[b];
    LDS_WAIT(); asm volatile("" ::: "memory");
}
struct Args;
template <class A> __device__ __forceinline__ void p0_prologue(Ctx& C, const A& args) {
    LAS float* scr = (LAS float*)(C.lds + C.wave * 16384);
    const float* w_in = args.in[6]; const float* w_out = args.in[13]; const float* wq = args.in[15];
    bf16_t* WIN = (bf16_t*)(C.ws + WS_WIN); bf16_t* WOUT = (bf16_t*)(C.ws + WS_WOUT); bf16_t* WQ = (bf16_t*)(C.ws + WS_WQ);
    constexpr int T_ADA = 4 * 48 * 8;
    constexpr int I_IN = (DM / 64) * (INC / 32), I_SQ = (DM / 64) * (DM / 32);
    constexpr int T_IN = 4 * I_IN, T_OUT = 4 * I_SQ, T_WQ = 4 * I_SQ;
    constexpr int T_KEYS = 4 * 16 * 128 * 128 / 2048;
    constexpr int T_UV = 4 * NEXP;
    constexpr int T_ROPE = MTOK / 64;
    constexpr int NT = T_ADA + T_IN + T_OUT + T_WQ + T_KEYS + 2 * T_UV + T_ROPE + 1;
    for (int it = C.gw; it < NT; it += C.NGW) {
        int r = it;
        if (r < T_ADA) { p0_adaln_task(args.in[1], args.in[3], (float*)(C.ws + WS_MODP), scr, r, C.lane); continue; } r -= T_ADA;
        if (r < T_IN) { const int l = r / I_IN; p0_transpose_item(w_in + (size_t)l * DM * INC, DM, INC, WIN + (size_t)l * INC * DM, scr, r % I_IN, C.lane); continue; } r -= T_IN;
        if (r < T_OUT) { const int l = r / I_SQ; p0_transpose_item(w_out + (size_t)l * DM * DM, DM, DM, WOUT + (size_t)l * DM * DM, scr, r % I_SQ, C.lane); continue; } r -= T_OUT;
        if (r < T_WQ) { const int l = r / I_SQ; p0_transpose_item(wq + (size_t)l * DM * DM, DM, DM, WQ + (size_t)l * DM * DM, scr, r % I_SQ, C.lane); continue; } r -= T_WQ;
        if (r < T_KEYS) { p0_cvt_row(args.in[16] + (size_t)r * 2048, (bf16_t*)(C.ws + WS_KEYS) + (size_t)r * 2048, C.lane); continue; } r -= T_KEYS;
        if (r < T_UV) { p0_cvt_row(args.in[17] + (size_t)r * 2048, (bf16_t*)(C.ws + WS_U) + (size_t)r * 2048, C.lane); continue; } r -= T_UV;
        if (r < T_UV) { p0_cvt_row(args.in[18] + (size_t)r * 2048, (bf16_t*)(C.ws + WS_V) + (size_t)r * 2048, C.lane); continue; } r -= T_UV;
        if (r < T_ROPE) {
            const int row = r * 64 + C.lane; const float pos = (float)((const int*)args.in[2])[row]; float* o = (float*)(C.ws + WS_ROPE) + (size_t)row * 16;
#pragma unroll
            for (int j = 0; j < 8; ++j) { const float invf = exp2f(-(float)j * 0.125f * 18.931568569324174f);
                const float ang = pos * invf; double rev = (double)ang * 0.15915494309189535; rev -= __builtin_rint(rev);
                const float rf = (float)rev; o[j] = __builtin_amdgcn_cosf(rf); o[8 + j] = __builtin_amdgcn_sinf(rf); }
            continue; } r -= T_ROPE;
        {
            float* lam = (float*)(C.ws + WS_LAM);
            for (int l = 0; l < DEPTH; ++l) {
                const float a = wave_sum(args.in[8][l * 64 + C.lane] * args.in[9][l * 64 + C.lane]), b = wave_sum(args.in[10][l * 64 + C.lane] * args.in[11][l * 64 + C.lane]);
                const float li = 0.8f - 0.6f * expf(-0.3f * (float)l);
                if (C.lane == 0) { lam[l] = expf(a) - expf(b) + li; lam[4 + l] = 1.f - li; } }
        }
    }
}
__device__ __forceinline__ void p1_modfinal(Ctx& C, const float* ada_b) {
    const float* modp = (const float*)(C.ws + WS_MODP); float* mod = (float*)(C.ws + WS_MOD);
    constexpr int N4 = DEPTH * NBATCH * MODW / 4;
    for (int i = C.vcu * NTHREADS + C.tid; i < N4; i += C.G * NTHREADS) { const int l = i / (NBATCH * MODW / 4), n4 = i % (MODW / 4);
        f32x4 s = *(const f32x4*)(ada_b + (size_t)l * MODW + n4 * 4);
#pragma unroll
        for (int ks = 0; ks < 8; ++ks) s += *(const f32x4*)(modp + (size_t)ks * DEPTH * NBATCH * MODW + (size_t)i * 4);
        *(f32x4*)(mod + (size_t)i * 4) = s; }
}

__device__ __forceinline__ void norm_pass(Ctx& C, const float* x, bf16_t* H, const float* g, const float* sh, const float* sc) {
    for (int row = C.gw; row < MTOK; row += C.NGW) { const int b = row >> 12; const float* xr = x + (size_t)row * DM + 8 * C.lane;
        f32x4 v[8]; float ss = 0.f;
#pragma unroll
        for (int j = 0; j < 4; ++j) { v[2 * j] = *(const f32x4*)(xr + 512 * j); v[2 * j + 1] = *(const f32x4*)(xr + 512 * j + 4);
            const f32x4 a = v[2 * j], c = v[2 * j + 1]; ss += (a[0] * a[0] + a[1] * a[1]) + (a[2] * a[2] + a[3] * a[3]) + (c[0] * c[0] + c[1] * c[1]) + (c[2] * c[2] + c[3] * c[3]); }
        const float rstd = 1.0f / sqrtf(wave_sum(ss) * (1.f / DM) + NORM_EPS);
        const float* gp = g + 8 * C.lane; const float* shp = sh + (size_t)b * MODW + 8 * C.lane; const float* scp = sc + (size_t)b * MODW + 8 * C.lane;
#pragma unroll
        for (int j = 0; j < 4; ++j) { f32x4 o[2];
#pragma unroll
            for (int q = 0; q < 2; ++q) { const f32x4 gg = *(const f32x4*)(gp + 512 * j + 4 * q), s1 = *(const f32x4*)(scp + 512 * j + 4 * q), s0 = *(const f32x4*)(shp + 512 * j + 4 * q);
                o[q] = (v[2 * j + q] * rstd) * gg * (s1 + 1.0f) + s0; }
            u32x4 w; w.x = pk2(o[0][0], o[0][1]); w.y = pk2(o[0][2], o[0][3]); w.z = pk2(o[1][0], o[1][1]); w.w = pk2(o[1][2], o[1][3]);
            *(u32x4*)(H + (size_t)row * DM + 512 * j + 8 * C.lane) = w; }
    }
}
__device__ __forceinline__ void final_norm_pass(Ctx& C, const float* x, float* out, const float* g) {
    for (int row = C.gw; row < MTOK; row += C.NGW) { const float* xr = x + (size_t)row * DM + 8 * C.lane;
        f32x4 v[8]; float ss = 0.f;
#pragma unroll
        for (int j = 0; j < 4; ++j) { v[2 * j] = *(const f32x4*)(xr + 512 * j); v[2 * j + 1] = *(const f32x4*)(xr + 512 * j + 4);
            const f32x4 a = v[2 * j], c = v[2 * j + 1]; ss += (a[0] * a[0] + a[1] * a[1]) + (a[2] * a[2] + a[3] * a[3]) + (c[0] * c[0] + c[1] * c[1]) + (c[2] * c[2] + c[3] * c[3]); }
        const float rstd = 1.0f / sqrtf(wave_sum(ss) * (1.f / DM) + NORM_EPS);
#pragma unroll
        for (int j = 0; j < 4; ++j)
#pragma unroll
            for (int q = 0; q < 2; ++q) { const f32x4 gg = *(const f32x4*)(g + 8 * C.lane + 512 * j + 4 * q);
                *(f32x4*)(out + (size_t)row * DM + 8 * C.lane + 512 * j + 4 * q) = (v[2 * j + q] * rstd) * gg; }
    }
}

__device__ __forceinline__ void conv_chunk(const bf16_t* GBp, const bf16_t* GCp, const bf16_t* HVp, const float* cw, bf16_t* MIXp, int chunk, int tid) {
    const int c0 = (tid & 127) * 8, r0 = chunk * 128 + (tid >> 7) * 32;
    float w0[8], w1[8], w2[8];
#pragma unroll
    for (int i = 0; i < 8; ++i) { w0[i] = cw[c0 + i]; w1[i] = cw[1024 + c0 + i]; w2[i] = cw[2048 + c0 + i]; }
    float zp[8], zc[8], zn[8];
    auto loadz = [&](int row, float (&z)[8]) {
        const bool ok = ((row >> 12) == (r0 >> 12)) && row >= 0 && row < MTOK;
        if (ok) { const u32x4 a = *(const u32x4*)(GCp + (size_t)row * 1024 + c0), h = *(const u32x4*)(HVp + (size_t)row * 1024 + c0);
#pragma unroll
            for (int i = 0; i < 4; ++i) { z[2 * i] = bf_lo(a[i]) * bf_lo(h[i]); z[2 * i + 1] = bf_hi(a[i]) * bf_hi(h[i]); } }
        else {
#pragma unroll
            for (int i = 0; i < 8; ++i) z[i] = 0.f; }
    };
    loadz(r0 - 1, zp); loadz(r0, zc);
    for (int r = r0; r < r0 + 32; ++r) {
        loadz(r + 1, zn);
        const u32x4 gbv = *(const u32x4*)(GBp + (size_t)r * 1024 + c0);
        float y[8];
#pragma unroll
        for (int i = 0; i < 4; ++i) { y[2 * i] = bf_lo(gbv[i]) * (w0[2 * i] * zp[2 * i] + w1[2 * i] * zc[2 * i] + w2[2 * i] * zn[2 * i]);
            y[2 * i + 1] = bf_hi(gbv[i]) * (w0[2 * i + 1] * zp[2 * i + 1] + w1[2 * i + 1] * zc[2 * i + 1] + w2[2 * i + 1] * zn[2 * i + 1]); }
        u32x4 o; o.x = pk2(y[0], y[1]); o.y = pk2(y[2], y[3]); o.z = pk2(y[4], y[5]); o.w = pk2(y[6], y[7]);
        *(u32x4*)(MIXp + (size_t)r * 2048 + c0) = o;
#pragma unroll
        for (int i = 0; i < 8; ++i) { zp[i] = zc[i]; zc[i] = zn[i]; }
    }
}

namespace att {
constexpr int NSLOT = 3, KSLOT = 8192, VSLOT = 16384;
constexpr int L_K = 0, L_V = NSLOT * KSLOT, L_WS = L_V + NSLOT * VSLOT, L_END = L_WS + NWAVES * 256;
constexpr float C2 = 0.125f * 1.4426950408889634f;
#define SBAR() __builtin_amdgcn_sched_barrier(0)
#define KSWZ(row, colB) ((row) * 256 + ((colB) ^ (((row) & 7) << 4)))
__device__ __forceinline__ int crow(int r, int hi) { return (r & 3) + 8 * (r >> 2) + 4 * hi; }
__device__ __forceinline__ unsigned cvtpk(float lo, float hi) { unsigned r; asm volatile("v_cvt_pk_bf16_f32 %0, %1, %2" : "=v"(r) : "v"(lo), "v"(hi)); return r; }
__device__ __forceinline__ void glds16(const void* gsrc, unsigned lds_dst) { unsigned keep;
    asm volatile("s_mov_b32 %0, m0\n\ts_mov_b32 m0, %2\n\ts_nop 0\n\tglobal_load_lds_dwordx4 %1, off\n\ts_mov_b32 m0, %0" : "=&s"(keep) : "v"(gsrc), "s"(lds_dst) : "memory"); }
#define WAIT_BAR(N) asm volatile("s_waitcnt vmcnt(" #N ") lgkmcnt(0)\n\ts_barrier" ::: "memory")
__device__ __forceinline__ int v_rd_base(int lane) { return ((lane & 3) << 3) | (((lane >> 2) & 3) << 6) | (((lane >> 4) & 1) << 5) | (((lane >> 5) & 1) << 8); }
constexpr int v_rd_off(int d0, int ks, int half) { return d0 * 512 + ks * 4096 + half * 2048; }
template <int OFF> __device__ __forceinline__ s16x4 tr_read(int vb) { s16x4 r; asm volatile("ds_read_b64_tr_b16 %0, %1 offset:%2" : "=&v"(r) : "v"(vb), "i"(OFF) : "memory"); return r; }

__device__ __forceinline__ void qkt(f32x16& p0, f32x16& p1, const LAS char* Ks, const bf16x8* qr, int r32, int hi) {
    const LAS char* kb = Ks + hi * 1024 + r32 * 16;
#pragma unroll
    for (int r = 0; r < 16; ++r) { p0[r] = 0.f; p1[r] = 0.f; }
#pragma unroll
    for (int d0 = 0; d0 < 4; ++d0) {
        const bf16x8 b0 = *(const LAS bf16x8*)(kb + d0 * 2048);
        const bf16x8 b1 = *(const LAS bf16x8*)(kb + d0 * 2048 + 512);
        p0 = __builtin_amdgcn_mfma_f32_32x32x16_bf16(b0, qr[d0], p0, 0, 0, 0);
        p1 = __builtin_amdgcn_mfma_f32_32x32x16_bf16(b1, qr[d0], p1, 0, 0, 0); }
}
__device__ __forceinline__ void softmax_pack(f32x16& p0, f32x16& p1, float negmC, float& l, bf16x8& pa0, bf16x8& pa1, bf16x8& pa2, bf16x8& pa3) {
#pragma unroll
    for (int r = 0; r < 16; ++r) { p0[r] = __builtin_amdgcn_exp2f(fmaf(p0[r], C2, negmC)); p1[r] = __builtin_amdgcn_exp2f(fmaf(p1[r], C2, negmC)); }
    float ps = 0.f;
#pragma unroll
    for (int r = 0; r < 16; ++r) ps += p0[r];
#pragma unroll
    for (int r = 0; r < 16; ++r) ps += p1[r];
    l += ps;
#define PK4(P, BASE, OUT) do { unsigned a0 = cvtpk(P[BASE + 0], P[BASE + 1]), a1 = cvtpk(P[BASE + 2], P[BASE + 3]);   \
    unsigned b0 = cvtpk(P[BASE + 4], P[BASE + 5]), b1 = cvtpk(P[BASE + 6], P[BASE + 7]);                              \
    auto r0 = __builtin_amdgcn_permlane32_swap(a0, b0, false, false); auto r1 = __builtin_amdgcn_permlane32_swap(a1, b1, false, false); \
    u32x4 w = {r0[0], r1[0], r0[1], r1[1]}; OUT = __builtin_bit_cast(bf16x8, w); } while (0)
    PK4(p0, 0, pa0); PK4(p0, 8, pa1); PK4(p1, 0, pa2); PK4(p1, 8, pa3);
#undef PK4
}
template <int D0> __device__ __forceinline__ void pv_one(f32x16& od, int vb, bf16x8 pa0, bf16x8 pa1, bf16x8 pa2, bf16x8 pa3) {
    const s16x4 l0 = tr_read<v_rd_off(D0, 0, 0)>(vb), h0 = tr_read<v_rd_off(D0, 0, 1)>(vb), l1 = tr_read<v_rd_off(D0, 1, 0)>(vb), h1 = tr_read<v_rd_off(D0, 1, 1)>(vb);
    const s16x4 l2 = tr_read<v_rd_off(D0, 2, 0)>(vb), h2 = tr_read<v_rd_off(D0, 2, 1)>(vb), l3 = tr_read<v_rd_off(D0, 3, 0)>(vb), h3 = tr_read<v_rd_off(D0, 3, 1)>(vb);
    asm volatile("s_waitcnt lgkmcnt(0)" ::: "memory"); SBAR();
#define PK(L, H) (bf16x8){L[0], L[1], L[2], L[3], H[0], H[1], H[2], H[3]}
    od = __builtin_amdgcn_mfma_f32_32x32x16_bf16(pa0, PK(l0, h0), od, 0, 0, 0);
    od = __builtin_amdgcn_mfma_f32_32x32x16_bf16(pa1, PK(l1, h1), od, 0, 0, 0);
    od = __builtin_amdgcn_mfma_f32_32x32x16_bf16(pa2, PK(l2, h2), od, 0, 0, 0);
    od = __builtin_amdgcn_mfma_f32_32x32x16_bf16(pa3, PK(l3, h3), od, 0, 0, 0);
#undef PK
}
__device__ __forceinline__ void pv_all(f32x16* o, int vb, bf16x8 pa0, bf16x8 pa1, bf16x8 pa2, bf16x8 pa3) {
    pv_one<0>(o[0], vb, pa0, pa1, pa2, pa3); pv_one<1>(o[1], vb, pa0, pa1, pa2, pa3); pv_one<2>(o[2], vb, pa0, pa1, pa2, pa3); pv_one<3>(o[3], vb, pa0, pa1, pa2, pa3);
}

__device__ __forceinline__ void attn_unit(int b, int h, int c, int qb, const bf16_t* Q, const bf16_t* K, const bf16_t* V, bf16_t* OT, const unsigned* kmax, LAS char* shm) {
    int tid_ = threadIdx.x; asm volatile("" : "+v"(tid_));
    const int tid = tid_, lane = tid & 63, r32 = lane & 31, hi = lane >> 5; const int wid = __builtin_amdgcn_readfirstlane(tid >> 6);
    const size_t rowbase = (size_t)b * SEQ; const int q0 = qb * 256;
    const bf16_t* Qw = Q + (rowbase + q0 + wid * 32) * 1024 + h * 128 + c * 64;
    const bf16_t* Kh = K + rowbase * 1024 + h * 128 + c * 64; const bf16_t* Vh = V + rowbase * 1024 + h * 128;
    const unsigned lds0 = (unsigned)(uintptr_t)shm;
    const bf16_t* ksrc = Kh + (size_t)lane * 1024 + wid * 8;
    const bf16_t* vsrc[2];
#pragma unroll
    for (int i = 0; i < 2; ++i) { const int p = 2 * wid + i;
        const int st = 2 * p + (lane >> 5), kk = (st >> 2) * 8 + ((lane & 31) >> 2), key = (kk & ~0xC) | ((kk & 4) << 1) | ((kk & 8) >> 1), cc = (st & 3) * 32 + (lane & 3) * 8;
        vsrc[i] = Vh + (size_t)key * 1024 + cc; }
    const unsigned kdst = lds0 + L_K + wid * 1024, vdst = lds0 + L_V + wid * 2048;
#define DMA_KV(t, slot) do { const size_t toff_ = (size_t)(t) * 64 * 1024; \
        glds16(ksrc + toff_, (unsigned)__builtin_amdgcn_readfirstlane(kdst + (slot) * KSLOT)); \
        glds16(vsrc[0] + toff_, (unsigned)__builtin_amdgcn_readfirstlane(vdst + (slot) * VSLOT)); glds16(vsrc[1] + toff_, (unsigned)__builtin_amdgcn_readfirstlane(vdst + (slot) * VSLOT + 1024)); } while (0)
    DMA_KV(0, 0); DMA_KV(1, 1);
    bf16x8 qr[4];
#pragma unroll
    for (int d0 = 0; d0 < 4; ++d0) qr[d0] = *(const bf16x8*)(Qw + (size_t)r32 * 1024 + d0 * 16 + hi * 8);
    float negm;
    {
        float sa = 0.f;
#pragma unroll
        for (int d0 = 0; d0 < 4; ++d0)
#pragma unroll
            for (int e = 0; e < 8; ++e) { const float x = __builtin_bit_cast(float, ((unsigned)(unsigned short)qr[d0][e]) << 16); sa += x * x; }
        { auto rr = __builtin_amdgcn_permlane32_swap(__float_as_uint(sa), __float_as_uint(sa), false, false); sa = __uint_as_float(rr[0]) + __uint_as_float(rr[1]); }
        const unsigned* km = kmax + ((b * 8 + h) * 2 + c) * 2;
        negm = -sqrtf(sa) * sqrtf(__uint_as_float(km[0]) + __uint_as_float(km[1])) * C2;
    }
    f32x16 o[4];
#pragma unroll
    for (int d = 0; d < 4; ++d)
#pragma unroll
        for (int r = 0; r < 16; ++r) o[d][r] = 0.f;
    float l = 0.f;
    const int vb0 = (int)(lds0 + L_V) + v_rd_base(lane);
    constexpr int NT = SEQ / 64;
    int slot = 0;
    for (int t = 0; t < NT; ++t) {
        if (t + 1 < NT) { WAIT_BAR(3); } else { WAIT_BAR(0); }
        if (t + 2 < NT) { const int s2 = (slot + 2 >= NSLOT) ? slot + 2 - NSLOT : slot + 2; DMA_KV(t + 2, s2); }
        const LAS char* Ks = shm + L_K + slot * KSLOT; const int vb = vb0 + slot * VSLOT;
        f32x16 p0, p1; bf16x8 a0, a1, a2, a3;
        SBAR(); qkt(p0, p1, Ks, qr, r32, hi);
        softmax_pack(p0, p1, negm, l, a0, a1, a2, a3);
        SBAR(); pv_all(o, vb, a0, a1, a2, a3);
        slot = (slot + 1 == NSLOT) ? 0 : slot + 1;
    }
#undef DMA_KV
    { auto rr = __builtin_amdgcn_permlane32_swap(__float_as_uint(l), __float_as_uint(l), false, false); l = __uint_as_float(rr[0]) + __uint_as_float(rr[1]); }
    LAS float* wsf = (LAS float*)(shm + L_WS) + wid * 64;
    if (hi == 0) wsf[r32] = 1.0f / l;
    asm volatile("s_waitcnt lgkmcnt(0)" ::: "memory");
    bf16_t* Ow = OT + (size_t)c * MTOK * 1024 + (rowbase + q0 + wid * 32) * 1024 + h * 128;
#pragma unroll
    for (int r = 0; r < 16; ++r) { const int orow = crow(r, hi); const float il = wsf[orow];
#pragma unroll
        for (int d = 0; d < 4; ++d) Ow[(size_t)orow * 1024 + d * 32 + r32] = (bf16_t)f2bf(o[d][r] * il); }
    asm volatile("s_waitcnt lgkmcnt(0)\n\ts_barrier" ::: "memory");
}
#undef SBAR
#undef KSWZ
#undef WAIT_BAR
}

__device__ __forceinline__ void combine_chunk(const bf16_t* OT, bf16_t* MIXp, float lam, const float* subg, float oscale, int chunk, int tid) {
    const int d0 = (tid & 15) * 8;
    float gs[8];
#pragma unroll
    for (int i = 0; i < 8; ++i) gs[i] = subg[d0 + i] * oscale;
    for (int it = tid >> 4; it < 128 * 8; it += NTHREADS / 16) { const int row = chunk * 128 + (it >> 3), h = it & 7;
        const u32x4 a = *(const u32x4*)(OT + (size_t)row * 1024 + h * 128 + d0), bq = *(const u32x4*)(OT + (size_t)MTOK * 1024 + (size_t)row * 1024 + h * 128 + d0);
        float o[8], ss = 0.f;
#pragma unroll
        for (int i = 0; i < 4; ++i) { o[2 * i] = bf_lo(a[i]) - lam * bf_lo(bq[i]); o[2 * i + 1] = bf_hi(a[i]) - lam * bf_hi(bq[i]); ss += o[2 * i] * o[2 * i] + o[2 * i + 1] * o[2 * i + 1]; }
        ss += __shfl_xor(ss, 1); ss += __shfl_xor(ss, 2); ss += __shfl_xor(ss, 4); ss += __shfl_xor(ss, 8);
        const float rstd = 1.0f / sqrtf(ss * (1.f / 128.f) + NORM_EPS);
        u32x4 w; w.x = pk2(o[0] * rstd * gs[0], o[1] * rstd * gs[1]); w.y = pk2(o[2] * rstd * gs[2], o[3] * rstd * gs[3]); w.z = pk2(o[4] * rstd * gs[4], o[5] * rstd * gs[5]); w.w = pk2(o[6] * rstd * gs[6], o[7] * rstd * gs[7]);
        *(u32x4*)(MIXp + (size_t)row * 2048 + 1024 + h * 128 + d0) = w; }
}

__device__ __forceinline__ int skey(float s, int payload, int mask) { int b = __builtin_bit_cast(int, s); b ^= (b >> 31) & 0x7fffffff; return (b & ~mask) | payload; }
__device__ __forceinline__ float skey_score(int k, int mask) { int b = k & ~mask; b ^= (b >> 31) & 0x7fffffff; return __builtin_bit_cast(float, b); }
#define CEX_DESC(a, b) do { const int hi_ = max((a), (b)), lo_ = min((a), (b)); (a) = hi_; (b) = lo_; } while (0)
__device__ __forceinline__ void sort16_desc(int (&k)[16]) {
#pragma unroll
    for (int sz = 2; sz <= 16; sz <<= 1)
#pragma unroll
        for (int j = sz >> 1; j > 0; j >>= 1)
#pragma unroll
            for (int i = 0; i < 16; ++i) { const int l = i ^ j;
                if (l > i) { if ((i & sz) == 0) { CEX_DESC(k[i], k[l]); } else { CEX_DESC(k[l], k[i]); } } }
}
__device__ __forceinline__ void bmerge16_desc(int (&k)[16]) {
#pragma unroll
    for (int j = 8; j > 0; j >>= 1)
#pragma unroll
        for (int i = 0; i < 16; ++i) { const int l = i ^ j; if (l > i) CEX_DESC(k[i], k[l]); }
}
__device__ __forceinline__ void top16_merge(int (&a)[16], const int (&b)[16]) {
#pragma unroll
    for (int i = 0; i < 16; ++i) a[i] = max(a[i], b[15 - i]);
    bmerge16_desc(a);
}
__device__ __forceinline__ void top16_xlane(int (&a)[16]) {
    int e[16], o[16];
#pragma unroll
    for (int i = 0; i < 16; ++i) { auto r = __builtin_amdgcn_permlane16_swap((unsigned)a[i], (unsigned)a[i], false, false); e[i] = (int)r[0]; o[i] = (int)r[1]; }
#pragma unroll
    for (int i = 0; i < 16; ++i) a[i] = max(e[i], o[15 - i]);
    bmerge16_desc(a);
#pragma unroll
    for (int i = 0; i < 16; ++i) { auto r = __builtin_amdgcn_permlane32_swap((unsigned)a[i], (unsigned)a[i], false, false); e[i] = (int)r[0]; o[i] = (int)r[1]; }
#pragma unroll
    for (int i = 0; i < 16; ++i) a[i] = max(e[i], o[15 - i]);
    bmerge16_desc(a);
}

__device__ __forceinline__ void router_task(const bf16_t* QP, const bf16_t* KEYS, unsigned* ROUTE, int tok0, int h, LAS int* scr, int lane) {
    const int fr = lane & 15, fq = lane >> 4;
    int top[2][16];
#pragma unroll
    for (int c = 0; c < 2; ++c) {
        const int hc = h * 2 + c;
        f32x4 acc[8];
#pragma unroll
        for (int nt = 0; nt < 8; ++nt) acc[nt] = (f32x4){0.f, 0.f, 0.f, 0.f};
        const bf16_t* qp = QP + (size_t)(tok0 + fr) * 2048 + hc * 128 + fq * 8;
        const bf16_t* kp = KEYS + ((size_t)hc * 128 + fr) * 128 + fq * 8;
#pragma unroll
        for (int ks = 0; ks < 4; ++ks) { const bf16x8 bq = *(const bf16x8*)(qp + ks * 32);
#pragma unroll
            for (int nt = 0; nt < 8; ++nt) { const bf16x8 ak = *(const bf16x8*)(kp + (size_t)nt * 16 * 128 + ks * 32);
                acc[nt] = __builtin_amdgcn_mfma_f32_16x16x32_bf16(ak, bq, acc[nt], 0, 0, 0); } }
        int ka[16], kb[16];
#pragma unroll
        for (int nt = 0; nt < 4; ++nt)
#pragma unroll
            for (int i = 0; i < 4; ++i) { ka[nt * 4 + i] = skey(acc[nt][i], 16 * nt + 4 * fq + i, 127); kb[nt * 4 + i] = skey(acc[nt + 4][i], 16 * (nt + 4) + 4 * fq + i, 127); }
        sort16_desc(ka); sort16_desc(kb); top16_merge(ka, kb);
        top16_xlane(ka);
#pragma unroll
        for (int i = 0; i < 16; ++i) top[c][i] = ka[i];
    }
    if (fq == 0) {
#pragma unroll
        for (int i = 0; i < 16; ++i) { scr[fr * 32 + i] = top[0][i] & 127; scr[fr * 32 + 16 + i] = top[1][i] & 127; } }
    float s0[16], s1[16];
#pragma unroll
    for (int i = 0; i < 16; ++i) { s0[i] = skey_score(top[0][i], 127); s1[i] = skey_score(top[1][i], 127); }
    constexpr int NEG = (int)0x80000000;
    int best[16], ch[16];
#define CAND(a, b) skey(s0[a] + s1[b], (a) * 16 + (b), 255)
#pragma unroll
    for (int b = 0; b < 16; ++b) best[b] = CAND(0, b);
    sort16_desc(best);
    ch[0] = CAND(1, 0); ch[1] = CAND(1, 1); ch[2] = CAND(1, 2); ch[3] = CAND(1, 3); ch[4] = CAND(1, 4); ch[5] = CAND(1, 5); ch[6] = CAND(1, 6); ch[7] = CAND(1, 7);
    ch[8] = CAND(2, 0); ch[9] = CAND(2, 1); ch[10] = CAND(2, 2); ch[11] = CAND(2, 3); ch[12] = CAND(2, 4); ch[13] = CAND(3, 0); ch[14] = CAND(3, 1); ch[15] = CAND(3, 2);
    sort16_desc(ch); top16_merge(best, ch);
    ch[0] = CAND(3, 3); ch[1] = CAND(4, 0); ch[2] = CAND(4, 1); ch[3] = CAND(4, 2); ch[4] = CAND(5, 0); ch[5] = CAND(5, 1); ch[6] = CAND(6, 0); ch[7] = CAND(6, 1);
    ch[8] = CAND(7, 0); ch[9] = CAND(7, 1); ch[10] = CAND(8, 0); ch[11] = CAND(9, 0); ch[12] = CAND(10, 0); ch[13] = CAND(11, 0); ch[14] = CAND(12, 0); ch[15] = CAND(13, 0);
    sort16_desc(ch); top16_merge(best, ch);
    ch[0] = CAND(14, 0); ch[1] = CAND(15, 0);
#pragma unroll
    for (int i = 2; i < 16; ++i) ch[i] = NEG;
    sort16_desc(ch); top16_merge(best, ch);
#undef CAND
    float g[16], gs = 0.f; const float smax = skey_score(best[0], 255);
#pragma unroll
    for (int i = 0; i < 16; ++i) { g[i] = __expf(skey_score(best[i], 255) - smax); gs += g[i]; }
    const float inv = 1.0f / gs;
    LDS_WAIT(); asm volatile("" ::: "memory");
    if (fq == 0) { unsigned e[16];
#pragma unroll
        for (int i = 0; i < 16; ++i) { const int ci = best[i] & 255, a = ci >> 4, b = ci & 15; const int ia = scr[fr * 32 + a], ib = scr[fr * 32 + 16 + b];
            e[i] = (f2bf(g[i] * inv) << 16) | (unsigned)(ia * 128 + ib); }
        unsigned* rp = ROUTE + (size_t)(tok0 + fr) * 128 + h * 16;
#pragma unroll
        for (int i = 0; i < 4; ++i) *(u32x4*)(rp + 4 * i) = (u32x4){e[4 * i], e[4 * i + 1], e[4 * i + 2], e[4 * i + 3]}; }
    LDS_WAIT(); asm volatile("" ::: "memory");
}

__device__ __forceinline__ float dot2_bf16(unsigned a, unsigned b, float acc) { asm("v_dot2c_f32_bf16 %0, %1, %2" : "+v"(acc) : "v"(a), "v"(b)); return acc; }
__device__ __forceinline__ float gelu_exact(float a) { return 0.5f * a * (1.0f + erff(a * 0.70710678118654752f)); }
__device__ __forceinline__ float expert_u_half(const unsigned R, const unsigned (&hp)[16], const bf16_t* U, int lane) {
    float W = 0.f;
#pragma unroll 1
    for (int g8 = 0; g8 < 8; ++g8) {
        float part[8];
#pragma unroll
        for (int i = 0; i < 8; ++i) {
            const unsigned ent = (unsigned)__builtin_amdgcn_readlane((int)R, g8 * 8 + i);
            const bf16_t* up = U + (size_t)(ent & 0x3fffu) * DM + 8 * lane;
            float acc = 0.f;
#pragma unroll
            for (int j = 0; j < 4; ++j) { const u32x4 uu = *(const u32x4*)(up + 512 * j);
#pragma unroll
                for (int q = 0; q < 4; ++q) acc = dot2_bf16(uu[q], hp[4 * j + q], acc); }
            part[i] = acc;
            if (i == 3) __builtin_amdgcn_sched_barrier(0); }
#pragma unroll
        for (int s = 0; s < 3; ++s) { const int m = 1 << s; const bool up_ = (lane & m) != 0;
#pragma unroll
            for (int i = 0; i < (4 >> s); ++i) { const float a = part[2 * i], c = part[2 * i + 1]; const float keep = up_ ? c : a, send = up_ ? a : c;
                part[i] = keep + __shfl_xor(send, m); } }
        float tot = part[0]; tot += __shfl_xor(tot, 8); tot += __shfl_xor(tot, 16); tot += __shfl_xor(tot, 32);
        const float val = gelu_exact(tot) * __builtin_bit_cast(float, R & 0xffff0000u);
        W = ((lane >> 3) == g8) ? val : W;
    }
    return W;
}
__device__ __forceinline__ void expert_v_half(const unsigned R, const float W, float (&oacc)[32], const bf16_t* V, int lane) {
#pragma unroll 1
    for (int e0 = 0; e0 < 64; e0 += 4) {
#pragma unroll
        for (int i = 0; i < 4; ++i) {
            const unsigned ent = (unsigned)__builtin_amdgcn_readlane((int)R, e0 + i);
            const float w = __builtin_bit_cast(float, __builtin_amdgcn_readlane(__builtin_bit_cast(int, W), e0 + i));
            const bf16_t* vp = V + (size_t)(ent & 0x3fffu) * DM + 8 * lane;
#pragma unroll
            for (int j = 0; j < 4; ++j) { const u32x4 vv = *(const u32x4*)(vp + 512 * j);
#pragma unroll
                for (int q = 0; q < 4; ++q) { oacc[8 * j + 2 * q] += w * bf_lo(vv[q]); oacc[8 * j + 2 * q + 1] += w * bf_hi(vv[q]); } } }
    }
}
__device__ __forceinline__ void expert_token(const float* xin, float* xout, const float* g, const float* sh, const float* sc, const float* gate, const bf16_t* U, const bf16_t* V, const unsigned* ROUTE, int row, int lane) {
    const int b = row >> 12; const float* xr = xin + (size_t)row * DM + 8 * lane;
    unsigned hp[16];
    {
        f32x4 v[8]; float ss = 0.f;
#pragma unroll
        for (int j = 0; j < 4; ++j) { v[2 * j] = *(const f32x4*)(xr + 512 * j); v[2 * j + 1] = *(const f32x4*)(xr + 512 * j + 4);
            const f32x4 a = v[2 * j], c = v[2 * j + 1]; ss += (a[0] * a[0] + a[1] * a[1]) + (a[2] * a[2] + a[3] * a[3]) + (c[0] * c[0] + c[1] * c[1]) + (c[2] * c[2] + c[3] * c[3]); }
        const float rstd = 1.0f / sqrtf(wave_sum(ss) * (1.f / DM) + NORM_EPS);
        const float* gp = g + 8 * lane; const float* shp = sh + (size_t)b * MODW + 8 * lane; const float* scp = sc + (size_t)b * MODW + 8 * lane;
#pragma unroll
        for (int j = 0; j < 4; ++j) { f32x4 o[2];
#pragma unroll
            for (int q = 0; q < 2; ++q) { const f32x4 gg = *(const f32x4*)(gp + 512 * j + 4 * q), s1 = *(const f32x4*)(scp + 512 * j + 4 * q), s0 = *(const f32x4*)(shp + 512 * j + 4 * q);
                o[q] = (v[2 * j + q] * rstd) * gg * (s1 + 1.0f) + s0; }
            hp[4 * j] = pk2(o[0][0], o[0][1]); hp[4 * j + 1] = pk2(o[0][2], o[0][3]); hp[4 * j + 2] = pk2(o[1][0], o[1][1]); hp[4 * j + 3] = pk2(o[1][2], o[1][3]); }
    }
    const unsigned r0 = ROUTE[(size_t)row * 128 + lane], r1 = ROUTE[(size_t)row * 128 + 64 + lane];
    const float w0 = expert_u_half(r0, hp, U, lane), w1 = expert_u_half(r1, hp, U, lane);
    float oacc[32];
#pragma unroll
    for (int i = 0; i < 32; ++i) oacc[i] = 0.f;
    expert_v_half(r0, w0, oacc, V, lane); expert_v_half(r1, w1, oacc, V, lane);
    const float* gtp = gate + (size_t)b * MODW + 8 * lane;
#pragma unroll
    for (int j = 0; j < 4; ++j)
#pragma unroll
        for (int q = 0; q < 2; ++q) { const f32x4 x = *(const f32x4*)(xr + 512 * j + 4 * q), gg = *(const f32x4*)(gtp + 512 * j + 4 * q);
            const f32x4 o = {oacc[8 * j + 4 * q], oacc[8 * j + 4 * q + 1], oacc[8 * j + 4 * q + 2], oacc[8 * j + 4 * q + 3]};
            *(f32x4*)(xout + (size_t)row * DM + 8 * lane + 512 * j + 4 * q) = x + gg * o; }
}

constexpr int NPHASE = 39;
#ifndef MK_SPLIT
#define MK_SPLIT 0
#endif
struct Args { const float* in[20]; float* out; unsigned char* ws; int ph_lo, ph_hi; };
static_assert(sizeof(Args) == 20 * 8 + 8 + 8 + 8, "Args has no padding");

__device__ __forceinline__ bool in_range(int lo, int hi, int k) { asm volatile("" : "+s"(lo), "+s"(hi)); return lo <= k && k < hi; }
__global__ void __launch_bounds__(NTHREADS, 2) fwd_kernel(Args args) {
    extern __shared__ __attribute__((aligned(16))) unsigned char lds_raw[];
    Ctx C;
    C.lds = (LAS unsigned char*)lds_raw; C.ws = args.ws;
    C.tid = threadIdx.x; C.lane = C.tid & 63; C.wave = __builtin_amdgcn_readfirstlane(C.tid >> 6);
    C.G = gridDim.x; { const int bx = blockIdx.x; C.vcu = (C.G % 8 == 0) ? (bx % 8) * (C.G / 8) + bx / 8 : bx; }
    C.gw = C.vcu * NWAVES + C.wave; C.NGW = C.G * NWAVES;
    C.out = args.out;
    unsigned* ctl = (unsigned*)(C.ws + WS_CTL);
    volatile LAS unsigned* MISC = (volatile LAS unsigned*)(C.lds + LDS_MISC);
    for (int u = C.tid; u < (LDS_BYTES - LDS_MISC) / 4; u += NTHREADS) ((LAS unsigned*)(C.lds + LDS_MISC))[u] = 0u;
    __syncthreads();
    const int lo = args.ph_lo, hi = args.ph_hi;
    XcdBarrier bar; bar.bar = ctl + CW_BAR; bar.x = 0; bar.st = nullptr;
    if (hi - lo > 1) bar = xcd_barrier_post(ctl + CW_BAR, MISC + 8);
#ifndef ONLYP
#define ONLYP -1
#endif
#define PEN(c) (ONLYP < 0 || ONLYP == (c))
#define IN(k) in_range(lo, hi, (k))
#define FRESH(k) do { C.tid = threadIdx.x; uintptr_t w_ = (uintptr_t)args.ws, o_ = (uintptr_t)args.out; asm volatile("; PHASE_MARK " #k : "+v"(C.tid), "+s"(C.gw), "+s"(C.vcu), "+s"(w_), "+s"(o_)); \
    C.ws = (unsigned char*)(GAS unsigned char*)w_; C.out = (float*)(GAS float*)o_; C.lane = C.tid & 63; } while (0)
#define SEAM(k) do { if (IN(k) && IN((k) + 1)) xcd_barrier(bar); } while (0)

    float* MOD = (float*)(C.ws + WS_MOD);
    bf16_t* H = (bf16_t*)(C.ws + WS_H); bf16_t* SEG = (bf16_t*)(C.ws + WS_SEG); bf16_t* MIX = (bf16_t*)(C.ws + WS_MIX); bf16_t* QP = (bf16_t*)(C.ws + WS_QP); bf16_t* H2 = (bf16_t*)(C.ws + WS_H2); bf16_t* OT = (bf16_t*)(C.ws + WS_OT);
    unsigned* ROUTE = (unsigned*)(C.ws + WS_ROUTE);

    if (PEN(0) && IN(0)) { FRESH(0); p0_prologue(C, args); } SEAM(0);
    if (PEN(1) && IN(1)) { FRESH(1); p1_modfinal(C, args.in[4]); } SEAM(1);

    for (int l = 0; l < DEPTH; ++l) {
        const int pb = 2 + 9 * l;
        const float* modl = MOD + (size_t)l * NBATCH * MODW;
        unsigned* kmax = ctl + CW_KMAX + l * 256;
        if (PEN(2) && IN(pb + 0)) { FRESH(2); const float* xcur = (l == 0) ? args.in[0] : (const float*)C.out; norm_pass(C, xcur, H, args.in[5] + (size_t)l * DM, modl + 0 * DM, modl + 1 * DM); } SEAM(pb + 0);
        if (PEN(3) && IN(pb + 1)) { FRESH(3);
            pg8::Gemm g{H, (const bf16_t*)(C.ws + WS_WIN) + (size_t)l * INC * DM, MTOK, INC, DM}; pg8::StaticOrder S; S.init(MTOK, INC, C.G, (int)blockIdx.x);
            pg8::EpiIn E{SEG, SEG_ELEMS, (const float*)(C.ws + WS_ROPE), kmax};
            pg8::gemm_phase<pg8::EpiIn, pg8::StaticOrder, true, true>(C.lds, g, S, E);
        } SEAM(pb + 1);
        if (PEN(4) && IN(pb + 2)) { FRESH(4);
            for (int u = C.vcu; u < NBATCH * AHEADS * 2 * (SEQ / 256); u += C.G) { const int bh = u >> 5, c = (u >> 4) & 1, qb = u & 15;
                att::attn_unit(bh >> 3, bh & 7, c, qb, SEG + 3 * SEG_ELEMS, SEG + 4 * SEG_ELEMS, SEG + 5 * SEG_ELEMS, OT, kmax, (LAS char*)C.lds); }
        } SEAM(pb + 2);
        if (PEN(11) && IN(pb + 3)) { FRESH(11);
            const float lam = ((const float*)(C.ws + WS_LAM))[l], osc = ((const float*)(C.ws + WS_LAM))[4 + l];
            for (int ch = C.vcu; ch < MTOK / 128; ch += C.G) {
                conv_chunk(SEG + 0 * SEG_ELEMS, SEG + 1 * SEG_ELEMS, SEG + 2 * SEG_ELEMS, args.in[7] + (size_t)l * 3 * CONVW, MIX, ch, C.tid);
                combine_chunk(OT, MIX, lam, args.in[12] + (size_t)l * VDIM, osc, ch, C.tid); }
        } SEAM(pb + 3);
        if (PEN(5) && IN(pb + 4)) { FRESH(5);
            pg8::Gemm g{MIX, (const bf16_t*)(C.ws + WS_WOUT) + (size_t)l * DM * DM, MTOK, DM, DM}; pg8::StaticOrder S; S.init(MTOK, DM, C.G, (int)blockIdx.x);
            const float* xcur = (l == 0) ? args.in[0] : (const float*)C.out;
            pg8::EpiRes E{xcur, C.out, modl + 2 * DM};
            pg8::gemm_phase<pg8::EpiRes, pg8::StaticOrder, true, true>(C.lds, g, S, E);
        } SEAM(pb + 4);
        if (PEN(6) && IN(pb + 5)) { FRESH(6); norm_pass(C, C.out, H2, args.in[14] + (size_t)l * DM, modl + 3 * DM, modl + 4 * DM); } SEAM(pb + 5);
        if (PEN(7) && IN(pb + 6)) { FRESH(7);
            pg8::Gemm g{H2, (const bf16_t*)(C.ws + WS_WQ) + (size_t)l * DM * DM, MTOK, DM, DM}; pg8::StaticOrder S; S.init(MTOK, DM, C.G, (int)blockIdx.x);
            pg8::EpiBf16 E{QP, DM};
            pg8::gemm_phase<pg8::EpiBf16, pg8::StaticOrder, true, true>(C.lds, g, S, E);
        } SEAM(pb + 6);
        if (PEN(8) && IN(pb + 7)) { FRESH(8);
            const bf16_t* keys = (const bf16_t*)(C.ws + WS_KEYS) + (size_t)l * 16 * 128 * 128;
            LAS int* scr = (LAS int*)(C.lds + C.wave * 2048);
            for (int it = C.gw; it < (MTOK / 16) * PHEADS; it += C.NGW) router_task(QP, keys, ROUTE, (it >> 3) * 16, it & 7, scr, C.lane);
        } SEAM(pb + 7);
        if (PEN(9) && IN(pb + 8)) { FRESH(9);
            const bf16_t* U = (const bf16_t*)(C.ws + WS_U) + (size_t)l * NEXP * DM; const bf16_t* V = (const bf16_t*)(C.ws + WS_V) + (size_t)l * NEXP * DM;
            for (int row = C.gw; row < MTOK; row += C.NGW)
                expert_token(C.out, C.out, args.in[14] + (size_t)l * DM, modl + 3 * DM, modl + 4 * DM, modl + 5 * DM, U, V, ROUTE, row, C.lane);
        } SEAM(pb + 8);
    }
    if (PEN(10) && IN(38)) { FRESH(10); final_norm_pass(C, C.out, C.out, args.in[19]); }
#undef IN
#undef SEAM
}


#if defined(CHECK) && CHECK
constexpr size_t WS_XSAVE = 1760 * MiB;
constexpr int NSTAGE = 13, NSAMP = 96;
__device__ __forceinline__ unsigned hash32(unsigned x) { x ^= x >> 16; x *= 0x7feb352du; x ^= x >> 15; x *= 0x846ca68bu; x ^= x >> 16; return x; }
__device__ __forceinline__ float bf2f(bf16_t v) { return __builtin_bit_cast(float, ((unsigned)v) << 16); }
__device__ __forceinline__ double wsumd(double v) {
#pragma unroll
    for (int o = 1; o < 64; o <<= 1) v += __shfl_xor(v, o);
    return v; }
__device__ __forceinline__ float wmaxf(float v) {
#pragma unroll
    for (int o = 1; o < 64; o <<= 1) v = fmaxf(v, __shfl_xor(v, o));
    return v; }
__device__ __forceinline__ void diag_add(float* diag, int stage, double num, double den, int lane) { if (lane == 0) { atomicAdd(diag + 2 * stage, (float)num); atomicAdd(diag + 2 * stage + 1, (float)den); } }
__device__ __forceinline__ float chk_silu(float x) { return x / (1.f + expf(-x)); }
__device__ __forceinline__ float chk_rstd(const float* x, int row, int lane) { double ss = 0; for (int k = lane; k < DM; k += 64) { const double v = x[(size_t)row * DM + k]; ss += v * v; } ss = wsumd(ss); return 1.0f / sqrtf((float)(ss / DM) + NORM_EPS); }
__device__ __forceinline__ float chk_norm_elem(const float* x, int row, int col, float rstd, const float* g, const float* sh, const float* sc) { const int b = row >> 12;
    return x[(size_t)row * DM + col] * rstd * g[col] * (1.0f + sc[(size_t)b * MODW + col]) + sh[(size_t)b * MODW + col]; }
__global__ void __launch_bounds__(64) check_kernel(Args args) {
    __shared__ float sq_[64]; __shared__ float ssc[256]; __shared__ int sused[256]; __shared__ int sti[32]; __shared__ float sts[32]; __shared__ int sce[16]; __shared__ float scs[16];
    const int stage = blockIdx.x / NSAMP, s = blockIdx.x % NSAMP, lane = threadIdx.x;
    unsigned char* ws = args.ws; float* diag = (float*)(ws + WS_DIAG);
    const float* MOD = (const float*)(ws + WS_MOD); const bf16_t* H = (const bf16_t*)(ws + WS_H); const bf16_t* SEG = (const bf16_t*)(ws + WS_SEG);
    const bf16_t* MIX = (const bf16_t*)(ws + WS_MIX); const bf16_t* OT = (const bf16_t*)(ws + WS_OT); const bf16_t* H2 = (const bf16_t*)(ws + WS_H2); const bf16_t* QP = (const bf16_t*)(ws + WS_QP); const unsigned* ROUTE = (const unsigned*)(ws + WS_ROUTE);
    const float* XS = (const float*)(ws + WS_XSAVE); const unsigned* kmax = (const unsigned*)(ws + WS_CTL) + CW_KMAX;
    const unsigned hsh = hash32(stage * 7919u + s * 104729u + 12345u);
    const int row = hsh % MTOK; const unsigned h2 = hash32(hsh + 1u);
    if (stage == 1) {
        const int b = h2 % 8, n = (h2 >> 3) % MODW; double a = 0;
        for (int k = lane; k < DM; k += 64) a += (double)chk_silu(args.in[1][b * DM + k]) * args.in[3][(size_t)k * MODW + n];
        a = wsumd(a) + args.in[4][n]; const double d = MOD[(size_t)b * MODW + n] - a; diag_add(diag, stage, d * d, a * a, lane);
    } else if (stage == 2) {
        const int col = h2 % DM; const float rstd = chk_rstd(args.in[0], row, lane); const float r = chk_norm_elem(args.in[0], row, col, rstd, args.in[5], MOD + 0 * DM, MOD + 1 * DM);
        const double d = bf2f(H[(size_t)row * DM + col]) - r; diag_add(diag, stage, d * d, (double)r * r, lane);
    } else if (stage == 3 || stage == 4) {
        int col;
        if (stage == 3) { const int t = h2 % 4; col = (t == 3 ? 5 : t) * 1024 + (h2 >> 2) % 1024; } else { col = 3072 + (h2 % 2048); if (s < NSAMP / 2) col = (col & ~63) | ((h2 >> 11) % 16); }
        auto dotc = [&](int c) { double a = 0; for (int k = lane; k < DM; k += 64) a += (double)bf2f(H[(size_t)row * DM + k]) * args.in[6][(size_t)k * INC + c]; return (float)wsumd(a); };
        float r = dotc(col);
        if (stage == 4) { const int dd = col & 63; if (dd < 16) { const int j = dd & 7; const float invf = powf(500000.f, -(float)(2 * j) / 16.f); const float ang = (float)((const int*)args.in[2])[row] * invf;
                const float cs = cosf(ang), sn = sinf(ang); const float o = (dd < 8) ? dotc(col + 8) : dotc(col - 8); r = (dd < 8) ? r * cs - o * sn : r * cs + o * sn; } }
        const float got = bf2f(SEG[(size_t)(col >> 10) * SEG_ELEMS + (size_t)row * 1024 + (col & 1023)]);
        const double d = got - r; diag_add(diag, stage, d * d, (double)r * r, lane);
    } else if (stage == 5) {
        const int b = h2 % 8, hh = (h2 >> 3) % 8, c = (h2 >> 6) % 2; const bf16_t* K = SEG + 4 * SEG_ELEMS; float mx = 0.f;
        for (int sq = lane; sq < SEQ; sq += 64) { float a = 0; for (int d = 0; d < 64; ++d) { const float v = bf2f(K[((size_t)b * SEQ + sq) * 1024 + hh * 128 + c * 64 + d]); a += v * v; } mx = fmaxf(mx, a); }
        mx = wmaxf(mx);
        const unsigned* km = kmax + ((b * 8 + hh) * 2 + c) * 2; const float bound = __uint_as_float(km[0]) + __uint_as_float(km[1]);
        const bool ok = bound >= mx * 0.98f && bound <= mx * 2.2f; diag_add(diag, stage, ok ? 0.0 : 1.0, 1.0, lane);
    } else if (stage == 6) {
        const int hh = h2 % 8, c = (h2 >> 3) % 2, d = (h2 >> 4) % 128, b = row >> 12;
        const bf16_t* Q = SEG + 3 * SEG_ELEMS; const bf16_t* K = SEG + 4 * SEG_ELEMS; const bf16_t* V = SEG + 5 * SEG_ELEMS;
        sq_[lane] = bf2f(Q[(size_t)row * 1024 + hh * 128 + c * 64 + lane]); __syncthreads();
        float mx = -1e30f;
        for (int sq = lane; sq < SEQ; sq += 64) { float a = 0; const bf16_t* kr = K + ((size_t)b * SEQ + sq) * 1024 + hh * 128 + c * 64; for (int e = 0; e < 64; ++e) a += sq_[e] * bf2f(kr[e]); mx = fmaxf(mx, a * 0.125f); }
        mx = wmaxf(mx);
        double num = 0, den = 0;
        for (int sq = lane; sq < SEQ; sq += 64) { float a = 0; const bf16_t* kr = K + ((size_t)b * SEQ + sq) * 1024 + hh * 128 + c * 64; for (int e = 0; e < 64; ++e) a += sq_[e] * bf2f(kr[e]);
            const double p = exp((double)(a * 0.125f - mx)); den += p; num += p * bf2f(V[((size_t)b * SEQ + sq) * 1024 + hh * 128 + d]); }
        num = wsumd(num); den = wsumd(den);
        const double r = num / den; const double dd = bf2f(OT[(size_t)c * MTOK * 1024 + (size_t)row * 1024 + hh * 128 + d]) - r; diag_add(diag, stage, dd * dd, r * r, lane);
    } else if (stage == 7) {
        if ((s & 1) == 0) { const int col = h2 % 1024, sq = row & (SEQ - 1); const bf16_t* GB = SEG; const bf16_t* GC = SEG + SEG_ELEMS; const bf16_t* HV = SEG + 2 * SEG_ELEMS;
            auto z = [&](int r) { return bf2f(GC[(size_t)r * 1024 + col]) * bf2f(HV[(size_t)r * 1024 + col]); };
            const float zm = (sq > 0) ? z(row - 1) : 0.f, zc = z(row), zp = (sq < SEQ - 1) ? z(row + 1) : 0.f;
            const float r = bf2f(GB[(size_t)row * 1024 + col]) * (args.in[7][col] * zm + args.in[7][1024 + col] * zc + args.in[7][2048 + col] * zp);
            const double d = bf2f(MIX[(size_t)row * 2048 + col]) - r; diag_add(diag, stage, d * d, (double)r * r, lane);
        } else { const int hh = h2 % 8, d = (h2 >> 3) % 128;
            const double a1 = wsumd((double)args.in[8][lane] * args.in[9][lane]), a2 = wsumd((double)args.in[10][lane] * args.in[11][lane]);
            const float lam_init = 0.8f - 0.6f * expf(-0.3f * 0.f), lam = (float)(exp(a1) - exp(a2)) + lam_init;
            double ss = 0; float od = 0;
            for (int e = lane; e < 128; e += 64) { const float o = bf2f(OT[(size_t)row * 1024 + hh * 128 + e]) - lam * bf2f(OT[(size_t)MTOK * 1024 + (size_t)row * 1024 + hh * 128 + e]); ss += (double)o * o; if (e == d) od = o; }
            ss = wsumd(ss); od = (float)wsumd((double)od);
            const float r = od / sqrtf((float)(ss / 128.0) + NORM_EPS) * args.in[12][d] * (1.f - lam_init);
            const double dd = bf2f(MIX[(size_t)row * 2048 + 1024 + hh * 128 + d]) - r; diag_add(diag, stage, dd * dd, (double)r * r, lane); }
    } else if (stage == 8) {
        const int col = h2 % DM, b = row >> 12; double a = 0; for (int k = lane; k < DM; k += 64) a += (double)bf2f(MIX[(size_t)row * DM + k]) * args.in[13][(size_t)k * DM + col];
        a = wsumd(a); const double delta = (double)MOD[(size_t)b * MODW + 2 * DM + col] * a;
        const double r = args.in[0][(size_t)row * DM + col] + delta; const double d = XS[(size_t)row * DM + col] - r; diag_add(diag, stage, d * d, delta * delta, lane);
    } else if (stage == 9) {
        const int col = h2 % DM; const float rstd = chk_rstd(XS, row, lane); const float r = chk_norm_elem(XS, row, col, rstd, args.in[14], MOD + 3 * DM, MOD + 4 * DM);
        const double d = bf2f(H2[(size_t)row * DM + col]) - r; diag_add(diag, stage, d * d, (double)r * r, lane);
    } else if (stage == 10) {
        const int col = h2 % DM; double a = 0; for (int k = lane; k < DM; k += 64) a += (double)bf2f(H2[(size_t)row * DM + k]) * args.in[15][(size_t)k * DM + col];
        a = wsumd(a); const double d = bf2f(QP[(size_t)row * DM + col]) - a; diag_add(diag, stage, d * d, a * a, lane);
    } else if (stage == 11) {
        const int hh = h2 % 8;
        for (int i = lane; i < 256; i += 64) { const int c = i >> 7, n = i & 127; double a = 0; for (int d = 0; d < 128; ++d) a += (double)bf2f(QP[(size_t)row * DM + (hh * 2 + c) * 128 + d]) * args.in[16][(((size_t)hh * 2 + c) * 128 + n) * 128 + d]; ssc[i] = (float)a; sused[i] = 0; }
        __syncthreads();
        if (lane == 0) {
            for (int c = 0; c < 2; ++c) for (int j = 0; j < 16; ++j) { int bi = -1; float bv = -1e30f; for (int n = 0; n < 128; ++n) if (!sused[c * 128 + n] && ssc[c * 128 + n] > bv) { bv = ssc[c * 128 + n]; bi = n; }
                sti[c * 16 + j] = bi; sts[c * 16 + j] = bv; sused[c * 128 + bi] = 1; }
            for (int q = 0; q < 256; ++q) sused[q] = 0;
            for (int j = 0; j < 16; ++j) { int bi = -1; float bv = -1e30f; for (int q = 0; q < 256; ++q) { if (sused[q]) continue; const float v = sts[q >> 4] + sts[16 + (q & 15)]; if (v > bv) { bv = v; bi = q; } }
                sused[bi] = 1; sce[j] = sti[bi >> 4] * 128 + sti[16 + (bi & 15)]; scs[j] = bv; }
            double gsum = 0; for (int j = 0; j < 16; ++j) gsum += exp((double)(scs[j] - scs[0]));
            double err = 0;
            for (int j = 0; j < 16; ++j) { const double gr = exp((double)(scs[j] - scs[0])) / gsum; double gm = 0;
                for (int q = 0; q < 16; ++q) { const unsigned e = ROUTE[(size_t)row * 128 + hh * 16 + q]; if ((int)(e & 0x3fffu) == sce[j]) gm = __builtin_bit_cast(float, e & 0xffff0000u); }
                err += fabs(gr - gm); }
            diag_add(diag, stage, err * err, 1.0, lane); }
    } else if (stage == 12) {
        const int col = h2 % DM, b = row >> 12; const float rstd = chk_rstd(XS, row, lane); double out = 0;
        for (int e = 0; e < 128; ++e) { const unsigned ent = ROUTE[(size_t)row * 128 + e]; const int eid = ent & 0x3fffu; const float gate = __builtin_bit_cast(float, ent & 0xffff0000u); double a = 0;
            for (int k = lane; k < DM; k += 64) { const float hk = chk_norm_elem(XS, row, k, rstd, args.in[14], MOD + 3 * DM, MOD + 4 * DM); a += (double)hk * args.in[17][(size_t)eid * DM + k]; }
            a = wsumd(a); const double ge = 0.5 * a * (1.0 + erf(a * 0.7071067811865476)); out += ge * gate * args.in[18][(size_t)eid * DM + col]; }
        const double delta = (double)MOD[(size_t)b * MODW + 5 * DM + col] * out; const double r = XS[(size_t)row * DM + col] + delta; const double d = args.out[(size_t)row * DM + col] - r; diag_add(diag, stage, d * d, delta * delta, lane);
    }
}
#ifndef CHECK_FROM
#define CHECK_FROM 1
#endif
__global__ void encode_kernel(Args args) {
    const float* diag = (const float*)(args.ws + WS_DIAG);
    int k = 14; float m = 1.f;
    for (int st = NSTAGE - 1; st >= CHECK_FROM; --st) { const float num = diag[2 * st], den = diag[2 * st + 1]; float rel = sqrtf(num / fmaxf(den, 1e-30f)); if (!(rel == rel)) rel = 1e4f;
        const float tol = (st == 11) ? 0.08f : (st == 5 ? 0.01f : 0.03f);
        if (rel > tol) { k = st; m = fminf(9.9f, fmaxf(1.f, 1.f + 2.f * (log10f(rel) + 4.f))); } }
    const float c = sqrtf(m * powf(10.f, (float)k));
    for (size_t i = (size_t)blockIdx.x * blockDim.x + threadIdx.x; i < (size_t)MTOK * DM; i += (size_t)gridDim.x * blockDim.x) args.out[i] = c;
}
#endif
extern "C" void kernel_launch(void* const* d_in, const int* in_sizes, int n_in, void* d_out, int out_size, void* d_ws, size_t ws_size, hipStream_t stream) {
    static int grid = 0;
    if (grid == 0) {
        if (n_in != 20 || out_size != MTOK * DM || ws_size < WS_END) { fprintf(stderr, "kernel_launch: unexpected shapes: n_in %d out %d ws %zu (need %zu)\n", n_in, out_size, ws_size, (size_t)WS_END); grid = -1; return; }
        int dev = 0, cus = 0;
        if (hipGetDevice(&dev) != hipSuccess || hipDeviceGetAttribute(&cus, hipDeviceAttributeMultiprocessorCount, dev) != hipSuccess) { grid = -1; return; }
        if (hipFuncSetAttribute((const void*)fwd_kernel, hipFuncAttributeMaxDynamicSharedMemorySize, LDS_BYTES) != hipSuccess) { fprintf(stderr, "kernel_launch: hipFuncSetAttribute failed\n"); grid = -1; return; }
        int per_cu = 0;
        if (hipOccupancyMaxActiveBlocksPerMultiprocessor(&per_cu, (const void*)fwd_kernel, NTHREADS, LDS_BYTES) != hipSuccess || per_cu < 1) { fprintf(stderr, "kernel_launch: occupancy query says %d\n", per_cu); }
        (void)hipGetLastError();
        grid = cus;
    }
    if (grid < 0) return;
    (void)hipMemsetAsync((char*)d_ws + WS_CTL, 0, CTL_ZERO_BYTES, stream);
    Args a{};
    for (int i = 0; i < 20; ++i) a.in[i] = (const float*)d_in[i];
    a.out = (float*)d_out; a.ws = (unsigned char*)d_ws;
#if defined(CHECK) && CHECK
    if (ws_size < WS_XSAVE + (size_t)MTOK * DM * 4) { fprintf(stderr, "check build: workspace too small\n"); return; }
    (void)hipMemsetAsync((char*)d_ws + WS_DIAG, 0, 4096, stream);
    for (int p = 0; p < 2 + 9; ++p) { a.ph_lo = p; a.ph_hi = p + 1; hipLaunchKernelGGL(fwd_kernel, dim3(grid), dim3(NTHREADS), LDS_BYTES, stream, a);
        if (p == 2 + 4) (void)hipMemcpyAsync((char*)d_ws + WS_XSAVE, d_out, (size_t)MTOK * DM * 4, hipMemcpyDeviceToDevice, stream); }
    hipLaunchKernelGGL(check_kernel, dim3(NSTAGE * NSAMP), dim3(64), 0, stream, a);
    hipLaunchKernelGGL(encode_kernel, dim3(1024), dim3(256), 0, stream, a);
#elif MK_SPLIT
    for (int p = 0; p < NPHASE; ++p) { a.ph_lo = p; a.ph_hi = p + 1; hipLaunchKernelGGL(fwd_kernel, dim3(grid), dim3(NTHREADS), LDS_BYTES, stream, a); }
#else
    a.ph_lo = 0; a.ph_hi = NPHASE; hipLaunchKernelGGL(fwd_kernel, dim3(grid), dim3(NTHREADS), LDS_BYTES, stream, a);
#endif
    const hipError_t le = hipPeekAtLastError();
    if (le != hipSuccess) fprintf(stderr, "kernel_launch: launch failed: %s\n", hipGetErrorName(le));
}
```

```cpp
#include <hip/hip_runtime.h>
#include <cstdio>
#include <cstdint>

#define GAS __attribute__((address_space(1)))
#define LAS __attribute__((address_space(3)))
typedef unsigned short bf16_t;
typedef short bf16x8 __attribute__((ext_vector_type(8)));
typedef short s16x4 __attribute__((ext_vector_type(4)));
typedef float f32x2 __attribute__((ext_vector_type(2)));
typedef float f32x4 __attribute__((ext_vector_type(4)));
typedef float f32x16 __attribute__((ext_vector_type(16)));
typedef unsigned u32x2 __attribute__((ext_vector_type(2)));
typedef unsigned u32x4 __attribute__((ext_vector_type(4)));
typedef __bf16 bf16x2_t __attribute__((ext_vector_type(2)));

constexpr int DM = 2048, NBATCH = 8, SEQ = 4096, DEPTH = 4, MTOK = NBATCH * SEQ;
constexpr int CONVW = 1024, AHEADS = 8, ATTW = 1024, VDIM = 128, SUBD = 64;
constexpr int INC = 6144;
constexpr int PHEADS = 8, NKEYS = 128, NEXP = 16384, TOPK = 16;
constexpr int MODW = 6 * DM;
constexpr float NORM_EPS = 1e-6f;
constexpr int NWAVES = 8, NTHREADS = 512;

constexpr size_t MiB = 1u << 20;
constexpr size_t WS_CTL = 0, CTL_ZERO_BYTES = 1 * MiB;
constexpr size_t WS_MOD = 2 * MiB;
constexpr size_t WS_MODP = 4 * MiB;
constexpr size_t WS_ROPE = 16 * MiB;
constexpr size_t WS_LAM = 18 * MiB;
constexpr size_t WS_KEYS = 20 * MiB;
constexpr size_t WS_WIN = 32 * MiB;
constexpr size_t WS_WOUT = 128 * MiB;
constexpr size_t WS_WQ = 160 * MiB;
constexpr size_t WS_U = 192 * MiB;
constexpr size_t WS_V = 448 * MiB;
constexpr size_t WS_USC = 24 * MiB, WS_VSC = 25 * MiB;
constexpr size_t WS_H = 704 * MiB;
constexpr size_t WS_SEG = 832 * MiB;
constexpr size_t SEG_ELEMS = (size_t)MTOK * 1024;
constexpr size_t WS_MIX = 1216 * MiB;
constexpr size_t WS_QP = 1344 * MiB;
constexpr size_t WS_ROUTE = 1472 * MiB;
constexpr size_t WS_DIAG = 1488 * MiB;
constexpr size_t WS_H2 = 1504 * MiB;
constexpr size_t WS_OT = 1632 * MiB;
constexpr size_t WS_END = 1760 * MiB;

constexpr int CW_BAR = 4096;
constexpr int CW_KMAX = 16384;

constexpr int LDS_BYTES = 147456;
constexpr int LDS_MISC = 131072;
namespace pg8 {
#define PG8_LAS __attribute__((address_space(3)))
typedef unsigned short bf16_t;
typedef short bf16x8 __attribute__((ext_vector_type(8)));
typedef float f32x4 __attribute__((ext_vector_type(4)));
typedef unsigned u32x4 __attribute__((ext_vector_type(4)));
constexpr int BM = 256, BK = 64, HALF = 128, HTB = HALF * BK * 2  , STAGE_BYTES = 8 * HTB, NXCD = 8, WGM = 8;

__host__ __device__ __forceinline__ int lds_byte(int r, int c) { const int st = (r >> 4) * 2 + (c >> 5), rr = r & 15, cc = c & 31, ob = rr * 64 + cc * 2; return st * 1024 + (ob ^ (((ob >> 9) & 1) << 5)); }
__host__ __device__ __forceinline__ void stage_rc(int b, int& R, int& C) { const int st = b / 1024, sb = b % 1024, swz = sb ^ (((sb >> 9) & 1) << 5); R = (st >> 1) * 16 + swz / 64; C = (st & 1) * 32 + (swz % 64) / 2; }
__host__ __device__ __forceinline__ int perm32(int rho) { const int n = rho >> 4, i = rho & 15; return 8 * (i >> 2) + 4 * n + (i & 3); }

struct Unit { int pm, pn; };
struct Gemm { const bf16_t* A; const bf16_t* Bt; int M, N, K; };

struct StaticOrder {
    int nM, nN, nwg, G, c;
    __host__ __device__ void init(int M, int N, int G_, int c_) { nM = M / BM; nN = N / BM; nwg = nM * nN; G = G_; c = c_; }
    __host__ __device__ bool next(int i, Unit& u) const {
        const long L = (long)i * G + c; if (L >= nwg) return false;
        int wgid = (int)L; { const int q = nwg / NXCD, r = nwg % NXCD, xcd = wgid % NXCD, off = wgid / NXCD; wgid = (xcd < r ? xcd * (q + 1) : r * (q + 1) + (xcd - r) * q) + off; }
        const int nig = WGM * nN, gid = wgid / nig, fm = gid * WGM, gsz = (nM - fm) < WGM ? (nM - fm) : WGM;
        u.pm = fm + ((wgid % nig) % gsz); u.pn = (wgid % nig) / gsz; return true;
    }
    __device__ __forceinline__ void a_ready(const Unit&) const {}
    __device__ __forceinline__ void done(const Unit&) const {}
};


__device__ __forceinline__ unsigned cvt_pk_bf16(float lo, float hi) { unsigned r; asm volatile("v_cvt_pk_bf16_f32 %0, %1, %2" : "=v"(r) : "v"(lo), "v"(hi)); return r; }

struct EpiBf16 {
    static constexpr bool PERM = true, AFTER_DRAIN = false;
    bf16_t* O; int ldc;
    __device__ __forceinline__ void operator()(const f32x4 (&acc)[2][2][4][2], const Unit& u, int wr, int wc, int fr, int fq) const {
        const int row0 = u.pm * BM + wr * 64 + fr, col0 = u.pn * BM + wc * 32 + 8 * fq;
#pragma unroll
        for (int ai = 0; ai < 2; ++ai)
#pragma unroll
            for (int m = 0; m < 4; ++m) { bf16_t* rowp = O + (size_t)(row0 + ai * HALF + m * 16) * ldc + col0;
#pragma unroll
                for (int bj = 0; bj < 2; ++bj) { const f32x4 v0 = acc[ai][bj][m][0], v1 = acc[ai][bj][m][1];
                    u32x4 w; w.x = cvt_pk_bf16(v0[0], v0[1]); w.y = cvt_pk_bf16(v0[2], v0[3]); w.z = cvt_pk_bf16(v1[0], v1[1]); w.w = cvt_pk_bf16(v1[2], v1[3]);
                    *(u32x4*)(rowp + bj * HALF) = w; } }
    }
};

struct EpiIn {
    static constexpr bool PERM = true, AFTER_DRAIN = false;
    bf16_t* seg0; size_t sege; const float* rope; unsigned* kmax;
    __device__ __forceinline__ void operator()(const f32x4 (&acc)[2][2][4][2], const Unit& u, int wr, int wc, int fr, int fq) const {
        const int t = u.pn >> 2, colt = (u.pn & 3) * BM;
        const int row0 = u.pm * BM + wr * 64 + fr, col0 = colt + wc * 32 + 8 * fq;
        bf16_t* base = seg0 + (size_t)t * sege;
        const bool isqk = (t == 3) || (t == 4);
        const bool ropew = isqk && ((wc & 1) == 0);
        const bool isk = (t == 4);
        float mx[2] = {0.f, 0.f};
#pragma unroll
        for (int ai = 0; ai < 2; ++ai)
#pragma unroll
            for (int m = 0; m < 4; ++m) { const int row = row0 + ai * HALF + m * 16; bf16_t* rowp = base + (size_t)row * 1024 + col0;
                f32x4 cs0 = {1.f, 1.f, 1.f, 1.f}, cs1 = cs0, sn0 = {0.f, 0.f, 0.f, 0.f}, sn1 = sn0;
                if (ropew && fq < 2) { const f32x4* rp = (const f32x4*)(rope + (size_t)row * 16); cs0 = rp[0]; cs1 = rp[1]; sn0 = rp[2]; sn1 = rp[3];
                    if (fq == 0) { sn0 = -sn0; sn1 = -sn1; } }
#pragma unroll
                for (int bj = 0; bj < 2; ++bj) { f32x4 v0 = acc[ai][bj][m][0], v1 = acc[ai][bj][m][1];
                    if (ropew) {
                        f32x4 p0, p1;
#pragma unroll
                        for (int i = 0; i < 4; ++i) { p0[i] = __shfl_xor(v0[i], 16); p1[i] = __shfl_xor(v1[i], 16); }
                        v0 = v0 * cs0 + p0 * sn0; v1 = v1 * cs1 + p1 * sn1;
                    }
                    u32x4 w; w.x = cvt_pk_bf16(v0[0], v0[1]); w.y = cvt_pk_bf16(v0[2], v0[3]); w.z = cvt_pk_bf16(v1[0], v1[1]); w.w = cvt_pk_bf16(v1[2], v1[3]);
                    *(u32x4*)(rowp + bj * HALF) = w;
                    if (isk) { float ss = (v0[0] * v0[0] + v0[1] * v0[1]) + (v0[2] * v0[2] + v0[3] * v0[3]) + (v1[0] * v1[0] + v1[1] * v1[1]) + (v1[2] * v1[2] + v1[3] * v1[3]);
                        ss += __shfl_xor(ss, 16); ss += __shfl_xor(ss, 32); mx[bj] = fmaxf(mx[bj], ss); } } }
        if (isk) {
#pragma unroll
            for (int bj = 0; bj < 2; ++bj) { float v = mx[bj];
                v = fmaxf(v, __shfl_xor(v, 1)); v = fmaxf(v, __shfl_xor(v, 2)); v = fmaxf(v, __shfl_xor(v, 4)); v = fmaxf(v, __shfl_xor(v, 8));
                if ((threadIdx.x & 63) == 0) { const int b = u.pm >> 4, head = (u.pn & 3) * 2 + bj, c = wc >> 1, half = wc & 1;
                    atomicMax(kmax + (((b * 8 + head) * 2 + c) * 2 + half), __float_as_uint(v)); } }
        }
    }
};

struct EpiRes {
    static constexpr bool PERM = true, AFTER_DRAIN = false;
    const float* xin; float* xout; const float* gate;
    __device__ __forceinline__ void operator()(const f32x4 (&acc)[2][2][4][2], const Unit& u, int wr, int wc, int fr, int fq) const {
        const int row0 = u.pm * BM + wr * 64 + fr, col0 = u.pn * BM + wc * 32 + 8 * fq, b = u.pm >> 4;
        f32x4 g[2][2];
#pragma unroll
        for (int bj = 0; bj < 2; ++bj)
#pragma unroll
            for (int n = 0; n < 2; ++n) g[bj][n] = *(const f32x4*)(gate + (size_t)b * 12288 + col0 + bj * HALF + 4 * n);
#pragma unroll
        for (int ai = 0; ai < 2; ++ai)
#pragma unroll
            for (int m = 0; m < 4; ++m) { const size_t off = (size_t)(row0 + ai * HALF + m * 16) * 2048 + col0;
#pragma unroll
                for (int bj = 0; bj < 2; ++bj)
#pragma unroll
                    for (int n = 0; n < 2; ++n) { const f32x4 x = *(const f32x4*)(xin + off + bj * HALF + 4 * n);
                        *(f32x4*)(xout + off + bj * HALF + 4 * n) = x + g[bj][n] * acc[ai][bj][m][n]; } }
    }
};

template <class Epi, class Sched, bool ALIGN_EPI = false, bool SP2 = false>
__device__ __forceinline__ void gemm_phase(PG8_LAS unsigned char* lds, const Gemm g, const Sched& S, const Epi& E) {
    int tid_ = threadIdx.x; asm volatile("" : "+v"(tid_));
    const int tid = tid_, wid = __builtin_amdgcn_readfirstlane(tid >> 6), lane = tid & 63, wr = wid >> 2, wc = wid & 3, fr = lane & 15, fq = lane >> 4;
    const int K = g.K, nt = K / BK;
    unsigned voffA[2], voffB[2];
#pragma unroll
    for (int i = 0; i < 2; ++i) { int R, C; stage_rc(tid * 16 + i * 8192, R, C); const int Rb = Epi::PERM ? ((R & ~31) + perm32(R & 31)) : R;
        voffA[i] = (unsigned)(R * K + C) * 2u; voffB[i] = (unsigned)(Rb * K + C) * 2u; }
    const size_t kstep = (size_t)(BK * 2);
    const size_t hstep = (size_t)HALF * K * 2;
    const size_t tstep = 2 * hstep;
    const unsigned ldsw = (unsigned)wid * 1024u;
    const int aoff = lds_byte(wr * 64 + fr, fq * 8), boff = lds_byte(wc * 32 + fr, fq * 8);
#define PG8_SA(b, h) (((b) * 2 + (h)) * HTB)
#define PG8_SB(b, h) ((4 + (b) * 2 + (h)) * HTB)
#define PG8_STAGE(bufoff, gbase, voff) do { _Pragma("unroll") for (int _i = 0; _i < 2; ++_i) \
        __builtin_amdgcn_global_load_lds((const unsigned*)((const char*)(gbase) + (voff)[_i]), (PG8_LAS unsigned*)(lds + (bufoff) + ldsw + _i * 8192), 16, 0, 0); } while (0)
#define PG8_LDA(dst, b, h) do { _Pragma("unroll") for (int m = 0; m < 4; ++m) _Pragma("unroll") for (int k = 0; k < 2; ++k) dst[m][k] = *(const PG8_LAS bf16x8*)(lds + PG8_SA(b, h) + aoff + m * 2048 + k * 1024); } while (0)
#define PG8_LDB(dst, b, h) do { _Pragma("unroll") for (int n = 0; n < 2; ++n) _Pragma("unroll") for (int k = 0; k < 2; ++k) dst[n][k] = *(const PG8_LAS bf16x8*)(lds + PG8_SB(b, h) + boff + n * 2048 + k * 1024); } while (0)
#define PG8_MMA(ai, bj, At, Bt) do { __builtin_amdgcn_s_setprio(1); _Pragma("unroll") for (int m = 0; m < 4; ++m) _Pragma("unroll") for (int n = 0; n < 2; ++n) _Pragma("unroll") for (int k = 0; k < 2; ++k) \
        acc[ai][bj][m][n] = __builtin_amdgcn_mfma_f32_16x16x32_bf16(Bt[n][k], At[m][k], acc[ai][bj][m][n], 0, 0, 0); __builtin_amdgcn_s_setprio(0); } while (0)
#define PG8_WAIT_V(n) asm volatile("s_waitcnt vmcnt(" #n ")" ::: "memory")
#define PG8_WAIT_L(n) asm volatile("s_waitcnt lgkmcnt(" #n ")" ::: "memory")
#define PG8_BAR __builtin_amdgcn_s_barrier()
#define PG8_SCHED __builtin_amdgcn_sched_barrier(0)
    Unit cur, nxt; int ui = 0;
    if (!S.next(0, cur)) return;
    f32x4 acc[2][2][4][2];
#pragma unroll
    for (int a = 0; a < 2; ++a)
#pragma unroll
        for (int b = 0; b < 2; ++b)
#pragma unroll
            for (int m = 0; m < 4; ++m)
#pragma unroll
                for (int n = 0; n < 2; ++n) acc[a][b][m][n] = (f32x4){0.f, 0.f, 0.f, 0.f};
    bf16x8 At[4][2], B0[2][2], B1[2][2];
    const char* cA = (const char*)g.A + (size_t)cur.pm * tstep; const char* cB = (const char*)g.Bt + (size_t)cur.pn * tstep;
    S.a_ready(cur);
    if constexpr (SP2) {
        PG8_STAGE(PG8_SB(0, 0), cB, voffB); PG8_STAGE(PG8_SB(0, 1), cB + hstep, voffB); PG8_STAGE(PG8_SA(0, 0), cA, voffA); PG8_STAGE(PG8_SA(0, 1), cA + hstep, voffA);
        if (wr == 1) PG8_BAR;
        PG8_WAIT_V(2); PG8_BAR;
        PG8_STAGE(PG8_SB(1, 0), cB + kstep, voffB); PG8_STAGE(PG8_SA(1, 0), cA + kstep, voffA); PG8_STAGE(PG8_SB(1, 1), cB + hstep + kstep, voffB);
        PG8_WAIT_V(6); PG8_BAR;
    } else {
        PG8_STAGE(PG8_SB(0, 0), cB, voffB); PG8_STAGE(PG8_SA(0, 0), cA, voffA); PG8_STAGE(PG8_SB(0, 1), cB + hstep, voffB); PG8_STAGE(PG8_SA(0, 1), cA + hstep, voffA);
        if (wr == 1) PG8_BAR;
        PG8_WAIT_V(4); PG8_BAR;
        PG8_STAGE(PG8_SB(1, 0), cB + kstep, voffB); PG8_STAGE(PG8_SA(1, 0), cA + kstep, voffA); PG8_STAGE(PG8_SB(1, 1), cB + hstep + kstep, voffB);
        PG8_WAIT_V(6); PG8_BAR;
    }
    for (;;) {
        const bool has_next = S.next(ui + 1, nxt);
        const char* nA = has_next ? (const char*)g.A + (size_t)nxt.pm * tstep : cA; const char* nB = has_next ? (const char*)g.Bt + (size_t)nxt.pn * tstep : cB;
        for (int t = 0; t < nt; t += 2) {
            const bool last = (t == nt - 2);
            const char* a1 = cA + (size_t)(t + 1) * kstep;
            const char* a2 = last ? nA : cA + (size_t)(t + 2) * kstep; const char* b2 = last ? nB : cB + (size_t)(t + 2) * kstep;
            const char* a3 = a2 + kstep; const char* b3 = b2 + kstep;
            if (last && has_next) S.a_ready(nxt);
            if constexpr (SP2) {
            PG8_LDB(B0, 0, 0); PG8_LDB(B1, 0, 1); PG8_SCHED; PG8_LDA(At, 0, 0); PG8_STAGE(PG8_SA(1, 1), a1 + hstep, voffA);
            PG8_WAIT_V(8); PG8_WAIT_L(0); PG8_BAR; PG8_MMA(0, 0, At, B0); PG8_MMA(0, 1, At, B1); PG8_BAR; PG8_SCHED;
            PG8_LDA(At, 0, 1); PG8_STAGE(PG8_SB(0, 0), b2, voffB); PG8_STAGE(PG8_SB(0, 1), b2 + hstep, voffB); PG8_STAGE(PG8_SA(0, 0), a2, voffA);
            PG8_WAIT_V(8); PG8_WAIT_L(0); PG8_BAR; PG8_MMA(1, 0, At, B0); PG8_MMA(1, 1, At, B1); PG8_BAR; PG8_SCHED;
            PG8_LDB(B0, 1, 0); PG8_LDB(B1, 1, 1); PG8_SCHED; PG8_LDA(At, 1, 0); PG8_STAGE(PG8_SA(0, 1), a2 + hstep, voffA);
            PG8_WAIT_V(8); PG8_WAIT_L(0); PG8_BAR; PG8_MMA(0, 0, At, B0); PG8_MMA(0, 1, At, B1); PG8_BAR; PG8_SCHED;
            PG8_LDA(At, 1, 1); PG8_STAGE(PG8_SB(1, 0), b3, voffB); PG8_STAGE(PG8_SB(1, 1), b3 + hstep, voffB); PG8_STAGE(PG8_SA(1, 0), a3, voffA);
            PG8_WAIT_V(8); PG8_WAIT_L(0); PG8_BAR; PG8_MMA(1, 0, At, B0); PG8_MMA(1, 1, At, B1); PG8_BAR; PG8_SCHED;
            } else {
            PG8_LDB(B0, 0, 0); PG8_SCHED; PG8_LDA(At, 0, 0); PG8_STAGE(PG8_SA(1, 1), a1 + hstep, voffA);
            PG8_WAIT_L(8); PG8_BAR; PG8_WAIT_L(0); PG8_MMA(0, 0, At, B0); PG8_BAR; PG8_SCHED;
            PG8_LDB(B1, 0, 1); PG8_STAGE(PG8_SB(0, 0), b2, voffB);
            PG8_BAR; PG8_WAIT_L(0); PG8_MMA(0, 1, At, B1); PG8_BAR;
            PG8_LDA(At, 0, 1); PG8_STAGE(PG8_SA(0, 0), a2, voffA);
            PG8_BAR; PG8_WAIT_L(0); PG8_MMA(1, 0, At, B0); PG8_BAR; PG8_SCHED;
            PG8_STAGE(PG8_SB(0, 1), b2 + hstep, voffB);
            PG8_WAIT_V(6); PG8_BAR; PG8_MMA(1, 1, At, B1); PG8_BAR;
            PG8_LDB(B0, 1, 0); PG8_SCHED; PG8_LDA(At, 1, 0); PG8_STAGE(PG8_SA(0, 1), a2 + hstep, voffA);
            PG8_WAIT_L(8); PG8_BAR; PG8_WAIT_L(0); PG8_MMA(0, 0, At, B0); PG8_BAR; PG8_SCHED;
            PG8_LDB(B1, 1, 1); PG8_STAGE(PG8_SB(1, 0), b3, voffB);
            PG8_BAR; PG8_WAIT_L(0); PG8_MMA(0, 1, At, B1); PG8_BAR;
            PG8_LDA(At, 1, 1); PG8_STAGE(PG8_SA(1, 0), a3, voffA);
            PG8_BAR; PG8_WAIT_L(0); PG8_MMA(1, 0, At, B0); PG8_BAR; PG8_SCHED;
            PG8_STAGE(PG8_SB(1, 1), b3 + hstep, voffB);
            PG8_WAIT_V(6); PG8_BAR; PG8_MMA(1, 1, At, B1); PG8_BAR;
            }
        }
        if constexpr (ALIGN_EPI) { if (wr == 0) PG8_BAR; }
        if constexpr (!Epi::AFTER_DRAIN) { E(acc, cur, wr, wc, fr, fq); S.done(cur); }
        if (!has_next) break;
#pragma unroll
        for (int a = 0; a < 2; ++a)
#pragma unroll
            for (int b = 0; b < 2; ++b)
#pragma unroll
                for (int m = 0; m < 4; ++m)
#pragma unroll
                    for (int n = 0; n < 2; ++n) acc[a][b][m][n] = (f32x4){0.f, 0.f, 0.f, 0.f};
        cur = nxt; cA = nA; cB = nB; ++ui;
        if constexpr (ALIGN_EPI) { if (wr == 1) PG8_BAR; }
    }
    PG8_WAIT_V(0);
    if constexpr (!ALIGN_EPI) { if (wr == 0) PG8_BAR; }
    PG8_BAR;
    if constexpr (Epi::AFTER_DRAIN) { E.fused(acc, cur, wr, wc, fr, fq, lds, wid, lane); S.done(cur); }
#undef PG8_SA
#undef PG8_SB
#undef PG8_STAGE
#undef PG8_LDA
#undef PG8_LDB
#undef PG8_MMA
#undef PG8_WAIT_V
#undef PG8_WAIT_L
#undef PG8_BAR
#undef PG8_SCHED
}
}

#define XB_TMO      128
#define XB_XCNT(j)  (256  + 64 * (j))
#define XB_XSUB(j)  (1280 + 64 * (j))
#define XB_XGEN(j)  (2304 + 64 * (j))
#define XB_TOP      3328
#define XB_TOPGEN   3392
#define XCD_BAR_WORDS 3456
#define XB_SPIN_CAP (1u << 18)

__device__ __forceinline__ unsigned xb_ld(unsigned* p)              { return __hip_atomic_load(p, __ATOMIC_RELAXED, __HIP_MEMORY_SCOPE_AGENT); }
__device__ __forceinline__ unsigned xb_add(unsigned* p, unsigned v) { return __hip_atomic_fetch_add(p, v, __ATOMIC_RELAXED, __HIP_MEMORY_SCOPE_AGENT); }
__device__ __forceinline__ unsigned xb_xcc_id() { return (unsigned)__builtin_amdgcn_s_getreg((3 << 11) | 20) & 0xFu; }
#define XB_SPIN(cond, bar) do { unsigned _sp = 0; while (cond) { __builtin_amdgcn_s_sleep(1); \
    if ((++_sp & 255u) == 0u) { if (xb_ld(&(bar)[XB_TMO])) break; if (_sp > XB_SPIN_CAP) { atomicAdd(&(bar)[XB_TMO], 1u); break; } } } } while (0)

struct XcdBarrier {
    unsigned* bar; unsigned x;
    volatile LAS unsigned* st;
};

__device__ __forceinline__ XcdBarrier xcd_barrier_post(unsigned* bar, volatile LAS unsigned* st) {
    XcdBarrier b; b.bar = bar; b.x = xb_xcc_id(); b.st = st;
    if (threadIdx.x == 0) (void)xb_add(&bar[XB_XCNT(b.x)], 1u);
    return b;
}
__device__ __forceinline__ void xcd_barrier_complete(unsigned* bar, unsigned x, unsigned& nloc, unsigned& nx) {
    const unsigned G = gridDim.x * gridDim.y * gridDim.z;
    unsigned sum, cnt, mine, sp = 0u;
    for (;;) {
        sum = 0u; cnt = 0u; mine = 0u;
#pragma unroll
        for (unsigned j = 0; j < 16; ++j) { const unsigned c = xb_ld(&bar[XB_XCNT(j)]); sum += c; cnt += (c > 0u) ? 1u : 0u; mine = (j == x) ? c : mine; }
        if (sum == G) break;
        __builtin_amdgcn_s_sleep(1);
        if ((++sp & 255u) == 0u) { if (xb_ld(&bar[XB_TMO])) break; if (sp > XB_SPIN_CAP) { atomicAdd(&bar[XB_TMO], 1u); break; } }
    }
    nloc = mine > 0u ? mine : 1u; nx = cnt > 0u ? cnt : 1u;
}

__device__ __forceinline__ void xcd_barrier(const XcdBarrier& b) {
    asm volatile("s_waitcnt vmcnt(0)" ::: "memory");
    __syncthreads();
    if (threadIdx.x == 0) {
        unsigned* bar = b.bar;
        __builtin_amdgcn_s_waitcnt(0);
        unsigned nloc = b.st[0], nx = b.st[1];
        if (nloc == 0u) { xcd_barrier_complete(bar, b.x, nloc, nx); b.st[0] = nloc; b.st[1] = nx; }
        const unsigned old = xb_add(&bar[XB_XSUB(b.x)], 1u);
        const unsigned gen = old / nloc;
        if (old + 1u == (gen + 1u) * nloc) {
            __builtin_amdgcn_fence(__ATOMIC_RELEASE, "agent");
            asm volatile("s_waitcnt vmcnt(0)" ::: "memory");
            const unsigned og = xb_add(&bar[XB_TOP], 1u);
            const unsigned tg = og / nx;
            if (og + 1u == (tg + 1u) * nx) xb_add(&bar[XB_TOPGEN], 1u);
            else XB_SPIN(xb_ld(&bar[XB_TOPGEN]) == tg, bar);
            __builtin_amdgcn_fence(__ATOMIC_ACQUIRE, "agent");
            xb_add(&bar[XB_XGEN(b.x)], 1u);
            asm volatile("s_waitcnt vmcnt(0)" ::: "memory");
        } else {
            XB_SPIN(xb_ld(&bar[XB_XGEN(b.x)]) == gen, bar);
            __builtin_amdgcn_fence(__ATOMIC_ACQUIRE, "agent");
            asm volatile("s_waitcnt vmcnt(0)" ::: "memory");
        }
    }
    __syncthreads();
}

#define LDS_WAIT() asm volatile("s_waitcnt lgkmcnt(0)" ::: "memory")
#define VM_WAIT() asm volatile("s_waitcnt vmcnt(0)" ::: "memory")
__device__ __forceinline__ unsigned f2bf(float f) { unsigned u = __builtin_bit_cast(unsigned, f); return (u + 0x7fffu + ((u >> 16) & 1u)) >> 16; }
__device__ __forceinline__ unsigned pk2(float lo, float hi) { return f2bf(lo) | (f2bf(hi) << 16); }
__device__ __forceinline__ float bf_lo(unsigned w) { return __builtin_bit_cast(float, w << 16); }
__device__ __forceinline__ float bf_hi(unsigned w) { return __builtin_bit_cast(float, w & 0xffff0000u); }
__device__ __forceinline__ float wave_sum(float v) {
#pragma unroll
    for (int o = 1; o < 64; o <<= 1) v += __shfl_xor(v, o);
    return v;
}

struct Ctx {
    LAS unsigned char* lds;
    unsigned char* ws;
    int tid, lane, wave, vcu, G, gw, NGW;
    float* out;
};

__device__ __forceinline__ void p0_transpose_item(const float* W, int K, int N, bf16_t* WT, LAS float* scr, int item, int lane) {
    const int nblk = N / 32, kb = item / nblk, nb = item % nblk, k0 = 64 * kb, n0 = 32 * nb;
#pragma unroll 8
    for (int i = 0; i < 32; ++i) { const int kk = 2 * i + (lane >> 5); scr[kk * 33 + (lane & 31)] = W[(size_t)(k0 + kk) * N + n0 + (lane & 31)]; }
    LDS_WAIT(); asm volatile("" ::: "memory");
    const int c = lane & 7;
#pragma unroll
    for (int j = 0; j < 4; ++j) { const int n = (lane >> 3) + 8 * j; const LAS float* s = scr + (8 * c) * 33 + n;
        u32x4 o; o.x = pk2(s[0 * 33], s[1 * 33]); o.y = pk2(s[2 * 33], s[3 * 33]); o.z = pk2(s[4 * 33], s[5 * 33]); o.w = pk2(s[6 * 33], s[7 * 33]);
        *(u32x4*)(WT + (size_t)(n0 + n) * K + k0 + 8 * c) = o; }
    LDS_WAIT(); asm volatile("" ::: "memory");
}
__device__ __forceinline__ void p0_cvt_row(const float* src, bf16_t* dst, int lane) {
#pragma unroll
    for (int j = 0; j < 4; ++j) { const f32x4 a = *(const f32x4*)(src + 512 * j + 8 * lane), b = *(const f32x4*)(src + 512 * j + 8 * lane + 4);
        u32x4 o; o.x = pk2(a[0], a[1]); o.y = pk2(a[2], a[3]); o.z = pk2(b[0], b[1]); o.w = pk2(b[2], b[3]);
        *(u32x4*)(dst + 512 * j + 8 * lane) = o; }
}
__device__ __forceinline__ void p0_cvt_row_fp8(const float* src, unsigned char* dst, float* inv_scale, int lane) {
    f32x4 v[8]; float amax = 0.f;
#pragma unroll
    for (int j = 0; j < 2; ++j)
#pragma unroll
        for (int q = 0; q < 4; ++q) { const f32x4 a = *(const f32x4*)(src + 1024 * j + 16 * lane + 4 * q); v[4 * j + q] = a;
            amax = fmaxf(amax, fmaxf(fmaxf(fabsf(a[0]), fabsf(a[1])), fmaxf(fabsf(a[2]), fabsf(a[3])))); }
#pragma unroll
    for (int o = 1; o < 64; o <<= 1) amax = fmaxf(amax, __shfl_xor(amax, o));
    const float sc = amax > 0.f ? 448.0f / amax : 1.0f;
#pragma unroll
    for (int j = 0; j < 2; ++j) { u32x4 o;
#pragma unroll
        for (int q = 0; q < 4; ++q) { const f32x4 a = v[4 * j + q] * sc; int w = 0; w = __builtin_amdgcn_cvt_pk_fp8_f32(a[0], a[1], w, false); w = __builtin_amdgcn_cvt_pk_fp8_f32(a[2], a[3], w, true); o[q] = (unsigned)w; }
        *(u32x4*)(dst + 1024 * j + 16 * lane) = o; }
    if (lane == 0) *inv_scale = amax > 0.f ? amax * (1.0f / 448.0f) : 1.0f;
}
__device__ __forceinline__ void p0_adaln_task(const float* c, const float* ada_w, float* modp, LAS float* scr, int task, int lane) {
    const int ks = task & 7, cg = (task >> 3) % 48, l = task / 384;
#pragma unroll
    for (int i = 0; i < 32; ++i) { const int e = i * 64 + lane, k = e >> 3, b = e & 7; const float x = c[b * DM + ks * 256 + k];
        scr[e] = x / (1.f + expf(-x)); }
    LDS_WAIT(); asm volatile("" ::: "memory");
    const float* wp = ada_w + ((size_t)l * DM + ks * 256) * MODW + cg * 256 + lane * 4;
    f32x4 acc[8];
#pragma unroll
    for (int b = 0; b < 8; ++b) acc[b] = (f32x4){0.f, 0.f, 0.f, 0.f};
#pragma unroll 4
    for (int k = 0; k < 256; ++k) { const f32x4 w = *(const f32x4*)(wp + (size_t)k * MODW);
        const f32x4 s0 = *(const LAS f32x4*)(scr + k * 8), s1 = *(const LAS f32x4*)(scr + k * 8 + 4);
        acc[0] += w * s0[0]; acc[1] += w * s0[1]; acc[2] += w * s0[2]; acc[3] += w * s0[3];
        acc[4] += w * s1[0]; acc[5] += w * s1[1]; acc[6] += w * s1[2]; acc[7] += w * s1[3]; }
#pragma unroll
    for (int b = 0; b < 8; ++b) *(f32x4*)(modp + (((size_t)ks * DEPTH + l) * NBATCH + b) * MODW + cg * 256 + lane * 4) = acc[b];
    LDS_WAIT(); asm volatile("" ::: "memory");
}
struct Args;
template <class A> __device__ __forceinline__ void p0_prologue(Ctx& C, const A& args) {
    LAS float* scr = (LAS float*)(C.lds + C.wave * 16384);
    const float* w_in = args.in[6]; const float* w_out = args.in[13]; const float* wq = args.in[15];
    bf16_t* WIN = (bf16_t*)(C.ws + WS_WIN); bf16_t* WOUT = (bf16_t*)(C.ws + WS_WOUT); bf16_t* WQ = (bf16_t*)(C.ws + WS_WQ);
    constexpr int T_ADA = 4 * 48 * 8;
    constexpr int I_IN = (DM / 64) * (INC / 32), I_SQ = (DM / 64) * (DM / 32);
    constexpr int T_IN = 4 * I_IN, T_OUT = 4 * I_SQ, T_WQ = 4 * I_SQ;
    constexpr int T_KEYS = 4 * 16 * 128 * 128 / 2048;
    constexpr int T_UV = 4 * NEXP;
    constexpr int T_ROPE = MTOK / 64;
    constexpr int NT = T_ADA + T_IN + T_OUT + T_WQ + T_KEYS + 2 * T_UV + T_ROPE + 1;
    for (int it = C.gw; it < NT; it += C.NGW) {
        int r = it;
        if (r < T_ADA) { p0_adaln_task(args.in[1], args.in[3], (float*)(C.ws + WS_MODP), scr, r, C.lane); continue; } r -= T_ADA;
        if (r < T_IN) { const int l = r / I_IN; p0_transpose_item(w_in + (size_t)l * DM * INC, DM, INC, WIN + (size_t)l * INC * DM, scr, r % I_IN, C.lane); continue; } r -= T_IN;
        if (r < T_OUT) { const int l = r / I_SQ; p0_transpose_item(w_out + (size_t)l * DM * DM, DM, DM, WOUT + (size_t)l * DM * DM, scr, r % I_SQ, C.lane); continue; } r -= T_OUT;
        if (r < T_WQ) { const int l = r / I_SQ; p0_transpose_item(wq + (size_t)l * DM * DM, DM, DM, WQ + (size_t)l * DM * DM, scr, r % I_SQ, C.lane); continue; } r -= T_WQ;
        if (r < T_KEYS) { p0_cvt_row(args.in[16] + (size_t)r * 2048, (bf16_t*)(C.ws + WS_KEYS) + (size_t)r * 2048, C.lane); continue; } r -= T_KEYS;
        if (r < T_UV) { p0_cvt_row_fp8(args.in[17] + (size_t)r * 2048, C.ws + WS_U + (size_t)r * 2048, (float*)(C.ws + WS_USC) + r, C.lane); continue; } r -= T_UV;
        if (r < T_UV) { p0_cvt_row_fp8(args.in[18] + (size_t)r * 2048, C.ws + WS_V + (size_t)r * 2048, (float*)(C.ws + WS_VSC) + r, C.lane); continue; } r -= T_UV;
        if (r < T_ROPE) {
            const int row = r * 64 + C.lane; const float pos = (float)((const int*)args.in[2])[row]; float* o = (float*)(C.ws + WS_ROPE) + (size_t)row * 16;
#pragma unroll
            for (int j = 0; j < 8; ++j) { const float invf = exp2f(-(float)j * 0.125f * 18.931568569324174f);
                const float ang = pos * invf; double rev = (double)ang * 0.15915494309189535; rev -= __builtin_rint(rev);
                const float rf = (float)rev; o[j] = __builtin_amdgcn_cosf(rf); o[8 + j] = __builtin_amdgcn_sinf(rf); }
            continue; } r -= T_ROPE;
        {
            float* lam = (float*)(C.ws + WS_LAM);
            for (int l = 0; l < DEPTH; ++l) {
                const float a = wave_sum(args.in[8][l * 64 + C.lane] * args.in[9][l * 64 + C.lane]), b = wave_sum(args.in[10][l * 64 + C.lane] * args.in[11][l * 64 + C.lane]);
                const float li = 0.8f - 0.6f * expf(-0.3f * (float)l);
                if (C.lane == 0) { lam[l] = expf(a) - expf(b) + li; lam[4 + l] = 1.f - li; } }
        }
    }
}
__device__ __forceinline__ void p1_modfinal(Ctx& C, const float* ada_b) {
    const float* modp = (const float*)(C.ws + WS_MODP); float* mod = (float*)(C.ws + WS_MOD);
    constexpr int N4 = DEPTH * NBATCH * MODW / 4;
    for (int i = C.vcu * NTHREADS + C.tid; i < N4; i += C.G * NTHREADS) { const int l = i / (NBATCH * MODW / 4), n4 = i % (MODW / 4);
        f32x4 s = *(const f32x4*)(ada_b + (size_t)l * MODW + n4 * 4);
#pragma unroll
        for (int ks = 0; ks < 8; ++ks) s += *(const f32x4*)(modp + (size_t)ks * DEPTH * NBATCH * MODW + (size_t)i * 4);
        *(f32x4*)(mod + (size_t)i * 4) = s; }
}

__device__ __forceinline__ void norm_pass(Ctx& C, const float* x, bf16_t* H, const float* g, const float* sh, const float* sc) {
    for (int row = C.gw; row < MTOK; row += C.NGW) { const int b = row >> 12; const float* xr = x + (size_t)row * DM + 8 * C.lane;
        f32x4 v[8]; float ss = 0.f;
#pragma unroll
        for (int j = 0; j < 4; ++j) { v[2 * j] = *(const f32x4*)(xr + 512 * j); v[2 * j + 1] = *(const f32x4*)(xr + 512 * j + 4);
            const f32x4 a = v[2 * j], c = v[2 * j + 1]; ss += (a[0] * a[0] + a[1] * a[1]) + (a[2] * a[2] + a[3] * a[3]) + (c[0] * c[0] + c[1] * c[1]) + (c[2] * c[2] + c[3] * c[3]); }
        const float rstd = 1.0f / sqrtf(wave_sum(ss) * (1.f / DM) + NORM_EPS);
        const float* gp = g + 8 * C.lane; const float* shp = sh + (size_t)b * MODW + 8 * C.lane; const float* scp = sc + (size_t)b * MODW + 8 * C.lane;
#pragma unroll
        for (int j = 0; j < 4; ++j) { f32x4 o[2];
#pragma unroll
            for (int q = 0; q < 2; ++q) { const f32x4 gg = *(const f32x4*)(gp + 512 * j + 4 * q), s1 = *(const f32x4*)(scp + 512 * j + 4 * q), s0 = *(const f32x4*)(shp + 512 * j + 4 * q);
                o[q] = (v[2 * j + q] * rstd) * gg * (s1 + 1.0f) + s0; }
            u32x4 w; w.x = pk2(o[0][0], o[0][1]); w.y = pk2(o[0][2], o[0][3]); w.z = pk2(o[1][0], o[1][1]); w.w = pk2(o[1][2], o[1][3]);
            *(u32x4*)(H + (size_t)row * DM + 512 * j + 8 * C.lane) = w; }
    }
}
__device__ __forceinline__ void final_norm_pass(Ctx& C, const float* x, float* out, const float* g) {
    for (int row = C.gw; row < MTOK; row += C.NGW) { const float* xr = x + (size_t)row * DM + 8 * C.lane;
        f32x4 v[8]; float ss = 0.f;
#pragma unroll
        for (int j = 0; j < 4; ++j) { v[2 * j] = *(const f32x4*)(xr + 512 * j); v[2 * j + 1] = *(const f32x4*)(xr + 512 * j + 4);
            const f32x4 a = v[2 * j], c = v[2 * j + 1]; ss += (a[0] * a[0] + a[1] * a[1]) + (a[2] * a[2] + a[3] * a[3]) + (c[0] * c[0] + c[1] * c[1]) + (c[2] * c[2] + c[3] * c[3]); }
        const float rstd = 1.0f / sqrtf(wave_sum(ss) * (1.f / DM) + NORM_EPS);
#pragma unroll
        for (int j = 0; j < 4; ++j)
#pragma unroll
            for (int q = 0; q < 2; ++q) { const f32x4 gg = *(const f32x4*)(g + 8 * C.lane + 512 * j + 4 * q);
                *(f32x4*)(out + (size_t)row * DM + 8 * C.lane + 512 * j + 4 * q) = (v[2 * j + q] * rstd) * gg; }
    }
}

__device__ __forceinline__ void conv_chunk(const bf16_t* GBp, const bf16_t* GCp, const bf16_t* HVp, const float* cw, bf16_t* MIXp, int chunk, int tid) {
    const int c0 = (tid & 127) * 8, r0 = chunk * 128 + (tid >> 7) * 32;
    float w0[8], w1[8], w2[8];
#pragma unroll
    for (int i = 0; i < 8; ++i) { w0[i] = cw[c0 + i]; w1[i] = cw[1024 + c0 + i]; w2[i] = cw[2048 + c0 + i]; }
    float zp[8], zc[8], zn[8];
    auto loadz = [&](int row, float (&z)[8]) {
        const bool ok = ((row >> 12) == (r0 >> 12)) && row >= 0 && row < MTOK;
        if (ok) { const u32x4 a = *(const u32x4*)(GCp + (size_t)row * 1024 + c0), h = *(const u32x4*)(HVp + (size_t)row * 1024 + c0);
#pragma unroll
            for (int i = 0; i < 4; ++i) { z[2 * i] = bf_lo(a[i]) * bf_lo(h[i]); z[2 * i + 1] = bf_hi(a[i]) * bf_hi(h[i]); } }
        else {
#pragma unroll
            for (int i = 0; i < 8; ++i) z[i] = 0.f; }
    };
    loadz(r0 - 1, zp); loadz(r0, zc);
    for (int r = r0; r < r0 + 32; ++r) {
        loadz(r + 1, zn);
        const u32x4 gbv = *(const u32x4*)(GBp + (size_t)r * 1024 + c0);
        float y[8];
#pragma unroll
        for (int i = 0; i < 4; ++i) { y[2 * i] = bf_lo(gbv[i]) * (w0[2 * i] * zp[2 * i] + w1[2 * i] * zc[2 * i] + w2[2 * i] * zn[2 * i]);
            y[2 * i + 1] = bf_hi(gbv[i]) * (w0[2 * i + 1] * zp[2 * i + 1] + w1[2 * i + 1] * zc[2 * i + 1] + w2[2 * i + 1] * zn[2 * i + 1]); }
        u32x4 o; o.x = pk2(y[0], y[1]); o.y = pk2(y[2], y[3]); o.z = pk2(y[4], y[5]); o.w = pk2(y[6], y[7]);
        *(u32x4*)(MIXp + (size_t)r * 2048 + c0) = o;
#pragma unroll
        for (int i = 0; i < 8; ++i) { zp[i] = zc[i]; zc[i] = zn[i]; }
    }
}

namespace att {
constexpr int NSLOT = 3, KSLOT = 8192, VSLOT = 16384;
constexpr int L_K = 0, L_V = NSLOT * KSLOT, L_WS = L_V + NSLOT * VSLOT, L_END = L_WS + NWAVES * 256;
constexpr float C2 = 0.125f * 1.4426950408889634f;
#define SBAR() __builtin_amdgcn_sched_barrier(0)
#define KSWZ(row, colB) ((row) * 256 + ((colB) ^ (((row) & 7) << 4)))
__device__ __forceinline__ int crow(int r, int hi) { return (r & 3) + 8 * (r >> 2) + 4 * hi; }
__device__ __forceinline__ unsigned cvtpk(float lo, float hi) { unsigned r; asm volatile("v_cvt_pk_bf16_f32 %0, %1, %2" : "=v"(r) : "v"(lo), "v"(hi)); return r; }
__device__ __forceinline__ void glds16(const void* gsrc, unsigned lds_dst) { unsigned keep;
    asm volatile("s_mov_b32 %0, m0\n\ts_mov_b32 m0, %2\n\ts_nop 0\n\tglobal_load_lds_dwordx4 %1, off\n\ts_mov_b32 m0, %0" : "=&s"(keep) : "v"(gsrc), "s"(lds_dst) : "memory"); }
#define WAIT_BAR(N) asm volatile("s_waitcnt vmcnt(" #N ") lgkmcnt(0)\n\ts_barrier" ::: "memory")
__device__ __forceinline__ int v_rd_base(int lane) { return ((lane & 3) << 3) | (((lane >> 2) & 3) << 6) | (((lane >> 4) & 1) << 5) | (((lane >> 5) & 1) << 8); }
constexpr int v_rd_off(int d0, int ks, int half) { return d0 * 512 + ks * 4096 + half * 2048; }
template <int OFF> __device__ __forceinline__ s16x4 tr_read(int vb) { s16x4 r; asm volatile("ds_read_b64_tr_b16 %0, %1 offset:%2" : "=&v"(r) : "v"(vb), "i"(OFF) : "memory"); return r; }

__device__ __forceinline__ void qkt(f32x16& p0, f32x16& p1, const LAS char* Ks, const bf16x8* qr, int r32, int hi) {
    const LAS char* kb = Ks + hi * 1024 + r32 * 16;
#pragma unroll
    for (int r = 0; r < 16; ++r) { p0[r] = 0.f; p1[r] = 0.f; }
#pragma unroll
    for (int d0 = 0; d0 < 4; ++d0) {
        const bf16x8 b0 = *(const LAS bf16x8*)(kb + d0 * 2048);
        const bf16x8 b1 = *(const LAS bf16x8*)(kb + d0 * 2048 + 512);
        p0 = __builtin_amdgcn_mfma_f32_32x32x16_bf16(b0, qr[d0], p0, 0, 0, 0);
        p1 = __builtin_amdgcn_mfma_f32_32x32x16_bf16(b1, qr[d0], p1, 0, 0, 0); }
}
__device__ __forceinline__ void softmax_pack(f32x16& p0, f32x16& p1, float negmC, float& l, bf16x8& pa0, bf16x8& pa1, bf16x8& pa2, bf16x8& pa3) {
#pragma unroll
    for (int r = 0; r < 16; ++r) { p0[r] = __builtin_amdgcn_exp2f(fmaf(p0[r], C2, negmC)); p1[r] = __builtin_amdgcn_exp2f(fmaf(p1[r], C2, negmC)); }
    float ps = 0.f;
#pragma unroll
    for (int r = 0; r < 16; ++r) ps += p0[r];
#pragma unroll
    for (int r = 0; r < 16; ++r) ps += p1[r];
    l += ps;
#define PK4(P, BASE, OUT) do { unsigned a0 = cvtpk(P[BASE + 0], P[BASE + 1]), a1 = cvtpk(P[BASE + 2], P[BASE + 3]);   \
    unsigned b0 = cvtpk(P[BASE + 4], P[BASE + 5]), b1 = cvtpk(P[BASE + 6], P[BASE + 7]);                              \
    auto r0 = __builtin_amdgcn_permlane32_swap(a0, b0, false, false); auto r1 = __builtin_amdgcn_permlane32_swap(a1, b1, false, false); \
    u32x4 w = {r0[0], r1[0], r0[1], r1[1]}; OUT = __builtin_bit_cast(bf16x8, w); } while (0)
    PK4(p0, 0, pa0); PK4(p0, 8, pa1); PK4(p1, 0, pa2); PK4(p1, 8, pa3);
#undef PK4
}
template <int D0> __device__ __forceinline__ void pv_one(f32x16& od, int vb, bf16x8 pa0, bf16x8 pa1, bf16x8 pa2, bf16x8 pa3) {
    const s16x4 l0 = tr_read<v_rd_off(D0, 0, 0)>(vb), h0 = tr_read<v_rd_off(D0, 0, 1)>(vb), l1 = tr_read<v_rd_off(D0, 1, 0)>(vb), h1 = tr_read<v_rd_off(D0, 1, 1)>(vb);
    const s16x4 l2 = tr_read<v_rd_off(D0, 2, 0)>(vb), h2 = tr_read<v_rd_off(D0, 2, 1)>(vb), l3 = tr_read<v_rd_off(D0, 3, 0)>(vb), h3 = tr_read<v_rd_off(D0, 3, 1)>(vb);
    asm volatile("s_waitcnt lgkmcnt(0)" ::: "memory"); SBAR();
#define PK(L, H) (bf16x8){L[0], L[1], L[2], L[3], H[0], H[1], H[2], H[3]}
    od = __builtin_amdgcn_mfma_f32_32x32x16_bf16(pa0, PK(l0, h0), od, 0, 0, 0);
    od = __builtin_amdgcn_mfma_f32_32x32x16_bf16(pa1, PK(l1, h1), od, 0, 0, 0);
    od = __builtin_amdgcn_mfma_f32_32x32x16_bf16(pa2, PK(l2, h2), od, 0, 0, 0);
    od = __builtin_amdgcn_mfma_f32_32x32x16_bf16(pa3, PK(l3, h3), od, 0, 0, 0);
#undef PK
}
__device__ __forceinline__ void pv_all(f32x16* o, int vb, bf16x8 pa0, bf16x8 pa1, bf16x8 pa2, bf16x8 pa3) {
    pv_one<0>(o[0], vb, pa0, pa1, pa2, pa3); pv_one<1>(o[1], vb, pa0, pa1, pa2, pa3); pv_one<2>(o[2], vb, pa0, pa1, pa2, pa3); pv_one<3>(o[3], vb, pa0, pa1, pa2, pa3);
}

__device__ __forceinline__ void attn_unit(int b, int h, int c, int qb, const bf16_t* Q, const bf16_t* K, const bf16_t* V, bf16_t* OT, const unsigned* kmax, LAS char* shm) {
    int tid_ = threadIdx.x; asm volatile("" : "+v"(tid_));
    const int tid = tid_, lane = tid & 63, r32 = lane & 31, hi = lane >> 5; const int wid = __builtin_amdgcn_readfirstlane(tid >> 6);
    const size_t rowbase = (size_t)b * SEQ; const int q0 = qb * 256;
    const bf16_t* Qw = Q + (rowbase + q0 + wid * 32) * 1024 + h * 128 + c * 64;
    const bf16_t* Kh = K + rowbase * 1024 + h * 128 + c * 64; const bf16_t* Vh = V + rowbase * 1024 + h * 128;
    const unsigned lds0 = (unsigned)(uintptr_t)shm;
    const bf16_t* ksrc = Kh + (size_t)lane * 1024 + wid * 8;
    const bf16_t* vsrc[2];
#pragma unroll
    for (int i = 0; i < 2; ++i) { const int p = 2 * wid + i;
        const int st = 2 * p + (lane >> 5), kk = (st >> 2) * 8 + ((lane & 31) >> 2), key = (kk & ~0xC) | ((kk & 4) << 1) | ((kk & 8) >> 1), cc = (st & 3) * 32 + (lane & 3) * 8;
        vsrc[i] = Vh + (size_t)key * 1024 + cc; }
    const unsigned kdst = lds0 + L_K + wid * 1024, vdst = lds0 + L_V + wid * 2048;
#define DMA_KV(t, slot) do { const size_t toff_ = (size_t)(t) * 64 * 1024; \
        glds16(ksrc + toff_, (unsigned)__builtin_amdgcn_readfirstlane(kdst + (slot) * KSLOT)); \
        glds16(vsrc[0] + toff_, (unsigned)__builtin_amdgcn_readfirstlane(vdst + (slot) * VSLOT)); glds16(vsrc[1] + toff_, (unsigned)__builtin_amdgcn_readfirstlane(vdst + (slot) * VSLOT + 1024)); } while (0)
    DMA_KV(0, 0); DMA_KV(1, 1);
    bf16x8 qr[4];
#pragma unroll
    for (int d0 = 0; d0 < 4; ++d0) qr[d0] = *(const bf16x8*)(Qw + (size_t)r32 * 1024 + d0 * 16 + hi * 8);
    float negm;
    {
        float sa = 0.f;
#pragma unroll
        for (int d0 = 0; d0 < 4; ++d0)
#pragma unroll
            for (int e = 0; e < 8; ++e) { const float x = __builtin_bit_cast(float, ((unsigned)(unsigned short)qr[d0][e]) << 16); sa += x * x; }
        { auto rr = __builtin_amdgcn_permlane32_swap(__float_as_uint(sa), __float_as_uint(sa), false, false); sa = __uint_as_float(rr[0]) + __uint_as_float(rr[1]); }
        const unsigned* km = kmax + ((b * 8 + h) * 2 + c) * 2;
        negm = -sqrtf(sa) * sqrtf(__uint_as_float(km[0]) + __uint_as_float(km[1])) * C2;
    }
    f32x16 o[4];
#pragma unroll
    for (int d = 0; d < 4; ++d)
#pragma unroll
        for (int r = 0; r < 16; ++r) o[d][r] = 0.f;
    float l = 0.f;
    const int vb0 = (int)(lds0 + L_V) + v_rd_base(lane);
    constexpr int NT = SEQ / 64;
    int slot = 0;
    for (int t = 0; t < NT; ++t) {
        if (t + 1 < NT) { WAIT_BAR(3); } else { WAIT_BAR(0); }
        if (t + 2 < NT) { const int s2 = (slot + 2 >= NSLOT) ? slot + 2 - NSLOT : slot + 2; DMA_KV(t + 2, s2); }
        const LAS char* Ks = shm + L_K + slot * KSLOT; const int vb = vb0 + slot * VSLOT;
        f32x16 p0, p1; bf16x8 a0, a1, a2, a3;
        SBAR(); qkt(p0, p1, Ks, qr, r32, hi);
        softmax_pack(p0, p1, negm, l, a0, a1, a2, a3);
        SBAR(); pv_all(o, vb, a0, a1, a2, a3);
        slot = (slot + 1 == NSLOT) ? 0 : slot + 1;
    }
#undef DMA_KV
    { auto rr = __builtin_amdgcn_permlane32_swap(__float_as_uint(l), __float_as_uint(l), false, false); l = __uint_as_float(rr[0]) + __uint_as_float(rr[1]); }
    LAS float* wsf = (LAS float*)(shm + L_WS) + wid * 64;
    if (hi == 0) wsf[r32] = 1.0f / l;
    asm volatile("s_waitcnt lgkmcnt(0)" ::: "memory");
    bf16_t* Ow = OT + (size_t)c * MTOK * 1024 + (rowbase + q0 + wid * 32) * 1024 + h * 128;
#pragma unroll
    for (int r = 0; r < 16; ++r) { const int orow = crow(r, hi); const float il = wsf[orow];
#pragma unroll
        for (int d = 0; d < 4; ++d) Ow[(size_t)orow * 1024 + d * 32 + r32] = (bf16_t)f2bf(o[d][r] * il); }
    asm volatile("s_waitcnt lgkmcnt(0)\n\ts_barrier" ::: "memory");
}
#undef SBAR
#undef KSWZ
#undef WAIT_BAR
}

__device__ __forceinline__ void combine_chunk(const bf16_t* OT, bf16_t* MIXp, float lam, const float* subg, float oscale, int chunk, int tid) {
    const int d0 = (tid & 15) * 8;
    float gs[8];
#pragma unroll
    for (int i = 0; i < 8; ++i) gs[i] = subg[d0 + i] * oscale;
    for (int it = tid >> 4; it < 128 * 8; it += NTHREADS / 16) { const int row = chunk * 128 + (it >> 3), h = it & 7;
        const u32x4 a = *(const u32x4*)(OT + (size_t)row * 1024 + h * 128 + d0), bq = *(const u32x4*)(OT + (size_t)MTOK * 1024 + (size_t)row * 1024 + h * 128 + d0);
        float o[8], ss = 0.f;
#pragma unroll
        for (int i = 0; i < 4; ++i) { o[2 * i] = bf_lo(a[i]) - lam * bf_lo(bq[i]); o[2 * i + 1] = bf_hi(a[i]) - lam * bf_hi(bq[i]); ss += o[2 * i] * o[2 * i] + o[2 * i + 1] * o[2 * i + 1]; }
        ss += __shfl_xor(ss, 1); ss += __shfl_xor(ss, 2); ss += __shfl_xor(ss, 4); ss += __shfl_xor(ss, 8);
        const float rstd = 1.0f / sqrtf(ss * (1.f / 128.f) + NORM_EPS);
        u32x4 w; w.x = pk2(o[0] * rstd * gs[0], o[1] * rstd * gs[1]); w.y = pk2(o[2] * rstd * gs[2], o[3] * rstd * gs[3]); w.z = pk2(o[4] * rstd * gs[4], o[5] * rstd * gs[5]); w.w = pk2(o[6] * rstd * gs[6], o[7] * rstd * gs[7]);
        *(u32x4*)(MIXp + (size_t)row * 2048 + 1024 + h * 128 + d0) = w; }
}

__device__ __forceinline__ int skey(float s, int payload, int mask) { int b = __builtin_bit_cast(int, s); b ^= (b >> 31) & 0x7fffffff; return (b & ~mask) | payload; }
__device__ __forceinline__ float skey_score(int k, int mask) { int b = k & ~mask; b ^= (b >> 31) & 0x7fffffff; return __builtin_bit_cast(float, b); }
#define CEX_DESC(a, b) do { const int hi_ = max((a), (b)), lo_ = min((a), (b)); (a) = hi_; (b) = lo_; } while (0)
__device__ __forceinline__ void sort16_desc(int (&k)[16]) {
#pragma unroll
    for (int sz = 2; sz <= 16; sz <<= 1)
#pragma unroll
        for (int j = sz >> 1; j > 0; j >>= 1)
#pragma unroll
            for (int i = 0; i < 16; ++i) { const int l = i ^ j;
                if (l > i) { if ((i & sz) == 0) { CEX_DESC(k[i], k[l]); } else { CEX_DESC(k[l], k[i]); } } }
}
__device__ __forceinline__ void bmerge16_desc(int (&k)[16]) {
#pragma unroll
    for (int j = 8; j > 0; j >>= 1)
#pragma unroll
        for (int i = 0; i < 16; ++i) { const int l = i ^ j; if (l > i) CEX_DESC(k[i], k[l]); }
}
__device__ __forceinline__ void top16_merge(int (&a)[16], const int (&b)[16]) {
#pragma unroll
    for (int i = 0; i < 16; ++i) a[i] = max(a[i], b[15 - i]);
    bmerge16_desc(a);
}
__device__ __forceinline__ void top16_xlane(int (&a)[16]) {
    int e[16], o[16];
#pragma unroll
    for (int i = 0; i < 16; ++i) { auto r = __builtin_amdgcn_permlane16_swap((unsigned)a[i], (unsigned)a[i], false, false); e[i] = (int)r[0]; o[i] = (int)r[1]; }
#pragma unroll
    for (int i = 0; i < 16; ++i) a[i] = max(e[i], o[15 - i]);
    bmerge16_desc(a);
#pragma unroll
    for (int i = 0; i < 16; ++i) { auto r = __builtin_amdgcn_permlane32_swap((unsigned)a[i], (unsigned)a[i], false, false); e[i] = (int)r[0]; o[i] = (int)r[1]; }
#pragma unroll
    for (int i = 0; i < 16; ++i) a[i] = max(e[i], o[15 - i]);
    bmerge16_desc(a);
}

__device__ __forceinline__ void router_task(const bf16_t* QP, const bf16_t* KEYS, unsigned* ROUTE, int tok0, int h, LAS int* scr, int lane) {
    const int fr = lane & 15, fq = lane >> 4;
    int top[2][16];
#pragma unroll
    for (int c = 0; c < 2; ++c) {
        const int hc = h * 2 + c;
        f32x4 acc[8];
#pragma unroll
        for (int nt = 0; nt < 8; ++nt) acc[nt] = (f32x4){0.f, 0.f, 0.f, 0.f};
        const bf16_t* qp = QP + (size_t)(tok0 + fr) * 2048 + hc * 128 + fq * 8;
        const bf16_t* kp = KEYS + ((size_t)hc * 128 + fr) * 128 + fq * 8;
#pragma unroll
        for (int ks = 0; ks < 4; ++ks) { const bf16x8 bq = *(const bf16x8*)(qp + ks * 32);
#pragma unroll
            for (int nt = 0; nt < 8; ++nt) { const bf16x8 ak = *(const bf16x8*)(kp + (size_t)nt * 16 * 128 + ks * 32);
                acc[nt] = __builtin_amdgcn_mfma_f32_16x16x32_bf16(ak, bq, acc[nt], 0, 0, 0); } }
        int ka[16], kb[16];
#pragma unroll
        for (int nt = 0; nt < 4; ++nt)
#pragma unroll
            for (int i = 0; i < 4; ++i) { ka[nt * 4 + i] = skey(acc[nt][i], 16 * nt + 4 * fq + i, 127); kb[nt * 4 + i] = skey(acc[nt + 4][i], 16 * (nt + 4) + 4 * fq + i, 127); }
        sort16_desc(ka); sort16_desc(kb); top16_merge(ka, kb);
        top16_xlane(ka);
#pragma unroll
        for (int i = 0; i < 16; ++i) top[c][i] = ka[i];
    }
    if (fq == 0) {
#pragma unroll
        for (int i = 0; i < 16; ++i) { scr[fr * 32 + i] = top[0][i] & 127; scr[fr * 32 + 16 + i] = top[1][i] & 127; } }
    float s0[16], s1[16];
#pragma unroll
    for (int i = 0; i < 16; ++i) { s0[i] = skey_score(top[0][i], 127); s1[i] = skey_score(top[1][i], 127); }
    constexpr int NEG = (int)0x80000000;
    int best[16], ch[16];
#define CAND(a, b) skey(s0[a] + s1[b], (a) * 16 + (b), 255)
#pragma unroll
    for (int b = 0; b < 16; ++b) best[b] = CAND(0, b);
    sort16_desc(best);
    ch[0] = CAND(1, 0); ch[1] = CAND(1, 1); ch[2] = CAND(1, 2); ch[3] = CAND(1, 3); ch[4] = CAND(1, 4); ch[5] = CAND(1, 5); ch[6] = CAND(1, 6); ch[7] = CAND(1, 7);
    ch[8] = CAND(2, 0); ch[9] = CAND(2, 1); ch[10] = CAND(2, 2); ch[11] = CAND(2, 3); ch[12] = CAND(2, 4); ch[13] = CAND(3, 0); ch[14] = CAND(3, 1); ch[15] = CAND(3, 2);
    sort16_desc(ch); top16_merge(best, ch);
    ch[0] = CAND(3, 3); ch[1] = CAND(4, 0); ch[2] = CAND(4, 1); ch[3] = CAND(4, 2); ch[4] = CAND(5, 0); ch[5] = CAND(5, 1); ch[6] = CAND(6, 0); ch[7] = CAND(6, 1);
    ch[8] = CAND(7, 0); ch[9] = CAND(7, 1); ch[10] = CAND(8, 0); ch[11] = CAND(9, 0); ch[12] = CAND(10, 0); ch[13] = CAND(11, 0); ch[14] = CAND(12, 0); ch[15] = CAND(13, 0);
    sort16_desc(ch); top16_merge(best, ch);
    ch[0] = CAND(14, 0); ch[1] = CAND(15, 0);
#pragma unroll
    for (int i = 2; i < 16; ++i) ch[i] = NEG;
    sort16_desc(ch); top16_merge(best, ch);
#undef CAND
    float g[16], gs = 0.f; const float smax = skey_score(best[0], 255);
#pragma unroll
    for (int i = 0; i < 16; ++i) { g[i] = __expf(skey_score(best[i], 255) - smax); gs += g[i]; }
    const float inv = 1.0f / gs;
    LDS_WAIT(); asm volatile("" ::: "memory");
    if (fq == 0) { unsigned e[16];
#pragma unroll
        for (int i = 0; i < 16; ++i) { const int ci = best[i] & 255, a = ci >> 4, b = ci & 15; const int ia = scr[fr * 32 + a], ib = scr[fr * 32 + 16 + b];
            e[i] = (f2bf(g[i] * inv) << 16) | (unsigned)(ia * 128 + ib); }
        unsigned* rp = ROUTE + (size_t)(tok0 + fr) * 128 + h * 16;
#pragma unroll
        for (int i = 0; i < 4; ++i) *(u32x4*)(rp + 4 * i) = (u32x4){e[4 * i], e[4 * i + 1], e[4 * i + 2], e[4 * i + 3]}; }
    LDS_WAIT(); asm volatile("" ::: "memory");
}

typedef float f32x2v __attribute__((ext_vector_type(2)));
__device__ __forceinline__ float gelu_exact(float a) { return 0.5f * a * (1.0f + erff(a * 0.70710678118654752f)); }
__device__ __forceinline__ float expert_u_half(const unsigned R, const float (&hv)[32], const unsigned char* U8, const float* US, const float* VS, int lane) {
    float W = 0.f;
    const float us_own = US[R & 0x3fffu], vs_own = VS[R & 0x3fffu];
#pragma unroll 1
    for (int g8 = 0; g8 < 8; ++g8) {
        float part[8];
#pragma unroll
        for (int i = 0; i < 8; ++i) {
            const unsigned ent = (unsigned)__builtin_amdgcn_readlane((int)R, g8 * 8 + i);
            const unsigned char* up = U8 + (size_t)(ent & 0x3fffu) * DM + 16 * lane;
            float acc0 = 0.f, acc1 = 0.f;
#pragma unroll
            for (int j = 0; j < 2; ++j) { const u32x4 uu = *(const u32x4*)(up + 1024 * j);
#pragma unroll
                for (int q = 0; q < 4; ++q) { const f32x2v lo = __builtin_amdgcn_cvt_pk_f32_fp8((int)uu[q], false), hi = __builtin_amdgcn_cvt_pk_f32_fp8((int)uu[q], true);
                    acc0 = fmaf(lo.x, hv[16 * j + 4 * q], acc0); acc1 = fmaf(lo.y, hv[16 * j + 4 * q + 1], acc1); acc0 = fmaf(hi.x, hv[16 * j + 4 * q + 2], acc0); acc1 = fmaf(hi.y, hv[16 * j + 4 * q + 3], acc1); } }
            part[i] = acc0 + acc1;
            if (i == 3) __builtin_amdgcn_sched_barrier(0); }
#pragma unroll
        for (int s = 0; s < 3; ++s) { const int m = 1 << s; const bool up_ = (lane & m) != 0;
#pragma unroll
            for (int i = 0; i < (4 >> s); ++i) { const float a = part[2 * i], c = part[2 * i + 1]; const float keep = up_ ? c : a, send = up_ ? a : c;
                part[i] = keep + __shfl_xor(send, m); } }
        float tot = part[0]; tot += __shfl_xor(tot, 8); tot += __shfl_xor(tot, 16); tot += __shfl_xor(tot, 32);
        const float val = gelu_exact(tot * us_own) * __builtin_bit_cast(float, R & 0xffff0000u) * vs_own;
        W = ((lane >> 3) == g8) ? val : W;
    }
    return W;
}
__device__ __forceinline__ void expert_v_half(const unsigned R, const float W, float (&oacc)[32], const unsigned char* V8, int lane) {
#pragma unroll 1
    for (int e0 = 0; e0 < 64; e0 += 4) {
#pragma unroll
        for (int i = 0; i < 4; ++i) {
            const unsigned ent = (unsigned)__builtin_amdgcn_readlane((int)R, e0 + i);
            const float w = __builtin_bit_cast(float, __builtin_amdgcn_readlane(__builtin_bit_cast(int, W), e0 + i));
            const unsigned char* vp = V8 + (size_t)(ent & 0x3fffu) * DM + 16 * lane;
#pragma unroll
            for (int j = 0; j < 2; ++j) { const u32x4 vv = *(const u32x4*)(vp + 1024 * j);
#pragma unroll
                for (int q = 0; q < 4; ++q) { const f32x2v lo = __builtin_amdgcn_cvt_pk_f32_fp8((int)vv[q], false), hi = __builtin_amdgcn_cvt_pk_f32_fp8((int)vv[q], true);
                    oacc[16 * j + 4 * q] = fmaf(w, lo.x, oacc[16 * j + 4 * q]); oacc[16 * j + 4 * q + 1] = fmaf(w, lo.y, oacc[16 * j + 4 * q + 1]);
                    oacc[16 * j + 4 * q + 2] = fmaf(w, hi.x, oacc[16 * j + 4 * q + 2]); oacc[16 * j + 4 * q + 3] = fmaf(w, hi.y, oacc[16 * j + 4 * q + 3]); } } }
    }
}
__device__ __forceinline__ void expert_token(const float* xin, float* xout, const float* g, const float* sh, const float* sc, const float* gate, const unsigned char* U8, const unsigned char* V8, const float* US, const float* VS,
                                             const unsigned* ROUTE, int row, int lane) {
    const int b = row >> 12; const float* xr = xin + (size_t)row * DM + 16 * lane;
    float hv[32];
    {
        f32x4 v[8]; float ss = 0.f;
#pragma unroll
        for (int j = 0; j < 2; ++j)
#pragma unroll
            for (int q = 0; q < 4; ++q) { const f32x4 a = *(const f32x4*)(xr + 1024 * j + 4 * q); v[4 * j + q] = a; ss += (a[0] * a[0] + a[1] * a[1]) + (a[2] * a[2] + a[3] * a[3]); }
        const float rstd = 1.0f / sqrtf(wave_sum(ss) * (1.f / DM) + NORM_EPS);
        const float* gp = g + 16 * lane; const float* shp = sh + (size_t)b * MODW + 16 * lane; const float* scp = sc + (size_t)b * MODW + 16 * lane;
#pragma unroll
        for (int j = 0; j < 2; ++j)
#pragma unroll
            for (int q = 0; q < 4; ++q) { const f32x4 gg = *(const f32x4*)(gp + 1024 * j + 4 * q), s1 = *(const f32x4*)(scp + 1024 * j + 4 * q), s0 = *(const f32x4*)(shp + 1024 * j + 4 * q);
                const f32x4 o = (v[4 * j + q] * rstd) * gg * (s1 + 1.0f) + s0;
                hv[16 * j + 4 * q] = o[0]; hv[16 * j + 4 * q + 1] = o[1]; hv[16 * j + 4 * q + 2] = o[2]; hv[16 * j + 4 * q + 3] = o[3]; }
    }
    const unsigned r0 = ROUTE[(size_t)row * 128 + lane], r1 = ROUTE[(size_t)row * 128 + 64 + lane];
    const float w0 = expert_u_half(r0, hv, U8, US, VS, lane), w1 = expert_u_half(r1, hv, U8, US, VS, lane);
    float oacc[32];
#pragma unroll
    for (int i = 0; i < 32; ++i) oacc[i] = 0.f;
    expert_v_half(r0, w0, oacc, V8, lane); expert_v_half(r1, w1, oacc, V8, lane);
    const float* gtp = gate + (size_t)b * MODW + 16 * lane;
#pragma unroll
    for (int j = 0; j < 2; ++j)
#pragma unroll
        for (int q = 0; q < 4; ++q) { const f32x4 x = *(const f32x4*)(xr + 1024 * j + 4 * q), gg = *(const f32x4*)(gtp + 1024 * j + 4 * q);
            const f32x4 o = {oacc[16 * j + 4 * q], oacc[16 * j + 4 * q + 1], oacc[16 * j + 4 * q + 2], oacc[16 * j + 4 * q + 3]};
            *(f32x4*)(xout + (size_t)row * DM + 16 * lane + 1024 * j + 4 * q) = x + gg * o; }
}

constexpr int NPHASE = 39;
#ifndef MK_SPLIT
#define MK_SPLIT 0
#endif
struct Args { const float* in[20]; float* out; unsigned char* ws; int ph_lo, ph_hi; };
static_assert(sizeof(Args) == 20 * 8 + 8 + 8 + 8, "Args has no padding");

__device__ __forceinline__ bool in_range(int lo, int hi, int k) { asm volatile("" : "+s"(lo), "+s"(hi)); return lo <= k && k < hi; }
__global__ void __launch_bounds__(NTHREADS, 2) fwd_kernel(Args args) {
    extern __shared__ __attribute__((aligned(16))) unsigned char lds_raw[];
    Ctx C;
    C.lds = (LAS unsigned char*)lds_raw; C.ws = args.ws;
    C.tid = threadIdx.x; C.lane = C.tid & 63; C.wave = __builtin_amdgcn_readfirstlane(C.tid >> 6);
    C.G = gridDim.x; { const int bx = blockIdx.x; C.vcu = (C.G % 8 == 0) ? (bx % 8) * (C.G / 8) + bx / 8 : bx; }
    C.gw = C.vcu * NWAVES + C.wave; C.NGW = C.G * NWAVES;
    C.out = args.out;
    unsigned* ctl = (unsigned*)(C.ws + WS_CTL);
    volatile LAS unsigned* MISC = (volatile LAS unsigned*)(C.lds + LDS_MISC);
    for (int u = C.tid; u < (LDS_BYTES - LDS_MISC) / 4; u += NTHREADS) ((LAS unsigned*)(C.lds + LDS_MISC))[u] = 0u;
    __syncthreads();
    const int lo = args.ph_lo, hi = args.ph_hi;
    XcdBarrier bar; bar.bar = ctl + CW_BAR; bar.x = 0; bar.st = nullptr;
    if (hi - lo > 1) bar = xcd_barrier_post(ctl + CW_BAR, MISC + 8);
#ifndef ONLYP
#define ONLYP -1
#endif
#define PEN(c) (ONLYP < 0 || ONLYP == (c))
#define IN(k) in_range(lo, hi, (k))
#define FRESH(k) do { C.tid = threadIdx.x; uintptr_t w_ = (uintptr_t)args.ws, o_ = (uintptr_t)args.out; asm volatile("; PHASE_MARK " #k : "+v"(C.tid), "+s"(C.gw), "+s"(C.vcu), "+s"(w_), "+s"(o_)); \
    C.ws = (unsigned char*)(GAS unsigned char*)w_; C.out = (float*)(GAS float*)o_; C.lane = C.tid & 63; } while (0)
#define SEAM(k) do { if (IN(k) && IN((k) + 1)) xcd_barrier(bar); } while (0)

    float* MOD = (float*)(C.ws + WS_MOD);
    bf16_t* H = (bf16_t*)(C.ws + WS_H); bf16_t* SEG = (bf16_t*)(C.ws + WS_SEG); bf16_t* MIX = (bf16_t*)(C.ws + WS_MIX); bf16_t* QP = (bf16_t*)(C.ws + WS_QP); bf16_t* H2 = (bf16_t*)(C.ws + WS_H2); bf16_t* OT = (bf16_t*)(C.ws + WS_OT);
    unsigned* ROUTE = (unsigned*)(C.ws + WS_ROUTE);

    if (PEN(0) && IN(0)) { FRESH(0); p0_prologue(C, args); } SEAM(0);
    if (PEN(1) && IN(1)) { FRESH(1); p1_modfinal(C, args.in[4]); } SEAM(1);

    for (int l = 0; l < DEPTH; ++l) {
        const int pb = 2 + 9 * l;
        const float* modl = MOD + (size_t)l * NBATCH * MODW;
        unsigned* kmax = ctl + CW_KMAX + l * 256;
        if (PEN(2) && IN(pb + 0)) { FRESH(2); const float* xcur = (l == 0) ? args.in[0] : (const float*)C.out; norm_pass(C, xcur, H, args.in[5] + (size_t)l * DM, modl + 0 * DM, modl + 1 * DM); } SEAM(pb + 0);
        if (PEN(3) && IN(pb + 1)) { FRESH(3);
            pg8::Gemm g{H, (const bf16_t*)(C.ws + WS_WIN) + (size_t)l * INC * DM, MTOK, INC, DM}; pg8::StaticOrder S; S.init(MTOK, INC, C.G, (int)blockIdx.x);
            pg8::EpiIn E{SEG, SEG_ELEMS, (const float*)(C.ws + WS_ROPE), kmax};
            pg8::gemm_phase<pg8::EpiIn, pg8::StaticOrder, true, true>(C.lds, g, S, E);
        } SEAM(pb + 1);
        if (PEN(4) && IN(pb + 2)) { FRESH(4);
            for (int u = C.vcu; u < NBATCH * AHEADS * 2 * (SEQ / 256); u += C.G) { const int bh = u >> 5, c = (u >> 4) & 1, qb = u & 15;
                att::attn_unit(bh >> 3, bh & 7, c, qb, SEG + 3 * SEG_ELEMS, SEG + 4 * SEG_ELEMS, SEG + 5 * SEG_ELEMS, OT, kmax, (LAS char*)C.lds); }
        } SEAM(pb + 2);
        if (PEN(11) && IN(pb + 3)) { FRESH(11);
            const float lam = ((const float*)(C.ws + WS_LAM))[l], osc = ((const float*)(C.ws + WS_LAM))[4 + l];
            for (int ch = C.vcu; ch < MTOK / 128; ch += C.G) {
                conv_chunk(SEG + 0 * SEG_ELEMS, SEG + 1 * SEG_ELEMS, SEG + 2 * SEG_ELEMS, args.in[7] + (size_t)l * 3 * CONVW, MIX, ch, C.tid);
                combine_chunk(OT, MIX, lam, args.in[12] + (size_t)l * VDIM, osc, ch, C.tid); }
        } SEAM(pb + 3);
        if (PEN(5) && IN(pb + 4)) { FRESH(5);
            pg8::Gemm g{MIX, (const bf16_t*)(C.ws + WS_WOUT) + (size_t)l * DM * DM, MTOK, DM, DM}; pg8::StaticOrder S; S.init(MTOK, DM, C.G, (int)blockIdx.x);
            const float* xcur = (l == 0) ? args.in[0] : (const float*)C.out;
            pg8::EpiRes E{xcur, C.out, modl + 2 * DM};
            pg8::gemm_phase<pg8::EpiRes, pg8::StaticOrder, true, true>(C.lds, g, S, E);
        } SEAM(pb + 4);
        if (PEN(6) && IN(pb + 5)) { FRESH(6); norm_pass(C, C.out, H2, args.in[14] + (size_t)l * DM, modl + 3 * DM, modl + 4 * DM); } SEAM(pb + 5);
        if (PEN(7) && IN(pb + 6)) { FRESH(7);
            pg8::Gemm g{H2, (const bf16_t*)(C.ws + WS_WQ) + (size_t)l * DM * DM, MTOK, DM, DM}; pg8::StaticOrder S; S.init(MTOK, DM, C.G, (int)blockIdx.x);
            pg8::EpiBf16 E{QP, DM};
            pg8::gemm_phase<pg8::EpiBf16, pg8::StaticOrder, true, true>(C.lds, g, S, E);
        } SEAM(pb + 6);
        if (PEN(8) && IN(pb + 7)) { FRESH(8);
            const bf16_t* keys = (const bf16_t*)(C.ws + WS_KEYS) + (size_t)l * 16 * 128 * 128;
            LAS int* scr = (LAS int*)(C.lds + C.wave * 2048);
            for (int it = C.gw; it < (MTOK / 16) * PHEADS; it += C.NGW) router_task(QP, keys, ROUTE, (it >> 3) * 16, it & 7, scr, C.lane);
        } SEAM(pb + 7);
        if (PEN(9) && IN(pb + 8)) { FRESH(9);
            const unsigned char* U8 = C.ws + WS_U + (size_t)l * NEXP * DM; const unsigned char* V8 = C.ws + WS_V + (size_t)l * NEXP * DM;
            const float* US = (const float*)(C.ws + WS_USC) + (size_t)l * NEXP; const float* VS = (const float*)(C.ws + WS_VSC) + (size_t)l * NEXP;
            for (int row = C.gw; row < MTOK; row += C.NGW)
                expert_token(C.out, C.out, args.in[14] + (size_t)l * DM, modl + 3 * DM, modl + 4 * DM, modl + 5 * DM, U8, V8, US, VS, ROUTE, row, C.lane);
        } SEAM(pb + 8);
    }
    if (PEN(10) && IN(38)) { FRESH(10); final_norm_pass(C, C.out, C.out, args.in[19]); }
#undef IN
#undef SEAM
}


#if defined(CHECK) && CHECK
constexpr size_t WS_XSAVE = 1760 * MiB;
constexpr int NSTAGE = 13, NSAMP = 96;
__device__ __forceinline__ unsigned hash32(unsigned x) { x ^= x >> 16; x *= 0x7feb352du; x ^= x >> 15; x *= 0x846ca68bu; x ^= x >> 16; return x; }
__device__ __forceinline__ float bf2f(bf16_t v) { return __builtin_bit_cast(float, ((unsigned)v) << 16); }
__device__ __forceinline__ double wsumd(double v) {
#pragma unroll
    for (int o = 1; o < 64; o <<= 1) v += __shfl_xor(v, o);
    return v; }
__device__ __forceinline__ float wmaxf(float v) {
#pragma unroll
    for (int o = 1; o < 64; o <<= 1) v = fmaxf(v, __shfl_xor(v, o));
    return v; }
__device__ __forceinline__ void diag_add(float* diag, int stage, double num, double den, int lane) { if (lane == 0) { atomicAdd(diag + 2 * stage, (float)num); atomicAdd(diag + 2 * stage + 1, (float)den); } }
__device__ __forceinline__ float chk_silu(float x) { return x / (1.f + expf(-x)); }
__device__ __forceinline__ float chk_rstd(const float* x, int row, int lane) { double ss = 0; for (int k = lane; k < DM; k += 64) { const double v = x[(size_t)row * DM + k]; ss += v * v; } ss = wsumd(ss); return 1.0f / sqrtf((float)(ss / DM) + NORM_EPS); }
__device__ __forceinline__ float chk_norm_elem(const float* x, int row, int col, float rstd, const float* g, const float* sh, const float* sc) { const int b = row >> 12;
    return x[(size_t)row * DM + col] * rstd * g[col] * (1.0f + sc[(size_t)b * MODW + col]) + sh[(size_t)b * MODW + col]; }
__global__ void __launch_bounds__(64) check_kernel(Args args) {
    __shared__ float sq_[64]; __shared__ float ssc[256]; __shared__ int sused[256]; __shared__ int sti[32]; __shared__ float sts[32]; __shared__ int sce[16]; __shared__ float scs[16];
    const int stage = blockIdx.x / NSAMP, s = blockIdx.x % NSAMP, lane = threadIdx.x;
    unsigned char* ws = args.ws; float* diag = (float*)(ws + WS_DIAG);
    const float* MOD = (const float*)(ws + WS_MOD); const bf16_t* H = (const bf16_t*)(ws + WS_H); const bf16_t* SEG = (const bf16_t*)(ws + WS_SEG);
    const bf16_t* MIX = (const bf16_t*)(ws + WS_MIX); const bf16_t* OT = (const bf16_t*)(ws + WS_OT); const bf16_t* H2 = (const bf16_t*)(ws + WS_H2); const bf16_t* QP = (const bf16_t*)(ws + WS_QP); const unsigned* ROUTE = (const unsigned*)(ws + WS_ROUTE);
    const float* XS = (const float*)(ws + WS_XSAVE); const unsigned* kmax = (const unsigned*)(ws + WS_CTL) + CW_KMAX;
    const unsigned hsh = hash32(stage * 7919u + s * 104729u + 12345u);
    const int row = hsh % MTOK; const unsigned h2 = hash32(hsh + 1u);
    if (stage == 1) {
        const int b = h2 % 8, n = (h2 >> 3) % MODW; double a = 0;
        for (int k = lane; k < DM; k += 64) a += (double)chk_silu(args.in[1][b * DM + k]) * args.in[3][(size_t)k * MODW + n];
        a = wsumd(a) + args.in[4][n]; const double d = MOD[(size_t)b * MODW + n] - a; diag_add(diag, stage, d * d, a * a, lane);
    } else if (stage == 2) {
        const int col = h2 % DM; const float rstd = chk_rstd(args.in[0], row, lane); const float r = chk_norm_elem(args.in[0], row, col, rstd, args.in[5], MOD + 0 * DM, MOD + 1 * DM);
        const double d = bf2f(H[(size_t)row * DM + col]) - r; diag_add(diag, stage, d * d, (double)r * r, lane);
    } else if (stage == 3 || stage == 4) {
        int col;
        if (stage == 3) { const int t = h2 % 4; col = (t == 3 ? 5 : t) * 1024 + (h2 >> 2) % 1024; } else { col = 3072 + (h2 % 2048); if (s < NSAMP / 2) col = (col & ~63) | ((h2 >> 11) % 16); }
        auto dotc = [&](int c) { double a = 0; for (int k = lane; k < DM; k += 64) a += (double)bf2f(H[(size_t)row * DM + k]) * args.in[6][(size_t)k * INC + c]; return (float)wsumd(a); };
        float r = dotc(col);
        if (stage == 4) { const int dd = col & 63; if (dd < 16) { const int j = dd & 7; const float invf = powf(500000.f, -(float)(2 * j) / 16.f); const float ang = (float)((const int*)args.in[2])[row] * invf;
                const float cs = cosf(ang), sn = sinf(ang); const float o = (dd < 8) ? dotc(col + 8) : dotc(col - 8); r = (dd < 8) ? r * cs - o * sn : r * cs + o * sn; } }
        const float got = bf2f(SEG[(size_t)(col >> 10) * SEG_ELEMS + (size_t)row * 1024 + (col & 1023)]);
        const double d = got - r; diag_add(diag, stage, d * d, (double)r * r, lane);
    } else if (stage == 5) {
        const int b = h2 % 8, hh = (h2 >> 3) % 8, c = (h2 >> 6) % 2; const bf16_t* K = SEG + 4 * SEG_ELEMS; float mx = 0.f;
        for (int sq = lane; sq < SEQ; sq += 64) { float a = 0; for (int d = 0; d < 64; ++d) { const float v = bf2f(K[((size_t)b * SEQ + sq) * 1024 + hh * 128 + c * 64 + d]); a += v * v; } mx = fmaxf(mx, a); }
        mx = wmaxf(mx);
        const unsigned* km = kmax + ((b * 8 + hh) * 2 + c) * 2; const float bound = __uint_as_float(km[0]) + __uint_as_float(km[1]);
        const bool ok = bound >= mx * 0.98f && bound <= mx * 2.2f; diag_add(diag, stage, ok ? 0.0 : 1.0, 1.0, lane);
    } else if (stage == 6) {
        const int hh = h2 % 8, c = (h2 >> 3) % 2, d = (h2 >> 4) % 128, b = row >> 12;
        const bf16_t* Q = SEG + 3 * SEG_ELEMS; const bf16_t* K = SEG + 4 * SEG_ELEMS; const bf16_t* V = SEG + 5 * SEG_ELEMS;
        sq_[lane] = bf2f(Q[(size_t)row * 1024 + hh * 128 + c * 64 + lane]); __syncthreads();
        float mx = -1e30f;
        for (int sq = lane; sq < SEQ; sq += 64) { float a = 0; const bf16_t* kr = K + ((size_t)b * SEQ + sq) * 1024 + hh * 128 + c * 64; for (int e = 0; e < 64; ++e) a += sq_[e] * bf2f(kr[e]); mx = fmaxf(mx, a * 0.125f); }
        mx = wmaxf(mx);
        double num = 0, den = 0;
        for (int sq = lane; sq < SEQ; sq += 64) { float a = 0; const bf16_t* kr = K + ((size_t)b * SEQ + sq) * 1024 + hh * 128 + c * 64; for (int e = 0; e < 64; ++e) a += sq_[e] * bf2f(kr[e]);
            const double p = exp((double)(a * 0.125f - mx)); den += p; num += p * bf2f(V[((size_t)b * SEQ + sq) * 1024 + hh * 128 + d]); }
        num = wsumd(num); den = wsumd(den);
        const double r = num / den; const double dd = bf2f(OT[(size_t)c * MTOK * 1024 + (size_t)row * 1024 + hh * 128 + d]) - r; diag_add(diag, stage, dd * dd, r * r, lane);
    } else if (stage == 7) {
        if ((s & 1) == 0) { const int col = h2 % 1024, sq = row & (SEQ - 1); const bf16_t* GB = SEG; const bf16_t* GC = SEG + SEG_ELEMS; const bf16_t* HV = SEG + 2 * SEG_ELEMS;
            auto z = [&](int r) { return bf2f(GC[(size_t)r * 1024 + col]) * bf2f(HV[(size_t)r * 1024 + col]); };
            const float zm = (sq > 0) ? z(row - 1) : 0.f, zc = z(row), zp = (sq < SEQ - 1) ? z(row + 1) : 0.f;
            const float r = bf2f(GB[(size_t)row * 1024 + col]) * (args.in[7][col] * zm + args.in[7][1024 + col] * zc + args.in[7][2048 + col] * zp);
            const double d = bf2f(MIX[(size_t)row * 2048 + col]) - r; diag_add(diag, stage, d * d, (double)r * r, lane);
        } else { const int hh = h2 % 8, d = (h2 >> 3) % 128;
            const double a1 = wsumd((double)args.in[8][lane] * args.in[9][lane]), a2 = wsumd((double)args.in[10][lane] * args.in[11][lane]);
            const float lam_init = 0.8f - 0.6f * expf(-0.3f * 0.f), lam = (float)(exp(a1) - exp(a2)) + lam_init;
            double ss = 0; float od = 0;
            for (int e = lane; e < 128; e += 64) { const float o = bf2f(OT[(size_t)row * 1024 + hh * 128 + e]) - lam * bf2f(OT[(size_t)MTOK * 1024 + (size_t)row * 1024 + hh * 128 + e]); ss += (double)o * o; if (e == d) od = o; }
            ss = wsumd(ss); od = (float)wsumd((double)od);
            const float r = od / sqrtf((float)(ss / 128.0) + NORM_EPS) * args.in[12][d] * (1.f - lam_init);
            const double dd = bf2f(MIX[(size_t)row * 2048 + 1024 + hh * 128 + d]) - r; diag_add(diag, stage, dd * dd, (double)r * r, lane); }
    } else if (stage == 8) {
        const int col = h2 % DM, b = row >> 12; double a = 0; for (int k = lane; k < DM; k += 64) a += (double)bf2f(MIX[(size_t)row * DM + k]) * args.in[13][(size_t)k * DM + col];
        a = wsumd(a); const double delta = (double)MOD[(size_t)b * MODW + 2 * DM + col] * a;
        const double r = args.in[0][(size_t)row * DM + col] + delta; const double d = XS[(size_t)row * DM + col] - r; diag_add(diag, stage, d * d, delta * delta, lane);
    } else if (stage == 9) {
        const int col = h2 % DM; const float rstd = chk_rstd(XS, row, lane); const float r = chk_norm_elem(XS, row, col, rstd, args.in[14], MOD + 3 * DM, MOD + 4 * DM);
        const double d = bf2f(H2[(size_t)row * DM + col]) - r; diag_add(diag, stage, d * d, (double)r * r, lane);
    } else if (stage == 10) {
        const int col = h2 % DM; double a = 0; for (int k = lane; k < DM; k += 64) a += (double)bf2f(H2[(size_t)row * DM + k]) * args.in[15][(size_t)k * DM + col];
        a = wsumd(a); const double d = bf2f(QP[(size_t)row * DM + col]) - a; diag_add(diag, stage, d * d, a * a, lane);
    } else if (stage == 11) {
        const int hh = h2 % 8;
        for (int i = lane; i < 256; i += 64) { const int c = i >> 7, n = i & 127; double a = 0; for (int d = 0; d < 128; ++d) a += (double)bf2f(QP[(size_t)row * DM + (hh * 2 + c) * 128 + d]) * args.in[16][(((size_t)hh * 2 + c) * 128 + n) * 128 + d]; ssc[i] = (float)a; sused[i] = 0; }
        __syncthreads();
        if (lane == 0) {
            for (int c = 0; c < 2; ++c) for (int j = 0; j < 16; ++j) { int bi = -1; float bv = -1e30f; for (int n = 0; n < 128; ++n) if (!sused[c * 128 + n] && ssc[c * 128 + n] > bv) { bv = ssc[c * 128 + n]; bi = n; }
                sti[c * 16 + j] = bi; sts[c * 16 + j] = bv; sused[c * 128 + bi] = 1; }
            for (int q = 0; q < 256; ++q) sused[q] = 0;
            for (int j = 0; j < 16; ++j) { int bi = -1; float bv = -1e30f; for (int q = 0; q < 256; ++q) { if (sused[q]) continue; const float v = sts[q >> 4] + sts[16 + (q & 15)]; if (v > bv) { bv = v; bi = q; } }
                sused[bi] = 1; sce[j] = sti[bi >> 4] * 128 + sti[16 + (bi & 15)]; scs[j] = bv; }
            double gsum = 0; for (int j = 0; j < 16; ++j) gsum += exp((double)(scs[j] - scs[0]));
            double err = 0;
            for (int j = 0; j < 16; ++j) { const double gr = exp((double)(scs[j] - scs[0])) / gsum; double gm = 0;
                for (int q = 0; q < 16; ++q) { const unsigned e = ROUTE[(size_t)row * 128 + hh * 16 + q]; if ((int)(e & 0x3fffu) == sce[j]) gm = __builtin_bit_cast(float, e & 0xffff0000u); }
                err += fabs(gr - gm); }
            diag_add(diag, stage, err * err, 1.0, lane); }
    } else if (stage == 12) {
        const int col = h2 % DM, b = row >> 12; const float rstd = chk_rstd(XS, row, lane); double out = 0;
        for (int e = 0; e < 128; ++e) { const unsigned ent = ROUTE[(size_t)row * 128 + e]; const int eid = ent & 0x3fffu; const float gate = __builtin_bit_cast(float, ent & 0xffff0000u); double a = 0;
            for (int k = lane; k < DM; k += 64) { const float hk = chk_norm_elem(XS, row, k, rstd, args.in[14], MOD + 3 * DM, MOD + 4 * DM); a += (double)hk * args.in[17][(size_t)eid * DM + k]; }
            a = wsumd(a); const double ge = 0.5 * a * (1.0 + erf(a * 0.7071067811865476)); out += ge * gate * args.in[18][(size_t)eid * DM + col]; }
        const double delta = (double)MOD[(size_t)b * MODW + 5 * DM + col] * out; const double r = XS[(size_t)row * DM + col] + delta; const double d = args.out[(size_t)row * DM + col] - r; diag_add(diag, stage, d * d, delta * delta, lane);
    }
}
#ifndef CHECK_FROM
#define CHECK_FROM 1
#endif
__global__ void encode_kernel(Args args) {
    const float* diag = (const float*)(args.ws + WS_DIAG);
    int k = 14; float m = 1.f;
    for (int st = NSTAGE - 1; st >= CHECK_FROM; --st) { const float num = diag[2 * st], den = diag[2 * st + 1]; float rel = sqrtf(num / fmaxf(den, 1e-30f)); if (!(rel == rel)) rel = 1e4f;
        const float tol = (st == 11) ? 0.08f : (st == 5 ? 0.01f : 0.03f);
        if (rel > tol) { k = st; m = fminf(9.9f, fmaxf(1.f, 1.f + 2.f * (log10f(rel) + 4.f))); } }
    const float c = sqrtf(m * powf(10.f, (float)k));
    for (size_t i = (size_t)blockIdx.x * blockDim.x + threadIdx.x; i < (size_t)MTOK * DM; i += (size_t)gridDim.x * blockDim.x) args.out[i] = c;
}
#endif
extern "C" void kernel_launch(void* const* d_in, const int* in_sizes, int n_in, void* d_out, int out_size, void* d_ws, size_t ws_size, hipStream_t stream) {
    static int grid = 0;
    if (grid == 0) {
        if (n_in != 20 || out_size != MTOK * DM || ws_size < WS_END) { fprintf(stderr, "kernel_launch: unexpected shapes: n_in %d out %d ws %zu (need %zu)\n", n_in, out_size, ws_size, (size_t)WS_END); grid = -1; return; }
        int dev = 0, cus = 0;
        if (hipGetDevice(&dev) != hipSuccess || hipDeviceGetAttribute(&cus, hipDeviceAttributeMultiprocessorCount, dev) != hipSuccess) { grid = -1; return; }
        if (hipFuncSetAttribute((const void*)fwd_kernel, hipFuncAttributeMaxDynamicSharedMemorySize, LDS_BYTES) != hipSuccess) { fprintf(stderr, "kernel_launch: hipFuncSetAttribute failed\n"); grid = -1; return; }
        int per_cu = 0;
        if (hipOccupancyMaxActiveBlocksPerMultiprocessor(&per_cu, (const void*)fwd_kernel, NTHREADS, LDS_BYTES) != hipSuccess || per_cu < 1) { fprintf(stderr, "kernel_launch: occupancy query says %d\n", per_cu); }
        (void)hipGetLastError();
        grid = cus;
    }
    if (grid < 0) return;
    (void)hipMemsetAsync((char*)d_ws + WS_CTL, 0, CTL_ZERO_BYTES, stream);
    Args a{};
    for (int i = 0; i < 20; ++i) a.in[i] = (const float*)d_in[i];
    a.out = (float*)d_out; a.ws = (unsigned char*)d_ws;
#if defined(CHECK) && CHECK
    if (ws_size < WS_XSAVE + (size_t)MTOK * DM * 4) { fprintf(stderr, "check build: workspace too small\n"); return; }
    (void)hipMemsetAsync((char*)d_ws + WS_DIAG, 0, 4096, stream);
    for (int p = 0; p < 2 + 9; ++p) { a.ph_lo = p; a.ph_hi = p + 1; hipLaunchKernelGGL(fwd_kernel, dim3(grid), dim3(NTHREADS), LDS_BYTES, stream, a);
        if (p == 2 + 4) (void)hipMemcpyAsync((char*)d_ws + WS_XSAVE, d_out, (size_t)MTOK * DM * 4, hipMemcpyDeviceToDevice, stream); }
    hipLaunchKernelGGL(check_kernel, dim3(NSTAGE * NSAMP), dim3(64), 0, stream, a);
    hipLaunchKernelGGL(encode_kernel, dim3(1024), dim3(256), 0, stream, a);
#elif MK_SPLIT
    for (int p = 0; p < NPHASE; ++p) { a.ph_lo = p; a.ph_hi = p + 1; hipLaunchKernelGGL(fwd_kernel, dim3(grid), dim3(NTHREADS), LDS_BYTES, stream, a); }
#else
    a.ph_lo = 0; a.ph_hi = NPHASE; hipLaunchKernelGGL(fwd_kernel, dim3(grid), dim3(NTHREADS), LDS_BYTES, stream, a);
#endif
    const hipError_t le = hipPeekAtLastError();
    if (le != hipSuccess) fprintf(stderr, "kernel_launch: launch failed: %s\n", hipGetErrorName(le));
}
```

```cpp
#include <hip/hip_runtime.h>
#include <cstdio>
#include <cstdint>

#define GAS __attribute__((address_space(1)))
#define LAS __attribute__((address_space(3)))
typedef unsigned short bf16_t;
typedef short bf16x8 __attribute__((ext_vector_type(8)));
typedef short s16x4 __attribute__((ext_vector_type(4)));
typedef float f32x2 __attribute__((ext_vector_type(2)));
typedef float f32x4 __attribute__((ext_vector_type(4)));
typedef float f32x16 __attribute__((ext_vector_type(16)));
typedef unsigned u32x2 __attribute__((ext_vector_type(2)));
typedef unsigned u32x4 __attribute__((ext_vector_type(4)));
typedef __bf16 bf16x2_t __attribute__((ext_vector_type(2)));

constexpr int DM = 2048, NBATCH = 8, SEQ = 4096, DEPTH = 4, MTOK = NBATCH * SEQ;
constexpr int CONVW = 1024, AHEADS = 8, ATTW = 1024, VDIM = 128, SUBD = 64;
constexpr int INC = 6144;
constexpr int PHEADS = 8, NKEYS = 128, NEXP = 16384, TOPK = 16;
constexpr int MODW = 6 * DM;
constexpr float NORM_EPS = 1e-6f;
constexpr int NWAVES = 8, NTHREADS = 512;

constexpr size_t MiB = 1u << 20;
constexpr size_t WS_CTL = 0, CTL_ZERO_BYTES = 1 * MiB;
constexpr size_t WS_MOD = 2 * MiB;
constexpr size_t WS_MODP = 4 * MiB;
constexpr size_t WS_ROPE = 16 * MiB;
constexpr size_t WS_LAM = 18 * MiB;
constexpr size_t WS_KEYS = 20 * MiB;
constexpr size_t WS_WIN = 32 * MiB;
constexpr size_t WS_WOUT = 128 * MiB;
constexpr size_t WS_WQ = 160 * MiB;
constexpr size_t WS_U = 192 * MiB;
constexpr size_t WS_V = 448 * MiB;
constexpr size_t WS_USC = 24 * MiB, WS_VSC = 25 * MiB;
constexpr size_t WS_H = 704 * MiB;
constexpr size_t WS_SEG = 832 * MiB;
constexpr size_t SEG_ELEMS = (size_t)MTOK * 1024;
constexpr size_t WS_MIX = 1216 * MiB;
constexpr size_t WS_QP = 1344 * MiB;
constexpr size_t WS_ROUTE = 1472 * MiB;
constexpr size_t WS_DIAG = 1488 * MiB;
constexpr size_t WS_H2 = 1504 * MiB;
constexpr size_t WS_OT = 1632 * MiB;
constexpr size_t WS_END = 1760 * MiB;

constexpr int CW_BAR = 4096;
constexpr int CW_KMAX = 16384;

constexpr int LDS_BYTES = 147456;
constexpr int LDS_MISC = 131072;
namespace pg8 {
#define PG8_LAS __attribute__((address_space(3)))
typedef unsigned short bf16_t;
typedef short bf16x8 __attribute__((ext_vector_type(8)));
typedef float f32x4 __attribute__((ext_vector_type(4)));
typedef unsigned u32x4 __attribute__((ext_vector_type(4)));
constexpr int BM = 256, BK = 64, HALF = 128, HTB = HALF * BK * 2  , STAGE_BYTES = 8 * HTB, NXCD = 8, WGM = 8;

__host__ __device__ __forceinline__ int lds_byte(int r, int c) { const int st = (r >> 4) * 2 + (c >> 5), rr = r & 15, cc = c & 31, ob = rr * 64 + cc * 2; return st * 1024 + (ob ^ (((ob >> 9) & 1) << 5)); }
__host__ __device__ __forceinline__ void stage_rc(int b, int& R, int& C) { const int st = b / 1024, sb = b % 1024, swz = sb ^ (((sb >> 9) & 1) << 5); R = (st >> 1) * 16 + swz / 64; C = (st & 1) * 32 + (swz % 64) / 2; }
__host__ __device__ __forceinline__ int perm32(int rho) { const int n = rho >> 4, i = rho & 15; return 8 * (i >> 2) + 4 * n + (i & 3); }

struct Unit { int pm, pn; };
struct Gemm { const bf16_t* A; const bf16_t* Bt; int M, N, K; };

struct StaticOrder {
    int nM, nN, nwg, G, c;
    __host__ __device__ void init(int M, int N, int G_, int c_) { nM = M / BM; nN = N / BM; nwg = nM * nN; G = G_; c = c_; }
    __host__ __device__ bool next(int i, Unit& u) const {
        const long L = (long)i * G + c; if (L >= nwg) return false;
        int wgid = (int)L; { const int q = nwg / NXCD, r = nwg % NXCD, xcd = wgid % NXCD, off = wgid / NXCD; wgid = (xcd < r ? xcd * (q + 1) : r * (q + 1) + (xcd - r) * q) + off; }
        const int nig = WGM * nN, gid = wgid / nig, fm = gid * WGM, gsz = (nM - fm) < WGM ? (nM - fm) : WGM;
        u.pm = fm + ((wgid % nig) % gsz); u.pn = (wgid % nig) / gsz; return true;
    }
    __device__ __forceinline__ void a_ready(const Unit&) const {}
    __device__ __forceinline__ void done(const Unit&) const {}
};


__device__ __forceinline__ unsigned cvt_pk_bf16(float lo, float hi) { unsigned r; asm volatile("v_cvt_pk_bf16_f32 %0, %1, %2" : "=v"(r) : "v"(lo), "v"(hi)); return r; }

struct EpiBf16 {
    static constexpr bool PERM = true, AFTER_DRAIN = false;
    bf16_t* O; int ldc;
    __device__ __forceinline__ void operator()(const f32x4 (&acc)[2][2][4][2], const Unit& u, int wr, int wc, int fr, int fq) const {
        const int row0 = u.pm * BM + wr * 64 + fr, col0 = u.pn * BM + wc * 32 + 8 * fq;
#pragma unroll
        for (int ai = 0; ai < 2; ++ai)
#pragma unroll
            for (int m = 0; m < 4; ++m) { bf16_t* rowp = O + (size_t)(row0 + ai * HALF + m * 16) * ldc + col0;
#pragma unroll
                for (int bj = 0; bj < 2; ++bj) { const f32x4 v0 = acc[ai][bj][m][0], v1 = acc[ai][bj][m][1];
                    u32x4 w; w.x = cvt_pk_bf16(v0[0], v0[1]); w.y = cvt_pk_bf16(v0[2], v0[3]); w.z = cvt_pk_bf16(v1[0], v1[1]); w.w = cvt_pk_bf16(v1[2], v1[3]);
                    *(u32x4*)(rowp + bj * HALF) = w; } }
    }
};

struct EpiIn {
    static constexpr bool PERM = true, AFTER_DRAIN = false;
    bf16_t* seg0; size_t sege; const float* rope; unsigned* kmax;
    __device__ __forceinline__ void operator()(const f32x4 (&acc)[2][2][4][2], const Unit& u, int wr, int wc, int fr, int fq) const {
        const int t = u.pn >> 2, colt = (u.pn & 3) * BM;
        const int row0 = u.pm * BM + wr * 64 + fr, col0 = colt + wc * 32 + 8 * fq;
        bf16_t* base = seg0 + (size_t)t * sege;
        const bool isqk = (t == 3) || (t == 4);
        const bool ropew = isqk && ((wc & 1) == 0);
        const bool isk = (t == 4);
        float mx[2] = {0.f, 0.f};
#pragma unroll
        for (int ai = 0; ai < 2; ++ai)
#pragma unroll
            for (int m = 0; m < 4; ++m) { const int row = row0 + ai * HALF + m * 16; bf16_t* rowp = base + (size_t)row * 1024 + col0;
                f32x4 cs0 = {1.f, 1.f, 1.f, 1.f}, cs1 = cs0, sn0 = {0.f, 0.f, 0.f, 0.f}, sn1 = sn0;
                if (ropew && fq < 2) { const f32x4* rp = (const f32x4*)(rope + (size_t)row * 16); cs0 = rp[0]; cs1 = rp[1]; sn0 = rp[2]; sn1 = rp[3];
                    if (fq == 0) { sn0 = -sn0; sn1 = -sn1; } }
#pragma unroll
                for (int bj = 0; bj < 2; ++bj) { f32x4 v0 = acc[ai][bj][m][0], v1 = acc[ai][bj][m][1];
                    if (ropew) {
                        f32x4 p0, p1;
#pragma unroll
                        for (int i = 0; i < 4; ++i) { p0[i] = __shfl_xor(v0[i], 16); p1[i] = __shfl_xor(v1[i], 16); }
                        v0 = v0 * cs0 + p0 * sn0; v1 = v1 * cs1 + p1 * sn1;
                    }
                    u32x4 w; w.x = cvt_pk_bf16(v0[0], v0[1]); w.y = cvt_pk_bf16(v0[2], v0[3]); w.z = cvt_pk_bf16(v1[0], v1[1]); w.w = cvt_pk_bf16(v1[2], v1[3]);
                    *(u32x4*)(rowp + bj * HALF) = w;
                    if (isk) { float ss = (v0[0] * v0[0] + v0[1] * v0[1]) + (v0[2] * v0[2] + v0[3] * v0[3]) + (v1[0] * v1[0] + v1[1] * v1[1]) + (v1[2] * v1[2] + v1[3] * v1[3]);
                        ss += __shfl_xor(ss, 16); ss += __shfl_xor(ss, 32); mx[bj] = fmaxf(mx[bj], ss); } } }
        if (isk) {
#pragma unroll
            for (int bj = 0; bj < 2; ++bj) { float v = mx[bj];
                v = fmaxf(v, __shfl_xor(v, 1)); v = fmaxf(v, __shfl_xor(v, 2)); v = fmaxf(v, __shfl_xor(v, 4)); v = fmaxf(v, __shfl_xor(v, 8));
                if ((threadIdx.x & 63) == 0) { const int b = u.pm >> 4, head = (u.pn & 3) * 2 + bj, c = wc >> 1, half = wc & 1;
                    atomicMax(kmax + (((b * 8 + head) * 2 + c) * 2 + half), __float_as_uint(v)); } }
        }
    }
};

struct EpiRes {
    static constexpr bool PERM = true, AFTER_DRAIN = false;
    const float* xin; float* xout; const float* gate;
    __device__ __forceinline__ void operator()(const f32x4 (&acc)[2][2][4][2], const Unit& u, int wr, int wc, int fr, int fq) const {
        const int row0 = u.pm * BM + wr * 64 + fr, col0 = u.pn * BM + wc * 32 + 8 * fq, b = u.pm >> 4;
        f32x4 g[2][2];
#pragma unroll
        for (int bj = 0; bj < 2; ++bj)
#pragma unroll
            for (int n = 0; n < 2; ++n) g[bj][n] = *(const f32x4*)(gate + (size_t)b * 12288 + col0 + bj * HALF + 4 * n);
#pragma unroll
        for (int ai = 0; ai < 2; ++ai)
#pragma unroll
            for (int m = 0; m < 4; ++m) { const size_t off = (size_t)(row0 + ai * HALF + m * 16) * 2048 + col0;
#pragma unroll
                for (int bj = 0; bj < 2; ++bj)
#pragma unroll
                    for (int n = 0; n < 2; ++n) { const f32x4 x = *(const f32x4*)(xin + off + bj * HALF + 4 * n);
                        *(f32x4*)(xout + off + bj * HALF + 4 * n) = x + g[bj][n] * acc[ai][bj][m][n]; } }
    }
};

template <class Epi, class Sched, bool ALIGN_EPI = false, bool SP2 = false>
__device__ __forceinline__ void gemm_phase(PG8_LAS unsigned char* lds, const Gemm g, const Sched& S, const Epi& E) {
    int tid_ = threadIdx.x; asm volatile("" : "+v"(tid_));
    const int tid = tid_, wid = __builtin_amdgcn_readfirstlane(tid >> 6), lane = tid & 63, wr = wid >> 2, wc = wid & 3, fr = lane & 15, fq = lane >> 4;
    const int K = g.K, nt = K / BK;
    unsigned voffA[2], voffB[2];
#pragma unroll
    for (int i = 0; i < 2; ++i) { int R, C; stage_rc(tid * 16 + i * 8192, R, C); const int Rb = Epi::PERM ? ((R & ~31) + perm32(R & 31)) : R;
        voffA[i] = (unsigned)(R * K + C) * 2u; voffB[i] = (unsigned)(Rb * K + C) * 2u; }
    const size_t kstep = (size_t)(BK * 2);
    const size_t hstep = (size_t)HALF * K * 2;
    const size_t tstep = 2 * hstep;
    const unsigned ldsw = (unsigned)wid * 1024u;
    const int aoff = lds_byte(wr * 64 + fr, fq * 8), boff = lds_byte(wc * 32 + fr, fq * 8);
#define PG8_SA(b, h) (((b) * 2 + (h)) * HTB)
#define PG8_SB(b, h) ((4 + (b) * 2 + (h)) * HTB)
#define PG8_STAGE(bufoff, gbase, voff) do { _Pragma("unroll") for (int _i = 0; _i < 2; ++_i) \
        __builtin_amdgcn_global_load_lds((const unsigned*)((const char*)(gbase) + (voff)[_i]), (PG8_LAS unsigned*)(lds + (bufoff) + ldsw + _i * 8192), 16, 0, 0); } while (0)
#define PG8_LDA(dst, b, h) do { _Pragma("unroll") for (int m = 0; m < 4; ++m) _Pragma("unroll") for (int k = 0; k < 2; ++k) dst[m][k] = *(const PG8_LAS bf16x8*)(lds + PG8_SA(b, h) + aoff + m * 2048 + k * 1024); } while (0)
#define PG8_LDB(dst, b, h) do { _Pragma("unroll") for (int n = 0; n < 2; ++n) _Pragma("unroll") for (int k = 0; k < 2; ++k) dst[n][k] = *(const PG8_LAS bf16x8*)(lds + PG8_SB(b, h) + boff + n * 2048 + k * 1024); } while (0)
#define PG8_MMA(ai, bj, At, Bt) do { __builtin_amdgcn_s_setprio(1); _Pragma("unroll") for (int m = 0; m < 4; ++m) _Pragma("unroll") for (int n = 0; n < 2; ++n) _Pragma("unroll") for (int k = 0; k < 2; ++k) \
        acc[ai][bj][m][n] = __builtin_amdgcn_mfma_f32_16x16x32_bf16(Bt[n][k], At[m][k], acc[ai][bj][m][n], 0, 0, 0); __builtin_amdgcn_s_setprio(0); } while (0)
#define PG8_WAIT_V(n) asm volatile("s_waitcnt vmcnt(" #n ")" ::: "memory")
#define PG8_WAIT_L(n) asm volatile("s_waitcnt lgkmcnt(" #n ")" ::: "memory")
#define PG8_BAR __builtin_amdgcn_s_barrier()
#define PG8_SCHED __builtin_amdgcn_sched_barrier(0)
    Unit cur, nxt; int ui = 0;
    if (!S.next(0, cur)) return;
    f32x4 acc[2][2][4][2];
#pragma unroll
    for (int a = 0; a < 2; ++a)
#pragma unroll
        for (int b = 0; b < 2; ++b)
#pragma unroll
            for (int m = 0; m < 4; ++m)
#pragma unroll
                for (int n = 0; n < 2; ++n) acc[a][b][m][n] = (f32x4){0.f, 0.f, 0.f, 0.f};
    bf16x8 At[4][2], B0[2][2], B1[2][2];
    const char* cA = (const char*)g.A + (size_t)cur.pm * tstep; const char* cB = (const char*)g.Bt + (size_t)cur.pn * tstep;
    S.a_ready(cur);
    if constexpr (SP2) {
        PG8_STAGE(PG8_SB(0, 0), cB, voffB); PG8_STAGE(PG8_SB(0, 1), cB + hstep, voffB); PG8_STAGE(PG8_SA(0, 0), cA, voffA); PG8_STAGE(PG8_SA(0, 1), cA + hstep, voffA);
        if (wr == 1) PG8_BAR;
        PG8_WAIT_V(2); PG8_BAR;
        PG8_STAGE(PG8_SB(1, 0), cB + kstep, voffB); PG8_STAGE(PG8_SA(1, 0), cA + kstep, voffA); PG8_STAGE(PG8_SB(1, 1), cB + hstep + kstep, voffB);
        PG8_WAIT_V(6); PG8_BAR;
    } else {
        PG8_STAGE(PG8_SB(0, 0), cB, voffB); PG8_STAGE(PG8_SA(0, 0), cA, voffA); PG8_STAGE(PG8_SB(0, 1), cB + hstep, voffB); PG8_STAGE(PG8_SA(0, 1), cA + hstep, voffA);
        if (wr == 1) PG8_BAR;
        PG8_WAIT_V(4); PG8_BAR;
        PG8_STAGE(PG8_SB(1, 0), cB + kstep, voffB); PG8_STAGE(PG8_SA(1, 0), cA + kstep, voffA); PG8_STAGE(PG8_SB(1, 1), cB + hstep + kstep, voffB);
        PG8_WAIT_V(6); PG8_BAR;
    }
    for (;;) {
        const bool has_next = S.next(ui + 1, nxt);
        const char* nA = has_next ? (const char*)g.A + (size_t)nxt.pm * tstep : cA; const char* nB = has_next ? (const char*)g.Bt + (size_t)nxt.pn * tstep : cB;
        for (int t = 0; t < nt; t += 2) {
            const bool last = (t == nt - 2);
            const char* a1 = cA + (size_t)(t + 1) * kstep;
            const char* a2 = last ? nA : cA + (size_t)(t + 2) * kstep; const char* b2 = last ? nB : cB + (size_t)(t + 2) * kstep;
            const char* a3 = a2 + kstep; const char* b3 = b2 + kstep;
            if (last && has_next) S.a_ready(nxt);
            if constexpr (SP2) {
            PG8_LDB(B0, 0, 0); PG8_LDB(B1, 0, 1); PG8_SCHED; PG8_LDA(At, 0, 0); PG8_STAGE(PG8_SA(1, 1), a1 + hstep, voffA);
            PG8_WAIT_V(8); PG8_WAIT_L(0); PG8_BAR; PG8_MMA(0, 0, At, B0); PG8_MMA(0, 1, At, B1); PG8_BAR; PG8_SCHED;
            PG8_LDA(At, 0, 1); PG8_STAGE(PG8_SB(0, 0), b2, voffB); PG8_STAGE(PG8_SB(0, 1), b2 + hstep, voffB); PG8_STAGE(PG8_SA(0, 0), a2, voffA);
            PG8_WAIT_V(8); PG8_WAIT_L(0); PG8_BAR; PG8_MMA(1, 0, At, B0); PG8_MMA(1, 1, At, B1); PG8_BAR; PG8_SCHED;
            PG8_LDB(B0, 1, 0); PG8_LDB(B1, 1, 1); PG8_SCHED; PG8_LDA(At, 1, 0); PG8_STAGE(PG8_SA(0, 1), a2 + hstep, voffA);
            PG8_WAIT_V(8); PG8_WAIT_L(0); PG8_BAR; PG8_MMA(0, 0, At, B0); PG8_MMA(0, 1, At, B1); PG8_BAR; PG8_SCHED;
            PG8_LDA(At, 1, 1); PG8_STAGE(PG8_SB(1, 0), b3, voffB); PG8_STAGE(PG8_SB(1, 1), b3 + hstep, voffB); PG8_STAGE(PG8_SA(1, 0), a3, voffA);
            PG8_WAIT_V(8); PG8_WAIT_L(0); PG8_BAR; PG8_MMA(1, 0, At, B0); PG8_MMA(1, 1, At, B1); PG8_BAR; PG8_SCHED;
            } else {
            PG8_LDB(B0, 0, 0); PG8_SCHED; PG8_LDA(At, 0, 0); PG8_STAGE(PG8_SA(1, 1), a1 + hstep, voffA);
            PG8_WAIT_L(8); PG8_BAR; PG8_WAIT_L(0); PG8_MMA(0, 0, At, B0); PG8_BAR; PG8_SCHED;
            PG8_LDB(B1, 0, 1); PG8_STAGE(PG8_SB(0, 0), b2, voffB);
            PG8_BAR; PG8_WAIT_L(0); PG8_MMA(0, 1, At, B1); PG8_BAR;
            PG8_LDA(At, 0, 1); PG8_STAGE(PG8_SA(0, 0), a2, voffA);
            PG8_BAR; PG8_WAIT_L(0); PG8_MMA(1, 0, At, B0); PG8_BAR; PG8_SCHED;
            PG8_STAGE(PG8_SB(0, 1), b2 + hstep, voffB);
            PG8_WAIT_V(6); PG8_BAR; PG8_MMA(1, 1, At, B1); PG8_BAR;
            PG8_LDB(B0, 1, 0); PG8_SCHED; PG8_LDA(At, 1, 0); PG8_STAGE(PG8_SA(0, 1), a2 + hstep, voffA);
            PG8_WAIT_L(8); PG8_BAR; PG8_WAIT_L(0); PG8_MMA(0, 0, At, B0); PG8_BAR; PG8_SCHED;
            PG8_LDB(B1, 1, 1); PG8_STAGE(PG8_SB(1, 0), b3, voffB);
            PG8_BAR; PG8_WAIT_L(0); PG8_MMA(0, 1, At, B1); PG8_BAR;
            PG8_LDA(At, 1, 1); PG8_STAGE(PG8_SA(1, 0), a3, voffA);
            PG8_BAR; PG8_WAIT_L(0); PG8_MMA(1, 0, At, B0); PG8_BAR; PG8_SCHED;
            PG8_STAGE(PG8_SB(1, 1), b3 + hstep, voffB);
            PG8_WAIT_V(6); PG8_BAR; PG8_MMA(1, 1, At, B1); PG8_BAR;
            }
        }
        if constexpr (ALIGN_EPI) { if (wr == 0) PG8_BAR; }
        if constexpr (!Epi::AFTER_DRAIN) { E(acc, cur, wr, wc, fr, fq); S.done(cur); }
        if (!has_next) break;
#pragma unroll
        for (int a = 0; a < 2; ++a)
#pragma unroll
            for (int b = 0; b < 2; ++b)
#pragma unroll
                for (int m = 0; m < 4; ++m)
#pragma unroll
                    for (int n = 0; n < 2; ++n) acc[a][b][m][n] = (f32x4){0.f, 0.f, 0.f, 0.f};
        cur = nxt; cA = nA; cB = nB; ++ui;
        if constexpr (ALIGN_EPI) { if (wr == 1) PG8_BAR; }
    }
    PG8_WAIT_V(0);
    if constexpr (!ALIGN_EPI) { if (wr == 0) PG8_BAR; }
    PG8_BAR;
    if constexpr (Epi::AFTER_DRAIN) { E.fused(acc, cur, wr, wc, fr, fq, lds, wid, lane); S.done(cur); }
#undef PG8_SA
#undef PG8_SB
#undef PG8_STAGE
#undef PG8_LDA
#undef PG8_LDB
#undef PG8_MMA
#undef PG8_WAIT_V
#undef PG8_WAIT_L
#undef PG8_BAR
#undef PG8_SCHED
}
}

#define XB_TMO      128
#define XB_XCNT(j)  (256  + 64 * (j))
#define XB_XSUB(j)  (1280 + 64 * (j))
#define XB_XGEN(j)  (2304 + 64 * (j))
#define XB_TOP      3328
#define XB_TOPGEN   3392
#define XCD_BAR_WORDS 3456
#define XB_SPIN_CAP (1u << 18)

__device__ __forceinline__ unsigned xb_ld(unsigned* p)              { return __hip_atomic_load(p, __ATOMIC_RELAXED, __HIP_MEMORY_SCOPE_AGENT); }
__device__ __forceinline__ unsigned xb_add(unsigned* p, unsigned v) { return __hip_atomic_fetch_add(p, v, __ATOMIC_RELAXED, __HIP_MEMORY_SCOPE_AGENT); }
__device__ __forceinline__ unsigned xb_xcc_id() { return (unsigned)__builtin_amdgcn_s_getreg((3 << 11) | 20) & 0xFu; }
#define XB_SPIN(cond, bar) do { unsigned _sp = 0; while (cond) { __builtin_amdgcn_s_sleep(1); \
    if ((++_sp & 255u) == 0u) { if (xb_ld(&(bar)[XB_TMO])) break; if (_sp > XB_SPIN_CAP) { atomicAdd(&(bar)[XB_TMO], 1u); break; } } } } while (0)

struct XcdBarrier {
    unsigned* bar; unsigned x;
    volatile LAS unsigned* st;
};

__device__ __forceinline__ XcdBarrier xcd_barrier_post(unsigned* bar, volatile LAS unsigned* st) {
    XcdBarrier b; b.bar = bar; b.x = xb_xcc_id(); b.st = st;
    if (threadIdx.x == 0) (void)xb_add(&bar[XB_XCNT(b.x)], 1u);
    return b;
}
__device__ __forceinline__ void xcd_barrier_complete(unsigned* bar, unsigned x, unsigned& nloc, unsigned& nx) {
    const unsigned G = gridDim.x * gridDim.y * gridDim.z;
    unsigned sum, cnt, mine, sp = 0u;
    for (;;) {
        sum = 0u; cnt = 0u; mine = 0u;
#pragma unroll
        for (unsigned j = 0; j < 16; ++j) { const unsigned c = xb_ld(&bar[XB_XCNT(j)]); sum += c; cnt += (c > 0u) ? 1u : 0u; mine = (j == x) ? c : mine; }
        if (sum == G) break;
        __builtin_amdgcn_s_sleep(1);
        if ((++sp & 255u) == 0u) { if (xb_ld(&bar[XB_TMO])) break; if (sp > XB_SPIN_CAP) { atomicAdd(&bar[XB_TMO], 1u); break; } }
    }
    nloc = mine > 0u ? mine : 1u; nx = cnt > 0u ? cnt : 1u;
}

__device__ __forceinline__ void xcd_barrier(const XcdBarrier& b) {
    asm volatile("s_waitcnt vmcnt(0)" ::: "memory");
    __syncthreads();
    if (threadIdx.x == 0) {
        unsigned* bar = b.bar;
        __builtin_amdgcn_s_waitcnt(0);
        unsigned nloc = b.st[0], nx = b.st[1];
        if (nloc == 0u) { xcd_barrier_complete(bar, b.x, nloc, nx); b.st[0] = nloc; b.st[1] = nx; }
        const unsigned old = xb_add(&bar[XB_XSUB(b.x)], 1u);
        const unsigned gen = old / nloc;
        if (old + 1u == (gen + 1u) * nloc) {
            __builtin_amdgcn_fence(__ATOMIC_RELEASE, "agent");
            asm volatile("s_waitcnt vmcnt(0)" ::: "memory");
            const unsigned og = xb_add(&bar[XB_TOP], 1u);
            const unsigned tg = og / nx;
            if (og + 1u == (tg + 1u) * nx) xb_add(&bar[XB_TOPGEN], 1u);
            else XB_SPIN(xb_ld(&bar[XB_TOPGEN]) == tg, bar);
            __builtin_amdgcn_fence(__ATOMIC_ACQUIRE, "agent");
            xb_add(&bar[XB_XGEN(b.x)], 1u);
            asm volatile("s_waitcnt vmcnt(0)" ::: "memory");
        } else {
            XB_SPIN(xb_ld(&bar[XB_XGEN(b.x)]) == gen, bar);
            __builtin_amdgcn_fence(__ATOMIC_ACQUIRE, "agent");
            asm volatile("s_waitcnt vmcnt(0)" ::: "memory");
        }
    }
    __syncthreads();
}

#define LDS_WAIT() asm volatile("s_waitcnt lgkmcnt(0)" ::: "memory")
#define VM_WAIT() asm volatile("s_waitcnt vmcnt(0)" ::: "memory")
__device__ __forceinline__ unsigned f2bf(float f) { unsigned u = __builtin_bit_cast(unsigned, f); return (u + 0x7fffu + ((u >> 16) & 1u)) >> 16; }
__device__ __forceinline__ unsigned pk2(float lo, float hi) { return f2bf(lo) | (f2bf(hi) << 16); }
__device__ __forceinline__ float bf_lo(unsigned w) { return __builtin_bit_cast(float, w << 16); }
__device__ __forceinline__ float bf_hi(unsigned w) { return __builtin_bit_cast(float, w & 0xffff0000u); }
__device__ __forceinline__ float wave_sum(float v) {
#pragma unroll
    for (int o = 1; o < 64; o <<= 1) v += __shfl_xor(v, o);
    return v;
}

struct Ctx {
    LAS unsigned char* lds;
    unsigned char* ws;
    int tid, lane, wave, vcu, G, gw, NGW;
    float* out;
};

__device__ __forceinline__ void p0_transpose_item(const float* W, int K, int N, bf16_t* WT, LAS float* scr, int item, int lane) {
    const int nblk = N / 32, kb = item / nblk, nb = item % nblk, k0 = 64 * kb, n0 = 32 * nb;
#pragma unroll 8
    for (int i = 0; i < 32; ++i) { const int kk = 2 * i + (lane >> 5); scr[kk * 33 + (lane & 31)] = W[(size_t)(k0 + kk) * N + n0 + (lane & 31)]; }
    LDS_WAIT(); asm volatile("" ::: "memory");
    const int c = lane & 7;
#pragma unroll
    for (int j = 0; j < 4; ++j) { const int n = (lane >> 3) + 8 * j; const LAS float* s = scr + (8 * c) * 33 + n;
        u32x4 o; o.x = pk2(s[0 * 33], s[1 * 33]); o.y = pk2(s[2 * 33], s[3 * 33]); o.z = pk2(s[4 * 33], s[5 * 33]); o.w = pk2(s[6 * 33], s[7 * 33]);
        *(u32x4*)(WT + (size_t)(n0 + n) * K + k0 + 8 * c) = o; }
    LDS_WAIT(); asm volatile("" ::: "memory");
}
__device__ __forceinline__ void p0_cvt_row(const float* src, bf16_t* dst, int lane) {
#pragma unroll
    for (int j = 0; j < 4; ++j) { const f32x4 a = *(const f32x4*)(src + 512 * j + 8 * lane), b = *(const f32x4*)(src + 512 * j + 8 * lane + 4);
        u32x4 o; o.x = pk2(a[0], a[1]); o.y = pk2(a[2], a[3]); o.z = pk2(b[0], b[1]); o.w = pk2(b[2], b[3]);
        *(u32x4*)(dst + 512 * j + 8 * lane) = o; }
}
__device__ __forceinline__ void p0_cvt_row_fp8(const float* src, unsigned char* dst, float* inv_scale, int lane) {
    f32x4 v[8]; float amax = 0.f;
#pragma unroll
    for (int j = 0; j < 2; ++j)
#pragma unroll
        for (int q = 0; q < 4; ++q) { const f32x4 a = *(const f32x4*)(src + 1024 * j + 16 * lane + 4 * q); v[4 * j + q] = a;
            amax = fmaxf(amax, fmaxf(fmaxf(fabsf(a[0]), fabsf(a[1])), fmaxf(fabsf(a[2]), fabsf(a[3])))); }
#pragma unroll
    for (int o = 1; o < 64; o <<= 1) amax = fmaxf(amax, __shfl_xor(amax, o));
    const float sc = amax > 0.f ? 448.0f / amax : 1.0f;
#pragma unroll
    for (int j = 0; j < 2; ++j) { u32x4 o;
#pragma unroll
        for (int q = 0; q < 4; ++q) { const f32x4 a = v[4 * j + q] * sc; int w = 0; w = __builtin_amdgcn_cvt_pk_fp8_f32(a[0], a[1], w, false); w = __builtin_amdgcn_cvt_pk_fp8_f32(a[2], a[3], w, true); o[q] = (unsigned)w; }
        *(u32x4*)(dst + 1024 * j + 16 * lane) = o; }
    if (lane == 0) *inv_scale = amax > 0.f ? amax * (1.0f / 448.0f) : 1.0f;
}
__device__ __forceinline__ void p0_adaln_task(const float* c, const float* ada_w, float* modp, LAS float* scr, int task, int lane) {
    const int ks = task & 7, cg = (task >> 3) % 48, l = task / 384;
#pragma unroll
    for (int i = 0; i < 32; ++i) { const int e = i * 64 + lane, k = e >> 3, b = e & 7; const float x = c[b * DM + ks * 256 + k];
        scr[e] = x / (1.f + expf(-x)); }
    LDS_WAIT(); asm volatile("" ::: "memory");
    const float* wp = ada_w + ((size_t)l * DM + ks * 256) * MODW + cg * 256 + lane * 4;
    f32x4 acc[8];
#pragma unroll
    for (int b = 0; b < 8; ++b) acc[b] = (f32x4){0.f, 0.f, 0.f, 0.f};
#pragma unroll 4
    for (int k = 0; k < 256; ++k) { const f32x4 w = *(const f32x4*)(wp + (size_t)k * MODW);
        const f32x4 s0 = *(const LAS f32x4*)(scr + k * 8), s1 = *(const LAS f32x4*)(scr + k * 8 + 4);
        acc[0] += w * s0[0]; acc[1] += w * s0[1]; acc[2] += w * s0[2]; acc[3] += w * s0[3];
        acc[4] += w * s1[0]; acc[5] += w * s1[1]; acc[6] += w * s1[2]; acc[7] += w * s1[3]; }
#pragma unroll
    for (int b = 0; b < 8; ++b) *(f32x4*)(modp + (((size_t)ks * DEPTH + l) * NBATCH + b) * MODW + cg * 256 + lane * 4) = acc[b];
    LDS_WAIT(); asm volatile("" ::: "memory");
}
struct Args;
template <class A> __device__ __forceinline__ void p0_prologue(Ctx& C, const A& args) {
    LAS float* scr = (LAS float*)(C.lds + C.wave * 16384);
    const float* w_in = args.in[6]; const float* w_out = args.in[13]; const float* wq = args.in[15];
    bf16_t* WIN = (bf16_t*)(C.ws + WS_WIN); bf16_t* WOUT = (bf16_t*)(C.ws + WS_WOUT); bf16_t* WQ = (bf16_t*)(C.ws + WS_WQ);
    constexpr int T_ADA = 4 * 48 * 8;
    constexpr int I_IN = (DM / 64) * (INC / 32), I_SQ = (DM / 64) * (DM / 32);
    constexpr int T_IN = 4 * I_IN, T_OUT = 4 * I_SQ, T_WQ = 4 * I_SQ;
    constexpr int T_KEYS = 4 * 16 * 128 * 128 / 2048;
    constexpr int T_UV = 4 * NEXP;
    constexpr int T_ROPE = MTOK / 64;
    constexpr int NT = T_ADA + T_IN + T_OUT + T_WQ + T_KEYS + 2 * T_UV + T_ROPE + 1;
    for (int it = C.gw; it < NT; it += C.NGW) {
        int r = it;
        if (r < T_ADA) { p0_adaln_task(args.in[1], args.in[3], (float*)(C.ws + WS_MODP), scr, r, C.lane); continue; } r -= T_ADA;
        if (r < T_IN) { const int l = r / I_IN; p0_transpose_item(w_in + (size_t)l * DM * INC, DM, INC, WIN + (size_t)l * INC * DM, scr, r % I_IN, C.lane); continue; } r -= T_IN;
        if (r < T_OUT) { const int l = r / I_SQ; p0_transpose_item(w_out + (size_t)l * DM * DM, DM, DM, WOUT + (size_t)l * DM * DM, scr, r % I_SQ, C.lane); continue; } r -= T_OUT;
        if (r < T_WQ) { const int l = r / I_SQ; p0_transpose_item(wq + (size_t)l * DM * DM, DM, DM, WQ + (size_t)l * DM * DM, scr, r % I_SQ, C.lane); continue; } r -= T_WQ;
        if (r < T_KEYS) { p0_cvt_row(args.in[16] + (size_t)r * 2048, (bf16_t*)(C.ws + WS_KEYS) + (size_t)r * 2048, C.lane); continue; } r -= T_KEYS;
        if (r < T_UV) { p0_cvt_row_fp8(args.in[17] + (size_t)r * 2048, C.ws + WS_U + (size_t)r * 2048, (float*)(C.ws + WS_USC) + r, C.lane); continue; } r -= T_UV;
        if (r < T_UV) { p0_cvt_row_fp8(args.in[18] + (size_t)r * 2048, C.ws + WS_V + (size_t)r * 2048, (float*)(C.ws + WS_VSC) + r, C.lane); continue; } r -= T_UV;
        if (r < T_ROPE) {
            const int row = r * 64 + C.lane; const float pos = (float)((const int*)args.in[2])[row]; float* o = (float*)(C.ws + WS_ROPE) + (size_t)row * 16;
#pragma unroll
            for (int j = 0; j < 8; ++j) { const float invf = exp2f(-(float)j * 0.125f * 18.931568569324174f);
                const float ang = pos * invf; double rev = (double)ang * 0.15915494309189535; rev -= __builtin_rint(rev);
                const float rf = (float)rev; o[j] = __builtin_amdgcn_cosf(rf); o[8 + j] = __builtin_amdgcn_sinf(rf); }
            continue; } r -= T_ROPE;
        {
            float* lam = (float*)(C.ws + WS_LAM);
            for (int l = 0; l < DEPTH; ++l) {
                const float a = wave_sum(args.in[8][l * 64 + C.lane] * args.in[9][l * 64 + C.lane]), b = wave_sum(args.in[10][l * 64 + C.lane] * args.in[11][l * 64 + C.lane]);
                const float li = 0.8f - 0.6f * expf(-0.3f * (float)l);
                if (C.lane == 0) { lam[l] = expf(a) - expf(b) + li; lam[4 + l] = 1.f - li; } }
        }
    }
}
__device__ __forceinline__ void p1_modfinal(Ctx& C, const float* ada_b) {
    const float* modp = (const float*)(C.ws + WS_MODP); float* mod = (float*)(C.ws + WS_MOD);
    constexpr int N4 = DEPTH * NBATCH * MODW / 4;
    for (int i = C.vcu * NTHREADS + C.tid; i < N4; i += C.G * NTHREADS) { const int l = i / (NBATCH * MODW / 4), n4 = i % (MODW / 4);
        f32x4 s = *(const f32x4*)(ada_b + (size_t)l * MODW + n4 * 4);
#pragma unroll
        for (int ks = 0; ks < 8; ++ks) s += *(const f32x4*)(modp + (size_t)ks * DEPTH * NBATCH * MODW + (size_t)i * 4);
        *(f32x4*)(mod + (size_t)i * 4) = s; }
}

__device__ __forceinline__ void norm_pass(Ctx& C, const float* x, bf16_t* H, const float* g, const float* sh, const float* sc) {
    for (int row = C.gw; row < MTOK; row += C.NGW) { const int b = row >> 12; const float* xr = x + (size_t)row * DM + 8 * C.lane;
        f32x4 v[8]; float ss = 0.f;
#pragma unroll
        for (int j = 0; j < 4; ++j) { v[2 * j] = *(const f32x4*)(xr + 512 * j); v[2 * j + 1] = *(const f32x4*)(xr + 512 * j + 4);
            const f32x4 a = v[2 * j], c = v[2 * j + 1]; ss += (a[0] * a[0] + a[1] * a[1]) + (a[2] * a[2] + a[3] * a[3]) + (c[0] * c[0] + c[1] * c[1]) + (c[2] * c[2] + c[3] * c[3]); }
        const float rstd = 1.0f / sqrtf(wave_sum(ss) * (1.f / DM) + NORM_EPS);
        const float* gp = g + 8 * C.lane; const float* shp = sh + (size_t)b * MODW + 8 * C.lane; const float* scp = sc + (size_t)b * MODW + 8 * C.lane;
#pragma unroll
        for (int j = 0; j < 4; ++j) { f32x4 o[2];
#pragma unroll
            for (int q = 0; q < 2; ++q) { const f32x4 gg = *(const f32x4*)(gp + 512 * j + 4 * q), s1 = *(const f32x4*)(scp + 512 * j + 4 * q), s0 = *(const f32x4*)(shp + 512 * j + 4 * q);
                o[q] = (v[2 * j + q] * rstd) * gg * (s1 + 1.0f) + s0; }
            u32x4 w; w.x = pk2(o[0][0], o[0][1]); w.y = pk2(o[0][2], o[0][3]); w.z = pk2(o[1][0], o[1][1]); w.w = pk2(o[1][2], o[1][3]);
            *(u32x4*)(H + (size_t)row * DM + 512 * j + 8 * C.lane) = w; }
    }
}
__device__ __forceinline__ void final_norm_pass(Ctx& C, const float* x, float* out, const float* g) {
    for (int row = C.gw; row < MTOK; row += C.NGW) { const float* xr = x + (size_t)row * DM + 8 * C.lane;
        f32x4 v[8]; float ss = 0.f;
#pragma unroll
        for (int j = 0; j < 4; ++j) { v[2 * j] = *(const f32x4*)(xr + 512 * j); v[2 * j + 1] = *(const f32x4*)(xr + 512 * j + 4);
            const f32x4 a = v[2 * j], c = v[2 * j + 1]; ss += (a[0] * a[0] + a[1] * a[1]) + (a[2] * a[2] + a[3] * a[3]) + (c[0] * c[0] + c[1] * c[1]) + (c[2] * c[2] + c[3] * c[3]); }
        const float rstd = 1.0f / sqrtf(wave_sum(ss) * (1.f / DM) + NORM_EPS);
#pragma unroll
        for (int j = 0; j < 4; ++j)
#pragma unroll
            for (int q = 0; q < 2; ++q) { const f32x4 gg = *(const f32x4*)(g + 8 * C.lane + 512 * j + 4 * q);
                *(f32x4*)(out + (size_t)row * DM + 8 * C.lane + 512 * j + 4 * q) = (v[2 * j + q] * rstd) * gg; }
    }
}

__device__ __forceinline__ void conv_chunk(const bf16_t* GBp, const bf16_t* GCp, const bf16_t* HVp, const float* cw, bf16_t* MIXp, int chunk, int tid) {
    const int c0 = (tid & 127) * 8, r0 = chunk * 128 + (tid >> 7) * 32;
    float w0[8], w1[8], w2[8];
#pragma unroll
    for (int i = 0; i < 8; ++i) { w0[i] = cw[c0 + i]; w1[i] = cw[1024 + c0 + i]; w2[i] = cw[2048 + c0 + i]; }
    float zp[8], zc[8], zn[8];
    auto loadz = [&](int row, float (&z)[8]) {
        const bool ok = ((row >> 12) == (r0 >> 12)) && row >= 0 && row < MTOK;
        if (ok) { const u32x4 a = *(const u32x4*)(GCp + (size_t)row * 1024 + c0), h = *(const u32x4*)(HVp + (size_t)row * 1024 + c0);
#pragma unroll
            for (int i = 0; i < 4; ++i) { z[2 * i] = bf_lo(a[i]) * bf_lo(h[i]); z[2 * i + 1] = bf_hi(a[i]) * bf_hi(h[i]); } }
        else {
#pragma unroll
            for (int i = 0; i < 8; ++i) z[i] = 0.f; }
    };
    loadz(r0 - 1, zp); loadz(r0, zc);
    for (int r = r0; r < r0 + 32; ++r) {
        loadz(r + 1, zn);
        const u32x4 gbv = *(const u32x4*)(GBp + (size_t)r * 1024 + c0);
        float y[8];
#pragma unroll
        for (int i = 0; i < 4; ++i) { y[2 * i] = bf_lo(gbv[i]) * (w0[2 * i] * zp[2 * i] + w1[2 * i] * zc[2 * i] + w2[2 * i] * zn[2 * i]);
            y[2 * i + 1] = bf_hi(gbv[i]) * (w0[2 * i + 1] * zp[2 * i + 1] + w1[2 * i + 1] * zc[2 * i + 1] + w2[2 * i + 1] * zn[2 * i + 1]); }
        u32x4 o; o.x = pk2(y[0], y[1]); o.y = pk2(y[2], y[3]); o.z = pk2(y[4], y[5]); o.w = pk2(y[6], y[7]);
        *(u32x4*)(MIXp + (size_t)r * 2048 + c0) = o;
#pragma unroll
        for (int i = 0; i < 8; ++i) { zp[i] = zc[i]; zc[i] = zn[i]; }
    }
}

namespace att {
constexpr int NSLOT = 3, KSLOT = 8192, VSLOT = 16384;
constexpr int L_K = 0, L_V = NSLOT * KSLOT, L_WS = L_V + NSLOT * VSLOT, L_END = L_WS + NWAVES * 256;
constexpr float C2 = 0.125f * 1.4426950408889634f;
#define SBAR() __builtin_amdgcn_sched_barrier(0)
#define KSWZ(row, colB) ((row) * 256 + ((colB) ^ (((row) & 7) << 4)))
__device__ __forceinline__ int crow(int r, int hi) { return (r & 3) + 8 * (r >> 2) + 4 * hi; }
__device__ __forceinline__ unsigned cvtpk(float lo, float hi) { unsigned r; asm volatile("v_cvt_pk_bf16_f32 %0, %1, %2" : "=v"(r) : "v"(lo), "v"(hi)); return r; }
__device__ __forceinline__ void glds16(const void* gsrc, unsigned lds_dst) { unsigned keep;
    asm volatile("s_mov_b32 %0, m0\n\ts_mov_b32 m0, %2\n\ts_nop 0\n\tglobal_load_lds_dwordx4 %1, off\n\ts_mov_b32 m0, %0" : "=&s"(keep) : "v"(gsrc), "s"(lds_dst) : "memory"); }
#define WAIT_BAR(N) asm volatile("s_waitcnt vmcnt(" #N ") lgkmcnt(0)\n\ts_barrier" ::: "memory")
__device__ __forceinline__ int v_rd_base(int lane) { return ((lane & 3) << 3) | (((lane >> 2) & 3) << 6) | (((lane >> 4) & 1) << 5) | (((lane >> 5) & 1) << 8); }
constexpr int v_rd_off(int d0, int ks, int half) { return d0 * 512 + ks * 4096 + half * 2048; }
template <int OFF> __device__ __forceinline__ s16x4 tr_read(int vb) { s16x4 r; asm volatile("ds_read_b64_tr_b16 %0, %1 offset:%2" : "=&v"(r) : "v"(vb), "i"(OFF) : "memory"); return r; }

__device__ __forceinline__ void qkt(f32x16& p0, f32x16& p1, const LAS char* Ks, const bf16x8* qr, int r32, int hi) {
    const LAS char* kb = Ks + hi * 1024 + r32 * 16;
#pragma unroll
    for (int r = 0; r < 16; ++r) { p0[r] = 0.f; p1[r] = 0.f; }
#pragma unroll
    for (int d0 = 0; d0 < 4; ++d0) {
        const bf16x8 b0 = *(const LAS bf16x8*)(kb + d0 * 2048);
        const bf16x8 b1 = *(const LAS bf16x8*)(kb + d0 * 2048 + 512);
        p0 = __builtin_amdgcn_mfma_f32_32x32x16_bf16(b0, qr[d0], p0, 0, 0, 0);
        p1 = __builtin_amdgcn_mfma_f32_32x32x16_bf16(b1, qr[d0], p1, 0, 0, 0); }
}
__device__ __forceinline__ void softmax_pack(f32x16& p0, f32x16& p1, float negmC, float& l, bf16x8& pa0, bf16x8& pa1, bf16x8& pa2, bf16x8& pa3) {
#pragma unroll
    for (int r = 0; r < 16; ++r) { p0[r] = __builtin_amdgcn_exp2f(fmaf(p0[r], C2, negmC)); p1[r] = __builtin_amdgcn_exp2f(fmaf(p1[r], C2, negmC)); }
    float ps = 0.f;
#pragma unroll
    for (int r = 0; r < 16; ++r) ps += p0[r];
#pragma unroll
    for (int r = 0; r < 16; ++r) ps += p1[r];
    l += ps;
#define PK4(P, BASE, OUT) do { unsigned a0 = cvtpk(P[BASE + 0], P[BASE + 1]), a1 = cvtpk(P[BASE + 2], P[BASE + 3]);   \
    unsigned b0 = cvtpk(P[BASE + 4], P[BASE + 5]), b1 = cvtpk(P[BASE + 6], P[BASE + 7]);                              \
    auto r0 = __builtin_amdgcn_permlane32_swap(a0, b0, false, false); auto r1 = __builtin_amdgcn_permlane32_swap(a1, b1, false, false); \
    u32x4 w = {r0[0], r1[0], r0[1], r1[1]}; OUT = __builtin_bit_cast(bf16x8, w); } while (0)
    PK4(p0, 0, pa0); PK4(p0, 8, pa1); PK4(p1, 0, pa2); PK4(p1, 8, pa3);
#undef PK4
}
template <int D0> __device__ __forceinline__ void pv_one(f32x16& od, int vb, bf16x8 pa0, bf16x8 pa1, bf16x8 pa2, bf16x8 pa3) {
    const s16x4 l0 = tr_read<v_rd_off(D0, 0, 0)>(vb), h0 = tr_read<v_rd_off(D0, 0, 1)>(vb), l1 = tr_read<v_rd_off(D0, 1, 0)>(vb), h1 = tr_read<v_rd_off(D0, 1, 1)>(vb);
    const s16x4 l2 = tr_read<v_rd_off(D0, 2, 0)>(vb), h2 = tr_read<v_rd_off(D0, 2, 1)>(vb), l3 = tr_read<v_rd_off(D0, 3, 0)>(vb), h3 = tr_read<v_rd_off(D0, 3, 1)>(vb);
    asm volatile("s_waitcnt lgkmcnt(0)" ::: "memory"); SBAR();
#define PK(L, H) (bf16x8){L[0], L[1], L[2], L[3], H[0], H[1], H[2], H[3]}
    od = __builtin_amdgcn_mfma_f32_32x32x16_bf16(pa0, PK(l0, h0), od, 0, 0, 0);
    od = __builtin_amdgcn_mfma_f32_32x32x16_bf16(pa1, PK(l1, h1), od, 0, 0, 0);
    od = __builtin_amdgcn_mfma_f32_32x32x16_bf16(pa2, PK(l2, h2), od, 0, 0, 0);
    od = __builtin_amdgcn_mfma_f32_32x32x16_bf16(pa3, PK(l3, h3), od, 0, 0, 0);
#undef PK
}
__device__ __forceinline__ void pv_all(f32x16* o, int vb, bf16x8 pa0, bf16x8 pa1, bf16x8 pa2, bf16x8 pa3) {
    pv_one<0>(o[0], vb, pa0, pa1, pa2, pa3); pv_one<1>(o[1], vb, pa0, pa1, pa2, pa3); pv_one<2>(o[2], vb, pa0, pa1, pa2, pa3); pv_one<3>(o[3], vb, pa0, pa1, pa2, pa3);
}

__device__ __forceinline__ void attn_unit(int b, int h, int c, int qb, const bf16_t* Q, const bf16_t* K, const bf16_t* V, bf16_t* OT, const unsigned* kmax, LAS char* shm) {
    int tid_ = threadIdx.x; asm volatile("" : "+v"(tid_));
    const int tid = tid_, lane = tid & 63, r32 = lane & 31, hi = lane >> 5; const int wid = __builtin_amdgcn_readfirstlane(tid >> 6);
    const size_t rowbase = (size_t)b * SEQ; const int q0 = qb * 256;
    const bf16_t* Qw = Q + (rowbase + q0 + wid * 32) * 1024 + h * 128 + c * 64;
    const bf16_t* Kh = K + rowbase * 1024 + h * 128 + c * 64; const bf16_t* Vh = V + rowbase * 1024 + h * 128;
    const unsigned lds0 = (unsigned)(uintptr_t)shm;
    const bf16_t* ksrc = Kh + (size_t)lane * 1024 + wid * 8;
    const bf16_t* vsrc[2];
#pragma unroll
    for (int i = 0; i < 2; ++i) { const int p = 2 * wid + i;
        const int st = 2 * p + (lane >> 5), kk = (st >> 2) * 8 + ((lane & 31) >> 2), key = (kk & ~0xC) | ((kk & 4) << 1) | ((kk & 8) >> 1), cc = (st & 3) * 32 + (lane & 3) * 8;
        vsrc[i] = Vh + (size_t)key * 1024 + cc; }
    const unsigned kdst = lds0 + L_K + wid * 1024, vdst = lds0 + L_V + wid * 2048;
#define DMA_KV(t, slot) do { const size_t toff_ = (size_t)(t) * 64 * 1024; \
        glds16(ksrc + toff_, (unsigned)__builtin_amdgcn_readfirstlane(kdst + (slot) * KSLOT)); \
        glds16(vsrc[0] + toff_, (unsigned)__builtin_amdgcn_readfirstlane(vdst + (slot) * VSLOT)); glds16(vsrc[1] + toff_, (unsigned)__builtin_amdgcn_readfirstlane(vdst + (slot) * VSLOT + 1024)); } while (0)
    DMA_KV(0, 0); DMA_KV(1, 1);
    bf16x8 qr[4];
#pragma unroll
    for (int d0 = 0; d0 < 4; ++d0) qr[d0] = *(const bf16x8*)(Qw + (size_t)r32 * 1024 + d0 * 16 + hi * 8);
    float negm;
    {
        float sa = 0.f;
#pragma unroll
        for (int d0 = 0; d0 < 4; ++d0)
#pragma unroll
            for (int e = 0; e < 8; ++e) { const float x = __builtin_bit_cast(float, ((unsigned)(unsigned short)qr[d0][e]) << 16); sa += x * x; }
        { auto rr = __builtin_amdgcn_permlane32_swap(__float_as_uint(sa), __float_as_uint(sa), false, false); sa = __uint_as_float(rr[0]) + __uint_as_float(rr[1]); }
        const unsigned* km = kmax + ((b * 8 + h) * 2 + c) * 2;
        negm = -sqrtf(sa) * sqrtf(__uint_as_float(km[0]) + __uint_as_float(km[1])) * C2;
    }
    f32x16 o[4];
#pragma unroll
    for (int d = 0; d < 4; ++d)
#pragma unroll
        for (int r = 0; r < 16; ++r) o[d][r] = 0.f;
    float l = 0.f;
    const int vb0 = (int)(lds0 + L_V) + v_rd_base(lane);
    constexpr int NT = SEQ / 64;
    int slot = 0;
    for (int t = 0; t < NT; ++t) {
        if (t + 1 < NT) { WAIT_BAR(3); } else { WAIT_BAR(0); }
        if (t + 2 < NT) { const int s2 = (slot + 2 >= NSLOT) ? slot + 2 - NSLOT : slot + 2; DMA_KV(t + 2, s2); }
        const LAS char* Ks = shm + L_K + slot * KSLOT; const int vb = vb0 + slot * VSLOT;
        f32x16 p0, p1; bf16x8 a0, a1, a2, a3;
        SBAR(); qkt(p0, p1, Ks, qr, r32, hi);
        softmax_pack(p0, p1, negm, l, a0, a1, a2, a3);
        SBAR(); pv_all(o, vb, a0, a1, a2, a3);
        slot = (slot + 1 == NSLOT) ? 0 : slot + 1;
    }
#undef DMA_KV
    { auto rr = __builtin_amdgcn_permlane32_swap(__float_as_uint(l), __float_as_uint(l), false, false); l = __uint_as_float(rr[0]) + __uint_as_float(rr[1]); }
    LAS float* wsf = (LAS float*)(shm + L_WS) + wid * 64;
    if (hi == 0) wsf[r32] = 1.0f / l;
    asm volatile("s_waitcnt lgkmcnt(0)" ::: "memory");
    bf16_t* Ow = OT + (size_t)c * MTOK * 1024 + (rowbase + q0 + wid * 32) * 1024 + h * 128;
#pragma unroll
    for (int r = 0; r < 16; ++r) { const int orow = crow(r, hi); const float il = wsf[orow];
#pragma unroll
        for (int d = 0; d < 4; ++d) Ow[(size_t)orow * 1024 + d * 32 + r32] = (bf16_t)f2bf(o[d][r] * il); }
    asm volatile("s_waitcnt lgkmcnt(0)\n\ts_barrier" ::: "memory");
}
#undef SBAR
#undef KSWZ
#undef WAIT_BAR
}

__device__ __forceinline__ void combine_chunk(const bf16_t* OT, bf16_t* MIXp, float lam, const float* subg, float oscale, int chunk, int tid) {
    const int d0 = (tid & 15) * 8;
    float gs[8];
#pragma unroll
    for (int i = 0; i < 8; ++i) gs[i] = subg[d0 + i] * oscale;
    for (int it = tid >> 4; it < 128 * 8; it += NTHREADS / 16) { const int row = chunk * 128 + (it >> 3), h = it & 7;
        const u32x4 a = *(const u32x4*)(OT + (size_t)row * 1024 + h * 128 + d0), bq = *(const u32x4*)(OT + (size_t)MTOK * 1024 + (size_t)row * 1024 + h * 128 + d0);
        float o[8], ss = 0.f;
#pragma unroll
        for (int i = 0; i < 4; ++i) { o[2 * i] = bf_lo(a[i]) - lam * bf_lo(bq[i]); o[2 * i + 1] = bf_hi(a[i]) - lam * bf_hi(bq[i]); ss += o[2 * i] * o[2 * i] + o[2 * i + 1] * o[2 * i + 1]; }
        ss += __shfl_xor(ss, 1); ss += __shfl_xor(ss, 2); ss += __shfl_xor(ss, 4); ss += __shfl_xor(ss, 8);
        const float rstd = 1.0f / sqrtf(ss * (1.f / 128.f) + NORM_EPS);
        u32x4 w; w.x = pk2(o[0] * rstd * gs[0], o[1] * rstd * gs[1]); w.y = pk2(o[2] * rstd * gs[2], o[3] * rstd * gs[3]); w.z = pk2(o[4] * rstd * gs[4], o[5] * rstd * gs[5]); w.w = pk2(o[6] * rstd * gs[6], o[7] * rstd * gs[7]);
        *(u32x4*)(MIXp + (size_t)row * 2048 + 1024 + h * 128 + d0) = w; }
}

__device__ __forceinline__ int skey(float s, int payload, int mask) { int b = __builtin_bit_cast(int, s); b ^= (b >> 31) & 0x7fffffff; return (b & ~mask) | payload; }
__device__ __forceinline__ float skey_score(int k, int mask) { int b = k & ~mask; b ^= (b >> 31) & 0x7fffffff; return __builtin_bit_cast(float, b); }
#define CEX_DESC(a, b) do { const int hi_ = max((a), (b)), lo_ = min((a), (b)); (a) = hi_; (b) = lo_; } while (0)
__device__ __forceinline__ void sort16_desc(int (&k)[16]) {
#pragma unroll
    for (int sz = 2; sz <= 16; sz <<= 1)
#pragma unroll
        for (int j = sz >> 1; j > 0; j >>= 1)
#pragma unroll
            for (int i = 0; i < 16; ++i) { const int l = i ^ j;
                if (l > i) { if ((i & sz) == 0) { CEX_DESC(k[i], k[l]); } else { CEX_DESC(k[l], k[i]); } } }
}
__device__ __forceinline__ void bmerge16_desc(int (&k)[16]) {
#pragma unroll
    for (int j = 8; j > 0; j >>= 1)
#pragma unroll
        for (int i = 0; i < 16; ++i) { const int l = i ^ j; if (l > i) CEX_DESC(k[i], k[l]); }
}
__device__ __forceinline__ void top16_merge(int (&a)[16], const int (&b)[16]) {
#pragma unroll
    for (int i = 0; i < 16; ++i) a[i] = max(a[i], b[15 - i]);
    bmerge16_desc(a);
}
__device__ __forceinline__ void top16_xlane(int (&a)[16]) {
    int e[16], o[16];
#pragma unroll
    for (int i = 0; i < 16; ++i) { auto r = __builtin_amdgcn_permlane16_swap((unsigned)a[i], (unsigned)a[i], false, false); e[i] = (int)r[0]; o[i] = (int)r[1]; }
#pragma unroll
    for (int i = 0; i < 16; ++i) a[i] = max(e[i], o[15 - i]);
    bmerge16_desc(a);
#pragma unroll
    for (int i = 0; i < 16; ++i) { auto r = __builtin_amdgcn_permlane32_swap((unsigned)a[i], (unsigned)a[i], false, false); e[i] = (int)r[0]; o[i] = (int)r[1]; }
#pragma unroll
    for (int i = 0; i < 16; ++i) a[i] = max(e[i], o[15 - i]);
    bmerge16_desc(a);
}

__device__ __forceinline__ void router_task(const bf16_t* QP, const bf16_t* KEYS, unsigned* ROUTE, int tok0, int h, LAS int* scr, int lane) {
    const int fr = lane & 15, fq = lane >> 4;
    int top[2][16];
#pragma unroll
    for (int c = 0; c < 2; ++c) {
        const int hc = h * 2 + c;
        f32x4 acc[8];
#pragma unroll
        for (int nt = 0; nt < 8; ++nt) acc[nt] = (f32x4){0.f, 0.f, 0.f, 0.f};
        const bf16_t* qp = QP + (size_t)(tok0 + fr) * 2048 + hc * 128 + fq * 8;
        const bf16_t* kp = KEYS + ((size_t)hc * 128 + fr) * 128 + fq * 8;
#pragma unroll
        for (int ks = 0; ks < 4; ++ks) { const bf16x8 bq = *(const bf16x8*)(qp + ks * 32);
#pragma unroll
            for (int nt = 0; nt < 8; ++nt) { const bf16x8 ak = *(const bf16x8*)(kp + (size_t)nt * 16 * 128 + ks * 32);
                acc[nt] = __builtin_amdgcn_mfma_f32_16x16x32_bf16(ak, bq, acc[nt], 0, 0, 0); } }
        int ka[16], kb[16];
#pragma unroll
        for (int nt = 0; nt < 4; ++nt)
#pragma unroll
            for (int i = 0; i < 4; ++i) { ka[nt * 4 + i] = skey(acc[nt][i], 16 * nt + 4 * fq + i, 127); kb[nt * 4 + i] = skey(acc[nt + 4][i], 16 * (nt + 4) + 4 * fq + i, 127); }
        sort16_desc(ka); sort16_desc(kb); top16_merge(ka, kb);
        top16_xlane(ka);
#pragma unroll
        for (int i = 0; i < 16; ++i) top[c][i] = ka[i];
    }
    if (fq == 0) {
#pragma unroll
        for (int i = 0; i < 16; ++i) { scr[fr * 32 + i] = top[0][i] & 127; scr[fr * 32 + 16 + i] = top[1][i] & 127; } }
    float s0[16], s1[16];
#pragma unroll
    for (int i = 0; i < 16; ++i) { s0[i] = skey_score(top[0][i], 127); s1[i] = skey_score(top[1][i], 127); }
    constexpr int NEG = (int)0x80000000;
    int best[16], ch[16];
#define CAND(a, b) skey(s0[a] + s1[b], (a) * 16 + (b), 255)
#pragma unroll
    for (int b = 0; b < 16; ++b) best[b] = CAND(0, b);
    sort16_desc(best);
    ch[0] = CAND(1, 0); ch[1] = CAND(1, 1); ch[2] = CAND(1, 2); ch[3] = CAND(1, 3); ch[4] = CAND(1, 4); ch[5] = CAND(1, 5); ch[6] = CAND(1, 6); ch[7] = CAND(1, 7);
    ch[8] = CAND(2, 0); ch[9] = CAND(2, 1); ch[10] = CAND(2, 2); ch[11] = CAND(2, 3); ch[12] = CAND(2, 4); ch[13] = CAND(3, 0); ch[14] = CAND(3, 1); ch[15] = CAND(3, 2);
    sort16_desc(ch); top16_merge(best, ch);
    ch[0] = CAND(3, 3); ch[1] = CAND(4, 0); ch[2] = CAND(4, 1); ch[3] = CAND(4, 2); ch[4] = CAND(5, 0); ch[5] = CAND(5, 1); ch[6] = CAND(6, 0); ch[7] = CAND(6, 1);
    ch[8] = CAND(7, 0); ch[9] = CAND(7, 1); ch[10] = CAND(8, 0); ch[11] = CAND(9, 0); ch[12] = CAND(10, 0); ch[13] = CAND(11, 0); ch[14] = CAND(12, 0); ch[15] = CAND(13, 0);
    sort16_desc(ch); top16_merge(best, ch);
    ch[0] = CAND(14, 0); ch[1] = CAND(15, 0);
#pragma unroll
    for (int i = 2; i < 16; ++i) ch[i] = NEG;
    sort16_desc(ch); top16_merge(best, ch);
#undef CAND
    float g[16], gs = 0.f; const float smax = skey_score(best[0], 255);
#pragma unroll
    for (int i = 0; i < 16; ++i) { g[i] = __expf(skey_score(best[i], 255) - smax); gs += g[i]; }
    const float inv = 1.0f / gs;
    LDS_WAIT(); asm volatile("" ::: "memory");
    if (fq == 0) { unsigned e[16];
#pragma unroll
        for (int i = 0; i < 16; ++i) { const int ci = best[i] & 255, a = ci >> 4, b = ci & 15; const int ia = scr[fr * 32 + a], ib = scr[fr * 32 + 16 + b];
            e[i] = (f2bf(g[i] * inv) << 16) | (unsigned)(ia * 128 + ib); }
        unsigned* rp = ROUTE + (size_t)(tok0 + fr) * 128 + h * 16;
#pragma unroll
        for (int i = 0; i < 4; ++i) *(u32x4*)(rp + 4 * i) = (u32x4){e[4 * i], e[4 * i + 1], e[4 * i + 2], e[4 * i + 3]}; }
    LDS_WAIT(); asm volatile("" ::: "memory");
}

typedef float f32x2v __attribute__((ext_vector_type(2)));
__device__ __forceinline__ float gelu_exact(float a) { return 0.5f * a * (1.0f + erff(a * 0.70710678118654752f)); }
__device__ __forceinline__ void ld_rows4(u32x4 (&buf)[4][2], const unsigned R, int idx0, const unsigned char* T8, int lane) {
#pragma unroll
    for (int i = 0; i < 4; ++i) { const unsigned ent = (unsigned)__builtin_amdgcn_readlane((int)R, idx0 + i); const unsigned char* p = T8 + (size_t)(ent & 0x3fffu) * DM + 16 * lane;
        buf[i][0] = *(const u32x4*)p; buf[i][1] = *(const u32x4*)(p + 1024); }
}
__device__ __forceinline__ float dot_row(const u32x4 (&r)[2], const float (&hv)[32]) {
    float acc0 = 0.f, acc1 = 0.f;
#pragma unroll
    for (int j = 0; j < 2; ++j)
#pragma unroll
        for (int q = 0; q < 4; ++q) { unsigned wq = r[j][q]; asm volatile("" : "+v"(wq));
            const f32x2v lo = __builtin_amdgcn_cvt_pk_f32_fp8((int)wq, false), hi = __builtin_amdgcn_cvt_pk_f32_fp8((int)wq, true);
            acc0 = fmaf(lo.x, hv[16 * j + 4 * q], acc0); acc1 = fmaf(lo.y, hv[16 * j + 4 * q + 1], acc1); acc0 = fmaf(hi.x, hv[16 * j + 4 * q + 2], acc0); acc1 = fmaf(hi.y, hv[16 * j + 4 * q + 3], acc1); }
    return acc0 + acc1;
}
__device__ __forceinline__ void axpy_row(const u32x4 (&r)[2], float w, float (&oacc)[32]) {
#pragma unroll
    for (int j = 0; j < 2; ++j)
#pragma unroll
        for (int q = 0; q < 4; ++q) { unsigned wq = r[j][q]; asm volatile("" : "+v"(wq));
            const f32x2v lo = __builtin_amdgcn_cvt_pk_f32_fp8((int)wq, false), hi = __builtin_amdgcn_cvt_pk_f32_fp8((int)wq, true);
            oacc[16 * j + 4 * q] = fmaf(w, lo.x, oacc[16 * j + 4 * q]); oacc[16 * j + 4 * q + 1] = fmaf(w, lo.y, oacc[16 * j + 4 * q + 1]);
            oacc[16 * j + 4 * q + 2] = fmaf(w, hi.x, oacc[16 * j + 4 * q + 2]); oacc[16 * j + 4 * q + 3] = fmaf(w, hi.y, oacc[16 * j + 4 * q + 3]); }
    asm volatile("" : "+v"(oacc[0]), "+v"(oacc[1]), "+v"(oacc[2]), "+v"(oacc[3]), "+v"(oacc[4]), "+v"(oacc[5]), "+v"(oacc[6]), "+v"(oacc[7]), "+v"(oacc[8]), "+v"(oacc[9]), "+v"(oacc[10]), "+v"(oacc[11]), "+v"(oacc[12]), "+v"(oacc[13]), "+v"(oacc[14]), "+v"(oacc[15]));
    asm volatile("" : "+v"(oacc[16]), "+v"(oacc[17]), "+v"(oacc[18]), "+v"(oacc[19]), "+v"(oacc[20]), "+v"(oacc[21]), "+v"(oacc[22]), "+v"(oacc[23]), "+v"(oacc[24]), "+v"(oacc[25]), "+v"(oacc[26]), "+v"(oacc[27]), "+v"(oacc[28]), "+v"(oacc[29]), "+v"(oacc[30]), "+v"(oacc[31]));
}
__device__ __forceinline__ float expert_u_half(const unsigned R, const float (&hv)[32], const unsigned char* U8, const float* US, const float* VS, int lane) {
    float W = 0.f;
    const float us_own = US[R & 0x3fffu], vs_own = VS[R & 0x3fffu];
    u32x4 bufA[4][2], bufB[4][2];
    __builtin_amdgcn_sched_barrier(0);
    ld_rows4(bufA, R, 0, U8, lane); __builtin_amdgcn_sched_barrier(0);
#pragma unroll 1
    for (int g8 = 0; g8 < 8; ++g8) {
        float part[8];
        ld_rows4(bufB, R, g8 * 8 + 4, U8, lane); __builtin_amdgcn_sched_barrier(0);
#pragma unroll
        for (int i = 0; i < 4; ++i) { part[i] = dot_row(bufA[i], hv); __builtin_amdgcn_sched_barrier(0); }
        __builtin_amdgcn_sched_barrier(0);
        ld_rows4(bufA, R, (g8 * 8 + 8) & 63, U8, lane); __builtin_amdgcn_sched_barrier(0);
#pragma unroll
        for (int i = 0; i < 4; ++i) { part[4 + i] = dot_row(bufB[i], hv); __builtin_amdgcn_sched_barrier(0); }
        __builtin_amdgcn_sched_barrier(0);
#pragma unroll
        for (int s = 0; s < 3; ++s) { const int m = 1 << s; const bool up_ = (lane & m) != 0;
#pragma unroll
            for (int i = 0; i < (4 >> s); ++i) { const float a = part[2 * i], c = part[2 * i + 1]; const float keep = up_ ? c : a, send = up_ ? a : c;
                part[i] = keep + __shfl_xor(send, m); } }
        float tot = part[0]; tot += __shfl_xor(tot, 8); tot += __shfl_xor(tot, 16); tot += __shfl_xor(tot, 32);
        const float val = gelu_exact(tot * us_own) * __builtin_bit_cast(float, R & 0xffff0000u) * vs_own;
        W = ((lane >> 3) == g8) ? val : W;
    }
    return W;
}
__device__ __forceinline__ void expert_v_half(const unsigned R, const float W, float (&oacc)[32], const unsigned char* V8, int lane) {
    u32x4 bufA[4][2], bufB[4][2];
    __builtin_amdgcn_sched_barrier(0);
    ld_rows4(bufA, R, 0, V8, lane); __builtin_amdgcn_sched_barrier(0);
#pragma unroll 1
    for (int e0 = 0; e0 < 64; e0 += 8) {
        ld_rows4(bufB, R, e0 + 4, V8, lane); __builtin_amdgcn_sched_barrier(0);
#pragma unroll
        for (int i = 0; i < 4; ++i) { axpy_row(bufA[i], __builtin_bit_cast(float, __builtin_amdgcn_readlane(__builtin_bit_cast(int, W), e0 + i)), oacc); __builtin_amdgcn_sched_barrier(0); }
        __builtin_amdgcn_sched_barrier(0);
        ld_rows4(bufA, R, (e0 + 8) & 63, V8, lane); __builtin_amdgcn_sched_barrier(0);
#pragma unroll
        for (int i = 0; i < 4; ++i) { axpy_row(bufB[i], __builtin_bit_cast(float, __builtin_amdgcn_readlane(__builtin_bit_cast(int, W), e0 + 4 + i)), oacc); __builtin_amdgcn_sched_barrier(0); }
        __builtin_amdgcn_sched_barrier(0);
    }
}
__device__ __forceinline__ void expert_token(const float* xin, float* xout, const float* g, const float* sh, const float* sc, const float* gate, const unsigned char* U8, const unsigned char* V8, const float* US, const float* VS,
                                             const unsigned* ROUTE, int row, int lane) {
    const int b = row >> 12; const float* xr = xin + (size_t)row * DM + 16 * lane;
    float hv[32];
    {
        f32x4 v[8]; float ss = 0.f;
#pragma unroll
        for (int j = 0; j < 2; ++j)
#pragma unroll
            for (int q = 0; q < 4; ++q) { const f32x4 a = *(const f32x4*)(xr + 1024 * j + 4 * q); v[4 * j + q] = a; ss += (a[0] * a[0] + a[1] * a[1]) + (a[2] * a[2] + a[3] * a[3]); }
        const float rstd = 1.0f / sqrtf(wave_sum(ss) * (1.f / DM) + NORM_EPS);
        const float* gp = g + 16 * lane; const float* shp = sh + (size_t)b * MODW + 16 * lane; const float* scp = sc + (size_t)b * MODW + 16 * lane;
#pragma unroll
        for (int j = 0; j < 2; ++j)
#pragma unroll
            for (int q = 0; q < 4; ++q) { const f32x4 gg = *(const f32x4*)(gp + 1024 * j + 4 * q), s1 = *(const f32x4*)(scp + 1024 * j + 4 * q), s0 = *(const f32x4*)(shp + 1024 * j + 4 * q);
                const f32x4 o = (v[4 * j + q] * rstd) * gg * (s1 + 1.0f) + s0;
                hv[16 * j + 4 * q] = o[0]; hv[16 * j + 4 * q + 1] = o[1]; hv[16 * j + 4 * q + 2] = o[2]; hv[16 * j + 4 * q + 3] = o[3];
                if (q == 1 || q == 3) __builtin_amdgcn_sched_barrier(0); }
    }
    const unsigned r0 = ROUTE[(size_t)row * 128 + lane], r1 = ROUTE[(size_t)row * 128 + 64 + lane];
    const float w0 = expert_u_half(r0, hv, U8, US, VS, lane), w1 = expert_u_half(r1, hv, U8, US, VS, lane);
    float oacc[32];
#pragma unroll
    for (int i = 0; i < 32; ++i) oacc[i] = 0.f;
    expert_v_half(r0, w0, oacc, V8, lane); expert_v_half(r1, w1, oacc, V8, lane);
    const float* gtp = gate + (size_t)b * MODW + 16 * lane;
#pragma unroll
    for (int j = 0; j < 2; ++j)
#pragma unroll
        for (int q = 0; q < 4; ++q) { const f32x4 x = *(const f32x4*)(xr + 1024 * j + 4 * q), gg = *(const f32x4*)(gtp + 1024 * j + 4 * q);
            const f32x4 o = {oacc[16 * j + 4 * q], oacc[16 * j + 4 * q + 1], oacc[16 * j + 4 * q + 2], oacc[16 * j + 4 * q + 3]};
            *(f32x4*)(xout + (size_t)row * DM + 16 * lane + 1024 * j + 4 * q) = x + gg * o; }
}

constexpr int NPHASE = 39;
#ifndef MK_SPLIT
#define MK_SPLIT 0
#endif
struct Args { const float* in[20]; float* out; unsigned char* ws; int ph_lo, ph_hi; };
static_assert(sizeof(Args) == 20 * 8 + 8 + 8 + 8, "Args has no padding");

__device__ __forceinline__ bool in_range(int lo, int hi, int k) { asm volatile("" : "+s"(lo), "+s"(hi)); return lo <= k && k < hi; }
__global__ void __launch_bounds__(NTHREADS, 2) fwd_kernel(Args args) {
    extern __shared__ __attribute__((aligned(16))) unsigned char lds_raw[];
    Ctx C;
    C.lds = (LAS unsigned char*)lds_raw; C.ws = args.ws;
    C.tid = threadIdx.x; C.lane = C.tid & 63; C.wave = __builtin_amdgcn_readfirstlane(C.tid >> 6);
    C.G = gridDim.x; { const int bx = blockIdx.x; C.vcu = (C.G % 8 == 0) ? (bx % 8) * (C.G / 8) + bx / 8 : bx; }
    C.gw = C.vcu * NWAVES + C.wave; C.NGW = C.G * NWAVES;
    C.out = args.out;
    unsigned* ctl = (unsigned*)(C.ws + WS_CTL);
    volatile LAS unsigned* MISC = (volatile LAS unsigned*)(C.lds + LDS_MISC);
    for (int u = C.tid; u < (LDS_BYTES - LDS_MISC) / 4; u += NTHREADS) ((LAS unsigned*)(C.lds + LDS_MISC))[u] = 0u;
    __syncthreads();
    const int lo = args.ph_lo, hi = args.ph_hi;
    XcdBarrier bar; bar.bar = ctl + CW_BAR; bar.x = 0; bar.st = nullptr;
    if (hi - lo > 1) bar = xcd_barrier_post(ctl + CW_BAR, MISC + 8);
#ifndef ONLYP
#define ONLYP -1
#endif
#define PEN(c) (ONLYP < 0 || ONLYP == (c))
#define IN(k) in_range(lo, hi, (k))
#define FRESH(k) do { C.tid = threadIdx.x; uintptr_t w_ = (uintptr_t)args.ws, o_ = (uintptr_t)args.out; asm volatile("; PHASE_MARK " #k : "+v"(C.tid), "+s"(C.gw), "+s"(C.vcu), "+s"(w_), "+s"(o_)); \
    C.ws = (unsigned char*)(GAS unsigned char*)w_; C.out = (float*)(GAS float*)o_; C.lane = C.tid & 63; } while (0)
#define SEAM(k) do { if (IN(k) && IN((k) + 1)) xcd_barrier(bar); } while (0)

    float* MOD = (float*)(C.ws + WS_MOD);
    bf16_t* H = (bf16_t*)(C.ws + WS_H); bf16_t* SEG = (bf16_t*)(C.ws + WS_SEG); bf16_t* MIX = (bf16_t*)(C.ws + WS_MIX); bf16_t* QP = (bf16_t*)(C.ws + WS_QP); bf16_t* H2 = (bf16_t*)(C.ws + WS_H2); bf16_t* OT = (bf16_t*)(C.ws + WS_OT);
    unsigned* ROUTE = (unsigned*)(C.ws + WS_ROUTE);

    if (PEN(0) && IN(0)) { FRESH(0); p0_prologue(C, args); } SEAM(0);
    if (PEN(1) && IN(1)) { FRESH(1); p1_modfinal(C, args.in[4]); } SEAM(1);

    for (int l = 0; l < DEPTH; ++l) {
        const int pb = 2 + 9 * l;
        const float* modl = MOD + (size_t)l * NBATCH * MODW;
        unsigned* kmax = ctl + CW_KMAX + l * 256;
        if (PEN(2) && IN(pb + 0)) { FRESH(2); const float* xcur = (l == 0) ? args.in[0] : (const float*)C.out; norm_pass(C, xcur, H, args.in[5] + (size_t)l * DM, modl + 0 * DM, modl + 1 * DM); } SEAM(pb + 0);
        if (PEN(3) && IN(pb + 1)) { FRESH(3);
            pg8::Gemm g{H, (const bf16_t*)(C.ws + WS_WIN) + (size_t)l * INC * DM, MTOK, INC, DM}; pg8::StaticOrder S; S.init(MTOK, INC, C.G, (int)blockIdx.x);
            pg8::EpiIn E{SEG, SEG_ELEMS, (const float*)(C.ws + WS_ROPE), kmax};
            pg8::gemm_phase<pg8::EpiIn, pg8::StaticOrder, true, true>(C.lds, g, S, E);
        } SEAM(pb + 1);
        if (PEN(4) && IN(pb + 2)) { FRESH(4);
            for (int u = C.vcu; u < NBATCH * AHEADS * 2 * (SEQ / 256); u += C.G) { const int bh = u >> 5, c = (u >> 4) & 1, qb = u & 15;
                att::attn_unit(bh >> 3, bh & 7, c, qb, SEG + 3 * SEG_ELEMS, SEG + 4 * SEG_ELEMS, SEG + 5 * SEG_ELEMS, OT, kmax, (LAS char*)C.lds); }
        } SEAM(pb + 2);
        if (PEN(11) && IN(pb + 3)) { FRESH(11);
            const float lam = ((const float*)(C.ws + WS_LAM))[l], osc = ((const float*)(C.ws + WS_LAM))[4 + l];
            for (int ch = C.vcu; ch < MTOK / 128; ch += C.G) {
                conv_chunk(SEG + 0 * SEG_ELEMS, SEG + 1 * SEG_ELEMS, SEG + 2 * SEG_ELEMS, args.in[7] + (size_t)l * 3 * CONVW, MIX, ch, C.tid);
                combine_chunk(OT, MIX, lam, args.in[12] + (size_t)l * VDIM, osc, ch, C.tid); }
        } SEAM(pb + 3);
        if (PEN(5) && IN(pb + 4)) { FRESH(5);
            pg8::Gemm g{MIX, (const bf16_t*)(C.ws + WS_WOUT) + (size_t)l * DM * DM, MTOK, DM, DM}; pg8::StaticOrder S; S.init(MTOK, DM, C.G, (int)blockIdx.x);
            const float* xcur = (l == 0) ? args.in[0] : (const float*)C.out;
            pg8::EpiRes E{xcur, C.out, modl + 2 * DM};
            pg8::gemm_phase<pg8::EpiRes, pg8::StaticOrder, true, true>(C.lds, g, S, E);
        } SEAM(pb + 4);
        if (PEN(6) && IN(pb + 5)) { FRESH(6); norm_pass(C, C.out, H2, args.in[14] + (size_t)l * DM, modl + 3 * DM, modl + 4 * DM); } SEAM(pb + 5);
        if (PEN(7) && IN(pb + 6)) { FRESH(7);
            pg8::Gemm g{H2, (const bf16_t*)(C.ws + WS_WQ) + (size_t)l * DM * DM, MTOK, DM, DM}; pg8::StaticOrder S; S.init(MTOK, DM, C.G, (int)blockIdx.x);
            pg8::EpiBf16 E{QP, DM};
            pg8::gemm_phase<pg8::EpiBf16, pg8::StaticOrder, true, true>(C.lds, g, S, E);
        } SEAM(pb + 6);
        if (PEN(8) && IN(pb + 7)) { FRESH(8);
            const bf16_t* keys = (const bf16_t*)(C.ws + WS_KEYS) + (size_t)l * 16 * 128 * 128;
            LAS int* scr = (LAS int*)(C.lds + C.wave * 2048);
            for (int it = C.gw; it < (MTOK / 16) * PHEADS; it += C.NGW) router_task(QP, keys, ROUTE, (it >> 3) * 16, it & 7, scr, C.lane);
        } SEAM(pb + 7);
        if (PEN(9) && IN(pb + 8)) { FRESH(9);
            const unsigned char* U8 = C.ws + WS_U + (size_t)l * NEXP * DM; const unsigned char* V8 = C.ws + WS_V + (size_t)l * NEXP * DM;
            const float* US = (const float*)(C.ws + WS_USC) + (size_t)l * NEXP; const float* VS = (const float*)(C.ws + WS_VSC) + (size_t)l * NEXP;
            for (int row = C.gw; row < MTOK; row += C.NGW)
                expert_token(C.out, C.out, args.in[14] + (size_t)l * DM, modl + 3 * DM, modl + 4 * DM, modl + 5 * DM, U8, V8, US, VS, ROUTE, row, C.lane);
        } SEAM(pb + 8);
    }
    if (PEN(10) && IN(38)) { FRESH(10); final_norm_pass(C, C.out, C.out, args.in[19]); }
#undef IN
#undef SEAM
}


#if defined(CHECK) && CHECK
constexpr size_t WS_XSAVE = 1760 * MiB;
constexpr int NSTAGE = 13, NSAMP = 96;
__device__ __forceinline__ unsigned hash32(unsigned x) { x ^= x >> 16; x *= 0x7feb352du; x ^= x >> 15; x *= 0x846ca68bu; x ^= x >> 16; return x; }
__device__ __forceinline__ float bf2f(bf16_t v) { return __builtin_bit_cast(float, ((unsigned)v) << 16); }
__device__ __forceinline__ double wsumd(double v) {
#pragma unroll
    for (int o = 1; o < 64; o <<= 1) v += __shfl_xor(v, o);
    return v; }
__device__ __forceinline__ float wmaxf(float v) {
#pragma unroll
    for (int o = 1; o < 64; o <<= 1) v = fmaxf(v, __shfl_xor(v, o));
    return v; }
__device__ __forceinline__ void diag_add(float* diag, int stage, double num, double den, int lane) { if (lane == 0) { atomicAdd(diag + 2 * stage, (float)num); atomicAdd(diag + 2 * stage + 1, (float)den); } }
__device__ __forceinline__ float chk_silu(float x) { return x / (1.f + expf(-x)); }
__device__ __forceinline__ float chk_rstd(const float* x, int row, int lane) { double ss = 0; for (int k = lane; k < DM; k += 64) { const double v = x[(size_t)row * DM + k]; ss += v * v; } ss = wsumd(ss); return 1.0f / sqrtf((float)(ss / DM) + NORM_EPS); }
__device__ __forceinline__ float chk_norm_elem(const float* x, int row, int col, float rstd, const float* g, const float* sh, const float* sc) { const int b = row >> 12;
    return x[(size_t)row * DM + col] * rstd * g[col] * (1.0f + sc[(size_t)b * MODW + col]) + sh[(size_t)b * MODW + col]; }
__global__ void __launch_bounds__(64) check_kernel(Args args) {
    __shared__ float sq_[64]; __shared__ float ssc[256]; __shared__ int sused[256]; __shared__ int sti[32]; __shared__ float sts[32]; __shared__ int sce[16]; __shared__ float scs[16];
    const int stage = blockIdx.x / NSAMP, s = blockIdx.x % NSAMP, lane = threadIdx.x;
    unsigned char* ws = args.ws; float* diag = (float*)(ws + WS_DIAG);
    const float* MOD = (const float*)(ws + WS_MOD); const bf16_t* H = (const bf16_t*)(ws + WS_H); const bf16_t* SEG = (const bf16_t*)(ws + WS_SEG);
    const bf16_t* MIX = (const bf16_t*)(ws + WS_MIX); const bf16_t* OT = (const bf16_t*)(ws + WS_OT); const bf16_t* H2 = (const bf16_t*)(ws + WS_H2); const bf16_t* QP = (const bf16_t*)(ws + WS_QP); const unsigned* ROUTE = (const unsigned*)(ws + WS_ROUTE);
    const float* XS = (const float*)(ws + WS_XSAVE); const unsigned* kmax = (const unsigned*)(ws + WS_CTL) + CW_KMAX;
    const unsigned hsh = hash32(stage * 7919u + s * 104729u + 12345u);
    const int row = hsh % MTOK; const unsigned h2 = hash32(hsh + 1u);
    if (stage == 1) {
        const int b = h2 % 8, n = (h2 >> 3) % MODW; double a = 0;
        for (int k = lane; k < DM; k += 64) a += (double)chk_silu(args.in[1][b * DM + k]) * args.in[3][(size_t)k * MODW + n];
        a = wsumd(a) + args.in[4][n]; const double d = MOD[(size_t)b * MODW + n] - a; diag_add(diag, stage, d * d, a * a, lane);
    } else if (stage == 2) {
        const int col = h2 % DM; const float rstd = chk_rstd(args.in[0], row, lane); const float r = chk_norm_elem(args.in[0], row, col, rstd, args.in[5], MOD + 0 * DM, MOD + 1 * DM);
        const double d = bf2f(H[(size_t)row * DM + col]) - r; diag_add(diag, stage, d * d, (double)r * r, lane);
    } else if (stage == 3 || stage == 4) {
        int col;
        if (stage == 3) { const int t = h2 % 4; col = (t == 3 ? 5 : t) * 1024 + (h2 >> 2) % 1024; } else { col = 3072 + (h2 % 2048); if (s < NSAMP / 2) col = (col & ~63) | ((h2 >> 11) % 16); }
        auto dotc = [&](int c) { double a = 0; for (int k = lane; k < DM; k += 64) a += (double)bf2f(H[(size_t)row * DM + k]) * args.in[6][(size_t)k * INC + c]; return (float)wsumd(a); };
        float r = dotc(col);
        if (stage == 4) { const int dd = col & 63; if (dd < 16) { const int j = dd & 7; const float invf = powf(500000.f, -(float)(2 * j) / 16.f); const float ang = (float)((const int*)args.in[2])[row] * invf;
                const float cs = cosf(ang), sn = sinf(ang); const float o = (dd < 8) ? dotc(col + 8) : dotc(col - 8); r = (dd < 8) ? r * cs - o * sn : r * cs + o * sn; } }
        const float got = bf2f(SEG[(size_t)(col >> 10) * SEG_ELEMS + (size_t)row * 1024 + (col & 1023)]);
        const double d = got - r; diag_add(diag, stage, d * d, (double)r * r, lane);
    } else if (stage == 5) {
        const int b = h2 % 8, hh = (h2 >> 3) % 8, c = (h2 >> 6) % 2; const bf16_t* K = SEG + 4 * SEG_ELEMS; float mx = 0.f;
        for (int sq = lane; sq < SEQ; sq += 64) { float a = 0; for (int d = 0; d < 64; ++d) { const float v = bf2f(K[((size_t)b * SEQ + sq) * 1024 + hh * 128 + c * 64 + d]); a += v * v; } mx = fmaxf(mx, a); }
        mx = wmaxf(mx);
        const unsigned* km = kmax + ((b * 8 + hh) * 2 + c) * 2; const float bound = __uint_as_float(km[0]) + __uint_as_float(km[1]);
        const bool ok = bound >= mx * 0.98f && bound <= mx * 2.2f; diag_add(diag, stage, ok ? 0.0 : 1.0, 1.0, lane);
    } else if (stage == 6) {
        const int hh = h2 % 8, c = (h2 >> 3) % 2, d = (h2 >> 4) % 128, b = row >> 12;
        const bf16_t* Q = SEG + 3 * SEG_ELEMS; const bf16_t* K = SEG + 4 * SEG_ELEMS; const bf16_t* V = SEG + 5 * SEG_ELEMS;
        sq_[lane] = bf2f(Q[(size_t)row * 1024 + hh * 128 + c * 64 + lane]); __syncthreads();
        float mx = -1e30f;
        for (int sq = lane; sq < SEQ; sq += 64) { float a = 0; const bf16_t* kr = K + ((size_t)b * SEQ + sq) * 1024 + hh * 128 + c * 64; for (int e = 0; e < 64; ++e) a += sq_[e] * bf2f(kr[e]); mx = fmaxf(mx, a * 0.125f); }
        mx = wmaxf(mx);
        double num = 0, den = 0;
        for (int sq = lane; sq < SEQ; sq += 64) { float a = 0; const bf16_t* kr = K + ((size_t)b * SEQ + sq) * 1024 + hh * 128 + c * 64; for (int e = 0; e < 64; ++e) a += sq_[e] * bf2f(kr[e]);
            const double p = exp((double)(a * 0.125f - mx)); den += p; num += p * bf2f(V[((size_t)b * SEQ + sq) * 1024 + hh * 128 + d]); }
        num = wsumd(num); den = wsumd(den);
        const double r = num / den; const double dd = bf2f(OT[(size_t)c * MTOK * 1024 + (size_t)row * 1024 + hh * 128 + d]) - r; diag_add(diag, stage, dd * dd, r * r, lane);
    } else if (stage == 7) {
        if ((s & 1) == 0) { const int col = h2 % 1024, sq = row & (SEQ - 1); const bf16_t* GB = SEG; const bf16_t* GC = SEG + SEG_ELEMS; const bf16_t* HV = SEG + 2 * SEG_ELEMS;
            auto z = [&](int r) { return bf2f(GC[(size_t)r * 1024 + col]) * bf2f(HV[(size_t)r * 1024 + col]); };
            const float zm = (sq > 0) ? z(row - 1) : 0.f, zc = z(row), zp = (sq < SEQ - 1) ? z(row + 1) : 0.f;
            const float r = bf2f(GB[(size_t)row * 1024 + col]) * (args.in[7][col] * zm + args.in[7][1024 + col] * zc + args.in[7][2048 + col] * zp);
            const double d = bf2f(MIX[(size_t)row * 2048 + col]) - r; diag_add(diag, stage, d * d, (double)r * r, lane);
        } else { const int hh = h2 % 8, d = (h2 >> 3) % 128;
            const double a1 = wsumd((double)args.in[8][lane] * args.in[9][lane]), a2 = wsumd((double)args.in[10][lane] * args.in[11][lane]);
            const float lam_init = 0.8f - 0.6f * expf(-0.3f * 0.f), lam = (float)(exp(a1) - exp(a2)) + lam_init;
            double ss = 0; float od = 0;
            for (int e = lane; e < 128; e += 64) { const float o = bf2f(OT[(size_t)row * 1024 + hh * 128 + e]) - lam * bf2f(OT[(size_t)MTOK * 1024 + (size_t)row * 1024 + hh * 128 + e]); ss += (double)o * o; if (e == d) od = o; }
            ss = wsumd(ss); od = (float)wsumd((double)od);
            const float r = od / sqrtf((float)(ss / 128.0) + NORM_EPS) * args.in[12][d] * (1.f - lam_init);
            const double dd = bf2f(MIX[(size_t)row * 2048 + 1024 + hh * 128 + d]) - r; diag_add(diag, stage, dd * dd, (double)r * r, lane); }
    } else if (stage == 8) {
        const int col = h2 % DM, b = row >> 12; double a = 0; for (int k = lane; k < DM; k += 64) a += (double)bf2f(MIX[(size_t)row * DM + k]) * args.in[13][(size_t)k * DM + col];
        a = wsumd(a); const double delta = (double)MOD[(size_t)b * MODW + 2 * DM + col] * a;
        const double r = args.in[0][(size_t)row * DM + col] + delta; const double d = XS[(size_t)row * DM + col] - r; diag_add(diag, stage, d * d, delta * delta, lane);
    } else if (stage == 9) {
        const int col = h2 % DM; const float rstd = chk_rstd(XS, row, lane); const float r = chk_norm_elem(XS, row, col, rstd, args.in[14], MOD + 3 * DM, MOD + 4 * DM);
        const double d = bf2f(H2[(size_t)row * DM + col]) - r; diag_add(diag, stage, d * d, (double)r * r, lane);
    } else if (stage == 10) {
        const int col = h2 % DM; double a = 0; for (int k = lane; k < DM; k += 64) a += (double)bf2f(H2[(size_t)row * DM + k]) * args.in[15][(size_t)k * DM + col];
        a = wsumd(a); const double d = bf2f(QP[(size_t)row * DM + col]) - a; diag_add(diag, stage, d * d, a * a, lane);
    } else if (stage == 11) {
        const int hh = h2 % 8;
        for (int i = lane; i < 256; i += 64) { const int c = i >> 7, n = i & 127; double a = 0; for (int d = 0; d < 128; ++d) a += (double)bf2f(QP[(size_t)row * DM + (hh * 2 + c) * 128 + d]) * args.in[16][(((size_t)hh * 2 + c) * 128 + n) * 128 + d]; ssc[i] = (float)a; sused[i] = 0; }
        __syncthreads();
        if (lane == 0) {
            for (int c = 0; c < 2; ++c) for (int j = 0; j < 16; ++j) { int bi = -1; float bv = -1e30f; for (int n = 0; n < 128; ++n) if (!sused[c * 128 + n] && ssc[c * 128 + n] > bv) { bv = ssc[c * 128 + n]; bi = n; }
                sti[c * 16 + j] = bi; sts[c * 16 + j] = bv; sused[c * 128 + bi] = 1; }
            for (int q = 0; q < 256; ++q) sused[q] = 0;
            for (int j = 0; j < 16; ++j) { int bi = -1; float bv = -1e30f; for (int q = 0; q < 256; ++q) { if (sused[q]) continue; const float v = sts[q >> 4] + sts[16 + (q & 15)]; if (v > bv) { bv = v; bi = q; } }
                sused[bi] = 1; sce[j] = sti[bi >> 4] * 128 + sti[16 + (bi & 15)]; scs[j] = bv; }
            double gsum = 0; for (int j = 0; j < 16; ++j) gsum += exp((double)(scs[j] - scs[0]));
            double err = 0;
            for (int j = 0; j < 16; ++j) { const double gr = exp((double)(scs[j] - scs[0])) / gsum; double gm = 0;
                for (int q = 0; q < 16; ++q) { const unsigned e = ROUTE[(size_t)row * 128 + hh * 16 + q]; if ((int)(e & 0x3fffu) == sce[j]) gm = __builtin_bit_cast(float, e & 0xffff0000u); }
                err += fabs(gr - gm); }
            diag_add(diag, stage, err * err, 1.0, lane); }
    } else if (stage == 12) {
        const int col = h2 % DM, b = row >> 12; const float rstd = chk_rstd(XS, row, lane); double out = 0;
        for (int e = 0; e < 128; ++e) { const unsigned ent = ROUTE[(size_t)row * 128 + e]; const int eid = ent & 0x3fffu; const float gate = __builtin_bit_cast(float, ent & 0xffff0000u); double a = 0;
            for (int k = lane; k < DM; k += 64) { const float hk = chk_norm_elem(XS, row, k, rstd, args.in[14], MOD + 3 * DM, MOD + 4 * DM); a += (double)hk * args.in[17][(size_t)eid * DM + k]; }
            a = wsumd(a); const double ge = 0.5 * a * (1.0 + erf(a * 0.7071067811865476)); out += ge * gate * args.in[18][(size_t)eid * DM + col]; }
        const double delta = (double)MOD[(size_t)b * MODW + 5 * DM + col] * out; const double r = XS[(size_t)row * DM + col] + delta; const double d = args.out[(size_t)row * DM + col] - r; diag_add(diag, stage, d * d, delta * delta, lane);
    }
}
#ifndef CHECK_FROM
#define CHECK_FROM 1
#endif
__global__ void encode_kernel(Args args) {
    const float* diag = (const float*)(args.ws + WS_DIAG);
    int k = 14; float m = 1.f;
    for (int st = NSTAGE - 1; st >= CHECK_FROM; --st) { const float num = diag[2 * st], den = diag[2 * st + 1]; float rel = sqrtf(num / fmaxf(den, 1e-30f)); if (!(rel == rel)) rel = 1e4f;
        const float tol = (st == 11) ? 0.08f : (st == 5 ? 0.01f : 0.03f);
        if (rel > tol) { k = st; m = fminf(9.9f, fmaxf(1.f, 1.f + 2.f * (log10f(rel) + 4.f))); } }
    const float c = sqrtf(m * powf(10.f, (float)k));
    for (size_t i = (size_t)blockIdx.x * blockDim.x + threadIdx.x; i < (size_t)MTOK * DM; i += (size_t)gridDim.x * blockDim.x) args.out[i] = c;
}
#endif
extern "C" void kernel_launch(void* const* d_in, const int* in_sizes, int n_in, void* d_out, int out_size, void* d_ws, size_t ws_size, hipStream_t stream) {
    static int grid = 0;
    if (grid == 0) {
        if (n_in != 20 || out_size != MTOK * DM || ws_size < WS_END) { fprintf(stderr, "kernel_launch: unexpected shapes: n_in %d out %d ws %zu (need %zu)\n", n_in, out_size, ws_size, (size_t)WS_END); grid = -1; return; }
        int dev = 0, cus = 0;
        if (hipGetDevice(&dev) != hipSuccess || hipDeviceGetAttribute(&cus, hipDeviceAttributeMultiprocessorCount, dev) != hipSuccess) { grid = -1; return; }
        if (hipFuncSetAttribute((const void*)fwd_kernel, hipFuncAttributeMaxDynamicSharedMemorySize, LDS_BYTES) != hipSuccess) { fprintf(stderr, "kernel_launch: hipFuncSetAttribute failed\n"); grid = -1; return; }
        int per_cu = 0;
        if (hipOccupancyMaxActiveBlocksPerMultiprocessor(&per_cu, (const void*)fwd_kernel, NTHREADS, LDS_BYTES) != hipSuccess || per_cu < 1) { fprintf(stderr, "kernel_launch: occupancy query says %d\n", per_cu); }
        (void)hipGetLastError();
        grid = cus;
    }
    if (grid < 0) return;
    (void)hipMemsetAsync((char*)d_ws + WS_CTL, 0, CTL_ZERO_BYTES, stream);
    Args a{};
    for (int i = 0; i < 20; ++i) a.in[i] = (const float*)d_in[i];
    a.out = (float*)d_out; a.ws = (unsigned char*)d_ws;
#if defined(CHECK) && CHECK
    if (ws_size < WS_XSAVE + (size_t)MTOK * DM * 4) { fprintf(stderr, "check build: workspace too small\n"); return; }
    (void)hipMemsetAsync((char*)d_ws + WS_DIAG, 0, 4096, stream);
    for (int p = 0; p < 2 + 9; ++p) { a.ph_lo = p; a.ph_hi = p + 1; hipLaunchKernelGGL(fwd_kernel, dim3(grid), dim3(NTHREADS), LDS_BYTES, stream, a);
        if (p == 2 + 4) (void)hipMemcpyAsync((char*)d_ws + WS_XSAVE, d_out, (size_t)MTOK * DM * 4, hipMemcpyDeviceToDevice, stream); }
    hipLaunchKernelGGL(check_kernel, dim3(NSTAGE * NSAMP), dim3(64), 0, stream, a);
    hipLaunchKernelGGL(encode_kernel, dim3(1024), dim3(256), 0, stream, a);
#elif MK_SPLIT
    for (int p = 0; p < NPHASE; ++p) { a.ph_lo = p; a.ph_hi = p + 1; hipLaunchKernelGGL(fwd_kernel, dim3(grid), dim3(NTHREADS), LDS_BYTES, stream, a); }
#else
    a.ph_lo = 0; a.ph_hi = NPHASE; hipLaunchKernelGGL(fwd_kernel, dim3(grid), dim3(NTHREADS), LDS_BYTES, stream, a);
#endif
    const hipError_t le = hipPeekAtLastError();
    if (le != hipSuccess) fprintf(stderr, "kernel_launch: launch failed: %s\n", hipGetErrorName(le));
}
```

```cpp
#include <hip/hip_runtime.h>
#include <cstdio>
#include <cstdint>

#define GAS __attribute__((address_space(1)))
#define LAS __attribute__((address_space(3)))
typedef unsigned short bf16_t;
typedef short bf16x8 __attribute__((ext_vector_type(8)));
typedef short s16x4 __attribute__((ext_vector_type(4)));
typedef float f32x2 __attribute__((ext_vector_type(2)));
typedef float f32x4 __attribute__((ext_vector_type(4)));
typedef float f32x16 __attribute__((ext_vector_type(16)));
typedef unsigned u32x2 __attribute__((ext_vector_type(2)));
typedef unsigned u32x4 __attribute__((ext_vector_type(4)));
typedef __bf16 bf16x2_t __attribute__((ext_vector_type(2)));

constexpr int DM = 2048, NBATCH = 8, SEQ = 4096, DEPTH = 4, MTOK = NBATCH * SEQ;
constexpr int CONVW = 1024, AHEADS = 8, ATTW = 1024, VDIM = 128, SUBD = 64;
constexpr int INC = 6144;
constexpr int PHEADS = 8, NKEYS = 128, NEXP = 16384, TOPK = 16;
constexpr int MODW = 6 * DM;
constexpr float NORM_EPS = 1e-6f;
constexpr int NWAVES = 8, NTHREADS = 512;

constexpr size_t MiB = 1u << 20;
constexpr size_t WS_CTL = 0, CTL_ZERO_BYTES = 1 * MiB;
constexpr size_t WS_MOD = 2 * MiB;
constexpr size_t WS_MODP = 4 * MiB;
constexpr size_t WS_ROPE = 16 * MiB;
constexpr size_t WS_LAM = 18 * MiB;
constexpr size_t WS_KEYS = 20 * MiB;
constexpr size_t WS_WIN = 32 * MiB;
constexpr size_t WS_WOUT = 128 * MiB;
constexpr size_t WS_WQ = 160 * MiB;
constexpr size_t WS_U = 192 * MiB;
constexpr size_t WS_V = 320 * MiB;
constexpr size_t WS_PART = 448 * MiB;
constexpr size_t WS_USC = 24 * MiB, WS_VSC = 25 * MiB;
constexpr size_t WS_H = 704 * MiB;
constexpr size_t WS_SEG = 832 * MiB;
constexpr size_t SEG_ELEMS = (size_t)MTOK * 1024;
constexpr size_t WS_MIX = 1216 * MiB;
constexpr size_t WS_QP = 1344 * MiB;
constexpr size_t WS_ROUTE = 1472 * MiB;
constexpr size_t WS_DIAG = 1488 * MiB;
constexpr size_t WS_H2 = 1504 * MiB;
constexpr size_t WS_WSC = 1494 * MiB;
constexpr size_t WS_HSC = 1492 * MiB;
constexpr size_t WS_OT = 1632 * MiB;
constexpr size_t WS_WR = 1760 * MiB;
constexpr size_t WS_H2I = WS_OT;
constexpr size_t WS_XB = 1776 * MiB;
constexpr size_t WS_END = 1904 * MiB;

constexpr int CW_BAR = 4096;
constexpr int CW_KMAX = 16384;

constexpr int LDS_BYTES = 147456;
constexpr int LDS_MISC = 131072;
namespace pg8 {
#define PG8_LAS __attribute__((address_space(3)))
typedef unsigned short bf16_t;
typedef short bf16x8 __attribute__((ext_vector_type(8)));
typedef float f32x4 __attribute__((ext_vector_type(4)));
typedef unsigned u32x4 __attribute__((ext_vector_type(4)));
constexpr int BM = 256, BK = 64, HALF = 128, HTB = HALF * BK * 2  , STAGE_BYTES = 8 * HTB, NXCD = 8, WGM = 8;

__host__ __device__ __forceinline__ int lds_byte(int r, int c) { const int st = (r >> 4) * 2 + (c >> 5), rr = r & 15, cc = c & 31, ob = rr * 64 + cc * 2; return st * 1024 + (ob ^ (((ob >> 9) & 1) << 5)); }
__host__ __device__ __forceinline__ void stage_rc(int b, int& R, int& C) { const int st = b / 1024, sb = b % 1024, swz = sb ^ (((sb >> 9) & 1) << 5); R = (st >> 1) * 16 + swz / 64; C = (st & 1) * 32 + (swz % 64) / 2; }
__host__ __device__ __forceinline__ int perm32(int rho) { const int n = rho >> 4, i = rho & 15; return 8 * (i >> 2) + 4 * n + (i & 3); }

struct Unit { int pm, pn; };
struct Gemm { const bf16_t* A; const bf16_t* Bt; int M, N, K; };

struct StaticOrder {
    int nM, nN, nwg, G, c;
    __host__ __device__ void init(int M, int N, int G_, int c_) { nM = M / BM; nN = N / BM; nwg = nM * nN; G = G_; c = c_; }
    __host__ __device__ bool next(int i, Unit& u) const {
        const long L = (long)i * G + c; if (L >= nwg) return false;
        int wgid = (int)L; { const int q = nwg / NXCD, r = nwg % NXCD, xcd = wgid % NXCD, off = wgid / NXCD; wgid = (xcd < r ? xcd * (q + 1) : r * (q + 1) + (xcd - r) * q) + off; }
        const int nig = WGM * nN, gid = wgid / nig, fm = gid * WGM, gsz = (nM - fm) < WGM ? (nM - fm) : WGM;
        u.pm = fm + ((wgid % nig) % gsz); u.pn = (wgid % nig) / gsz; return true;
    }
    __device__ __forceinline__ void a_ready(const Unit&) const {}
    __device__ __forceinline__ void done(const Unit&) const {}
};


__device__ __forceinline__ unsigned cvt_pk_bf16(float lo, float hi) { unsigned r; asm volatile("v_cvt_pk_bf16_f32 %0, %1, %2" : "=v"(r) : "v"(lo), "v"(hi)); return r; }

struct EpiBf16 {
    static constexpr bool PERM = true, AFTER_DRAIN = false;
    bf16_t* O; int ldc;
    __device__ __forceinline__ void operator()(const f32x4 (&acc)[2][2][4][2], const Unit& u, int wr, int wc, int fr, int fq) const {
        const int row0 = u.pm * BM + wr * 64 + fr, col0 = u.pn * BM + wc * 32 + 8 * fq;
#pragma unroll
        for (int ai = 0; ai < 2; ++ai)
#pragma unroll
            for (int m = 0; m < 4; ++m) { bf16_t* rowp = O + (size_t)(row0 + ai * HALF + m * 16) * ldc + col0;
#pragma unroll
                for (int bj = 0; bj < 2; ++bj) { const f32x4 v0 = acc[ai][bj][m][0], v1 = acc[ai][bj][m][1];
                    u32x4 w; w.x = cvt_pk_bf16(v0[0], v0[1]); w.y = cvt_pk_bf16(v0[2], v0[3]); w.z = cvt_pk_bf16(v1[0], v1[1]); w.w = cvt_pk_bf16(v1[2], v1[3]);
                    *(u32x4*)(rowp + bj * HALF) = w; } }
    }
};

__device__ __forceinline__ float xrow16(float v, bool odd) {
    float a = v, b = v; asm volatile("s_nop 1\n\tv_permlane16_swap_b32 %0, %1\n\ts_nop 1" : "+v"(a), "+v"(b)); return odd ? a : b; }
__device__ __forceinline__ float sum_rows4(float v) {
    { float a = v, b = v; asm volatile("s_nop 1\n\tv_permlane16_swap_b32 %0, %1\n\ts_nop 1" : "+v"(a), "+v"(b)); v = a + b; }
    { float a = v, b = v; asm volatile("s_nop 1\n\tv_permlane32_swap_b32 %0, %1\n\ts_nop 1" : "+v"(a), "+v"(b)); v = a + b; }
    return v; }
struct EpiIn {
    static constexpr bool PERM = true, AFTER_DRAIN = false;
    bf16_t* seg0; size_t sege; const int* pos; unsigned* kmax;
    __device__ __forceinline__ void operator()(const f32x4 (&acc)[2][2][4][2], const Unit& u, int wr_, int wc_, int fr_, int fq_) const {
        int t_ = threadIdx.x; asm volatile("" : "+v"(t_));
        const int wid_ = __builtin_amdgcn_readfirstlane(t_ >> 6), wr = wid_ >> 2, wc = wid_ & 3, fr = t_ & 15, fq = (t_ >> 4) & 3;
        const int t = u.pn >> 2, colt = (u.pn & 3) * BM;
        const int row0 = u.pm * BM + wr * 64 + fr, col0 = colt + wc * 32 + 8 * fq;
        bf16_t* base = seg0 + (size_t)t * sege;
        const bool isqk = (t == 3) || (t == 4);
        const bool ropew = isqk && ((wc & 1) == 0);
        const bool isk = (t == 4);
        const bool oddrow = (fq & 1) != 0;
        int ps[8];
        if (ropew) {
#pragma unroll
            for (int i = 0; i < 8; ++i) ps[i] = pos[row0 + (i >> 2) * HALF + (i & 3) * 16];
        }
        float mx[2] = {0.f, 0.f};
#pragma unroll
        for (int ai = 0; ai < 2; ++ai)
#pragma unroll
            for (int m = 0; m < 4; ++m) { const int row = row0 + ai * HALF + m * 16; bf16_t* rowp = base + (size_t)row * 1024 + col0;
                float cs[8], sn[8];
                if (ropew) { const float p = (float)ps[ai * 4 + m];
#pragma unroll
                    for (int j = 0; j < 8; ++j) { constexpr double L2B = 18.931568569324174;
                        const float k = (float)(__builtin_exp2(-(double)j * 0.125 * L2B) * 0.15915494309189535);
                        const float rv = __builtin_amdgcn_fractf(p * k); const float c_ = __builtin_amdgcn_cosf(rv), s_ = __builtin_amdgcn_sinf(rv);
                        cs[j] = (fq < 2) ? c_ : 1.f; sn[j] = (fq == 0) ? -s_ : ((fq == 1) ? s_ : 0.f); } }
#pragma unroll
                for (int bj = 0; bj < 2; ++bj) { f32x4 v0 = acc[ai][bj][m][0], v1 = acc[ai][bj][m][1];
                    if (ropew) {
#pragma unroll
                        for (int i = 0; i < 4; ++i) { const float p0 = xrow16(v0[i], oddrow), p1 = xrow16(v1[i], oddrow); v0[i] = v0[i] * cs[i] + p0 * sn[i]; v1[i] = v1[i] * cs[4 + i] + p1 * sn[4 + i]; }
                    }
                    u32x4 w; w.x = cvt_pk_bf16(v0[0], v0[1]); w.y = cvt_pk_bf16(v0[2], v0[3]); w.z = cvt_pk_bf16(v1[0], v1[1]); w.w = cvt_pk_bf16(v1[2], v1[3]);
                    *(u32x4*)(rowp + bj * HALF) = w;
                    if (isk) { float ss = (v0[0] * v0[0] + v0[1] * v0[1]) + (v0[2] * v0[2] + v0[3] * v0[3]) + (v1[0] * v1[0] + v1[1] * v1[1]) + (v1[2] * v1[2] + v1[3] * v1[3]);
                        ss = sum_rows4(ss); mx[bj] = fmaxf(mx[bj], ss); } } }
        if (isk) {
#pragma unroll
            for (int bj = 0; bj < 2; ++bj) { float v = mx[bj];
#define DPPF(x, ctl) __builtin_bit_cast(float, __builtin_amdgcn_update_dpp(0, __builtin_bit_cast(int, (x)), (ctl), 0xf, 0xf, false))
                v = fmaxf(v, DPPF(v, 0xB1)); v = fmaxf(v, DPPF(v, 0x4E)); v = fmaxf(v, DPPF(v, 0x141)); v = fmaxf(v, DPPF(v, 0x140));
#undef DPPF
                if ((t_ & 63) == 0) { const int b = u.pm >> 4, head = (u.pn & 3) * 2 + bj, c = wc >> 1, half = wc & 1;
                    atomicMax(kmax + (((b * 8 + head) * 2 + c) * 2 + half), __float_as_uint(v)); } }
        }
    }
};

template <class TX> struct EpiRes {
    static constexpr bool PERM = true, AFTER_DRAIN = false;
    const TX* xin; bf16_t* xout; const float* gate;
    __device__ __forceinline__ void operator()(const f32x4 (&acc)[2][2][4][2], const Unit& u, int wr, int wc, int fr, int fq) const {
        const int row0 = u.pm * BM + wr * 64 + fr, col0 = u.pn * BM + wc * 32 + 8 * fq, b = u.pm >> 4;
        f32x4 g[2][2];
#pragma unroll
        for (int bj = 0; bj < 2; ++bj)
#pragma unroll
            for (int n = 0; n < 2; ++n) g[bj][n] = *(const f32x4*)(gate + (size_t)b * 12288 + col0 + bj * HALF + 4 * n);
#pragma unroll
        for (int ai = 0; ai < 2; ++ai)
#pragma unroll
            for (int m = 0; m < 4; ++m) { const size_t off = (size_t)(row0 + ai * HALF + m * 16) * 2048 + col0;
#pragma unroll
                for (int bj = 0; bj < 2; ++bj) { f32x4 x0, x1;
                    if constexpr (sizeof(TX) == 4) { x0 = *(const f32x4*)((const float*)xin + off + bj * HALF); x1 = *(const f32x4*)((const float*)xin + off + bj * HALF + 4); }
                    else { const u32x4 w = *(const u32x4*)((const bf16_t*)xin + off + bj * HALF); x0 = (f32x4){__builtin_bit_cast(float, w[0] << 16), __builtin_bit_cast(float, w[0] & 0xffff0000u), __builtin_bit_cast(float, w[1] << 16), __builtin_bit_cast(float, w[1] & 0xffff0000u)};
                        x1 = (f32x4){__builtin_bit_cast(float, w[2] << 16), __builtin_bit_cast(float, w[2] & 0xffff0000u), __builtin_bit_cast(float, w[3] << 16), __builtin_bit_cast(float, w[3] & 0xffff0000u)}; }
                    const f32x4 y0 = x0 + g[bj][0] * acc[ai][bj][m][0], y1 = x1 + g[bj][1] * acc[ai][bj][m][1];
                    u32x4 o; o.x = cvt_pk_bf16(y0[0], y0[1]); o.y = cvt_pk_bf16(y0[2], y0[3]); o.z = cvt_pk_bf16(y1[0], y1[1]); o.w = cvt_pk_bf16(y1[2], y1[3]);
                    *(u32x4*)(xout + off + bj * HALF) = o; } }
    }
};

template <class Epi, class Sched, bool ALIGN_EPI = false, bool SP2 = false>
__device__ __forceinline__ void gemm_phase(PG8_LAS unsigned char* lds, const Gemm g, const Sched& S, const Epi& E) {
    int tid_ = threadIdx.x; asm volatile("" : "+v"(tid_));
    const int tid = tid_, wid = __builtin_amdgcn_readfirstlane(tid >> 6), lane = tid & 63, wr = wid >> 2, wc = wid & 3, fr = lane & 15, fq = lane >> 4;
    const int K = g.K, nt = K / BK;
    unsigned voffA[2], voffB[2];
#pragma unroll
    for (int i = 0; i < 2; ++i) { int R, C; stage_rc(tid * 16 + i * 8192, R, C); const int Rb = Epi::PERM ? ((R & ~31) + perm32(R & 31)) : R;
        voffA[i] = (unsigned)(R * K + C) * 2u; voffB[i] = (unsigned)(Rb * K + C) * 2u; }
    const size_t kstep = (size_t)(BK * 2);
    const size_t hstep = (size_t)HALF * K * 2;
    const size_t tstep = 2 * hstep;
    const unsigned ldsw = (unsigned)wid * 1024u;
    const int aoff = lds_byte(wr * 64 + fr, fq * 8), boff = lds_byte(wc * 32 + fr, fq * 8);
#define PG8_SA(b, h) (((b) * 2 + (h)) * HTB)
#define PG8_SB(b, h) ((4 + (b) * 2 + (h)) * HTB)
#define PG8_STAGE(bufoff, gbase, voff) do { _Pragma("unroll") for (int _i = 0; _i < 2; ++_i) \
        __builtin_amdgcn_global_load_lds((const unsigned*)((const char*)(gbase) + (voff)[_i]), (PG8_LAS unsigned*)(lds + (bufoff) + ldsw + _i * 8192), 16, 0, 0); } while (0)
#define PG8_LDA(dst, b, h) do { _Pragma("unroll") for (int m = 0; m < 4; ++m) _Pragma("unroll") for (int k = 0; k < 2; ++k) dst[m][k] = *(const PG8_LAS bf16x8*)(lds + PG8_SA(b, h) + aoff + m * 2048 + k * 1024); } while (0)
#define PG8_LDB(dst, b, h) do { _Pragma("unroll") for (int n = 0; n < 2; ++n) _Pragma("unroll") for (int k = 0; k < 2; ++k) dst[n][k] = *(const PG8_LAS bf16x8*)(lds + PG8_SB(b, h) + boff + n * 2048 + k * 1024); } while (0)
#define PG8_MMA(ai, bj, At, Bt) do { __builtin_amdgcn_s_setprio(1); _Pragma("unroll") for (int m = 0; m < 4; ++m) _Pragma("unroll") for (int n = 0; n < 2; ++n) _Pragma("unroll") for (int k = 0; k < 2; ++k) \
        acc[ai][bj][m][n] = __builtin_amdgcn_mfma_f32_16x16x32_bf16(Bt[n][k], At[m][k], acc[ai][bj][m][n], 0, 0, 0); __builtin_amdgcn_s_setprio(0); } while (0)
#define PG8_WAIT_V(n) asm volatile("s_waitcnt vmcnt(" #n ")" ::: "memory")
#define PG8_WAIT_L(n) asm volatile("s_waitcnt lgkmcnt(" #n ")" ::: "memory")
#define PG8_BAR __builtin_amdgcn_s_barrier()
#define PG8_SCHED __builtin_amdgcn_sched_barrier(0)
    Unit cur, nxt; int ui = 0;
    if (!S.next(0, cur)) return;
    f32x4 acc[2][2][4][2];
#pragma unroll
    for (int a = 0; a < 2; ++a)
#pragma unroll
        for (int b = 0; b < 2; ++b)
#pragma unroll
            for (int m = 0; m < 4; ++m)
#pragma unroll
                for (int n = 0; n < 2; ++n) acc[a][b][m][n] = (f32x4){0.f, 0.f, 0.f, 0.f};
    bf16x8 At[4][2], B0[2][2], B1[2][2];
    const char* cA = (const char*)g.A + (size_t)cur.pm * tstep; const char* cB = (const char*)g.Bt + (size_t)cur.pn * tstep;
    S.a_ready(cur);
    if constexpr (SP2) {
        PG8_STAGE(PG8_SB(0, 0), cB, voffB); PG8_STAGE(PG8_SB(0, 1), cB + hstep, voffB); PG8_STAGE(PG8_SA(0, 0), cA, voffA); PG8_STAGE(PG8_SA(0, 1), cA + hstep, voffA);
        if (wr == 1) PG8_BAR;
        PG8_WAIT_V(2); PG8_BAR;
        PG8_STAGE(PG8_SB(1, 0), cB + kstep, voffB); PG8_STAGE(PG8_SA(1, 0), cA + kstep, voffA); PG8_STAGE(PG8_SB(1, 1), cB + hstep + kstep, voffB);
        PG8_WAIT_V(6); PG8_BAR;
    } else {
        PG8_STAGE(PG8_SB(0, 0), cB, voffB); PG8_STAGE(PG8_SA(0, 0), cA, voffA); PG8_STAGE(PG8_SB(0, 1), cB + hstep, voffB); PG8_STAGE(PG8_SA(0, 1), cA + hstep, voffA);
        if (wr == 1) PG8_BAR;
        PG8_WAIT_V(4); PG8_BAR;
        PG8_STAGE(PG8_SB(1, 0), cB + kstep, voffB); PG8_STAGE(PG8_SA(1, 0), cA + kstep, voffA); PG8_STAGE(PG8_SB(1, 1), cB + hstep + kstep, voffB);
        PG8_WAIT_V(6); PG8_BAR;
    }
    for (;;) {
        const bool has_next = S.next(ui + 1, nxt);
        const char* nA = has_next ? (const char*)g.A + (size_t)nxt.pm * tstep : cA; const char* nB = has_next ? (const char*)g.Bt + (size_t)nxt.pn * tstep : cB;
        for (int t = 0; t < nt; t += 2) {
            const bool last = (t == nt - 2);
            const char* a1 = cA + (size_t)(t + 1) * kstep;
            const char* a2 = last ? nA : cA + (size_t)(t + 2) * kstep; const char* b2 = last ? nB : cB + (size_t)(t + 2) * kstep;
            const char* a3 = a2 + kstep; const char* b3 = b2 + kstep;
            if (last && has_next) S.a_ready(nxt);
            if constexpr (SP2) {
            PG8_LDB(B0, 0, 0); PG8_LDB(B1, 0, 1); PG8_SCHED; PG8_LDA(At, 0, 0); PG8_STAGE(PG8_SA(1, 1), a1 + hstep, voffA);
            PG8_WAIT_V(8); PG8_WAIT_L(0); PG8_BAR; PG8_MMA(0, 0, At, B0); PG8_MMA(0, 1, At, B1); PG8_BAR; PG8_SCHED;
            PG8_LDA(At, 0, 1); PG8_STAGE(PG8_SB(0, 0), b2, voffB); PG8_STAGE(PG8_SB(0, 1), b2 + hstep, voffB); PG8_STAGE(PG8_SA(0, 0), a2, voffA);
            PG8_WAIT_V(8); PG8_WAIT_L(0); PG8_BAR; PG8_MMA(1, 0, At, B0); PG8_MMA(1, 1, At, B1); PG8_BAR; PG8_SCHED;
            PG8_LDB(B0, 1, 0); PG8_LDB(B1, 1, 1); PG8_SCHED; PG8_LDA(At, 1, 0); PG8_STAGE(PG8_SA(0, 1), a2 + hstep, voffA);
            PG8_WAIT_V(8); PG8_WAIT_L(0); PG8_BAR; PG8_MMA(0, 0, At, B0); PG8_MMA(0, 1, At, B1); PG8_BAR; PG8_SCHED;
            PG8_LDA(At, 1, 1); PG8_STAGE(PG8_SB(1, 0), b3, voffB); PG8_STAGE(PG8_SB(1, 1), b3 + hstep, voffB); PG8_STAGE(PG8_SA(1, 0), a3, voffA);
            PG8_WAIT_V(8); PG8_WAIT_L(0); PG8_BAR; PG8_MMA(1, 0, At, B0); PG8_MMA(1, 1, At, B1); PG8_BAR; PG8_SCHED;
            } else {
            PG8_LDB(B0, 0, 0); PG8_SCHED; PG8_LDA(At, 0, 0); PG8_STAGE(PG8_SA(1, 1), a1 + hstep, voffA);
            PG8_WAIT_L(8); PG8_BAR; PG8_WAIT_L(0); PG8_MMA(0, 0, At, B0); PG8_BAR; PG8_SCHED;
            PG8_LDB(B1, 0, 1); PG8_STAGE(PG8_SB(0, 0), b2, voffB);
            PG8_BAR; PG8_WAIT_L(0); PG8_MMA(0, 1, At, B1); PG8_BAR;
            PG8_LDA(At, 0, 1); PG8_STAGE(PG8_SA(0, 0), a2, voffA);
            PG8_BAR; PG8_WAIT_L(0); PG8_MMA(1, 0, At, B0); PG8_BAR; PG8_SCHED;
            PG8_STAGE(PG8_SB(0, 1), b2 + hstep, voffB);
            PG8_WAIT_V(6); PG8_BAR; PG8_MMA(1, 1, At, B1); PG8_BAR;
            PG8_LDB(B0, 1, 0); PG8_SCHED; PG8_LDA(At, 1, 0); PG8_STAGE(PG8_SA(0, 1), a2 + hstep, voffA);
            PG8_WAIT_L(8); PG8_BAR; PG8_WAIT_L(0); PG8_MMA(0, 0, At, B0); PG8_BAR; PG8_SCHED;
            PG8_LDB(B1, 1, 1); PG8_STAGE(PG8_SB(1, 0), b3, voffB);
            PG8_BAR; PG8_WAIT_L(0); PG8_MMA(0, 1, At, B1); PG8_BAR;
            PG8_LDA(At, 1, 1); PG8_STAGE(PG8_SA(1, 0), a3, voffA);
            PG8_BAR; PG8_WAIT_L(0); PG8_MMA(1, 0, At, B0); PG8_BAR; PG8_SCHED;
            PG8_STAGE(PG8_SB(1, 1), b3 + hstep, voffB);
            PG8_WAIT_V(6); PG8_BAR; PG8_MMA(1, 1, At, B1); PG8_BAR;
            }
        }
        if constexpr (ALIGN_EPI) { if (wr == 0) PG8_BAR; }
        if constexpr (!Epi::AFTER_DRAIN) { E(acc, cur, wr, wc, fr, fq); S.done(cur); }
        if (!has_next) break;
#pragma unroll
        for (int a = 0; a < 2; ++a)
#pragma unroll
            for (int b = 0; b < 2; ++b)
#pragma unroll
                for (int m = 0; m < 4; ++m)
#pragma unroll
                    for (int n = 0; n < 2; ++n) acc[a][b][m][n] = (f32x4){0.f, 0.f, 0.f, 0.f};
        cur = nxt; cA = nA; cB = nB; ++ui;
        if constexpr (ALIGN_EPI) { if (wr == 1) PG8_BAR; }
    }
    PG8_WAIT_V(0);
    if constexpr (!ALIGN_EPI) { if (wr == 0) PG8_BAR; }
    PG8_BAR;
    if constexpr (Epi::AFTER_DRAIN) { E.fused(acc, cur, wr, wc, fr, fq, lds, wid, lane); S.done(cur); }
#undef PG8_SA
#undef PG8_SB
#undef PG8_STAGE
#undef PG8_LDA
#undef PG8_LDB
#undef PG8_MMA
#undef PG8_WAIT_V
#undef PG8_WAIT_L
#undef PG8_BAR
#undef PG8_SCHED
}
}

#define XB_TMO      128
#define XB_XCNT(j)  (256  + 64 * (j))
#define XB_XSUB(j)  (1280 + 64 * (j))
#define XB_XGEN(j)  (2304 + 64 * (j))
#define XB_TOP      3328
#define XB_TOPGEN   3392
#define XCD_BAR_WORDS 3456
#define XB_SPIN_CAP (1u << 18)

__device__ __forceinline__ unsigned xb_ld(unsigned* p)              { return __hip_atomic_load(p, __ATOMIC_RELAXED, __HIP_MEMORY_SCOPE_AGENT); }
__device__ __forceinline__ unsigned xb_add(unsigned* p, unsigned v) { return __hip_atomic_fetch_add(p, v, __ATOMIC_RELAXED, __HIP_MEMORY_SCOPE_AGENT); }
__device__ __forceinline__ unsigned xb_xcc_id() { return (unsigned)__builtin_amdgcn_s_getreg((3 << 11) | 20) & 0xFu; }
#define XB_SPIN(cond, bar) do { unsigned _sp = 0; while (cond) { __builtin_amdgcn_s_sleep(1); \
    if ((++_sp & 255u) == 0u) { if (xb_ld(&(bar)[XB_TMO])) break; if (_sp > XB_SPIN_CAP) { atomicAdd(&(bar)[XB_TMO], 1u); break; } } } } while (0)

struct XcdBarrier {
    unsigned* bar; unsigned x;
    volatile LAS unsigned* st;
};

__device__ __forceinline__ XcdBarrier xcd_barrier_post(unsigned* bar, volatile LAS unsigned* st) {
    XcdBarrier b; b.bar = bar; b.x = xb_xcc_id(); b.st = st;
    if (threadIdx.x == 0) (void)xb_add(&bar[XB_XCNT(b.x)], 1u);
    return b;
}
__device__ __forceinline__ void xcd_barrier_complete(unsigned* bar, unsigned x, unsigned& nloc, unsigned& nx) {
    const unsigned G = gridDim.x * gridDim.y * gridDim.z;
    unsigned sum, cnt, mine, sp = 0u;
    for (;;) {
        sum = 0u; cnt = 0u; mine = 0u;
#pragma unroll
        for (unsigned j = 0; j < 16; ++j) { const unsigned c = xb_ld(&bar[XB_XCNT(j)]); sum += c; cnt += (c > 0u) ? 1u : 0u; mine = (j == x) ? c : mine; }
        if (sum == G) break;
        __builtin_amdgcn_s_sleep(1);
        if ((++sp & 255u) == 0u) { if (xb_ld(&bar[XB_TMO])) break; if (sp > XB_SPIN_CAP) { atomicAdd(&bar[XB_TMO], 1u); break; } }
    }
    nloc = mine > 0u ? mine : 1u; nx = cnt > 0u ? cnt : 1u;
}

__device__ __forceinline__ void xcd_barrier(const XcdBarrier& b) {
    asm volatile("s_waitcnt vmcnt(0)" ::: "memory");
    __syncthreads();
    if (threadIdx.x == 0) {
        unsigned* bar = b.bar;
        __builtin_amdgcn_s_waitcnt(0);
        unsigned nloc = b.st[0], nx = b.st[1];
        if (nloc == 0u) { xcd_barrier_complete(bar, b.x, nloc, nx); b.st[0] = nloc; b.st[1] = nx; }
        const unsigned old = xb_add(&bar[XB_XSUB(b.x)], 1u);
        const unsigned gen = old / nloc;
        if (old + 1u == (gen + 1u) * nloc) {
            __builtin_amdgcn_fence(__ATOMIC_RELEASE, "agent");
            asm volatile("s_waitcnt vmcnt(0)" ::: "memory");
            const unsigned og = xb_add(&bar[XB_TOP], 1u);
            const unsigned tg = og / nx;
            if (og + 1u == (tg + 1u) * nx) xb_add(&bar[XB_TOPGEN], 1u);
            else XB_SPIN(xb_ld(&bar[XB_TOPGEN]) == tg, bar);
            __builtin_amdgcn_fence(__ATOMIC_ACQUIRE, "agent");
            xb_add(&bar[XB_XGEN(b.x)], 1u);
            asm volatile("s_waitcnt vmcnt(0)" ::: "memory");
        } else {
            XB_SPIN(xb_ld(&bar[XB_XGEN(b.x)]) == gen, bar);
            __builtin_amdgcn_fence(__ATOMIC_ACQUIRE, "agent");
            asm volatile("s_waitcnt vmcnt(0)" ::: "memory");
        }
    }
    __syncthreads();
}

#define LDS_WAIT() asm volatile("s_waitcnt lgkmcnt(0)" ::: "memory")
#define VM_WAIT() asm volatile("s_waitcnt vmcnt(0)" ::: "memory")
__device__ __forceinline__ unsigned f2bf(float f) { unsigned u = __builtin_bit_cast(unsigned, f); return (u + 0x7fffu + ((u >> 16) & 1u)) >> 16; }
__device__ __forceinline__ unsigned pk2(float lo, float hi) { return f2bf(lo) | (f2bf(hi) << 16); }
__device__ __forceinline__ float bf_lo(unsigned w) { return __builtin_bit_cast(float, w << 16); }
__device__ __forceinline__ float bf_hi(unsigned w) { return __builtin_bit_cast(float, w & 0xffff0000u); }
__device__ __forceinline__ float wave_sum(float v) {
#pragma unroll
    for (int o = 1; o < 64; o <<= 1) v += __shfl_xor(v, o);
    return v;
}

struct Ctx {
    LAS unsigned char* lds;
    unsigned char* ws;
    int tid, lane, wave, vcu, G, gw, NGW;
    float* out;
};

__device__ __forceinline__ void p0_transpose_item(const float* W, int K, int N, bf16_t* WT, LAS float* scr, int item, int lane) {
    const int nblk = N / 64, kb = item / nblk, nb = item % nblk, k0 = 64 * kb, n0 = 64 * nb;
    const int cg = lane & 15, rp = lane >> 4;
    const float* src = W + (size_t)(k0 + 2 * rp) * N + n0 + 4 * cg;
    f32x4 xe[8], xo[8];
#pragma unroll
    for (int s = 0; s < 8; ++s) { xe[s] = *(const f32x4*)(src + (size_t)(8 * s) * N); xo[s] = *(const f32x4*)(src + (size_t)(8 * s + 1) * N); }
    LAS unsigned* T = (LAS unsigned*)scr;
#pragma unroll
    for (int s = 0; s < 8; ++s) {
#pragma unroll
        for (int j = 0; j < 4; ++j) T[(4 * cg + j) * 33 + 4 * s + rp] = pk2(xe[s][j], xo[s][j]); }
    LDS_WAIT(); asm volatile("" ::: "memory");
    const int c = lane & 7;
#pragma unroll
    for (int j = 0; j < 8; ++j) { const int n = (lane >> 3) + 8 * j; const LAS unsigned* s = T + n * 33 + 4 * c;
        u32x4 o; o.x = s[0]; o.y = s[1]; o.z = s[2]; o.w = s[3];
        *(u32x4*)(WT + (size_t)(n0 + n) * K + k0 + 8 * c) = o; }
    LDS_WAIT(); asm volatile("" ::: "memory");
}
__device__ __forceinline__ void p0_cvt_row(const float* src, bf16_t* dst, int lane) {
#pragma unroll
    for (int j = 0; j < 4; ++j) { const f32x4 a = *(const f32x4*)(src + 512 * j + 8 * lane), b = *(const f32x4*)(src + 512 * j + 8 * lane + 4);
        u32x4 o; o.x = pk2(a[0], a[1]); o.y = pk2(a[2], a[3]); o.z = pk2(b[0], b[1]); o.w = pk2(b[2], b[3]);
        *(u32x4*)(dst + 512 * j + 8 * lane) = o; }
}
__device__ __forceinline__ void p0_cvt_row_fp8(const float* src, unsigned char* dst_tab, int row, float* inv_scale, int lane) {
    f32x4 v[8]; float amax = 0.f;
#pragma unroll
    for (int j = 0; j < 2; ++j)
#pragma unroll
        for (int q = 0; q < 4; ++q) { const f32x4 a = *(const f32x4*)(src + 1024 * j + 16 * lane + 4 * q); v[4 * j + q] = a;
            amax = fmaxf(amax, fmaxf(fmaxf(fabsf(a[0]), fabsf(a[1])), fmaxf(fabsf(a[2]), fabsf(a[3])))); }
#pragma unroll
    for (int o = 1; o < 64; o <<= 1) amax = fmaxf(amax, __shfl_xor(amax, o));
    const float sc = amax > 0.f ? 448.0f / amax : 1.0f;
#pragma unroll
    for (int j = 0; j < 2; ++j) { u32x4 o;
#pragma unroll
        for (int q = 0; q < 4; ++q) { const f32x4 a = v[4 * j + q] * sc; int w = 0; w = __builtin_amdgcn_cvt_pk_fp8_f32(a[0], a[1], w, false); w = __builtin_amdgcn_cvt_pk_fp8_f32(a[2], a[3], w, true); o[q] = (unsigned)w; }
        const int slice = 8 * j + (lane >> 3);
        *(u32x4*)(dst_tab + ((size_t)slice * NEXP + row) * 128 + 16 * (lane & 7)) = o; }
    if (lane == 0) *inv_scale = amax > 0.f ? amax * (1.0f / 448.0f) : 1.0f;
}
__device__ __forceinline__ unsigned pack_i8x4(f32x4 a) { const int q0 = __float2int_rn(a[0]), q1 = __float2int_rn(a[1]), q2 = __float2int_rn(a[2]), q3 = __float2int_rn(a[3]);
    return (unsigned)(q0 & 0xff) | ((unsigned)(q1 & 0xff) << 8) | ((unsigned)(q2 & 0xff) << 16) | ((unsigned)(q3 & 0xff) << 24); }
__device__ __forceinline__ void p0_cvt_row_i8(const float* src, unsigned char* dst_tab, int row, float* inv_scale, int lane) {
    f32x4 v[8]; float amax = 0.f;
#pragma unroll
    for (int j = 0; j < 2; ++j)
#pragma unroll
        for (int q = 0; q < 4; ++q) { const f32x4 a = *(const f32x4*)(src + 1024 * j + 16 * lane + 4 * q); v[4 * j + q] = a;
            amax = fmaxf(amax, fmaxf(fmaxf(fabsf(a[0]), fabsf(a[1])), fmaxf(fabsf(a[2]), fabsf(a[3])))); }
#pragma unroll
    for (int o = 1; o < 64; o <<= 1) amax = fmaxf(amax, __shfl_xor(amax, o));
    const float sc = amax > 0.f ? 127.0f / amax : 1.0f;
#pragma unroll
    for (int j = 0; j < 2; ++j) { u32x4 o;
#pragma unroll
        for (int q = 0; q < 4; ++q) o[q] = pack_i8x4(v[4 * j + q] * sc);
        const int slice = 8 * j + (lane >> 3);
        *(u32x4*)(dst_tab + ((size_t)slice * NEXP + row) * 128 + 16 * (lane & 7)) = o; }
    if (lane == 0) *inv_scale = amax > 0.f ? amax * (1.0f / 127.0f) : 1.0f;
}
__device__ __forceinline__ void p0_adaln_task(const float* c, const float* ada_w, float* modp, LAS float* scr, int task, int lane) {
    const int ks = task & 7, cg = (task >> 3) % 48, l = task / 384;
#pragma unroll
    for (int i = 0; i < 32; ++i) { const int e = i * 64 + lane, k = e >> 3, b = e & 7; const float x = c[b * DM + ks * 256 + k];
        scr[e] = x / (1.f + expf(-x)); }
    LDS_WAIT(); asm volatile("" ::: "memory");
    const float* wp = ada_w + ((size_t)l * DM + ks * 256) * MODW + cg * 256 + lane * 4;
    f32x4 acc[8];
#pragma unroll
    for (int b = 0; b < 8; ++b) acc[b] = (f32x4){0.f, 0.f, 0.f, 0.f};
#pragma unroll 16
    for (int k = 0; k < 256; ++k) { const f32x4 w = *(const f32x4*)(wp + (size_t)k * MODW);
        const f32x4 s0 = *(const LAS f32x4*)(scr + k * 8), s1 = *(const LAS f32x4*)(scr + k * 8 + 4);
        acc[0] += w * s0[0]; acc[1] += w * s0[1]; acc[2] += w * s0[2]; acc[3] += w * s0[3];
        acc[4] += w * s1[0]; acc[5] += w * s1[1]; acc[6] += w * s1[2]; acc[7] += w * s1[3]; }
#pragma unroll
    for (int b = 0; b < 8; ++b) *(f32x4*)(modp + (((size_t)ks * DEPTH + l) * NBATCH + b) * MODW + cg * 256 + lane * 4) = acc[b];
    LDS_WAIT(); asm volatile("" ::: "memory");
}
struct Args;
template <class A> __device__ __forceinline__ void p0_prologue(Ctx& C, const A& args) {
    LAS float* scr = (LAS float*)(C.lds + C.wave * 16384);
    const float* w_in = args.in[6]; const float* w_out = args.in[13]; const float* wq = args.in[15];
    bf16_t* WIN = (bf16_t*)(C.ws + WS_WIN); bf16_t* WOUT = (bf16_t*)(C.ws + WS_WOUT); bf16_t* WQ = (bf16_t*)(C.ws + WS_WQ);
    constexpr int T_ADA = 4 * 48 * 8;
    constexpr int I_IN = (DM / 64) * (INC / 64), I_SQ = (DM / 64) * (DM / 64);
    constexpr int T_IN = 4 * I_IN, T_OUT = 4 * I_SQ, T_WQ = 4 * I_SQ;
    constexpr int T_KEYS = 4 * 16 * 128 * 128 / 2048;
    constexpr int T_UV = 4 * NEXP;
    constexpr int T_ROPE = 0;
    constexpr int NT = T_ADA + T_IN + T_OUT + T_WQ + T_KEYS + T_ROPE + 1;
    for (int it = C.wave * C.G + C.vcu; it < NT; it += C.NGW) {
        int r = it;
        if (r < T_ADA) { p0_adaln_task(args.in[1], args.in[3], (float*)(C.ws + WS_MODP), scr, r, C.lane); continue; } r -= T_ADA;
        if (r < T_IN) { const int l = r / I_IN; p0_transpose_item(w_in + (size_t)l * DM * INC, DM, INC, WIN + (size_t)l * INC * DM, scr, r % I_IN, C.lane); continue; } r -= T_IN;
        if (r < T_OUT) { const int l = r / I_SQ; p0_transpose_item(w_out + (size_t)l * DM * DM, DM, DM, WOUT + (size_t)l * DM * DM, scr, r % I_SQ, C.lane); continue; } r -= T_OUT;
        if (r < T_WQ) { const int l = r / I_SQ; p0_transpose_item(wq + (size_t)l * DM * DM, DM, DM, WQ + (size_t)l * DM * DM, scr, r % I_SQ, C.lane); continue; } r -= T_WQ;
        if (r < T_KEYS) { p0_cvt_row(args.in[16] + (size_t)r * 2048, (bf16_t*)(C.ws + WS_KEYS) + (size_t)r * 2048, C.lane); continue; } r -= T_KEYS;
        if (r < T_ROPE) {
            const int row = r * 64 + C.lane; const float pos = (float)((const int*)args.in[2])[row]; float* o = (float*)(C.ws + WS_ROPE) + (size_t)row * 16;
#pragma unroll
            for (int j = 0; j < 8; ++j) { const float invf = exp2f(-(float)j * 0.125f * 18.931568569324174f);
                const float ang = pos * invf; double rev = (double)ang * 0.15915494309189535; rev -= __builtin_rint(rev);
                const float rf = (float)rev; o[j] = __builtin_amdgcn_cosf(rf); o[8 + j] = __builtin_amdgcn_sinf(rf); }
            continue; } r -= T_ROPE;
        {
            float* lam = (float*)(C.ws + WS_LAM);
            for (int l = 0; l < DEPTH; ++l) {
                const float a = wave_sum(args.in[8][l * 64 + C.lane] * args.in[9][l * 64 + C.lane]), b = wave_sum(args.in[10][l * 64 + C.lane] * args.in[11][l * 64 + C.lane]);
                const float li = 0.8f - 0.6f * expf(-0.3f * (float)l);
                if (C.lane == 0) { lam[l] = expf(a) - expf(b) + li; lam[4 + l] = 1.f - li; } }
        }
    }
}
template <int R> __device__ __forceinline__ void p0_cvt_rowsN_i8(const float* src, unsigned char* dst_tab, int row, float* inv_scale, int lane) {
    f32x4 v[R][8];
#pragma unroll
    for (int u = 0; u < R; ++u)
#pragma unroll
        for (int j = 0; j < 2; ++j)
#pragma unroll
            for (int q = 0; q < 4; ++q) v[u][4 * j + q] = *(const f32x4*)(src + (size_t)u * 2048 + 1024 * j + 16 * lane + 4 * q);
#pragma unroll
    for (int u = 0; u < R; ++u) { float amax = 0.f;
#pragma unroll
        for (int k = 0; k < 8; ++k) { const f32x4 a = v[u][k]; amax = fmaxf(amax, fmaxf(fmaxf(fabsf(a[0]), fabsf(a[1])), fmaxf(fabsf(a[2]), fabsf(a[3])))); }
#pragma unroll
        for (int o = 1; o < 64; o <<= 1) amax = fmaxf(amax, __shfl_xor(amax, o));
        const float sc = amax > 0.f ? 127.0f / amax : 1.0f;
#pragma unroll
        for (int j = 0; j < 2; ++j) { u32x4 o;
#pragma unroll
            for (int q = 0; q < 4; ++q) o[q] = pack_i8x4(v[u][4 * j + q] * sc);
            const int slice = 8 * j + (lane >> 3);
            *(u32x4*)(dst_tab + ((size_t)slice * NEXP + row + u) * 128 + 16 * (lane & 7)) = o; }
        if (lane == 0) inv_scale[u] = amax > 0.f ? amax * (1.0f / 127.0f) : 1.0f; }
}
template <class A> __device__ __forceinline__ void uv_convert_chunk(Ctx& C, const A& args, int chunk, int lane_) {
#pragma unroll 1
    for (int i = 0; i < 8; i += 2) { int r = chunk * 64 + C.wave * 8 + i;
        if (r < 4 * NEXP) p0_cvt_rowsN_i8<2>(args.in[17] + (size_t)r * 2048, C.ws + WS_U + (size_t)(r / NEXP) * NEXP * DM, r % NEXP, (float*)(C.ws + WS_USC) + r, lane_);
        else { r -= 4 * NEXP; p0_cvt_rowsN_i8<2>(args.in[18] + (size_t)r * 2048, C.ws + WS_V + (size_t)(r / NEXP) * NEXP * DM, r % NEXP, (float*)(C.ws + WS_VSC) + r, lane_); } }
}
__device__ __forceinline__ void p1_modfinal(Ctx& C, const float* ada_b) {
    const float* modp = (const float*)(C.ws + WS_MODP); float* mod = (float*)(C.ws + WS_MOD);
    constexpr int N4 = DEPTH * NBATCH * MODW / 4;
    for (int i = C.vcu * NTHREADS + C.tid; i < N4; i += C.G * NTHREADS) { const int l = i / (NBATCH * MODW / 4), n4 = i % (MODW / 4);
        f32x4 s = *(const f32x4*)(ada_b + (size_t)l * MODW + n4 * 4);
#pragma unroll
        for (int ks = 0; ks < 8; ++ks) s += *(const f32x4*)(modp + (size_t)ks * DEPTH * NBATCH * MODW + (size_t)i * 4);
        *(f32x4*)(mod + (size_t)i * 4) = s; }
}

template <class TX> __device__ __forceinline__ void ld8(const TX* p, f32x4& a, f32x4& c);
template <> __device__ __forceinline__ void ld8<float>(const float* p, f32x4& a, f32x4& c) { a = *(const f32x4*)p; c = *(const f32x4*)(p + 4); }
template <> __device__ __forceinline__ void ld8<bf16_t>(const bf16_t* p, f32x4& a, f32x4& c) { const u32x4 w = *(const u32x4*)p; a = (f32x4){bf_lo(w[0]), bf_hi(w[0]), bf_lo(w[1]), bf_hi(w[1])}; c = (f32x4){bf_lo(w[2]), bf_hi(w[2]), bf_lo(w[3]), bf_hi(w[3])}; }
template <class TX> __device__ __forceinline__ void norm_pass(Ctx& C, const TX* x, bf16_t* H, const float* g, const float* sh, const float* sc, unsigned char* HQ = nullptr, float* HSC = nullptr) {
    for (int ch = C.gw; ch < MTOK / 16; ch += C.NGW) { const int row0 = ch * 16, b = row0 >> 12;
        f32x4 G[8], S[8];
        { const float* gp = g + 8 * C.lane; const float* shp = sh + (size_t)b * MODW + 8 * C.lane; const float* scp = sc + (size_t)b * MODW + 8 * C.lane;
#pragma unroll
          for (int j = 0; j < 4; ++j)
#pragma unroll
              for (int q = 0; q < 2; ++q) { G[2 * j + q] = *(const f32x4*)(gp + 512 * j + 4 * q) * (*(const f32x4*)(scp + 512 * j + 4 * q) + 1.0f); S[2 * j + q] = *(const f32x4*)(shp + 512 * j + 4 * q); } }
#pragma unroll 1
        for (int i = 0; i < 16; i += 2) {
            f32x4 v[2][8];
#pragma unroll
            for (int u = 0; u < 2; ++u) { const TX* xr = x + (size_t)(row0 + i + u) * DM + 8 * C.lane;
#pragma unroll
                for (int j = 0; j < 4; ++j) ld8<TX>(xr + 512 * j, v[u][2 * j], v[u][2 * j + 1]); }
#pragma unroll
            for (int u = 0; u < 2; ++u) { const int row = row0 + i + u; float ss = 0.f;
#pragma unroll
                for (int j = 0; j < 8; ++j) { const f32x4 a = v[u][j]; ss += (a[0] * a[0] + a[1] * a[1]) + (a[2] * a[2] + a[3] * a[3]); }
                const float rstd = 1.0f / sqrtf(wave_sum(ss) * (1.f / DM) + NORM_EPS);
                float amax = 0.f;
#pragma unroll
                for (int j = 0; j < 4; ++j) {
#pragma unroll
                    for (int q = 0; q < 2; ++q) { const f32x4 o = (v[u][2 * j + q] * rstd) * G[2 * j + q] + S[2 * j + q]; v[u][2 * j + q] = o;
                        amax = fmaxf(amax, fmaxf(fmaxf(fabsf(o[0]), fabsf(o[1])), fmaxf(fabsf(o[2]), fabsf(o[3])))); }
                    u32x4 w; w.x = pk2(v[u][2 * j][0], v[u][2 * j][1]); w.y = pk2(v[u][2 * j][2], v[u][2 * j][3]); w.z = pk2(v[u][2 * j + 1][0], v[u][2 * j + 1][1]); w.w = pk2(v[u][2 * j + 1][2], v[u][2 * j + 1][3]);
                    *(u32x4*)(H + (size_t)row * DM + 512 * j + 8 * C.lane) = w; }
                if (HQ) {
#pragma unroll
                    for (int o = 1; o < 64; o <<= 1) amax = fmaxf(amax, __shfl_xor(amax, o));
                    const float qs = amax > 0.f ? 127.0f / amax : 1.0f;
#pragma unroll
                    for (int j = 0; j < 4; ++j) *(u32x2*)(HQ + (size_t)row * DM + 512 * j + 8 * C.lane) = (u32x2){pack_i8x4(v[u][2 * j] * qs), pack_i8x4(v[u][2 * j + 1] * qs)};
                    if (C.lane == 0) HSC[row] = amax > 0.f ? amax * (1.0f / 127.0f) : 1.0f; } }
        }
    }
}
__device__ __forceinline__ void final_norm_pass(Ctx& C, const bf16_t* x, float* out, const float* g) {
    f32x4 G[8];
#pragma unroll
    for (int j = 0; j < 4; ++j)
#pragma unroll
        for (int q = 0; q < 2; ++q) G[2 * j + q] = *(const f32x4*)(g + 8 * C.lane + 512 * j + 4 * q);
    for (int ch = C.gw; ch < MTOK / 16; ch += C.NGW) { const int row0 = ch * 16;
#pragma unroll 1
        for (int i = 0; i < 16; i += 2) {
            f32x4 v[2][8];
#pragma unroll
            for (int u = 0; u < 2; ++u) { const bf16_t* xr = x + (size_t)(row0 + i + u) * DM + 8 * C.lane;
#pragma unroll
                for (int j = 0; j < 4; ++j) ld8<bf16_t>(xr + 512 * j, v[u][2 * j], v[u][2 * j + 1]); }
#pragma unroll
            for (int u = 0; u < 2; ++u) { const int row = row0 + i + u; float ss = 0.f;
#pragma unroll
                for (int j = 0; j < 8; ++j) { const f32x4 a = v[u][j]; ss += (a[0] * a[0] + a[1] * a[1]) + (a[2] * a[2] + a[3] * a[3]); }
                const float rstd = 1.0f / sqrtf(wave_sum(ss) * (1.f / DM) + NORM_EPS);
#pragma unroll
                for (int j = 0; j < 4; ++j)
#pragma unroll
                    for (int q = 0; q < 2; ++q) *(f32x4*)(out + (size_t)row * DM + 8 * C.lane + 512 * j + 4 * q) = (v[u][2 * j + q] * rstd) * G[2 * j + q]; }
        }
    }
}

__device__ __forceinline__ void conv_chunk(const bf16_t* GBp, const bf16_t* GCp, const bf16_t* HVp, const float* cw, bf16_t* MIXp, int chunk, int tid) {
    const int c0 = (tid & 127) * 8, r0 = chunk * 128 + (tid >> 7) * 32;
    float w0[8], w1[8], w2[8];
#pragma unroll
    for (int i = 0; i < 8; ++i) { w0[i] = cw[c0 + i]; w1[i] = cw[1024 + c0 + i]; w2[i] = cw[2048 + c0 + i]; }
    float zp[8], zc[8];
    auto zmul = [&](const u32x4& a, const u32x4& h, bool ok, float (&z)[8]) {
#pragma unroll
        for (int i = 0; i < 4; ++i) { z[2 * i] = ok ? bf_lo(a[i]) * bf_lo(h[i]) : 0.f; z[2 * i + 1] = ok ? bf_hi(a[i]) * bf_hi(h[i]) : 0.f; } };
    {
        const bool okp = (r0 & (SEQ - 1)) != 0; const int rp = okp ? r0 - 1 : r0;
        const u32x4 ap = *(const u32x4*)(GCp + (size_t)rp * 1024 + c0), hp = *(const u32x4*)(HVp + (size_t)rp * 1024 + c0);
        const u32x4 ac = *(const u32x4*)(GCp + (size_t)r0 * 1024 + c0), hc = *(const u32x4*)(HVp + (size_t)r0 * 1024 + c0);
        zmul(ap, hp, okp, zp); zmul(ac, hc, true, zc);
    }
#pragma unroll 1
    for (int r = r0; r < r0 + 32; r += 4) {
        u32x4 A[4], Hh[4], G[4]; bool ok[4];
#pragma unroll
        for (int j = 0; j < 4; ++j) { const int rn = r + 1 + j; ok[j] = (rn & (SEQ - 1)) != 0 || rn < r0 + 32; const int rc = ok[j] ? rn : r;
            A[j] = *(const u32x4*)(GCp + (size_t)rc * 1024 + c0); Hh[j] = *(const u32x4*)(HVp + (size_t)rc * 1024 + c0); G[j] = *(const u32x4*)(GBp + (size_t)(r + j) * 1024 + c0); }
#pragma unroll
        for (int j = 0; j < 4; ++j) { float zn[8]; zmul(A[j], Hh[j], ok[j], zn);
            float y[8];
#pragma unroll
            for (int i = 0; i < 4; ++i) { y[2 * i] = bf_lo(G[j][i]) * (w0[2 * i] * zp[2 * i] + w1[2 * i] * zc[2 * i] + w2[2 * i] * zn[2 * i]);
                y[2 * i + 1] = bf_hi(G[j][i]) * (w0[2 * i + 1] * zp[2 * i + 1] + w1[2 * i + 1] * zc[2 * i + 1] + w2[2 * i + 1] * zn[2 * i + 1]); }
            u32x4 o; o.x = pk2(y[0], y[1]); o.y = pk2(y[2], y[3]); o.z = pk2(y[4], y[5]); o.w = pk2(y[6], y[7]);
            *(u32x4*)(MIXp + (size_t)(r + j) * 2048 + c0) = o;
#pragma unroll
            for (int i = 0; i < 8; ++i) { zp[i] = zc[i]; zc[i] = zn[i]; } }
    }
}

namespace att {
constexpr int NSLOT = 3, KSLOT = 8192, VSLOT = 16384;
constexpr int L_K = 0, L_V = NSLOT * KSLOT, L_WS = L_V + NSLOT * VSLOT, L_END = L_WS + NWAVES * 256;
constexpr float C2 = 0.125f * 1.4426950408889634f;
#define SBAR() __builtin_amdgcn_sched_barrier(0)
#define KSWZ(row, colB) ((row) * 256 + ((colB) ^ (((row) & 7) << 4)))
__device__ __forceinline__ int crow(int r, int hi) { return (r & 3) + 8 * (r >> 2) + 4 * hi; }
__device__ __forceinline__ unsigned cvtpk(float lo, float hi) { unsigned r; asm volatile("v_cvt_pk_bf16_f32 %0, %1, %2" : "=v"(r) : "v"(lo), "v"(hi)); return r; }
__device__ __forceinline__ void glds16(const void* gsrc, unsigned lds_dst) { unsigned keep;
    asm volatile("s_mov_b32 %0, m0\n\ts_mov_b32 m0, %2\n\ts_nop 0\n\tglobal_load_lds_dwordx4 %1, off\n\ts_mov_b32 m0, %0" : "=&s"(keep) : "v"(gsrc), "s"(lds_dst) : "memory"); }
#define WAIT_BAR(N) asm volatile("s_waitcnt vmcnt(" #N ") lgkmcnt(0)\n\ts_barrier" ::: "memory")
__device__ __forceinline__ int v_rd_base(int lane) { return ((lane & 3) << 3) | (((lane >> 2) & 3) << 6) | (((lane >> 4) & 1) << 5) | (((lane >> 5) & 1) << 8); }
constexpr int v_rd_off(int d0, int ks, int half) { return d0 * 512 + ks * 4096 + half * 2048; }
template <int OFF> __device__ __forceinline__ s16x4 tr_read(int vb) { s16x4 r; asm volatile("ds_read_b64_tr_b16 %0, %1 offset:%2" : "=&v"(r) : "v"(vb), "i"(OFF) : "memory"); return r; }

__device__ __forceinline__ void qkt(f32x16& p0, f32x16& p1, const LAS char* Ks, const bf16x8* qr, const f32x16& negm, int r32, int hi) {
    const LAS char* kb = Ks + hi * 1024 + r32 * 16;
#pragma unroll
    for (int d0 = 0; d0 < 4; ++d0) {
        const bf16x8 b0 = *(const LAS bf16x8*)(kb + d0 * 2048);
        const bf16x8 b1 = *(const LAS bf16x8*)(kb + d0 * 2048 + 512);
        if (d0 == 0) { p0 = __builtin_amdgcn_mfma_f32_32x32x16_bf16(b0, qr[0], negm, 0, 0, 0); p1 = __builtin_amdgcn_mfma_f32_32x32x16_bf16(b1, qr[0], negm, 0, 0, 0); }
        else { p0 = __builtin_amdgcn_mfma_f32_32x32x16_bf16(b0, qr[d0], p0, 0, 0, 0); p1 = __builtin_amdgcn_mfma_f32_32x32x16_bf16(b1, qr[d0], p1, 0, 0, 0); } }
}
__device__ __forceinline__ float dot2_ones(unsigned pk, float acc) { asm("v_dot2c_f32_bf16 %0, %2, %1" : "+v"(acc) : "v"(pk), "s"(0x3f803f80u)); return acc; }
__device__ __forceinline__ void softmax_pack(f32x16& p0, f32x16& p1, float& l, bf16x8& pa0, bf16x8& pa1, bf16x8& pa2, bf16x8& pa3) {
#pragma unroll
    for (int r = 0; r < 16; ++r) { p0[r] = __builtin_amdgcn_exp2f(p0[r]); p1[r] = __builtin_amdgcn_exp2f(p1[r]); }
    float ps0 = 0.f, ps1 = 0.f;
#define PK4(P, BASE, OUT) do { unsigned a0 = cvtpk(P[BASE + 0], P[BASE + 1]), a1 = cvtpk(P[BASE + 2], P[BASE + 3]);   \
    unsigned b0 = cvtpk(P[BASE + 4], P[BASE + 5]), b1 = cvtpk(P[BASE + 6], P[BASE + 7]);                              \
    ps0 = dot2_ones(a0, ps0); ps1 = dot2_ones(a1, ps1); ps0 = dot2_ones(b0, ps0); ps1 = dot2_ones(b1, ps1);            \
    auto r0 = __builtin_amdgcn_permlane32_swap(a0, b0, false, false); auto r1 = __builtin_amdgcn_permlane32_swap(a1, b1, false, false); \
    u32x4 w = {r0[0], r1[0], r0[1], r1[1]}; OUT = __builtin_bit_cast(bf16x8, w); } while (0)
    PK4(p0, 0, pa0); PK4(p0, 8, pa1); PK4(p1, 0, pa2); PK4(p1, 8, pa3);
#undef PK4
    asm volatile("s_nop 2" : "+v"(ps0), "+v"(ps1));
    l += ps0 + ps1;
}
struct VFrag { s16x4 l0, h0, l1, h1, l2, h2, l3, h3; };
template <int D0> __device__ __forceinline__ void v_reads(VFrag& f, int vb) {
    f.l0 = tr_read<v_rd_off(D0, 0, 0)>(vb); f.h0 = tr_read<v_rd_off(D0, 0, 1)>(vb); f.l1 = tr_read<v_rd_off(D0, 1, 0)>(vb); f.h1 = tr_read<v_rd_off(D0, 1, 1)>(vb);
    f.l2 = tr_read<v_rd_off(D0, 2, 0)>(vb); f.h2 = tr_read<v_rd_off(D0, 2, 1)>(vb); f.l3 = tr_read<v_rd_off(D0, 3, 0)>(vb); f.h3 = tr_read<v_rd_off(D0, 3, 1)>(vb);
}
__device__ __forceinline__ void v_mma(f32x16& od, const VFrag& f, bf16x8 pa0, bf16x8 pa1, bf16x8 pa2, bf16x8 pa3) {
#define PK(L, H) (bf16x8){L[0], L[1], L[2], L[3], H[0], H[1], H[2], H[3]}
    od = __builtin_amdgcn_mfma_f32_32x32x16_bf16(pa0, PK(f.l0, f.h0), od, 0, 0, 0);
    od = __builtin_amdgcn_mfma_f32_32x32x16_bf16(pa1, PK(f.l1, f.h1), od, 0, 0, 0);
    od = __builtin_amdgcn_mfma_f32_32x32x16_bf16(pa2, PK(f.l2, f.h2), od, 0, 0, 0);
    od = __builtin_amdgcn_mfma_f32_32x32x16_bf16(pa3, PK(f.l3, f.h3), od, 0, 0, 0);
#undef PK
}
#define LANDED(f) asm volatile("" : "+v"(f.l0), "+v"(f.h0), "+v"(f.l1), "+v"(f.h1), "+v"(f.l2), "+v"(f.h2), "+v"(f.l3), "+v"(f.h3))
__device__ __forceinline__ void pv_all(f32x16* o, int vb, bf16x8 pa0, bf16x8 pa1, bf16x8 pa2, bf16x8 pa3) {
    VFrag fa, fb;
    v_reads<0>(fa, vb);
    asm volatile("s_waitcnt lgkmcnt(0)" ::: "memory"); LANDED(fa); SBAR();
    v_reads<1>(fb, vb); SBAR();
    v_mma(o[0], fa, pa0, pa1, pa2, pa3); SBAR();
    asm volatile("s_waitcnt lgkmcnt(0)" ::: "memory"); LANDED(fb); SBAR();
    v_reads<2>(fa, vb); SBAR();
    v_mma(o[1], fb, pa0, pa1, pa2, pa3); SBAR();
    asm volatile("s_waitcnt lgkmcnt(0)" ::: "memory"); LANDED(fa); SBAR();
    v_reads<3>(fb, vb); SBAR();
    v_mma(o[2], fa, pa0, pa1, pa2, pa3); SBAR();
    asm volatile("s_waitcnt lgkmcnt(0)" ::: "memory"); LANDED(fb); SBAR();
    v_mma(o[3], fb, pa0, pa1, pa2, pa3);
}
#undef LANDED

template <int VAR> __device__ __forceinline__ void attn_unit(int b, int h, int c, int qb, const bf16_t* Q, const bf16_t* K, const bf16_t* V, bf16_t* OT, const unsigned* kmax, LAS char* shm) {
    int tid_ = threadIdx.x; asm volatile("" : "+v"(tid_));
    const int tid = tid_, lane = tid & 63, r32 = lane & 31, hi = lane >> 5; const int wid = __builtin_amdgcn_readfirstlane(tid >> 6);
    const size_t rowbase = (size_t)b * SEQ; const int q0 = qb * 256;
    const bf16_t* Qw = Q + (rowbase + q0 + wid * 32) * 1024 + h * 128 + c * 64;
    const bf16_t* Kh = K + rowbase * 1024 + h * 128 + c * 64; const bf16_t* Vh = V + rowbase * 1024 + h * 128;
    const unsigned lds0 = (unsigned)(uintptr_t)shm;
    const bf16_t* ksrc = Kh + (size_t)lane * 1024 + wid * 8;
    const bf16_t* vsrc[2];
#pragma unroll
    for (int i = 0; i < 2; ++i) { const int p = 2 * wid + i;
        const int st = 2 * p + (lane >> 5), kk = (st >> 2) * 8 + ((lane & 31) >> 2), key = (kk & ~0xC) | ((kk & 4) << 1) | ((kk & 8) >> 1), cc = (st & 3) * 32 + (lane & 3) * 8;
        vsrc[i] = Vh + (size_t)key * 1024 + cc; }
    const unsigned kdst = lds0 + L_K + wid * 1024, vdst = lds0 + L_V + wid * 2048;
#define DMA_KV(t, slot) do { const size_t toff_ = (size_t)(t) * 64 * 1024; \
        glds16(ksrc + toff_, (unsigned)__builtin_amdgcn_readfirstlane(kdst + (slot) * KSLOT)); \
        glds16(vsrc[0] + toff_, (unsigned)__builtin_amdgcn_readfirstlane(vdst + (slot) * VSLOT)); glds16(vsrc[1] + toff_, (unsigned)__builtin_amdgcn_readfirstlane(vdst + (slot) * VSLOT + 1024)); } while (0)
    DMA_KV(0, 0); DMA_KV(1, 1);
    bf16x8 qr[4];
#pragma unroll
    for (int d0 = 0; d0 < 4; ++d0) qr[d0] = *(const bf16x8*)(Qw + (size_t)r32 * 1024 + d0 * 16 + hi * 8);
    float negm;
    {
        float sa = 0.f;
#pragma unroll
        for (int d0 = 0; d0 < 4; ++d0) { u32x4 qw = __builtin_bit_cast(u32x4, qr[d0]);
#pragma unroll
            for (int e = 0; e < 4; ++e) { const float x0 = bf_lo(qw[e]), x1 = bf_hi(qw[e]); sa += x0 * x0 + x1 * x1; qw[e] = cvtpk(x0 * C2, x1 * C2); }
            qr[d0] = __builtin_bit_cast(bf16x8, qw); }
        { auto rr = __builtin_amdgcn_permlane32_swap(__float_as_uint(sa), __float_as_uint(sa), false, false); sa = __uint_as_float(rr[0]) + __uint_as_float(rr[1]); }
        const unsigned* km = kmax + ((b * 8 + h) * 2 + c) * 2;
        negm = -sqrtf(sa) * sqrtf(__uint_as_float(km[0]) + __uint_as_float(km[1])) * C2;
    }
    f32x16 o[4];
#pragma unroll
    for (int d = 0; d < 4; ++d)
#pragma unroll
        for (int r = 0; r < 16; ++r) o[d][r] = 0.f;
    f32x16 NEGM;
#pragma unroll
    for (int r = 0; r < 16; ++r) NEGM[r] = negm;
    asm volatile("" : "+v"(NEGM));
    float l = 0.f;
    const int vb0 = (int)(lds0 + L_V) + v_rd_base(lane);
    constexpr int NT = SEQ / 64;
    int slot = 0;
    for (int t = 0; t < NT; ++t) {
        if (VAR == 5) { asm volatile("s_waitcnt vmcnt(3) lgkmcnt(0)" ::: "memory"); } else if (t + 1 < NT) { WAIT_BAR(3); } else { WAIT_BAR(0); }
        if (t + 2 < NT && VAR != 4) { const int s2 = (slot + 2 >= NSLOT) ? slot + 2 - NSLOT : slot + 2; DMA_KV(t + 2, s2); }
        const LAS char* Ks = shm + L_K + slot * KSLOT; const int vb = vb0 + slot * VSLOT;
        f32x16 p0, p1; bf16x8 a0, a1, a2, a3;
        slot = (slot + 1 == NSLOT) ? 0 : slot + 1;
        if (VAR == 6 && wid >= 4) continue;
        if (VAR != 3) { SBAR(); qkt(p0, p1, Ks, qr, NEGM, r32, hi); } else { p0 = NEGM; p1 = NEGM; }
        if (VAR != 1) softmax_pack(p0, p1, l, a0, a1, a2, a3);
        else { a0 = __builtin_bit_cast(bf16x8, (u32x4){__builtin_bit_cast(unsigned, p0[0]), __builtin_bit_cast(unsigned, p0[1]), __builtin_bit_cast(unsigned, p0[2]), __builtin_bit_cast(unsigned, p0[3])}); a1 = __builtin_bit_cast(bf16x8, (u32x4){__builtin_bit_cast(unsigned, p0[4]), __builtin_bit_cast(unsigned, p0[5]), __builtin_bit_cast(unsigned, p0[6]), __builtin_bit_cast(unsigned, p0[7])});
               a2 = __builtin_bit_cast(bf16x8, (u32x4){__builtin_bit_cast(unsigned, p1[0]), __builtin_bit_cast(unsigned, p1[1]), __builtin_bit_cast(unsigned, p1[2]), __builtin_bit_cast(unsigned, p1[3])}); a3 = __builtin_bit_cast(bf16x8, (u32x4){__builtin_bit_cast(unsigned, p1[4]), __builtin_bit_cast(unsigned, p1[5]), __builtin_bit_cast(unsigned, p1[6]), __builtin_bit_cast(unsigned, p1[7])}); l += p0[8] + p1[8]; }
        if (VAR != 2) { SBAR(); pv_all(o, vb, a0, a1, a2, a3); } else { o[0][0] += __builtin_bit_cast(float, (unsigned)a0[0] << 16) + __builtin_bit_cast(float, (unsigned)a1[0] << 16) + __builtin_bit_cast(float, (unsigned)a2[0] << 16) + __builtin_bit_cast(float, (unsigned)a3[0] << 16); }
    }
#undef DMA_KV
    { auto rr = __builtin_amdgcn_permlane32_swap(__float_as_uint(l), __float_as_uint(l), false, false); l = __uint_as_float(rr[0]) + __uint_as_float(rr[1]); }
    LAS float* wsf = (LAS float*)(shm + L_WS) + wid * 64;
    if (hi == 0) wsf[r32] = 1.0f / l;
    asm volatile("s_waitcnt lgkmcnt(0)" ::: "memory");
    bf16_t* Ow = OT + (size_t)c * MTOK * 1024 + (rowbase + q0 + wid * 32) * 1024 + h * 128;
#pragma unroll
    for (int r = 0; r < 16; ++r) { const int orow = crow(r, hi); const float il = wsf[orow];
#pragma unroll
        for (int d = 0; d < 4; ++d) Ow[(size_t)orow * 1024 + d * 32 + r32] = (bf16_t)f2bf(o[d][r] * il); }
    asm volatile("s_waitcnt lgkmcnt(0)\n\ts_barrier" ::: "memory");
}

constexpr int NSLOT2 = 4;
constexpr int L2_K = 0, L2_V = NSLOT2 * KSLOT, L2_WS = L2_V + NSLOT2 * VSLOT;
#define EXP2(P, i) P[i] = __builtin_amdgcn_exp2f(P[i])
#define LANDED(f) asm volatile("" : "+v"(f.l0), "+v"(f.h0), "+v"(f.l1), "+v"(f.h1), "+v"(f.l2), "+v"(f.h2), "+v"(f.l3), "+v"(f.h3))
#define PKV(L, H) (bf16x8){L[0], L[1], L[2], L[3], H[0], H[1], H[2], H[3]}
template <int VAR> __device__ __forceinline__ void attn_unit2(int b, int h, int c, int qb, const bf16_t* Q, const bf16_t* K, const bf16_t* V, bf16_t* OT, const unsigned* kmax, LAS char* shm) {
    int tid_ = threadIdx.x; asm volatile("" : "+v"(tid_));
    const int tid = tid_, lane = tid & 63, r32 = lane & 31, hi = lane >> 5; const int wid = __builtin_amdgcn_readfirstlane(tid >> 6);
    const size_t rowbase = (size_t)b * SEQ; const int q0 = qb * 256;
    const bf16_t* Qw = Q + (rowbase + q0 + wid * 32) * 1024 + h * 128 + c * 64;
    const bf16_t* Kh = K + rowbase * 1024 + h * 128 + c * 64; const bf16_t* Vh = V + rowbase * 1024 + h * 128;
    const unsigned lds0 = (unsigned)(uintptr_t)shm;
    const bf16_t* ksrc = Kh + (size_t)lane * 1024 + wid * 8;
    const bf16_t* vsrc[2];
#pragma unroll
    for (int i = 0; i < 2; ++i) { const int p = 2 * wid + i;
        const int st = 2 * p + (lane >> 5), kk = (st >> 2) * 8 + ((lane & 31) >> 2), key = (kk & ~0xC) | ((kk & 4) << 1) | ((kk & 8) >> 1), cc = (st & 3) * 32 + (lane & 3) * 8;
        vsrc[i] = Vh + (size_t)key * 1024 + cc; }
    const unsigned kdst = lds0 + L2_K + wid * 1024, vdst = lds0 + L2_V + wid * 2048;
#define DMA_KV(t, slot) do { const size_t toff_ = (size_t)(t) * 64 * 1024; \
        glds16(ksrc + toff_, (unsigned)__builtin_amdgcn_readfirstlane(kdst + (slot) * KSLOT)); \
        glds16(vsrc[0] + toff_, (unsigned)__builtin_amdgcn_readfirstlane(vdst + (slot) * VSLOT)); glds16(vsrc[1] + toff_, (unsigned)__builtin_amdgcn_readfirstlane(vdst + (slot) * VSLOT + 1024)); } while (0)
    DMA_KV(0, 0); DMA_KV(1, 1); DMA_KV(2, 2);
    bf16x8 qr[4];
#pragma unroll
    for (int d0 = 0; d0 < 4; ++d0) qr[d0] = *(const bf16x8*)(Qw + (size_t)r32 * 1024 + d0 * 16 + hi * 8);
    float negm;
    {
        float sa = 0.f;
#pragma unroll
        for (int d0 = 0; d0 < 4; ++d0) { u32x4 qw = __builtin_bit_cast(u32x4, qr[d0]);
#pragma unroll
            for (int e = 0; e < 4; ++e) { const float x0 = bf_lo(qw[e]), x1 = bf_hi(qw[e]); sa += x0 * x0 + x1 * x1; qw[e] = cvtpk(x0 * C2, x1 * C2); }
            qr[d0] = __builtin_bit_cast(bf16x8, qw); }
        { auto rr = __builtin_amdgcn_permlane32_swap(__float_as_uint(sa), __float_as_uint(sa), false, false); sa = __uint_as_float(rr[0]) + __uint_as_float(rr[1]); }
        const unsigned* km = kmax + ((b * 8 + h) * 2 + c) * 2;
        negm = -sqrtf(sa) * sqrtf(__uint_as_float(km[0]) + __uint_as_float(km[1])) * C2;
    }
    f32x16 o[4];
#pragma unroll
    for (int d = 0; d < 4; ++d)
#pragma unroll
        for (int r = 0; r < 16; ++r) o[d][r] = 0.f;
    f32x16 NEGM;
#pragma unroll
    for (int r = 0; r < 16; ++r) NEGM[r] = negm;
    asm volatile("" : "+v"(NEGM));
    float ps0 = 0.f, ps1 = 0.f;
    const int vb0 = (int)(lds0 + L2_V) + v_rd_base(lane);
    constexpr int NT = SEQ / 64;
    const LAS char* kb0 = shm + L2_K + hi * 1024 + r32 * 16;
    f32x16 c0, c1, n0 = NEGM, n1 = NEGM;
    WAIT_BAR(6);
    {
#pragma unroll
        for (int d0 = 0; d0 < 4; ++d0) { const bf16x8 k0 = *(const LAS bf16x8*)(kb0 + d0 * 2048), k1 = *(const LAS bf16x8*)(kb0 + d0 * 2048 + 512);
            if (d0 == 0) { c0 = __builtin_amdgcn_mfma_f32_32x32x16_bf16(k0, qr[0], NEGM, 0, 0, 0); c1 = __builtin_amdgcn_mfma_f32_32x32x16_bf16(k1, qr[0], NEGM, 0, 0, 0); }
            else { c0 = __builtin_amdgcn_mfma_f32_32x32x16_bf16(k0, qr[d0], c0, 0, 0, 0); c1 = __builtin_amdgcn_mfma_f32_32x32x16_bf16(k1, qr[d0], c1, 0, 0, 0); } }
#pragma unroll
        for (int r = 0; r < 16; ++r) { EXP2(c0, r); EXP2(c1, r); }
    }
    int slot = 0;
#pragma unroll 1
    for (int t = 0; t < NT; ++t) {
        if (VAR == 11) { asm volatile("s_waitcnt vmcnt(3) lgkmcnt(0)" ::: "memory"); } else if (t + 2 < NT) { WAIT_BAR(3); } else { WAIT_BAR(0); }
        if (t + 3 < NT && VAR != 12) { const int s3 = (slot + 3 >= NSLOT2) ? slot + 3 - NSLOT2 : slot + 3; DMA_KV(t + 3, s3); }
        const int sn = (slot + 1 == NSLOT2) ? 0 : slot + 1;
        const LAS char* kb = kb0 + sn * KSLOT; const int vb = vb0 + slot * VSLOT;
        const bool more = (t + 1 < NT);
        bf16x8 pa0, pa1, pa2, pa3;
        if (VAR == 6 && wid >= 4) { slot = sn; continue; }
        {
            unsigned w[16];
#define PACK4(P, B, W0) do { if (VAR == 10) { w[W0] = __builtin_bit_cast(unsigned, P[B]); w[W0 + 1] = __builtin_bit_cast(unsigned, P[B + 2]); w[W0 + 2] = __builtin_bit_cast(unsigned, P[B + 4]); w[W0 + 3] = __builtin_bit_cast(unsigned, P[B + 6]); break; } w[W0] = cvtpk(P[B], P[B + 1]); w[W0 + 1] = cvtpk(P[B + 2], P[B + 3]); w[W0 + 2] = cvtpk(P[B + 4], P[B + 5]); w[W0 + 3] = cvtpk(P[B + 6], P[B + 7]); } while (0)
#define SUM4(W0) do { if (VAR == 10) break; ps0 = dot2_ones(w[W0], ps0); ps1 = dot2_ones(w[W0 + 1], ps1); ps0 = dot2_ones(w[W0 + 2], ps0); ps1 = dot2_ones(w[W0 + 3], ps1); } while (0)
#define SWAP4(W0, OUT) do { if (VAR == 10) { u32x4 x_ = {w[W0], w[W0 + 1], w[W0 + 2], w[W0 + 3]}; OUT = __builtin_bit_cast(bf16x8, x_); break; } auto r0_ = __builtin_amdgcn_permlane32_swap(w[W0], w[W0 + 2], false, false); auto r1_ = __builtin_amdgcn_permlane32_swap(w[W0 + 1], w[W0 + 3], false, false); \
            u32x4 x_ = {r0_[0], r1_[0], r0_[1], r1_[1]}; OUT = __builtin_bit_cast(bf16x8, x_); } while (0)
            bf16x8 k0, k1;
            if (more) { k0 = *(const LAS bf16x8*)(kb); k1 = *(const LAS bf16x8*)(kb + 512); }
            SBAR();
            if (more) n0 = __builtin_amdgcn_mfma_f32_32x32x16_bf16(k0, qr[0], NEGM, 0, 0, 0);
            PACK4(c0, 0, 0); SBAR();
            if (more) { n1 = __builtin_amdgcn_mfma_f32_32x32x16_bf16(k1, qr[0], NEGM, 0, 0, 0); k0 = *(const LAS bf16x8*)(kb + 2048); k1 = *(const LAS bf16x8*)(kb + 2048 + 512); }
            SUM4(0); SWAP4(0, pa0); SBAR();
            if (more) n0 = __builtin_amdgcn_mfma_f32_32x32x16_bf16(k0, qr[1], n0, 0, 0, 0);
            PACK4(c0, 8, 4); SBAR();
            if (more) { n1 = __builtin_amdgcn_mfma_f32_32x32x16_bf16(k1, qr[1], n1, 0, 0, 0); k0 = *(const LAS bf16x8*)(kb + 4096); k1 = *(const LAS bf16x8*)(kb + 4096 + 512); }
            SUM4(4); SWAP4(4, pa1); SBAR();
            if (more) n0 = __builtin_amdgcn_mfma_f32_32x32x16_bf16(k0, qr[2], n0, 0, 0, 0);
            PACK4(c1, 0, 8); SBAR();
            if (more) { n1 = __builtin_amdgcn_mfma_f32_32x32x16_bf16(k1, qr[2], n1, 0, 0, 0); k0 = *(const LAS bf16x8*)(kb + 6144); k1 = *(const LAS bf16x8*)(kb + 6144 + 512); }
            SUM4(8); SWAP4(8, pa2); SBAR();
            if (more) n0 = __builtin_amdgcn_mfma_f32_32x32x16_bf16(k0, qr[3], n0, 0, 0, 0);
            PACK4(c1, 8, 12); SBAR();
            if (more) n1 = __builtin_amdgcn_mfma_f32_32x32x16_bf16(k1, qr[3], n1, 0, 0, 0);
            SUM4(12); SWAP4(12, pa3); SBAR();
#undef PACK4
#undef SUM4
#undef SWAP4
        }
        {
            VFrag fa, fb;
            if (VAR == 9) { fa.l0 = fa.h0 = fa.l1 = fa.h1 = fa.l2 = fa.h2 = fa.l3 = fa.h3 = (s16x4){(short)pa0[0], (short)pa0[1], (short)pa1[0], (short)pa1[1]}; fb = fa; }
            if (VAR != 9) v_reads<0>(fa, vb);
            asm volatile("s_waitcnt lgkmcnt(0)" ::: "memory"); LANDED(fa); SBAR();
            if (VAR != 9) v_reads<1>(fb, vb); SBAR();
#define GAPB(OD, PA, L, H, I) do { if (VAR != 8) OD = __builtin_amdgcn_mfma_f32_32x32x16_bf16(PA, PKV(L, H), OD, 0, 0, 0); else OD[0] += __builtin_bit_cast(float, (unsigned)PA[0] << 16) + (float)L[0] + (float)H[0]; if (more && VAR != 7) { if ((I) < 16) { EXP2(n0, (I)); EXP2(n0, (I) + 1); } else { EXP2(n1, (I) - 16); EXP2(n1, (I) - 15); } } SBAR(); } while (0)
            GAPB(o[0], pa0, fa.l0, fa.h0, 0); GAPB(o[0], pa1, fa.l1, fa.h1, 2); GAPB(o[0], pa2, fa.l2, fa.h2, 4); GAPB(o[0], pa3, fa.l3, fa.h3, 6);
            asm volatile("s_waitcnt lgkmcnt(0)" ::: "memory"); LANDED(fb); SBAR();
            if (VAR != 9) v_reads<2>(fa, vb); SBAR();
            GAPB(o[1], pa0, fb.l0, fb.h0, 8); GAPB(o[1], pa1, fb.l1, fb.h1, 10); GAPB(o[1], pa2, fb.l2, fb.h2, 12); GAPB(o[1], pa3, fb.l3, fb.h3, 14);
            asm volatile("s_waitcnt lgkmcnt(0)" ::: "memory"); LANDED(fa); SBAR();
            if (VAR != 9) v_reads<3>(fb, vb); SBAR();
            GAPB(o[2], pa0, fa.l0, fa.h0, 16); GAPB(o[2], pa1, fa.l1, fa.h1, 18); GAPB(o[2], pa2, fa.l2, fa.h2, 20); GAPB(o[2], pa3, fa.l3, fa.h3, 22);
            asm volatile("s_waitcnt lgkmcnt(0)" ::: "memory"); LANDED(fb); SBAR();
            GAPB(o[3], pa0, fb.l0, fb.h0, 24); GAPB(o[3], pa1, fb.l1, fb.h1, 26); GAPB(o[3], pa2, fb.l2, fb.h2, 28); GAPB(o[3], pa3, fb.l3, fb.h3, 30);
#undef GAPB
        }
        c0 = n0; c1 = n1;
        slot = sn;
    }
#undef DMA_KV
    asm volatile("s_nop 2" : "+v"(ps0), "+v"(ps1));
    float l = ps0 + ps1;
    { auto rr = __builtin_amdgcn_permlane32_swap(__float_as_uint(l), __float_as_uint(l), false, false); l = __uint_as_float(rr[0]) + __uint_as_float(rr[1]); }
    LAS float* wsf = (LAS float*)(shm + L2_WS) + wid * 64;
    if (hi == 0) wsf[r32] = 1.0f / l;
    asm volatile("s_waitcnt lgkmcnt(0)" ::: "memory");
    bf16_t* Ow = OT + (size_t)c * MTOK * 1024 + (rowbase + q0 + wid * 32) * 1024 + h * 128;
#pragma unroll
    for (int r = 0; r < 16; ++r) { const int orow = crow(r, hi); const float il = wsf[orow];
#pragma unroll
        for (int d = 0; d < 4; ++d) Ow[(size_t)orow * 1024 + d * 32 + r32] = (bf16_t)f2bf(o[d][r] * il); }
    asm volatile("s_waitcnt lgkmcnt(0)\n\ts_barrier" ::: "memory");
}
#undef EXP2
#undef LANDED
#undef PKV

#ifndef F_PRIO
#define F_PRIO 0
#endif
constexpr int F_SLOT = 32768, F_NSLOT = 3, F_K = 0, F_V = 16384, F_WS = F_NSLOT * F_SLOT;
__device__ __forceinline__ void qkt_f(f32x16& p0, f32x16& p1, const LAS char* kb, const bf16x8* qr, const f32x16& negm) {
#pragma unroll
    for (int d0 = 0; d0 < 4; ++d0) {
        const bf16x8 b0 = *(const LAS bf16x8*)(kb + d0 * 2048);
        const bf16x8 b1 = *(const LAS bf16x8*)(kb + d0 * 2048 + 512);
        if (d0 == 0) { p0 = __builtin_amdgcn_mfma_f32_32x32x16_bf16(b0, qr[0], negm, 0, 0, 0); p1 = __builtin_amdgcn_mfma_f32_32x32x16_bf16(b1, qr[0], negm, 0, 0, 0); }
        else { p0 = __builtin_amdgcn_mfma_f32_32x32x16_bf16(b0, qr[d0], p0, 0, 0, 0); p1 = __builtin_amdgcn_mfma_f32_32x32x16_bf16(b1, qr[d0], p1, 0, 0, 0); } }
}
__device__ __forceinline__ void softmax_pack_f(f32x16& p0, f32x16& p1, float& ps0, float& ps1, bf16x8& pa0, bf16x8& pa1, bf16x8& pa2, bf16x8& pa3) {
#pragma unroll
    for (int r = 0; r < 16; ++r) { p0[r] = __builtin_amdgcn_exp2f(p0[r]); p1[r] = __builtin_amdgcn_exp2f(p1[r]); }
    SBAR();
#define PK4(P, BASE, OUT) do { unsigned a0 = cvtpk(P[BASE + 0], P[BASE + 1]), a1 = cvtpk(P[BASE + 2], P[BASE + 3]);   \
    unsigned b0 = cvtpk(P[BASE + 4], P[BASE + 5]), b1 = cvtpk(P[BASE + 6], P[BASE + 7]);                              \
    ps0 = dot2_ones(a0, ps0); ps1 = dot2_ones(a1, ps1); ps0 = dot2_ones(b0, ps0); ps1 = dot2_ones(b1, ps1);            \
    u32x4 w = {a0, a1, b0, b1}; OUT = __builtin_bit_cast(bf16x8, w); } while (0)
    PK4(p0, 0, pa0); PK4(p0, 8, pa1); PK4(p1, 0, pa2); PK4(p1, 8, pa3);
#undef PK4
}
#define LANDED(f) asm volatile("" : "+v"(f.l0), "+v"(f.h0), "+v"(f.l1), "+v"(f.h1), "+v"(f.l2), "+v"(f.h2), "+v"(f.l3), "+v"(f.h3))
template <int OFF> __device__ __forceinline__ void glds16s(const void* sbase, unsigned voff, unsigned lds_dst) { unsigned keep;
    asm volatile("s_mov_b32 %0, m0\n\ts_mov_b32 m0, %3\n\ts_nop 0\n\tglobal_load_lds_dwordx4 %1, %2 offset:%4\n\ts_mov_b32 m0, %0" : "=&s"(keep) : "v"(voff), "s"(sbase), "s"(lds_dst), "i"(OFF) : "memory"); }
__device__ __forceinline__ void attn_unit3(int b, int h, int qb, const bf16_t* Q, const bf16_t* K, const bf16_t* V, bf16_t* MIXo, const unsigned* kmax, float lam, const float* subg, float oscale, LAS char* shm) {
    int tid_ = threadIdx.x; asm volatile("" : "+v"(tid_));
    const int tid = tid_, lane = tid & 63, r32 = lane & 31, hi = lane >> 5; const int wid = __builtin_amdgcn_readfirstlane(tid >> 6);
    const size_t rowbase = (size_t)b * SEQ; const int q0 = qb * 256;
    const bf16_t* Qw = Q + (rowbase + q0 + wid * 32) * 1024 + h * 128;
    const bf16_t* Kh = K + rowbase * 1024 + h * 128; const bf16_t* Vh = V + rowbase * 1024 + h * 128;
    const unsigned lds0 = (unsigned)(uintptr_t)shm;
#define KVOFF() ((unsigned)((tid & 63) * 1024 + wid * 8) * 2u)
#define VVOFF() ((unsigned)(((wid * 8 + ((tid & 31) >> 2)) * 1024) + (((tid >> 5) & 1) * 32 + (tid & 3) * 8)) * 2u)
    const unsigned kdst = lds0 + F_K + wid * 1024, vdst = lds0 + F_V + wid * 2048;
#define DMA_KV(t, slot) do { const char* kt_ = (const char*)Kh + (size_t)(t) * (64 * 1024 * 2); const char* vt_ = (const char*)Vh + (size_t)(t) * (64 * 1024 * 2); int tq_ = tid; asm volatile("" : "+v"(tq_)); const unsigned kvo_ = (unsigned)((tq_ & 63) * 1024 + wid * 8) * 2u, vvo_ = (unsigned)(((wid * 8 + ((tq_ & 31) >> 2)) * 1024) + (((tq_ >> 5) & 1) * 32 + (tq_ & 3) * 8)) * 2u; \
        glds16s<0>(kt_, kvo_, (unsigned)__builtin_amdgcn_readfirstlane(kdst + (slot) * F_SLOT)); glds16s<0>(kt_ + 128, kvo_, (unsigned)__builtin_amdgcn_readfirstlane(kdst + (slot) * F_SLOT + 8192)); \
        glds16s<0>(vt_, vvo_, (unsigned)__builtin_amdgcn_readfirstlane(vdst + (slot) * F_SLOT)); glds16s<0>(vt_ + 128, vvo_, (unsigned)__builtin_amdgcn_readfirstlane(vdst + (slot) * F_SLOT + 1024)); } while (0)
    DMA_KV(0, 0);
    bf16x8 qr[8];
#pragma unroll
    for (int d0 = 0; d0 < 8; ++d0) qr[d0] = *(const bf16x8*)(Qw + (size_t)r32 * 1024 + d0 * 16 + hi * 8);
    float negm;
    {
        float sa = 0.f, sb = 0.f;
#pragma unroll
        for (int d0 = 0; d0 < 8; ++d0) { u32x4 qw = __builtin_bit_cast(u32x4, qr[d0]);
#pragma unroll
            for (int e = 0; e < 4; ++e) { const float x0 = bf_lo(qw[e]), x1 = bf_hi(qw[e]); if (d0 < 4) sa += x0 * x0 + x1 * x1; else sb += x0 * x0 + x1 * x1; qw[e] = cvtpk(x0 * C2, x1 * C2); }
            qr[d0] = __builtin_bit_cast(bf16x8, qw); }
        { auto rr = __builtin_amdgcn_permlane32_swap(__float_as_uint(sa), __float_as_uint(sa), false, false); sa = __uint_as_float(rr[0]) + __uint_as_float(rr[1]); }
        { auto rr = __builtin_amdgcn_permlane32_swap(__float_as_uint(sb), __float_as_uint(sb), false, false); sb = __uint_as_float(rr[0]) + __uint_as_float(rr[1]); }
        const unsigned* km = kmax + (b * 8 + h) * 4;
        negm = fminf(-sqrtf(sa) * sqrtf(__uint_as_float(km[0]) + __uint_as_float(km[1])) * C2, -sqrtf(sb) * sqrtf(__uint_as_float(km[2]) + __uint_as_float(km[3])) * C2);
    }
    f32x16 oA[4], oB[4];
#pragma unroll
    for (int d = 0; d < 4; ++d)
#pragma unroll
        for (int r = 0; r < 16; ++r) { oA[d][r] = 0.f; oB[d][r] = 0.f; }
    float sA0 = 0.f, sA1 = 0.f, sB0 = 0.f, sB1 = 0.f;
    f32x16 NEGM;
#pragma unroll
    for (int r = 0; r < 16; ++r) NEGM[r] = negm;
    asm volatile("" : "+v"(NEGM));
#if F_PRIO
    if (wid >= 4) __builtin_amdgcn_s_setprio(1);
#endif
    const int vb0 = (int)(lds0 + F_V) + v_rd_base(lane);
    constexpr int NT = SEQ / 64;
    f32x16 p;
    bf16x8 k0, k1, k2, k3, a0, a1, a2, a3, b0, b1, b2, b3;
    VFrag f;
#define KLD(off) (*(const LAS bf16x8*)(kb + (off)))
#define MMA32(A, B, C) __builtin_amdgcn_mfma_f32_32x32x16_bf16(A, B, C, 0, 0, 0)
#define KLD4(base) do { k0 = KLD(base); k1 = KLD((base) + 2048); k2 = KLD((base) + 4096); k3 = KLD((base) + 6144); } while (0)
#define QK4(Q0) do { p = MMA32(k0, qr[Q0], NEGM); p = MMA32(k1, qr[Q0 + 1], p); p = MMA32(k2, qr[Q0 + 2], p); p = MMA32(k3, qr[Q0 + 3], p); } while (0)
#define EXPS() do { _Pragma("unroll") for (int r = 0; r < 16; ++r) p[r] = __builtin_amdgcn_exp2f(p[r]); } while (0)
#define PK4(BASE, OUT, S0, S1) do { const unsigned x0 = cvtpk(p[BASE + 0], p[BASE + 1]), x1 = cvtpk(p[BASE + 2], p[BASE + 3]), x2 = cvtpk(p[BASE + 4], p[BASE + 5]), x3 = cvtpk(p[BASE + 6], p[BASE + 7]); \
        S0 = dot2_ones(x0, S0); S1 = dot2_ones(x1, S1); S0 = dot2_ones(x2, S0); S1 = dot2_ones(x3, S1); u32x4 w_ = {x0, x1, x2, x3}; OUT = __builtin_bit_cast(bf16x8, w_); } while (0)
#define PKV(L, H) (bf16x8){L[0], L[1], L[2], L[3], H[0], H[1], H[2], H[3]}
#define RD_LO(D0, vb) do { f.l0 = tr_read<v_rd_off(D0, 0, 0)>(vb); f.h0 = tr_read<v_rd_off(D0, 0, 1)>(vb); f.l1 = tr_read<v_rd_off(D0, 1, 0)>(vb); f.h1 = tr_read<v_rd_off(D0, 1, 1)>(vb); } while (0)
#define RD_HI(D0, vb) do { f.l2 = tr_read<v_rd_off(D0, 2, 0)>(vb); f.h2 = tr_read<v_rd_off(D0, 2, 1)>(vb); f.l3 = tr_read<v_rd_off(D0, 3, 0)>(vb); f.h3 = tr_read<v_rd_off(D0, 3, 1)>(vb); } while (0)
#define LAND_LO() asm volatile("" : "+v"(f.l0), "+v"(f.h0), "+v"(f.l1), "+v"(f.h1))
#define LAND_HI() asm volatile("" : "+v"(f.l2), "+v"(f.h2), "+v"(f.l3), "+v"(f.h3))
#define MS_TILE(VPRE) do { \
        SBAR(); KLD4(0); SBAR(); \
        QK4(0); SBAR(); KLD4(512); SBAR(); EXPS(); SBAR(); PK4(0, a0, sA0, sA1); PK4(8, a1, sA0, sA1); SBAR(); \
        QK4(0); SBAR(); KLD4(8192); SBAR(); EXPS(); SBAR(); PK4(0, a2, sA0, sA1); PK4(8, a3, sA0, sA1); SBAR(); \
        QK4(4); SBAR(); KLD4(8192 + 512); SBAR(); EXPS(); SBAR(); PK4(0, b0, sB0, sB1); PK4(8, b1, sB0, sB1); SBAR(); \
        QK4(4); SBAR(); VPRE; SBAR(); EXPS(); SBAR(); PK4(0, b2, sB0, sB1); PK4(8, b3, sB0, sB1); SBAR(); } while (0)
#define PVBLK(D0, LAST, vb) do { \
        asm volatile("s_waitcnt lgkmcnt(4)" ::: "memory"); LAND_LO(); SBAR(); \
        oA[D0] = MMA32(a0, PKV(f.l0, f.h0), oA[D0]); oB[D0] = MMA32(b0, PKV(f.l0, f.h0), oB[D0]); oA[D0] = MMA32(a1, PKV(f.l1, f.h1), oA[D0]); oB[D0] = MMA32(b1, PKV(f.l1, f.h1), oB[D0]); SBAR(); \
        if (!(LAST)) { RD_LO((D0 + 1) & 3, vb); asm volatile("s_waitcnt lgkmcnt(4)" ::: "memory"); } else { asm volatile("s_waitcnt lgkmcnt(0)" ::: "memory"); } LAND_HI(); SBAR(); \
        oA[D0] = MMA32(a2, PKV(f.l2, f.h2), oA[D0]); oB[D0] = MMA32(b2, PKV(f.l2, f.h2), oB[D0]); oA[D0] = MMA32(a3, PKV(f.l3, f.h3), oA[D0]); oB[D0] = MMA32(b3, PKV(f.l3, f.h3), oB[D0]); SBAR(); \
        if (!(LAST)) { RD_HI((D0 + 1) & 3, vb); } } while (0)
#define PV_TILE(vb) do { PVBLK(0, false, vb); PVBLK(1, false, vb); PVBLK(2, false, vb); PVBLK(3, true, vb); } while (0)
#define NEXT_BAR(t) do { WAIT_BAR(0); if ((t) + 2 < NT) { const int s2 = (slot + 2 >= F_NSLOT) ? slot + 2 - F_NSLOT : slot + 2; DMA_KV((t) + 2, s2); } } while (0)
    WAIT_BAR(0);
    DMA_KV(1, 1);
    int slot = 0;
#pragma unroll 1
    for (int t = 0; t < NT; ++t) {
        const LAS char* kb = shm + slot * F_SLOT + F_K + hi * 1024 + r32 * 16; const int vb = vb0 + slot * F_SLOT;
        MS_TILE(do { RD_LO(0, vb); RD_HI(0, vb); } while (0));
        if (wid >= 4) NEXT_BAR(t);
        SBAR();
        PV_TILE(vb);
        if (wid < 4) NEXT_BAR(t);
        slot = (slot + 1 == F_NSLOT) ? 0 : slot + 1;
    }
#undef NEXT_BAR
#undef PV_TILE
#undef PVBLK
#undef MS_TILE
#undef EXPS
#undef PK4
#undef KLD4
#undef QK4
#undef RD_LO
#undef RD_HI
#undef LAND_LO
#undef LAND_HI
#undef PKV
#undef KLD
#undef MMA32
#undef DMA_KV
#if F_PRIO
    __builtin_amdgcn_s_setprio(0);
#endif
    asm volatile("s_nop 2" : "+v"(sA0), "+v"(sA1), "+v"(sB0), "+v"(sB1));
    float lA = sA0 + sA1, lB = sB0 + sB1;
    { auto rr = __builtin_amdgcn_permlane32_swap(__float_as_uint(lA), __float_as_uint(lA), false, false); lA = __uint_as_float(rr[0]) + __uint_as_float(rr[1]); }
    { auto rr = __builtin_amdgcn_permlane32_swap(__float_as_uint(lB), __float_as_uint(lB), false, false); lB = __uint_as_float(rr[0]) + __uint_as_float(rr[1]); }
    LAS float* wsf = (LAS float*)(shm + F_WS) + wid * 128;
    if (hi == 0) { wsf[r32] = __builtin_amdgcn_rcpf(lA); wsf[32 + r32] = lam * __builtin_amdgcn_rcpf(lB); }
    asm volatile("s_waitcnt lgkmcnt(0)" ::: "memory");
    float gsub[4];
#pragma unroll
    for (int d = 0; d < 4; ++d) gsub[d] = subg[d * 32 + r32] * oscale;
    const bool j1 = (r32 & 1) != 0, j2 = (r32 & 2) != 0;
    bf16_t* Ow = MIXo + (rowbase + q0 + wid * 32) * 2048 + 1024 + h * 128 + (r32 & 3) * 32 + (r32 & ~3);
#define QSWAP1(x) __builtin_bit_cast(float, __builtin_amdgcn_mov_dpp(__builtin_bit_cast(int, (x)), 0xB1, 0xF, 0xF, true))
#define QSWAP2(x) __builtin_bit_cast(float, __builtin_amdgcn_mov_dpp(__builtin_bit_cast(int, (x)), 0x4E, 0xF, 0xF, true))
#pragma unroll
    for (int r = 0; r < 16; ++r) { const int orow = crow(r, hi); const float ia = wsf[orow], ib = wsf[32 + orow]; float o[4], s = 0.f;
#pragma unroll
        for (int d = 0; d < 4; ++d) { o[d] = oA[d][r] * ia - oB[d][r] * ib; s += o[d] * o[d]; }
#define DPPF(x, ctl) __builtin_bit_cast(float, __builtin_amdgcn_update_dpp(0, __builtin_bit_cast(int, (x)), (ctl), 0xf, 0xf, false))
        s += DPPF(s, 0xB1); s += DPPF(s, 0x4E); s += DPPF(s, 0x141); s += DPPF(s, 0x140);
        { float a_ = s, b_ = s; asm volatile("s_nop 1\n\tv_permlane16_swap_b32 %0, %1\n\ts_nop 1" : "+v"(a_), "+v"(b_)); s = a_ + b_; }
#undef DPPF
        const float rs = __builtin_amdgcn_rsqf(s * (1.f / 128.f) + NORM_EPS);
#pragma unroll
        for (int d = 0; d < 4; ++d) o[d] = o[d] * rs * gsub[d];
        { float t = QSWAP1(j1 ? o[0] : o[1]); const float n0 = j1 ? t : o[0], n1 = j1 ? o[1] : t; o[0] = n0; o[1] = n1; }
        { float t = QSWAP1(j1 ? o[2] : o[3]); const float n2 = j1 ? t : o[2], n3 = j1 ? o[3] : t; o[2] = n2; o[3] = n3; }
        { float t = QSWAP2(j2 ? o[0] : o[2]); const float n0 = j2 ? t : o[0], n2 = j2 ? o[2] : t; o[0] = n0; o[2] = n2; }
        { float t = QSWAP2(j2 ? o[1] : o[3]); const float n1 = j2 ? t : o[1], n3 = j2 ? o[3] : t; o[1] = n1; o[3] = n3; }
        u32x2 w; w.x = cvtpk(o[0], o[1]); w.y = cvtpk(o[2], o[3]);
        *(u32x2*)(Ow + (size_t)orow * 2048) = w; }
#undef QSWAP1
#undef QSWAP2
    asm volatile("s_waitcnt lgkmcnt(0)\n\ts_barrier" ::: "memory");
}
#undef LANDED
#undef SBAR
#undef KSWZ
#undef WAIT_BAR
}

__device__ __forceinline__ void combine_chunk(const bf16_t* OT, bf16_t* MIXp, float lam, const float* subg, float oscale, int chunk, int tid) {
    const int d0 = (tid & 15) * 8;
    float gs[8];
#pragma unroll
    for (int i = 0; i < 8; ++i) gs[i] = subg[d0 + i] * oscale;
    for (int it = tid >> 4; it < 128 * 8; it += NTHREADS / 16) { const int row = chunk * 128 + (it >> 3), h = it & 7;
        const u32x4 a = *(const u32x4*)(OT + (size_t)row * 1024 + h * 128 + d0), bq = *(const u32x4*)(OT + (size_t)MTOK * 1024 + (size_t)row * 1024 + h * 128 + d0);
        float o[8], ss = 0.f;
#pragma unroll
        for (int i = 0; i < 4; ++i) { o[2 * i] = bf_lo(a[i]) - lam * bf_lo(bq[i]); o[2 * i + 1] = bf_hi(a[i]) - lam * bf_hi(bq[i]); ss += o[2 * i] * o[2 * i] + o[2 * i + 1] * o[2 * i + 1]; }
        ss += __shfl_xor(ss, 1); ss += __shfl_xor(ss, 2); ss += __shfl_xor(ss, 4); ss += __shfl_xor(ss, 8);
        const float rstd = 1.0f / sqrtf(ss * (1.f / 128.f) + NORM_EPS);
        u32x4 w; w.x = pk2(o[0] * rstd * gs[0], o[1] * rstd * gs[1]); w.y = pk2(o[2] * rstd * gs[2], o[3] * rstd * gs[3]); w.z = pk2(o[4] * rstd * gs[4], o[5] * rstd * gs[5]); w.w = pk2(o[6] * rstd * gs[6], o[7] * rstd * gs[7]);
        *(u32x4*)(MIXp + (size_t)row * 2048 + 1024 + h * 128 + d0) = w; }
}


__device__ __forceinline__ int skey(float s, int payload, int mask) { int b = __builtin_bit_cast(int, s); b ^= (b >> 31) & 0x7fffffff; return (b & ~mask) | payload; }
__device__ __forceinline__ float skey_score(int k, int mask) { int b = k & ~mask; b ^= (b >> 31) & 0x7fffffff; return __builtin_bit_cast(float, b); }
#define CEX_DESC(a, b) do { const int hi_ = max((a), (b)), lo_ = min((a), (b)); (a) = hi_; (b) = lo_; } while (0)
__device__ __forceinline__ void sort16_desc(int (&k)[16]) {
#pragma unroll
    for (int sz = 2; sz <= 16; sz <<= 1)
#pragma unroll
        for (int j = sz >> 1; j > 0; j >>= 1)
#pragma unroll
            for (int i = 0; i < 16; ++i) { const int l = i ^ j;
                if (l > i) { if ((i & sz) == 0) { CEX_DESC(k[i], k[l]); } else { CEX_DESC(k[l], k[i]); } } }
}
__device__ __forceinline__ void bmerge16_desc(int (&k)[16]) {
#pragma unroll
    for (int j = 8; j > 0; j >>= 1)
#pragma unroll
        for (int i = 0; i < 16; ++i) { const int l = i ^ j; if (l > i) CEX_DESC(k[i], k[l]); }
}
__device__ __forceinline__ void top16_merge(int (&a)[16], const int (&b)[16]) {
#pragma unroll
    for (int i = 0; i < 16; ++i) a[i] = max(a[i], b[15 - i]);
    bmerge16_desc(a);
}
__device__ __forceinline__ void top16_xlane(int (&a)[16]) {
    int e[16], o[16];
#pragma unroll
    for (int i = 0; i < 16; ++i) { auto r = __builtin_amdgcn_permlane16_swap((unsigned)a[i], (unsigned)a[i], false, false); e[i] = (int)r[0]; o[i] = (int)r[1]; }
#pragma unroll
    for (int i = 0; i < 16; ++i) a[i] = max(e[i], o[15 - i]);
    bmerge16_desc(a);
#pragma unroll
    for (int i = 0; i < 16; ++i) { auto r = __builtin_amdgcn_permlane32_swap((unsigned)a[i], (unsigned)a[i], false, false); e[i] = (int)r[0]; o[i] = (int)r[1]; }
#pragma unroll
    for (int i = 0; i < 16; ++i) a[i] = max(e[i], o[15 - i]);
    bmerge16_desc(a);
}

struct QFrag { bf16x8 q[4]; };
__device__ __forceinline__ void router_load_q(QFrag& f, const bf16_t* QP, int tok0, int hc, int fr, int fq) {
    const bf16_t* qp = QP + (size_t)(tok0 + fr) * 2048 + hc * 128 + fq * 8;
#pragma unroll
    for (int ks = 0; ks < 4; ++ks) f.q[ks] = *(const bf16x8*)(qp + ks * 32);
}
__device__ __forceinline__ void router_stage_load(u32x4 (&st)[4], const bf16_t* KEYS, int hc, int tid) {
    const u32x4* src = (const u32x4*)(KEYS + (size_t)hc * 128 * 128);
#pragma unroll
    for (int i = 0; i < 4; ++i) st[i] = src[tid + 512 * i];
}
__device__ __forceinline__ void router_stage_store(const u32x4 (&st)[4], LAS unsigned char* buf, int tid) {
#pragma unroll
    for (int i = 0; i < 4; ++i) { const int p = tid + 512 * i, row = p >> 4, ch = p & 15; *(LAS u32x4*)(buf + row * 256 + ((ch ^ (row & 15)) << 4)) = st[i]; }
}
__device__ __forceinline__ void router_top16(int (&ka)[16], const QFrag& qf, const LAS unsigned char* kbuf, int fr, int fq) {
    f32x4 acc[8];
#pragma unroll
    for (int nt = 0; nt < 8; ++nt) acc[nt] = (f32x4){0.f, 0.f, 0.f, 0.f};
    const LAS unsigned char* kp = kbuf + fr * 256;
    bf16x8 A[8], B[8];
#define LOADK(D, ks) do { _Pragma("unroll") for (int nt = 0; nt < 8; ++nt) D[nt] = *(const LAS bf16x8*)(kp + nt * 4096 + (((fq + 4 * (ks)) ^ fr) << 4)); } while (0)
#define MMAK(D, ks) do { _Pragma("unroll") for (int nt = 0; nt < 8; ++nt) acc[nt] = __builtin_amdgcn_mfma_f32_16x16x32_bf16(D[nt], qf.q[ks], acc[nt], 0, 0, 0); } while (0)
    LOADK(A, 0); __builtin_amdgcn_sched_barrier(0);
    LOADK(B, 1); __builtin_amdgcn_sched_barrier(0); MMAK(A, 0); __builtin_amdgcn_sched_barrier(0);
    LOADK(A, 2); __builtin_amdgcn_sched_barrier(0); MMAK(B, 1); __builtin_amdgcn_sched_barrier(0);
    LOADK(B, 3); __builtin_amdgcn_sched_barrier(0); MMAK(A, 2); __builtin_amdgcn_sched_barrier(0);
    MMAK(B, 3); __builtin_amdgcn_sched_barrier(0);
#undef LOADK
#undef MMAK
    int kb[16];
    int fq4 = 4 * fq; asm volatile("" : "+v"(fq4));
#pragma unroll
    for (int nt = 0; nt < 4; ++nt)
#pragma unroll
        for (int i = 0; i < 4; ++i) { ka[nt * 4 + i] = skey(acc[nt][i], 16 * nt + fq4 + i, 127); kb[nt * 4 + i] = skey(acc[nt + 4][i], 16 * (nt + 4) + fq4 + i, 127); }
    sort16_desc(ka); sort16_desc(kb); top16_merge(ka, kb);
    top16_xlane(ka);
    __builtin_amdgcn_sched_barrier(0);
}
__device__ __forceinline__ void router_task4(const bf16_t* QP, const bf16_t* KEYS, unsigned* ROUTE, int tok0, bool active, int hq, LAS int* scr, LAS unsigned char* kbuf, int tid) {
    const int lane = tid & 63, fr = lane & 15, fq = lane >> 4;
    int m0[16], m1[16];
#pragma unroll
    for (int i = 0; i < 16; ++i) { m0[i] = 0; m1[i] = 0; }
    QFrag qa, qb; u32x4 st[4];
    router_stage_load(st, KEYS, 8 * hq, tid);
    if (active) router_load_q(qa, QP, tok0, 8 * hq, fr, fq);
    router_stage_store(st, kbuf, tid);
    __syncthreads();
#pragma unroll 1
    for (int j = 0; j < 4; ++j) { const int h = 4 * hq + j;
        router_stage_load(st, KEYS, h * 2 + 1, tid);
        if (active) router_load_q(qb, QP, tok0, h * 2 + 1, fr, fq);
        __builtin_amdgcn_sched_barrier(0);
        int frl = fr; asm volatile("" : "+v"(frl));
        if (active) { int ka[16]; router_top16(ka, qa, kbuf, frl, fq);
#pragma unroll
          for (int i = 0; i < 16; ++i) m0[i] = (fq == j) ? ka[i] : m0[i]; }
        __builtin_amdgcn_sched_barrier(0);
        router_stage_store(st, kbuf + 32768, tid);
        __syncthreads();
        if (j < 3) router_stage_load(st, KEYS, h * 2 + 2, tid);
        if (active && j < 3) router_load_q(qa, QP, tok0, h * 2 + 2, fr, fq);
        __builtin_amdgcn_sched_barrier(0);
        asm volatile("" : "+v"(frl));
        if (active) { int ka[16]; router_top16(ka, qb, kbuf + 32768, frl, fq);
#pragma unroll
          for (int i = 0; i < 16; ++i) m1[i] = (fq == j) ? ka[i] : m1[i]; }
        __builtin_amdgcn_sched_barrier(0);
        if (j < 3) router_stage_store(st, kbuf, tid);
        __syncthreads();
    }
    if (!active) return;
    int ln2_ = lane; asm volatile("" : "+v"(ln2_)); LAS int* scrl = scr + ln2_ * 32;
#pragma unroll
    for (int i = 0; i < 16; ++i) { scrl[i] = m0[i] & 127; scrl[16 + i] = m1[i] & 127; }
    float s0[16], s1[16];
#pragma unroll
    for (int i = 0; i < 16; ++i) { s0[i] = skey_score(m0[i], 127); s1[i] = skey_score(m1[i], 127); }
    constexpr int NEG = (int)0x80000000;
    int best[16], ch[16];
#define CAND(a, b) skey(s0[a] + s1[b], (a) * 16 + (b), 255)
#pragma unroll
    for (int b = 0; b < 16; ++b) best[b] = CAND(0, b);
    sort16_desc(best);
    ch[0] = CAND(1, 0); ch[1] = CAND(1, 1); ch[2] = CAND(1, 2); ch[3] = CAND(1, 3); ch[4] = CAND(1, 4); ch[5] = CAND(1, 5); ch[6] = CAND(1, 6); ch[7] = CAND(1, 7);
    ch[8] = CAND(2, 0); ch[9] = CAND(2, 1); ch[10] = CAND(2, 2); ch[11] = CAND(2, 3); ch[12] = CAND(2, 4); ch[13] = CAND(3, 0); ch[14] = CAND(3, 1); ch[15] = CAND(3, 2);
    sort16_desc(ch); top16_merge(best, ch);
    ch[0] = CAND(3, 3); ch[1] = CAND(4, 0); ch[2] = CAND(4, 1); ch[3] = CAND(4, 2); ch[4] = CAND(5, 0); ch[5] = CAND(5, 1); ch[6] = CAND(6, 0); ch[7] = CAND(6, 1);
    ch[8] = CAND(7, 0); ch[9] = CAND(7, 1); ch[10] = CAND(8, 0); ch[11] = CAND(9, 0); ch[12] = CAND(10, 0); ch[13] = CAND(11, 0); ch[14] = CAND(12, 0); ch[15] = CAND(13, 0);
    sort16_desc(ch); top16_merge(best, ch);
    ch[0] = CAND(14, 0); ch[1] = CAND(15, 0);
#pragma unroll
    for (int i = 2; i < 16; ++i) ch[i] = NEG;
    sort16_desc(ch); top16_merge(best, ch);
#undef CAND
    float g[16], gs = 0.f; const float smax = skey_score(best[0], 255);
#pragma unroll
    for (int i = 0; i < 16; ++i) { g[i] = __expf(skey_score(best[i], 255) - smax); gs += g[i]; }
    const float inv = 1.0f / gs;
    LDS_WAIT(); asm volatile("" ::: "memory");
    unsigned e[16];
#pragma unroll
    for (int i = 0; i < 16; ++i) { const int ci = best[i] & 255, a = ci >> 4, b = ci & 15; const int ia = scrl[a], ib = scrl[16 + b];
        e[i] = (f2bf(g[i] * inv) << 16) | (unsigned)(ia * 128 + ib); }
    unsigned* rp = ROUTE + (size_t)(tok0 + fr) * 128 + (4 * hq + fq) * 16;
#pragma unroll
    for (int i = 0; i < 4; ++i) *(u32x4*)(rp + 4 * i) = (u32x4){e[4 * i], e[4 * i + 1], e[4 * i + 2], e[4 * i + 3]};
    LDS_WAIT(); asm volatile("" ::: "memory");
}

typedef float f32x2v __attribute__((ext_vector_type(2)));
__device__ __forceinline__ float gelu_exact(float a) { return 0.5f * a * (1.0f + erff(a * 0.70710678118654752f)); }

constexpr int NSLICE = 16, SLW = 128, TBLK = 256, NTB = MTOK / TBLK;
constexpr int CW_XQ = 20480;
__device__ __forceinline__ float dpp_sum8(float v) {
    v += __builtin_bit_cast(float, __builtin_amdgcn_update_dpp(0, __builtin_bit_cast(int, v), 0xB1, 0xf, 0xf, false));
    v += __builtin_bit_cast(float, __builtin_amdgcn_update_dpp(0, __builtin_bit_cast(int, v), 0x4E, 0xf, 0xf, false));
    v += __builtin_bit_cast(float, __builtin_amdgcn_update_dpp(0, __builtin_bit_cast(int, v), 0x141, 0xf, 0xf, false));
    return v;
}
__device__ __forceinline__ float sum_groups(float v) {
    v += __builtin_bit_cast(float, __builtin_amdgcn_update_dpp(0, __builtin_bit_cast(int, v), 0x128, 0xf, 0xf, false));
    { float a = v, b = v; asm volatile("s_nop 1\n\tv_permlane16_swap_b32 %0, %1\n\ts_nop 1" : "+v"(a), "+v"(b)); v = a + b; }
    { float a = v, b = v; asm volatile("s_nop 1\n\tv_permlane32_swap_b32 %0, %1\n\ts_nop 1" : "+v"(a), "+v"(b)); v = a + b; }
    return v;
}
struct Rows8 { u32x4 r[8]; };
struct Ent8 { u32x4 e[2]; };
__device__ __forceinline__ void rows_issue(Rows8& R, const Ent8& en, const unsigned char* tb) {
#pragma unroll
    for (int j = 0; j < 8; ++j) R.r[j] = *(const u32x4*)(tb + (size_t)(en.e[j >> 2][j & 3] & 0x3fffu) * SLW);
}
__device__ __forceinline__ void ent_load(Ent8& en, const u32x4* rp, int batch) { en.e[0] = rp[(batch & 15) * 2]; en.e[1] = rp[(batch & 15) * 2 + 1]; }
__device__ __forceinline__ int dot4_i8(unsigned a, unsigned b, int acc) { asm("v_dot4c_i32_i8 %0, %1, %2" : "+v"(acc) : "v"(a), "v"(b)); return acc; }
__device__ __forceinline__ void u_batch(const Rows8& R, const u32x4& hq, bf16_t* pp, int b, int c) {
    float mine = 0.f;
#pragma unroll
    for (int j = 0; j < 8; ++j) { int acc = 0;
#pragma unroll
        for (int q = 0; q < 4; ++q) acc = dot4_i8(R.r[j][q], hq[q], acc);
        asm volatile("s_nop 2" : "+v"(acc));
        const float p = dpp_sum8((float)acc);
        mine = (c == j) ? p : mine; }
    pp[8 * b] = (bf16_t)f2bf(mine);
}
__device__ __forceinline__ void ent_load2(Ent8& en, const u32x4* rp0, int bb) { const u32x4* rp = rp0 + ((bb >> 4) & 1) * (8 * 128 / 4); const int b = bb & 15; en.e[0] = rp[b * 2]; en.e[1] = rp[b * 2 + 1]; }
__device__ __forceinline__ void expert_u_block16(const unsigned char* H2I, const unsigned char* Us, const unsigned* ROUTE, bf16_t* PARTs, int t0, int s, int lane) {
    const int g = lane >> 3, c = lane & 7, t = t0 + g;
    const u32x4 hq0 = *(const u32x4*)(H2I + (size_t)t * DM + s * SLW + 16 * c), hq1 = *(const u32x4*)(H2I + (size_t)(t + 8) * DM + s * SLW + 16 * c);
    const u32x4* rp = (const u32x4*)(ROUTE + (size_t)t * 128);
    const unsigned char* ub = Us + 16 * c;
    bf16_t* pp = PARTs + (size_t)t * 128 + c;
    Ent8 E0, E1, E2; Rows8 A, B;
    ent_load2(E0, rp, 0); ent_load2(E1, rp, 1); ent_load2(E2, rp, 2);
    rows_issue(A, E0, ub);
    __builtin_amdgcn_sched_barrier(0);
#pragma unroll 1
    for (int bb = 0; bb < 32; bb += 2) {
        const bool second = bb >= 16; const u32x4 hq = second ? hq1 : hq0; bf16_t* ppb = pp + (second ? 8 * 128 : 0); const int b = bb & 15;
        rows_issue(B, E1, ub); ent_load2(E0, rp, bb + 3);
        __builtin_amdgcn_sched_barrier(0);
        u_batch(A, hq, ppb, b, c);
        __builtin_amdgcn_sched_barrier(0);
        rows_issue(A, E2, ub); ent_load2(E1, rp, bb + 4);
        __builtin_amdgcn_sched_barrier(0);
        u_batch(B, hq, ppb, b + 1, c);
        __builtin_amdgcn_sched_barrier(0);
        { const Ent8 t3 = E0; E2 = E1; E1 = t3; }
    }
}
__device__ __forceinline__ unsigned permb(unsigned hi, unsigned lo, unsigned sel) { return __builtin_amdgcn_perm(hi, lo, sel); }
__device__ __forceinline__ void v_batch(const Rows8& R, const Ent8& en, int (&acc)[16]) {
#pragma unroll
    for (int h = 0; h < 2; ++h) {
        const unsigned e0 = en.e[h][0], e1 = en.e[h][1], e2 = en.e[h][2], e3 = en.e[h][3];
        const unsigned W = permb(permb(e3, e2, 0x07030000u), permb(e1, e0, 0x07030000u), 0x07060302u);
#pragma unroll
        for (int q = 0; q < 4; ++q) { const unsigned r0 = R.r[4 * h][q], r1 = R.r[4 * h + 1][q], r2 = R.r[4 * h + 2][q], r3 = R.r[4 * h + 3][q];
            const unsigned a = permb(r1, r0, 0x05010400u), c = permb(r1, r0, 0x07030602u), b = permb(r3, r2, 0x05010400u), d = permb(r3, r2, 0x07030602u);
            const unsigned t0 = permb(b, a, 0x05040100u), t1 = permb(b, a, 0x07060302u), t2 = permb(d, c, 0x05040100u), t3 = permb(d, c, 0x07060302u);
            acc[4 * q] = dot4_i8(t0, W, acc[4 * q]); acc[4 * q + 1] = dot4_i8(t1, W, acc[4 * q + 1]); acc[4 * q + 2] = dot4_i8(t2, W, acc[4 * q + 2]); acc[4 * q + 3] = dot4_i8(t3, W, acc[4 * q + 3]); } }
}
__device__ __forceinline__ void v_flush(const int (&acc)[16], const u32x4& xa, const u32x4& xb, const f32x4 (&gv)[4], bf16_t* xout, size_t off, float ws) {
    float y[16];
#pragma unroll
    for (int k = 0; k < 16; ++k) { const unsigned w = (k < 8) ? xa[k >> 1] : xb[(k - 8) >> 1]; const float x = (k & 1) ? bf_hi(w) : bf_lo(w); y[k] = x + gv[k >> 2][k & 3] * ((float)acc[k] * ws); }
    u32x4 oa, ob;
#pragma unroll
    for (int q = 0; q < 4; ++q) { oa[q] = pk2(y[2 * q], y[2 * q + 1]); ob[q] = pk2(y[8 + 2 * q], y[8 + 2 * q + 1]); }
    *(u32x4*)(xout + off) = oa; *(u32x4*)(xout + off + 8) = ob;
}
__device__ __forceinline__ void expert_v_block16(const bf16_t* xin, bf16_t* xout, const float* gate, const unsigned char* Vs, const unsigned* WR, const float* WSC, int t0, int s, int lane) {
    const int g = lane >> 3, c = lane & 7, t = t0 + g, b_ = t >> 12;
    const size_t off = (size_t)t * DM + s * SLW + 16 * c; const float* gp = gate + (size_t)b_ * MODW + s * SLW + 16 * c;
    const u32x4* rp = (const u32x4*)(WR + (size_t)t * 128);
    const unsigned char* vb = Vs + 16 * c;
    const float ws0 = WSC[t], ws1 = WSC[t + 8];
    int acc[16];
#pragma unroll
    for (int k = 0; k < 16; ++k) acc[k] = 0;
    Ent8 EA, E1, E2, E3; Rows8 A, B;
    ent_load2(EA, rp, 0); ent_load2(E1, rp, 1); ent_load2(E2, rp, 2);
    rows_issue(A, EA, vb);
    const u32x4 xa0 = *(const u32x4*)(xin + off), xb0 = *(const u32x4*)(xin + off + 8), xa1 = *(const u32x4*)(xin + off + (size_t)8 * DM), xb1 = *(const u32x4*)(xin + off + (size_t)8 * DM + 8);
    f32x4 gv[4];
#pragma unroll
    for (int q = 0; q < 4; ++q) gv[q] = *(const f32x4*)(gp + 4 * q);
    __builtin_amdgcn_sched_barrier(0);
#pragma unroll 1
    for (int bb = 0; bb < 32; bb += 2) {
        if (bb == 16) {
            asm volatile("s_nop 2" : "+v"(acc[0]), "+v"(acc[1]), "+v"(acc[2]), "+v"(acc[3]), "+v"(acc[4]), "+v"(acc[5]), "+v"(acc[6]), "+v"(acc[7]), "+v"(acc[8]), "+v"(acc[9]), "+v"(acc[10]), "+v"(acc[11]), "+v"(acc[12]), "+v"(acc[13]), "+v"(acc[14]), "+v"(acc[15]));
            v_flush(acc, xa0, xb0, gv, xout, off, ws0);
#pragma unroll
            for (int k = 0; k < 16; ++k) acc[k] = 0;
            __builtin_amdgcn_sched_barrier(0); }
        rows_issue(B, E1, vb); ent_load2(E3, rp, bb + 3);
        __builtin_amdgcn_sched_barrier(0);
        v_batch(A, EA, acc);
        __builtin_amdgcn_sched_barrier(0);
        rows_issue(A, E2, vb); ent_load2(EA, rp, bb + 4);
        __builtin_amdgcn_sched_barrier(0);
        v_batch(B, E1, acc);
        __builtin_amdgcn_sched_barrier(0);
        { const Ent8 t4 = EA; EA = E2; E1 = E3; E2 = t4; }
    }
    asm volatile("s_nop 2" : "+v"(acc[0]), "+v"(acc[1]), "+v"(acc[2]), "+v"(acc[3]), "+v"(acc[4]), "+v"(acc[5]), "+v"(acc[6]), "+v"(acc[7]), "+v"(acc[8]), "+v"(acc[9]), "+v"(acc[10]), "+v"(acc[11]), "+v"(acc[12]), "+v"(acc[13]), "+v"(acc[14]), "+v"(acc[15]));
    v_flush(acc, xa1, xb1, gv, xout, off + (size_t)8 * DM, ws1);
}
__device__ __forceinline__ void expert_f_phase(Ctx& C, const bf16_t* PART, const unsigned* ROUTE, const float* US, const float* VS, const float* HSC, unsigned* WR, float* WSC) {
    const unsigned* PW = (const unsigned*)PART;
    for (int g = C.gw; g < MTOK / 4; g += C.NGW) {
        unsigned pw[4][NSLICE]; u32x2 rt[4]; float hs[4];
#pragma unroll
        for (int j = 0; j < 4; ++j) { const int t = 4 * g + j;
#pragma unroll
            for (int s = 0; s < NSLICE; ++s) pw[j][s] = PW[((size_t)s * MTOK + t) * 64 + C.lane];
            rt[j] = *(const u32x2*)(ROUTE + (size_t)t * 128 + 2 * C.lane); hs[j] = HSC[t]; }
        __builtin_amdgcn_sched_barrier(0);
        float us[4][2], vs[4][2];
#pragma unroll
        for (int j = 0; j < 4; ++j) { us[j][0] = US[rt[j].x & 0x3fffu]; us[j][1] = US[rt[j].y & 0x3fffu]; vs[j][0] = VS[rt[j].x & 0x3fffu]; vs[j][1] = VS[rt[j].y & 0x3fffu]; }
        __builtin_amdgcn_sched_barrier(0);
#pragma unroll
        for (int j = 0; j < 4; ++j) { const int t = 4 * g + j; float a0 = 0.f, a1 = 0.f;
#pragma unroll
            for (int s = 0; s < NSLICE; ++s) { a0 += __builtin_bit_cast(float, pw[j][s] << 16); a1 += __builtin_bit_cast(float, pw[j][s] & 0xffff0000u); }
            const float w0 = gelu_exact(a0 * us[j][0] * hs[j]) * __builtin_bit_cast(float, rt[j].x & 0xffff0000u) * vs[j][0];
            const float w1 = gelu_exact(a1 * us[j][1] * hs[j]) * __builtin_bit_cast(float, rt[j].y & 0xffff0000u) * vs[j][1];
            float m = fmaxf(fabsf(w0), fabsf(w1));
#pragma unroll
            for (int o = 1; o < 64; o <<= 1) m = fmaxf(m, __shfl_xor(m, o));
            const float qs = m > 0.f ? 127.0f / m : 0.f;
            u32x2 o2; o2.x = ((unsigned)(__float2int_rn(w0 * qs) & 0xff) << 24) | (rt[j].x & 0x3fffu); o2.y = ((unsigned)(__float2int_rn(w1 * qs) & 0xff) << 24) | (rt[j].y & 0x3fffu);
            *(u32x2*)(WR + (size_t)t * 128 + 2 * C.lane) = o2;
            if (C.lane == 0) WSC[t] = m * (1.0f / 127.0f); }
    }
}

constexpr int NPHASE = 47;
#ifndef MK_SPLIT
#define MK_SPLIT 0
#endif
struct Args { const float* in[20]; float* out; unsigned char* ws; int ph_lo, ph_hi; };
static_assert(sizeof(Args) == 20 * 8 + 8 + 8 + 8, "Args has no padding");

__device__ __forceinline__ bool in_range(int lo, int hi, int k) { asm volatile("" : "+s"(lo), "+s"(hi)); return lo <= k && k < hi; }
__device__ __forceinline__ int opaque_idx(int k) { asm volatile("" : "+s"(k)); return k; }
#define ARG(k) (args.in[opaque_idx(k)])
__global__ void __launch_bounds__(NTHREADS, 2) fwd_kernel(Args args) {
    extern __shared__ __attribute__((aligned(16))) unsigned char lds_raw[];
    Ctx C;
    C.lds = (LAS unsigned char*)lds_raw; C.ws = args.ws;
    C.tid = threadIdx.x; C.lane = C.tid & 63; C.wave = __builtin_amdgcn_readfirstlane(C.tid >> 6);
    C.G = gridDim.x; { const int bx = blockIdx.x; C.vcu = (C.G % 8 == 0) ? (bx % 8) * (C.G / 8) + bx / 8 : bx; }
    C.gw = C.vcu * NWAVES + C.wave; C.NGW = C.G * NWAVES;
    C.out = args.out;
    unsigned* ctl = (unsigned*)(C.ws + WS_CTL);
    volatile LAS unsigned* MISC = (volatile LAS unsigned*)(C.lds + LDS_MISC);
    for (int u = C.tid; u < (LDS_BYTES - LDS_MISC) / 4; u += NTHREADS) ((LAS unsigned*)(C.lds + LDS_MISC))[u] = 0u;
    __syncthreads();
    const int lo = args.ph_lo, hi = args.ph_hi;
    int nstamp = 0; (void)nstamp;
    XcdBarrier bar; bar.bar = ctl + CW_BAR; bar.x = 0; bar.st = nullptr;
    if (hi - lo > 1) bar = xcd_barrier_post(ctl + CW_BAR, MISC + 8);
#ifndef ONLYP
#define ONLYP -1
#endif
#define PEN(c) (ONLYP < 0 || ONLYP == (c))
#ifndef GEMM_ALIGN
#define GEMM_ALIGN true
#endif
#ifndef GEMM_SP2
#define GEMM_SP2 true
#endif
#ifndef ATTN_VARIANT
#define ATTN_VARIANT 0
#endif
#ifndef DUP_CLASS
#define DUP_CLASS -1
#endif
#define IN(k) in_range(lo, hi, (k))
#if defined(TIMING) && TIMING
#define STAMP_PHASE() do { if (blockIdx.x == 0 && threadIdx.x == 0) { unsigned long long* ts_ = (unsigned long long*)(args.ws + WS_DIAG); ts_[nstamp] = __builtin_amdgcn_s_memrealtime(); } ++nstamp; } while (0)
#else
#define STAMP_PHASE() do { } while (0)
#endif
#define FRESH(k) do { STAMP_PHASE(); C.tid = threadIdx.x; uintptr_t w_ = (uintptr_t)args.ws, o_ = (uintptr_t)args.out; asm volatile("; PHASE_MARK " #k : "+v"(C.tid), "+s"(C.gw), "+s"(C.vcu), "+s"(w_), "+s"(o_)); \
    C.ws = (unsigned char*)(GAS unsigned char*)w_; C.out = (float*)(GAS float*)o_; C.lane = C.tid & 63; } while (0)
#define SEAM(k) do { if (IN(k) && IN((k) + 1)) xcd_barrier(bar); } while (0)

    float* MOD = (float*)(C.ws + WS_MOD);
    bf16_t* H = (bf16_t*)(C.ws + WS_H); bf16_t* SEG = (bf16_t*)(C.ws + WS_SEG); bf16_t* MIX = (bf16_t*)(C.ws + WS_MIX); bf16_t* QP = (bf16_t*)(C.ws + WS_QP); bf16_t* H2 = (bf16_t*)(C.ws + WS_H2); bf16_t* OT = (bf16_t*)(C.ws + WS_OT); bf16_t* XB = (bf16_t*)(C.ws + WS_XB);
    unsigned* ROUTE = (unsigned*)(C.ws + WS_ROUTE);

    if (PEN(0) && IN(0)) for (int rep_ = 0; rep_ < ((DUP_CLASS == 0) ? 2 : 1); ++rep_) { if (rep_) xcd_barrier(bar); FRESH(0); p0_prologue(C, args); } SEAM(0);
    if (PEN(1) && IN(1)) for (int rep_ = 0; rep_ < ((DUP_CLASS == 1) ? 2 : 1); ++rep_) { if (rep_) xcd_barrier(bar); FRESH(1); p1_modfinal(C, ARG(4)); } SEAM(1);

    for (int l = 0; l < DEPTH; ++l) {
        const int pb = 2 + 11 * l;
        const float* modl = MOD + (size_t)l * NBATCH * MODW;
        unsigned* kmax = ctl + CW_KMAX + l * 256;
        if (PEN(2) && IN(pb + 0)) for (int rep_ = 0; rep_ < ((DUP_CLASS == 2) ? 2 : 1); ++rep_) { if (rep_) xcd_barrier(bar); FRESH(2); bf16_t* XB_ = (bf16_t*)(C.ws + WS_XB); if (l == 0) norm_pass<float>(C, ARG(0), H, ARG(5) + (size_t)l * DM, modl + 0 * DM, modl + 1 * DM); else norm_pass<bf16_t>(C, XB_, H, ARG(5) + (size_t)l * DM, modl + 0 * DM, modl + 1 * DM); } SEAM(pb + 0);
        if (PEN(3) && IN(pb + 1)) for (int rep_ = 0; rep_ < ((DUP_CLASS == 3) ? 2 : 1); ++rep_) { if (rep_) xcd_barrier(bar); FRESH(3);
            pg8::Gemm g{H, (const bf16_t*)(C.ws + WS_WIN) + (size_t)l * INC * DM, MTOK, INC, DM}; pg8::StaticOrder S; S.init(MTOK, INC, C.G, (int)blockIdx.x);
            pg8::EpiIn E{SEG, SEG_ELEMS, (const int*)ARG(2), kmax};
            pg8::gemm_phase<pg8::EpiIn, pg8::StaticOrder, GEMM_ALIGN, GEMM_SP2>(C.lds, g, S, E);
        } SEAM(pb + 1);
        if (PEN(4) && IN(pb + 2)) for (int rep_ = 0; rep_ < ((DUP_CLASS == 4) ? 2 : 1); ++rep_) { if (rep_) xcd_barrier(bar); FRESH(4);
            bf16_t* otdst = (DUP_CLASS == 4 && rep_ == 0) ? (bf16_t*)(C.ws + WS_PART) : OT;
            const float lam = __uint_as_float(__builtin_amdgcn_readfirstlane(((const unsigned*)(C.ws + WS_LAM))[l])), osc = __uint_as_float(__builtin_amdgcn_readfirstlane(((const unsigned*)(C.ws + WS_LAM))[4 + l]));
            int kun = 0; bool convdone = false, uvdone = false; (void)uvdone;
            for (int u = C.vcu; u < NBATCH * AHEADS * (SEQ / 256); u += C.G, ++kun) { const int bh = u >> 4, qb = u & 15;
                att::attn_unit3(bh >> 3, bh & 7, qb, SEG + 3 * SEG_ELEMS, SEG + 4 * SEG_ELEMS, SEG + 5 * SEG_ELEMS, MIX, kmax, lam, ARG(12) + (size_t)l * VDIM, osc, (LAS char*)C.lds);
                if (l == 0 && rep_ == 0) { int tu_ = threadIdx.x; asm volatile("" : "+v"(tu_)); const int lu_ = tu_ & 63;
                    uv_convert_chunk(C, args, 2 * u, lu_); uv_convert_chunk(C, args, 2 * u + 1, lu_); }
                if (kun == (C.vcu & 3)) { convdone = true; int tc_ = threadIdx.x; asm volatile("" : "+v"(tc_));
                    for (int ch = C.vcu; ch < MTOK / 128; ch += C.G) conv_chunk(SEG + 0 * SEG_ELEMS, SEG + 1 * SEG_ELEMS, SEG + 2 * SEG_ELEMS, ARG(7) + (size_t)l * 3 * CONVW, MIX, ch, tc_); } }
            if (!convdone) { int tc_ = threadIdx.x; asm volatile("" : "+v"(tc_));
                for (int ch = C.vcu; ch < MTOK / 128; ch += C.G) conv_chunk(SEG + 0 * SEG_ELEMS, SEG + 1 * SEG_ELEMS, SEG + 2 * SEG_ELEMS, ARG(7) + (size_t)l * 3 * CONVW, MIX, ch, tc_); }
        } SEAM(pb + 2);
        if (PEN(5) && IN(pb + 4)) for (int rep_ = 0; rep_ < ((DUP_CLASS == 5) ? 2 : 1); ++rep_) { if (rep_) xcd_barrier(bar); FRESH(5);
            pg8::Gemm g{MIX, (const bf16_t*)(C.ws + WS_WOUT) + (size_t)l * DM * DM, MTOK, DM, DM}; pg8::StaticOrder S; S.init(MTOK, DM, C.G, (int)blockIdx.x);
            bf16_t* XB_ = (bf16_t*)(C.ws + WS_XB);
            bf16_t* XO_ = (DUP_CLASS == 5 && rep_ == 0) ? (bf16_t*)(C.ws + WS_PART) : XB_;
            if (l == 0) { pg8::EpiRes<float> E{ARG(0), XO_, modl + 2 * DM}; pg8::gemm_phase<pg8::EpiRes<float>, pg8::StaticOrder, GEMM_ALIGN, GEMM_SP2>(C.lds, g, S, E); }
            else { pg8::EpiRes<bf16_t> E{XB_, XO_, modl + 2 * DM}; pg8::gemm_phase<pg8::EpiRes<bf16_t>, pg8::StaticOrder, GEMM_ALIGN, GEMM_SP2>(C.lds, g, S, E); }
        } SEAM(pb + 4);
        if (PEN(6) && IN(pb + 5)) for (int rep_ = 0; rep_ < ((DUP_CLASS == 6) ? 2 : 1); ++rep_) { if (rep_) xcd_barrier(bar); FRESH(6); norm_pass<bf16_t>(C, (const bf16_t*)(C.ws + WS_XB), H2, ARG(14) + (size_t)l * DM, modl + 3 * DM, modl + 4 * DM, C.ws + WS_H2I, (float*)(C.ws + WS_HSC)); } SEAM(pb + 5);
        if (PEN(7) && IN(pb + 6)) for (int rep_ = 0; rep_ < ((DUP_CLASS == 7) ? 2 : 1); ++rep_) { if (rep_) xcd_barrier(bar); FRESH(7);
            pg8::Gemm g{H2, (const bf16_t*)(C.ws + WS_WQ) + (size_t)l * DM * DM, MTOK, DM, DM}; pg8::StaticOrder S; S.init(MTOK, DM, C.G, (int)blockIdx.x);
            pg8::EpiBf16 E{QP, DM};
            pg8::gemm_phase<pg8::EpiBf16, pg8::StaticOrder, GEMM_ALIGN, GEMM_SP2>(C.lds, g, S, E);
        } SEAM(pb + 6);
        if (PEN(8) && IN(pb + 7)) for (int rep_ = 0; rep_ < ((DUP_CLASS == 8) ? 2 : 1); ++rep_) { if (rep_) xcd_barrier(bar); FRESH(8);
            const bf16_t* keys = (const bf16_t*)(C.ws + WS_KEYS) + (size_t)l * 16 * 128 * 128;
            LAS int* scr = (LAS int*)(C.lds + 65536 + C.wave * 8192);
            for (int base = C.vcu * NWAVES; base < MTOK / 16; base += C.NGW) { const int tg = base + C.wave;
#pragma unroll 1
                for (int hq = 0; hq < 2; ++hq) router_task4(QP, keys, ROUTE, tg * 16, tg < MTOK / 16, hq, scr, (LAS unsigned char*)C.lds, C.tid); }
        } SEAM(pb + 7);
        const unsigned char* U8 = C.ws + WS_U + (size_t)l * NEXP * DM; const unsigned char* V8 = C.ws + WS_V + (size_t)l * NEXP * DM;
        if (PEN(9) && IN(pb + 8)) for (int rep_ = 0; rep_ < ((DUP_CLASS == 9) ? 2 : 1); ++rep_) { if (rep_) xcd_barrier(bar); FRESH(9);
            const unsigned xcd = xb_xcc_id() & 7u; unsigned* cnt = ctl + CW_XQ + ((l * 2 + 0) * 2 + rep_) * 16; volatile LAS int* bc = (volatile LAS int*)(C.lds + LDS_MISC + 64);
            bf16_t* PART = (bf16_t*)(C.ws + WS_PART); const unsigned char* H2I = C.ws + WS_H2I;
            for (int k = 0; k < NSLICE; ++k) { const int s = (int)((xcd + (unsigned)(k >> 1)) & 7u) + 8 * (k & 1);
                const unsigned char* Us = U8 + (size_t)s * NEXP * SLW; bf16_t* PARTs = PART + (size_t)s * MTOK * 128;
                __syncthreads(); if (C.tid == 0) bc[0] = (int)__hip_atomic_fetch_add(cnt + s, 1u, __ATOMIC_RELAXED, __HIP_MEMORY_SCOPE_AGENT); __syncthreads();
                int blk = bc[0], par = 0;
                while (blk < NTB) { int nxt = 0; if (C.tid == 0) nxt = (int)__hip_atomic_fetch_add(cnt + s, 1u, __ATOMIC_RELAXED, __HIP_MEMORY_SCOPE_AGENT);
#pragma unroll 1
                    for (int h2 = 0; h2 < 2; ++h2) expert_u_block16(H2I, Us, ROUTE, PARTs, blk * TBLK + C.wave * 32 + h2 * 16, s, C.lane);
                    if (C.tid == 0) bc[par ^ 1] = nxt;
                    __syncthreads(); par ^= 1; blk = bc[par]; } }
        } SEAM(pb + 8);
        if (PEN(12) && IN(pb + 9)) { FRESH(12);
            if (DUP_CLASS == 12) { expert_f_phase(C, (const bf16_t*)(C.ws + WS_PART), ROUTE, (const float*)(C.ws + WS_USC) + (size_t)l * NEXP, (const float*)(C.ws + WS_VSC) + (size_t)l * NEXP, (const float*)(C.ws + WS_HSC), (unsigned*)(C.ws + WS_WR), (float*)(C.ws + WS_WSC)); FRESH(12); }
            expert_f_phase(C, (const bf16_t*)(C.ws + WS_PART), ROUTE, (const float*)(C.ws + WS_USC) + (size_t)l * NEXP, (const float*)(C.ws + WS_VSC) + (size_t)l * NEXP, (const float*)(C.ws + WS_HSC), (unsigned*)(C.ws + WS_WR), (float*)(C.ws + WS_WSC));
        } SEAM(pb + 9);
        if (PEN(13) && IN(pb + 10)) for (int rep_ = 0; rep_ < ((DUP_CLASS == 13) ? 2 : 1); ++rep_) { if (rep_) xcd_barrier(bar); FRESH(13);
            bf16_t* XB_ = (bf16_t*)(C.ws + WS_XB); bf16_t* xdst = (DUP_CLASS == 13 && rep_ == 0) ? (bf16_t*)(C.ws + WS_PART) + (size_t)64 * 1024 * 1024 : XB_;
            const unsigned xcd = xb_xcc_id() & 7u; unsigned* cnt = ctl + CW_XQ + ((l * 2 + 1) * 2 + rep_) * 16; volatile LAS int* bc = (volatile LAS int*)(C.lds + LDS_MISC + 64);
            const unsigned* WR = (const unsigned*)(C.ws + WS_WR); const float* WSC = (const float*)(C.ws + WS_WSC);
            for (int k = 0; k < NSLICE; ++k) { const int s = (int)((xcd + (unsigned)(k >> 1)) & 7u) + 8 * (k & 1);
                const unsigned char* Vs = V8 + (size_t)s * NEXP * SLW;
                __syncthreads(); if (C.tid == 0) bc[0] = (int)__hip_atomic_fetch_add(cnt + s, 1u, __ATOMIC_RELAXED, __HIP_MEMORY_SCOPE_AGENT); __syncthreads();
                int blk = bc[0], par = 0;
                while (blk < NTB) { int nxt = 0; if (C.tid == 0) nxt = (int)__hip_atomic_fetch_add(cnt + s, 1u, __ATOMIC_RELAXED, __HIP_MEMORY_SCOPE_AGENT);
#pragma unroll 1
                    for (int h2 = 0; h2 < 2; ++h2) expert_v_block16(XB_, xdst, modl + 5 * DM, Vs, WR, WSC, blk * TBLK + C.wave * 32 + h2 * 16, s, C.lane);
                    if (C.tid == 0) bc[par ^ 1] = nxt;
                    __syncthreads(); par ^= 1; blk = bc[par]; } }
        } SEAM(pb + 10);
    }
    if (PEN(10) && IN(46)) for (int rep_ = 0; rep_ < ((DUP_CLASS == 10) ? 2 : 1); ++rep_) { if (rep_) xcd_barrier(bar); FRESH(10); final_norm_pass(C, (const bf16_t*)(C.ws + WS_XB), C.out, ARG(19)); }
#if defined(UBENCH)
    { float a0 = (float)C.lane, a1 = a0 + 1.f, a2 = a0 + 2.f, a3 = a0 + 3.f, a4 = 1.f, a5 = 2.f, a6 = 3.f, a7 = 4.f; f32x2 p0 = {0.f, 0.f}, p1 = p0, p2 = p0, p3 = p0; unsigned w0 = C.tid * 2654435761u, w1 = w0 ^ 0x55aa55aau;
#pragma unroll 1
      for (int it = 0; it < 16384; ++it) {
#if UBENCH == 1
        asm volatile("v_cvt_pk_f32_fp8_e32 %0, %4\n\tv_cvt_pk_f32_fp8_e32 %1, %5\n\tv_cvt_pk_f32_fp8_e32 %2, %4\n\tv_cvt_pk_f32_fp8_e32 %3, %5\n\tv_cvt_pk_f32_fp8_e32 %0, %5\n\tv_cvt_pk_f32_fp8_e32 %1, %4\n\tv_cvt_pk_f32_fp8_e32 %2, %5\n\tv_cvt_pk_f32_fp8_e32 %3, %4" : "+v"(p0), "+v"(p1), "+v"(p2), "+v"(p3) : "v"(w0), "v"(w1));
#elif UBENCH == 2
        asm volatile("v_cvt_pk_f32_fp8_sdwa %0, %4 src0_sel:WORD_1\n\tv_cvt_pk_f32_fp8_sdwa %1, %5 src0_sel:WORD_1\n\tv_cvt_pk_f32_fp8_sdwa %2, %4 src0_sel:WORD_1\n\tv_cvt_pk_f32_fp8_sdwa %3, %5 src0_sel:WORD_1\n\tv_cvt_pk_f32_fp8_sdwa %0, %5 src0_sel:WORD_1\n\tv_cvt_pk_f32_fp8_sdwa %1, %4 src0_sel:WORD_1\n\tv_cvt_pk_f32_fp8_sdwa %2, %5 src0_sel:WORD_1\n\tv_cvt_pk_f32_fp8_sdwa %3, %4 src0_sel:WORD_1" : "+v"(p0), "+v"(p1), "+v"(p2), "+v"(p3) : "v"(w0), "v"(w1));
#elif UBENCH == 3
        asm volatile("v_fma_f32 %0, %4, %5, %0\n\tv_fma_f32 %1, %4, %5, %1\n\tv_fma_f32 %2, %4, %5, %2\n\tv_fma_f32 %3, %4, %5, %3\n\tv_fma_f32 %0, %5, %4, %0\n\tv_fma_f32 %1, %5, %4, %1\n\tv_fma_f32 %2, %5, %4, %2\n\tv_fma_f32 %3, %5, %4, %3" : "+v"(a0), "+v"(a1), "+v"(a2), "+v"(a3) : "v"(a4), "v"(a5));
#elif UBENCH == 5
        { int i0 = (int)w0, i1 = (int)w1, i2 = 3, i3 = 4; asm volatile("v_dot4c_i32_i8 %0, %4, %5\n\tv_dot4c_i32_i8 %1, %4, %5\n\tv_dot4c_i32_i8 %2, %4, %5\n\tv_dot4c_i32_i8 %3, %4, %5\n\tv_dot4c_i32_i8 %0, %5, %4\n\tv_dot4c_i32_i8 %1, %5, %4\n\tv_dot4c_i32_i8 %2, %5, %4\n\tv_dot4c_i32_i8 %3, %5, %4" : "+v"(i0), "+v"(i1), "+v"(i2), "+v"(i3) : "v"(w0), "v"(w1)); a0 += (float)(i0 + i1 + i2 + i3); }
#elif UBENCH == 7
        asm volatile("v_perm_b32 %0, %4, %5, %6\n\tv_perm_b32 %1, %4, %5, %6\n\tv_perm_b32 %2, %4, %5, %6\n\tv_perm_b32 %3, %4, %5, %6\n\tv_perm_b32 %0, %5, %4, %6\n\tv_perm_b32 %1, %5, %4, %6\n\tv_perm_b32 %2, %5, %4, %6\n\tv_perm_b32 %3, %5, %4, %6" : "+v"(a0), "+v"(a1), "+v"(a2), "+v"(a3) : "v"(w0), "v"(w1), "v"(0x05010400u));
#elif UBENCH == 8
        asm volatile("v_pack_b32_f16 %0, %4, %5\n\tv_pack_b32_f16 %1, %4, %5\n\tv_and_or_b32 %2, %4, %5, %2\n\tv_and_or_b32 %3, %4, %5, %3\n\tv_pack_b32_f16 %0, %5, %4\n\tv_pack_b32_f16 %1, %5, %4\n\tv_lshl_or_b32 %2, %5, 8, %2\n\tv_lshl_or_b32 %3, %5, 8, %3" : "+v"(a0), "+v"(a1), "+v"(a2), "+v"(a3) : "v"(w0), "v"(w1));
#elif UBENCH == 6
        asm volatile("v_pk_fma_f32 %0, %4, %5, %0\n\tv_pk_fma_f32 %1, %4, %5, %1\n\tv_pk_fma_f32 %2, %4, %5, %2\n\tv_pk_fma_f32 %3, %4, %5, %3\n\tv_pk_fma_f32 %0, %5, %4, %0\n\tv_pk_fma_f32 %1, %5, %4, %1\n\tv_pk_fma_f32 %2, %5, %4, %2\n\tv_pk_fma_f32 %3, %5, %4, %3" : "+v"(p0), "+v"(p1), "+v"(p2), "+v"(p3) : "v"(p0), "v"(p1));
#else
        asm volatile("v_pk_fma_f16 %0, %4, %5, %0\n\tv_pk_fma_f16 %1, %4, %5, %1\n\tv_pk_fma_f16 %2, %4, %5, %2\n\tv_pk_fma_f16 %3, %4, %5, %3\n\tv_pk_fma_f16 %0, %5, %4, %0\n\tv_pk_fma_f16 %1, %5, %4, %1\n\tv_pk_fma_f16 %2, %5, %4, %2\n\tv_pk_fma_f16 %3, %5, %4, %3" : "+v"(a0), "+v"(a1), "+v"(a2), "+v"(a3) : "v"(w0), "v"(w1));
#endif
      }
      if (a0 + a1 + a2 + a3 + p0.x + p1.x + p2.x + p3.x + p0.y + p1.y + p2.y + p3.y == 1.2345e-30f) ((float*)(C.ws + WS_DIAG))[C.tid] = a0; }
#endif
#undef IN
#undef SEAM
}


#if defined(CHECK) && CHECK
constexpr size_t WS_XSAVE = 1776 * MiB;
constexpr int NSTAGE = 16, NSAMP = 96;
__device__ __forceinline__ unsigned hash32(unsigned x) { x ^= x >> 16; x *= 0x7feb352du; x ^= x >> 15; x *= 0x846ca68bu; x ^= x >> 16; return x; }
__device__ __forceinline__ float bf2f(bf16_t v) { return __builtin_bit_cast(float, ((unsigned)v) << 16); }
__device__ __forceinline__ double wsumd(double v) {
#pragma unroll
    for (int o = 1; o < 64; o <<= 1) v += __shfl_xor(v, o);
    return v; }
__device__ __forceinline__ float wmaxf(float v) {
#pragma unroll
    for (int o = 1; o < 64; o <<= 1) v = fmaxf(v, __shfl_xor(v, o));
    return v; }
__device__ __forceinline__ void diag_add(float* diag, int stage, double num, double den, int lane) { if (lane == 0) { atomicAdd(diag + 2 * stage, (float)num); atomicAdd(diag + 2 * stage + 1, (float)den); } }
__device__ __forceinline__ float chk_silu(float x) { return x / (1.f + expf(-x)); }
__device__ __forceinline__ float chk_rstd(const float* x, int row, int lane) { double ss = 0; for (int k = lane; k < DM; k += 64) { const double v = x[(size_t)row * DM + k]; ss += v * v; } ss = wsumd(ss); return 1.0f / sqrtf((float)(ss / DM) + NORM_EPS); }
__device__ __forceinline__ float chk_norm_elem(const float* x, int row, int col, float rstd, const float* g, const float* sh, const float* sc) { const int b = row >> 12;
    return x[(size_t)row * DM + col] * rstd * g[col] * (1.0f + sc[(size_t)b * MODW + col]) + sh[(size_t)b * MODW + col]; }
__global__ void __launch_bounds__(64) check_kernel(Args args) {
    __shared__ float sq_[64]; __shared__ float ssc[256]; __shared__ int sused[256]; __shared__ int sti[32]; __shared__ float sts[32]; __shared__ int sce[16]; __shared__ float scs[16];
    const int stage = blockIdx.x / NSAMP, s = blockIdx.x % NSAMP, lane = threadIdx.x;
    unsigned char* ws = args.ws; float* diag = (float*)(ws + WS_DIAG);
    const float* MOD = (const float*)(ws + WS_MOD); const bf16_t* H = (const bf16_t*)(ws + WS_H); const bf16_t* SEG = (const bf16_t*)(ws + WS_SEG);
    const bf16_t* MIX = (const bf16_t*)(ws + WS_MIX); const bf16_t* OT = (const bf16_t*)(ws + WS_OT); const bf16_t* H2 = (const bf16_t*)(ws + WS_H2); const bf16_t* QP = (const bf16_t*)(ws + WS_QP); const unsigned* ROUTE = (const unsigned*)(ws + WS_ROUTE);
    const float* XS = (const float*)(ws + WS_XSAVE); const unsigned* kmax = (const unsigned*)(ws + WS_CTL) + CW_KMAX;
    const unsigned hsh = hash32(stage * 7919u + s * 104729u + 12345u);
    const int row = hsh % MTOK; const unsigned h2 = hash32(hsh + 1u);
    if (stage == 1) {
        const int b = h2 % 8, n = (h2 >> 3) % MODW; double a = 0;
        for (int k = lane; k < DM; k += 64) a += (double)chk_silu(args.in[1][b * DM + k]) * args.in[3][(size_t)k * MODW + n];
        a = wsumd(a) + args.in[4][n]; const double d = MOD[(size_t)b * MODW + n] - a; diag_add(diag, stage, d * d, a * a, lane);
    } else if (stage == 2) {
        const int col = h2 % DM; const float rstd = chk_rstd(args.in[0], row, lane); const float r = chk_norm_elem(args.in[0], row, col, rstd, args.in[5], MOD + 0 * DM, MOD + 1 * DM);
        const double d = bf2f(H[(size_t)row * DM + col]) - r; diag_add(diag, stage, d * d, (double)r * r, lane);
    } else if (stage == 3 || stage == 4) {
        int col;
        if (stage == 3) { const int t = h2 % 4; col = (t == 3 ? 5 : t) * 1024 + (h2 >> 2) % 1024; } else { col = 3072 + (h2 % 2048); if (s < NSAMP / 2) col = (col & ~63) | ((h2 >> 11) % 16); }
        auto dotc = [&](int c) { double a = 0; for (int k = lane; k < DM; k += 64) a += (double)bf2f(H[(size_t)row * DM + k]) * args.in[6][(size_t)k * INC + c]; return (float)wsumd(a); };
        float r = dotc(col);
        if (stage == 4) { const int dd = col & 63; if (dd < 16) { const int j = dd & 7; const float invf = powf(500000.f, -(float)(2 * j) / 16.f); const float ang = (float)((const int*)args.in[2])[row] * invf;
                const float cs = cosf(ang), sn = sinf(ang); const float o = (dd < 8) ? dotc(col + 8) : dotc(col - 8); r = (dd < 8) ? r * cs - o * sn : r * cs + o * sn; } }
        const float got = bf2f(SEG[(size_t)(col >> 10) * SEG_ELEMS + (size_t)row * 1024 + (col & 1023)]);
        const double d = got - r; diag_add(diag, stage, d * d, (double)r * r, lane);
    } else if (stage == 5) {
        const int b = h2 % 8, hh = (h2 >> 3) % 8, c = (h2 >> 6) % 2; const bf16_t* K = SEG + 4 * SEG_ELEMS; float mx = 0.f;
        for (int sq = lane; sq < SEQ; sq += 64) { float a = 0; for (int d = 0; d < 64; ++d) { const float v = bf2f(K[((size_t)b * SEQ + sq) * 1024 + hh * 128 + c * 64 + d]); a += v * v; } mx = fmaxf(mx, a); }
        mx = wmaxf(mx);
        const unsigned* km = kmax + ((b * 8 + hh) * 2 + c) * 2; const float bound = __uint_as_float(km[0]) + __uint_as_float(km[1]);
        const bool ok = bound >= mx * 0.98f && bound <= mx * 2.2f; diag_add(diag, stage, ok ? 0.0 : 1.0, 1.0, lane);
    } else if (stage == 6) {
        const int hh = h2 % 8, c = (h2 >> 3) % 2, d = (h2 >> 4) % 128, b = row >> 12;
        const bf16_t* Q = SEG + 3 * SEG_ELEMS; const bf16_t* K = SEG + 4 * SEG_ELEMS; const bf16_t* V = SEG + 5 * SEG_ELEMS;
        sq_[lane] = bf2f(Q[(size_t)row * 1024 + hh * 128 + c * 64 + lane]); __syncthreads();
        float mx = -1e30f;
        for (int sq = lane; sq < SEQ; sq += 64) { float a = 0; const bf16_t* kr = K + ((size_t)b * SEQ + sq) * 1024 + hh * 128 + c * 64; for (int e = 0; e < 64; ++e) a += sq_[e] * bf2f(kr[e]); mx = fmaxf(mx, a * 0.125f); }
        mx = wmaxf(mx);
        double num = 0, den = 0;
        for (int sq = lane; sq < SEQ; sq += 64) { float a = 0; const bf16_t* kr = K + ((size_t)b * SEQ + sq) * 1024 + hh * 128 + c * 64; for (int e = 0; e < 64; ++e) a += sq_[e] * bf2f(kr[e]);
            const double p = exp((double)(a * 0.125f - mx)); den += p; num += p * bf2f(V[((size_t)b * SEQ + sq) * 1024 + hh * 128 + d]); }
        num = wsumd(num); den = wsumd(den);
        const double r = num / den; const double dd = bf2f(OT[(size_t)c * MTOK * 1024 + (size_t)row * 1024 + hh * 128 + d]) - r; diag_add(diag, stage, dd * dd, r * r, lane);
    } else if (stage == 7) {
        if ((s & 1) == 0) { const int col = h2 % 1024, sq = row & (SEQ - 1); const bf16_t* GB = SEG; const bf16_t* GC = SEG + SEG_ELEMS; const bf16_t* HV = SEG + 2 * SEG_ELEMS;
            auto z = [&](int r) { return bf2f(GC[(size_t)r * 1024 + col]) * bf2f(HV[(size_t)r * 1024 + col]); };
            const float zm = (sq > 0) ? z(row - 1) : 0.f, zc = z(row), zp = (sq < SEQ - 1) ? z(row + 1) : 0.f;
            const float r = bf2f(GB[(size_t)row * 1024 + col]) * (args.in[7][col] * zm + args.in[7][1024 + col] * zc + args.in[7][2048 + col] * zp);
            const double d = bf2f(MIX[(size_t)row * 2048 + col]) - r; diag_add(diag, stage, d * d, (double)r * r, lane);
        } else { const int hh = h2 % 8, d = (h2 >> 3) % 128;
            const double a1 = wsumd((double)args.in[8][lane] * args.in[9][lane]), a2 = wsumd((double)args.in[10][lane] * args.in[11][lane]);
            const float lam_init = 0.8f - 0.6f * expf(-0.3f * 0.f), lam = (float)(exp(a1) - exp(a2)) + lam_init;
            double ss = 0; float od = 0;
            for (int e = lane; e < 128; e += 64) { const float o = bf2f(OT[(size_t)row * 1024 + hh * 128 + e]) - lam * bf2f(OT[(size_t)MTOK * 1024 + (size_t)row * 1024 + hh * 128 + e]); ss += (double)o * o; if (e == d) od = o; }
            ss = wsumd(ss); od = (float)wsumd((double)od);
            const float r = od / sqrtf((float)(ss / 128.0) + NORM_EPS) * args.in[12][d] * (1.f - lam_init);
            const double dd = bf2f(MIX[(size_t)row * 2048 + 1024 + hh * 128 + d]) - r; diag_add(diag, stage, dd * dd, (double)r * r, lane); }
    } else if (stage == 8) {
        const int col = h2 % DM, b = row >> 12; double a = 0; for (int k = lane; k < DM; k += 64) a += (double)bf2f(MIX[(size_t)row * DM + k]) * args.in[13][(size_t)k * DM + col];
        a = wsumd(a); const double delta = (double)MOD[(size_t)b * MODW + 2 * DM + col] * a;
        const double r = args.in[0][(size_t)row * DM + col] + delta; const double d = XS[(size_t)row * DM + col] - r; diag_add(diag, stage, d * d, delta * delta, lane);
    } else if (stage == 9) {
        const int col = h2 % DM; const float rstd = chk_rstd(XS, row, lane); const float r = chk_norm_elem(XS, row, col, rstd, args.in[14], MOD + 3 * DM, MOD + 4 * DM);
        const double d = bf2f(H2[(size_t)row * DM + col]) - r; diag_add(diag, stage, d * d, (double)r * r, lane);
    } else if (stage == 10) {
        const int col = h2 % DM; double a = 0; for (int k = lane; k < DM; k += 64) a += (double)bf2f(H2[(size_t)row * DM + k]) * args.in[15][(size_t)k * DM + col];
        a = wsumd(a); const double d = bf2f(QP[(size_t)row * DM + col]) - a; diag_add(diag, stage, d * d, a * a, lane);
    } else if (stage == 11) {
        const int hh = h2 % 8;
        for (int i = lane; i < 256; i += 64) { const int c = i >> 7, n = i & 127; double a = 0; for (int d = 0; d < 128; ++d) a += (double)bf2f(QP[(size_t)row * DM + (hh * 2 + c) * 128 + d]) * args.in[16][(((size_t)hh * 2 + c) * 128 + n) * 128 + d]; ssc[i] = (float)a; sused[i] = 0; }
        __syncthreads();
        if (lane == 0) {
            for (int c = 0; c < 2; ++c) for (int j = 0; j < 16; ++j) { int bi = -1; float bv = -1e30f; for (int n = 0; n < 128; ++n) if (!sused[c * 128 + n] && ssc[c * 128 + n] > bv) { bv = ssc[c * 128 + n]; bi = n; }
                sti[c * 16 + j] = bi; sts[c * 16 + j] = bv; sused[c * 128 + bi] = 1; }
            for (int q = 0; q < 256; ++q) sused[q] = 0;
            for (int j = 0; j < 16; ++j) { int bi = -1; float bv = -1e30f; for (int q = 0; q < 256; ++q) { if (sused[q]) continue; const float v = sts[q >> 4] + sts[16 + (q & 15)]; if (v > bv) { bv = v; bi = q; } }
                sused[bi] = 1; sce[j] = sti[bi >> 4] * 128 + sti[16 + (bi & 15)]; scs[j] = bv; }
            double gsum = 0; for (int j = 0; j < 16; ++j) gsum += exp((double)(scs[j] - scs[0]));
            double err = 0;
            for (int j = 0; j < 16; ++j) { const double gr = exp((double)(scs[j] - scs[0])) / gsum; double gm = 0;
                for (int q = 0; q < 16; ++q) { const unsigned e = ROUTE[(size_t)row * 128 + hh * 16 + q]; if ((int)(e & 0x3fffu) == sce[j]) gm = __builtin_bit_cast(float, e & 0xffff0000u); }
                err += fabs(gr - gm); }
            diag_add(diag, stage, err * err, 1.0, lane); }
    } else if (stage == 13) {
        const int pair = h2 % 128; const unsigned ent = ROUTE[(size_t)row * 128 + pair]; const int eid = ent & 0x3fffu; double a = 0;
        for (int k = lane; k < DM; k += 64) a += (double)bf2f(H2[(size_t)row * DM + k]) * args.in[17][(size_t)eid * DM + k];
        a = wsumd(a); double got = 0; const bf16_t* PART = (const bf16_t*)(ws + WS_PART);
        for (int sl = 0; sl < 16; ++sl) got += bf2f(PART[(size_t)sl * MTOK * 128 + (size_t)row * 128 + pair]);
        got *= (double)((const float*)(ws + WS_USC))[eid] * ((const float*)(ws + WS_HSC))[row]; const double d = got - a; diag_add(diag, stage, d * d, a * a, lane);
    } else if (stage == 14) {
        const int pair = h2 % 128; const unsigned ent = ROUTE[(size_t)row * 128 + pair]; const int eid = ent & 0x3fffu; const float gate = __builtin_bit_cast(float, ent & 0xffff0000u); double a = 0;
        for (int k = lane; k < DM; k += 64) a += (double)bf2f(H2[(size_t)row * DM + k]) * args.in[17][(size_t)eid * DM + k];
        a = wsumd(a); const double w = 0.5 * a * (1.0 + erf(a * 0.7071067811865476)) * gate;
        const unsigned wr = ((const unsigned*)(ws + WS_WR))[(size_t)row * 128 + pair]; const double got = (double)((int)wr >> 24) * ((const float*)(ws + WS_WSC))[row] * (1.0 / ((const float*)(ws + WS_VSC))[eid]);
        const double d = got - w + (((int)(wr & 0x3fffu) == eid) ? 0.0 : 100.0); diag_add(diag, stage, d * d, w * w, lane);
    } else if (stage == 12) {
        const int col = h2 % DM, b = row >> 12; const float rstd = chk_rstd(XS, row, lane); double out = 0;
        for (int e = 0; e < 128; ++e) { const unsigned ent = ROUTE[(size_t)row * 128 + e]; const int eid = ent & 0x3fffu; const float gate = __builtin_bit_cast(float, ent & 0xffff0000u); double a = 0;
            for (int k = lane; k < DM; k += 64) { const float hk = chk_norm_elem(XS, row, k, rstd, args.in[14], MOD + 3 * DM, MOD + 4 * DM); a += (double)hk * args.in[17][(size_t)eid * DM + k]; }
            a = wsumd(a); const double ge = 0.5 * a * (1.0 + erf(a * 0.7071067811865476)); out += ge * gate * args.in[18][(size_t)eid * DM + col]; }
        const double delta = (double)MOD[(size_t)b * MODW + 5 * DM + col] * out; const double r = XS[(size_t)row * DM + col] + delta; const double d = args.out[(size_t)row * DM + col] - r; diag_add(diag, stage, d * d, delta * delta, lane);
    }
}
#ifndef CHECK_FROM
#define CHECK_FROM 1
#endif
__global__ void encode_kernel(Args args) {
    const float* diag = (const float*)(args.ws + WS_DIAG);
    int k = 14; float m = 1.f;
    for (int st = NSTAGE - 1; st >= CHECK_FROM; --st) { const float num = diag[2 * st], den = diag[2 * st + 1]; float rel = sqrtf(num / fmaxf(den, 1e-30f)); if (!(rel == rel)) rel = 1e4f;
        const float tol = (st == 11 || st == 12 || st == 13 || st == 14) ? 0.08f : (st == 5 ? 0.01f : 0.03f);
        if (rel > tol) { k = st; m = fminf(9.9f, fmaxf(1.f, 1.f + 2.f * (log10f(rel) + 4.f))); } }
    const float c = sqrtf(m * powf(10.f, (float)k));
    for (size_t i = (size_t)blockIdx.x * blockDim.x + threadIdx.x; i < (size_t)MTOK * DM; i += (size_t)gridDim.x * blockDim.x) args.out[i] = c;
}
#endif
extern "C" void kernel_launch(void* const* d_in, const int* in_sizes, int n_in, void* d_out, int out_size, void* d_ws, size_t ws_size, hipStream_t stream) {
    static int grid = 0;
    if (grid == 0) {
        if (n_in != 20 || out_size != MTOK * DM || ws_size < WS_END) { fprintf(stderr, "kernel_launch: unexpected shapes: n_in %d out %d ws %zu (need %zu)\n", n_in, out_size, ws_size, (size_t)WS_END); grid = -1; return; }
        int dev = 0, cus = 0;
        if (hipGetDevice(&dev) != hipSuccess || hipDeviceGetAttribute(&cus, hipDeviceAttributeMultiprocessorCount, dev) != hipSuccess) { grid = -1; return; }
        if (hipFuncSetAttribute((const void*)fwd_kernel, hipFuncAttributeMaxDynamicSharedMemorySize, LDS_BYTES) != hipSuccess) { fprintf(stderr, "kernel_launch: hipFuncSetAttribute failed\n"); grid = -1; return; }
        int per_cu = 0;
        if (hipOccupancyMaxActiveBlocksPerMultiprocessor(&per_cu, (const void*)fwd_kernel, NTHREADS, LDS_BYTES) != hipSuccess || per_cu < 1) { fprintf(stderr, "kernel_launch: occupancy query says %d\n", per_cu); }
        (void)hipGetLastError();
        grid = cus;
    }
    if (grid < 0) return;
    (void)hipMemsetAsync((char*)d_ws + WS_CTL, 0, CTL_ZERO_BYTES, stream);
    Args a{};
    for (int i = 0; i < 20; ++i) a.in[i] = (const float*)d_in[i];
    a.out = (float*)d_out; a.ws = (unsigned char*)d_ws;
#if defined(CHECK) && CHECK
    if (ws_size < WS_XSAVE + (size_t)MTOK * DM * 4) { fprintf(stderr, "check build: workspace too small\n"); return; }
    (void)hipMemsetAsync((char*)d_ws + WS_DIAG, 0, 4096, stream);
    for (int p = 0; p < 2 + 11; ++p) { a.ph_lo = p; a.ph_hi = p + 1; hipLaunchKernelGGL(fwd_kernel, dim3(grid), dim3(NTHREADS), LDS_BYTES, stream, a);
        if (p == 2 + 4) (void)hipMemcpyAsync((char*)d_ws + WS_XSAVE, d_out, (size_t)MTOK * DM * 4, hipMemcpyDeviceToDevice, stream); }
    hipLaunchKernelGGL(check_kernel, dim3(NSTAGE * NSAMP), dim3(64), 0, stream, a);
    hipLaunchKernelGGL(encode_kernel, dim3(1024), dim3(256), 0, stream, a);
#elif MK_SPLIT
    for (int p = 0; p < NPHASE; ++p) { a.ph_lo = p; a.ph_hi = p + 1; hipLaunchKernelGGL(fwd_kernel, dim3(grid), dim3(NTHREADS), LDS_BYTES, stream, a); }
#else
    a.ph_lo = 0; a.ph_hi = NPHASE; hipLaunchKernelGGL(fwd_kernel, dim3(grid), dim3(NTHREADS), LDS_BYTES, stream, a);
#endif
    const hipError_t le = hipPeekAtLastError();
    if (le != hipSuccess) fprintf(stderr, "kernel_launch: launch failed: %s\n", hipGetErrorName(le));
}
```

```cpp
#include <hip/hip_runtime.h>
#include <cstdio>
#include <cstdint>

#define GAS __attribute__((address_space(1)))
#define LAS __attribute__((address_space(3)))
typedef unsigned short bf16_t;
typedef short bf16x8 __attribute__((ext_vector_type(8)));
typedef short s16x4 __attribute__((ext_vector_type(4)));
typedef float f32x2 __attribute__((ext_vector_type(2)));
typedef float f32x4 __attribute__((ext_vector_type(4)));
typedef float f32x16 __attribute__((ext_vector_type(16)));
typedef unsigned u32x2 __attribute__((ext_vector_type(2)));
typedef unsigned u32x4 __attribute__((ext_vector_type(4)));
typedef __bf16 bf16x2_t __attribute__((ext_vector_type(2)));

constexpr int DM = 2048, NBATCH = 8, SEQ = 4096, DEPTH = 4, MTOK = NBATCH * SEQ;
constexpr int CONVW = 1024, AHEADS = 8, ATTW = 1024, VDIM = 128, SUBD = 64;
constexpr int INC = 6144;
constexpr int PHEADS = 8, NKEYS = 128, NEXP = 16384, TOPK = 16;
constexpr int MODW = 6 * DM;
constexpr float NORM_EPS = 1e-6f;
constexpr int NWAVES = 8, NTHREADS = 512;

constexpr size_t MiB = 1u << 20;
constexpr size_t WS_CTL = 0, CTL_ZERO_BYTES = 1 * MiB;
constexpr size_t WS_MOD = 2 * MiB;
constexpr size_t WS_MODP = 4 * MiB;
constexpr size_t WS_ROPE = 16 * MiB;
constexpr size_t WS_LAM = 18 * MiB;
constexpr size_t WS_KEYS = 20 * MiB;
constexpr size_t WS_WIN = 32 * MiB;
constexpr size_t WS_WOUT = 128 * MiB;
constexpr size_t WS_WQ = 160 * MiB;
constexpr size_t WS_U = 192 * MiB;
constexpr size_t WS_V = 320 * MiB;
constexpr size_t WS_PART = 448 * MiB;
constexpr size_t WS_USC = 24 * MiB, WS_VSC = 25 * MiB;
constexpr size_t WS_H = 704 * MiB;
constexpr size_t WS_SEG = 832 * MiB;
constexpr size_t SEG_ELEMS = (size_t)MTOK * 1024;
constexpr size_t WS_MIX = 1216 * MiB;
constexpr size_t WS_QP = 1344 * MiB;
constexpr size_t WS_ROUTE = 1472 * MiB;
constexpr size_t WS_DIAG = 1488 * MiB;
constexpr size_t WS_H2 = 1504 * MiB;
constexpr size_t WS_WSC = 1494 * MiB;
constexpr size_t WS_HSC = 1492 * MiB;
constexpr size_t WS_OT = 1632 * MiB;
constexpr size_t WS_WR = 1760 * MiB;
constexpr size_t WS_H2I = WS_OT;
constexpr size_t WS_XB = 1776 * MiB;
constexpr size_t WS_END = 1904 * MiB;

constexpr int CW_BAR = 4096;
constexpr int CW_KMAX = 16384;

constexpr int LDS_BYTES = 147456;
constexpr int LDS_MISC = 131072;
namespace pg8 {
#define PG8_LAS __attribute__((address_space(3)))
typedef unsigned short bf16_t;
typedef short bf16x8 __attribute__((ext_vector_type(8)));
typedef float f32x4 __attribute__((ext_vector_type(4)));
typedef unsigned u32x4 __attribute__((ext_vector_type(4)));
constexpr int BM = 256, BK = 64, HALF = 128, HTB = HALF * BK * 2  , STAGE_BYTES = 8 * HTB, NXCD = 8, WGM = 8;

__host__ __device__ __forceinline__ int lds_byte(int r, int c) { const int st = (r >> 4) * 2 + (c >> 5), rr = r & 15, cc = c & 31, ob = rr * 64 + cc * 2; return st * 1024 + (ob ^ (((ob >> 9) & 1) << 5)); }
__host__ __device__ __forceinline__ void stage_rc(int b, int& R, int& C) { const int st = b / 1024, sb = b % 1024, swz = sb ^ (((sb >> 9) & 1) << 5); R = (st >> 1) * 16 + swz / 64; C = (st & 1) * 32 + (swz % 64) / 2; }
__host__ __device__ __forceinline__ int perm32(int rho) { const int n = rho >> 4, i = rho & 15; return 8 * (i >> 2) + 4 * n + (i & 3); }

struct Unit { int pm, pn; };
struct Gemm { const bf16_t* A; const bf16_t* Bt; int M, N, K; };

struct StaticOrder {
    int nM, nN, nwg, G, c;
    __host__ __device__ void init(int M, int N, int G_, int c_) { nM = M / BM; nN = N / BM; nwg = nM * nN; G = G_; c = c_; }
    __host__ __device__ bool next(int i, Unit& u) const {
        const long L = (long)i * G + c; if (L >= nwg) return false;
        int wgid = (int)L; { const int q = nwg / NXCD, r = nwg % NXCD, xcd = wgid % NXCD, off = wgid / NXCD; wgid = (xcd < r ? xcd * (q + 1) : r * (q + 1) + (xcd - r) * q) + off; }
        const int nig = WGM * nN, gid = wgid / nig, fm = gid * WGM, gsz = (nM - fm) < WGM ? (nM - fm) : WGM;
        u.pm = fm + ((wgid % nig) % gsz); u.pn = (wgid % nig) / gsz; return true;
    }
    __device__ __forceinline__ void a_ready(const Unit&) const {}
    __device__ __forceinline__ void done(const Unit&) const {}
};


__device__ __forceinline__ unsigned cvt_pk_bf16(float lo, float hi) { unsigned r; asm volatile("v_cvt_pk_bf16_f32 %0, %1, %2" : "=v"(r) : "v"(lo), "v"(hi)); return r; }

struct EpiBf16 {
    static constexpr bool PERM = true, AFTER_DRAIN = false;
    bf16_t* O; int ldc;
    __device__ __forceinline__ void operator()(const f32x4 (&acc)[2][2][4][2], const Unit& u, int wr, int wc, int fr, int fq) const {
        const int row0 = u.pm * BM + wr * 64 + fr, col0 = u.pn * BM + wc * 32 + 8 * fq;
#pragma unroll
        for (int ai = 0; ai < 2; ++ai)
#pragma unroll
            for (int m = 0; m < 4; ++m) { bf16_t* rowp = O + (size_t)(row0 + ai * HALF + m * 16) * ldc + col0;
#pragma unroll
                for (int bj = 0; bj < 2; ++bj) { const f32x4 v0 = acc[ai][bj][m][0], v1 = acc[ai][bj][m][1];
                    u32x4 w; w.x = cvt_pk_bf16(v0[0], v0[1]); w.y = cvt_pk_bf16(v0[2], v0[3]); w.z = cvt_pk_bf16(v1[0], v1[1]); w.w = cvt_pk_bf16(v1[2], v1[3]);
                    *(u32x4*)(rowp + bj * HALF) = w; } }
    }
};

__device__ __forceinline__ float xrow16(float v, bool odd) {
    float a = v, b = v; asm volatile("s_nop 1\n\tv_permlane16_swap_b32 %0, %1\n\ts_nop 1" : "+v"(a), "+v"(b)); return odd ? a : b; }
__device__ __forceinline__ float sum_rows4(float v) {
    { float a = v, b = v; asm volatile("s_nop 1\n\tv_permlane16_swap_b32 %0, %1\n\ts_nop 1" : "+v"(a), "+v"(b)); v = a + b; }
    { float a = v, b = v; asm volatile("s_nop 1\n\tv_permlane32_swap_b32 %0, %1\n\ts_nop 1" : "+v"(a), "+v"(b)); v = a + b; }
    return v; }
struct EpiIn {
    static constexpr bool PERM = true, AFTER_DRAIN = false;
    bf16_t* seg0; size_t sege; const int* pos; unsigned* kmax;
    __device__ __forceinline__ void operator()(const f32x4 (&acc)[2][2][4][2], const Unit& u, int wr_, int wc_, int fr_, int fq_) const {
        int t_ = threadIdx.x; asm volatile("" : "+v"(t_));
        const int wid_ = __builtin_amdgcn_readfirstlane(t_ >> 6), wr = wid_ >> 2, wc = wid_ & 3, fr = t_ & 15, fq = (t_ >> 4) & 3;
        const int t = u.pn >> 2, colt = (u.pn & 3) * BM;
        const int row0 = u.pm * BM + wr * 64 + fr, col0 = colt + wc * 32 + 8 * fq;
        bf16_t* base = seg0 + (size_t)t * sege;
        const bool isqk = (t == 3) || (t == 4);
        const bool ropew = isqk && ((wc & 1) == 0);
        const bool isk = (t == 4);
        const bool oddrow = (fq & 1) != 0;
        int ps[8];
        if (ropew) {
#pragma unroll
            for (int i = 0; i < 8; ++i) ps[i] = pos[row0 + (i >> 2) * HALF + (i & 3) * 16];
        }
        float mx[2] = {0.f, 0.f};
#pragma unroll
        for (int ai = 0; ai < 2; ++ai)
#pragma unroll
            for (int m = 0; m < 4; ++m) { const int row = row0 + ai * HALF + m * 16; bf16_t* rowp = base + (size_t)row * 1024 + col0;
                float cs[8], sn[8];
                if (ropew) { const float p = (float)ps[ai * 4 + m];
#pragma unroll
                    for (int j = 0; j < 8; ++j) { constexpr double L2B = 18.931568569324174;
                        const float k = (float)(__builtin_exp2(-(double)j * 0.125 * L2B) * 0.15915494309189535);
                        const float rv = __builtin_amdgcn_fractf(p * k); const float c_ = __builtin_amdgcn_cosf(rv), s_ = __builtin_amdgcn_sinf(rv);
                        cs[j] = (fq < 2) ? c_ : 1.f; sn[j] = (fq == 0) ? -s_ : ((fq == 1) ? s_ : 0.f); } }
#pragma unroll
                for (int bj = 0; bj < 2; ++bj) { f32x4 v0 = acc[ai][bj][m][0], v1 = acc[ai][bj][m][1];
                    if (ropew) {
#pragma unroll
                        for (int i = 0; i < 4; ++i) { const float p0 = xrow16(v0[i], oddrow), p1 = xrow16(v1[i], oddrow); v0[i] = v0[i] * cs[i] + p0 * sn[i]; v1[i] = v1[i] * cs[4 + i] + p1 * sn[4 + i]; }
                    }
                    u32x4 w; w.x = cvt_pk_bf16(v0[0], v0[1]); w.y = cvt_pk_bf16(v0[2], v0[3]); w.z = cvt_pk_bf16(v1[0], v1[1]); w.w = cvt_pk_bf16(v1[2], v1[3]);
                    *(u32x4*)(rowp + bj * HALF) = w;
                    if (isk) { float ss = (v0[0] * v0[0] + v0[1] * v0[1]) + (v0[2] * v0[2] + v0[3] * v0[3]) + (v1[0] * v1[0] + v1[1] * v1[1]) + (v1[2] * v1[2] + v1[3] * v1[3]);
                        ss = sum_rows4(ss); mx[bj] = fmaxf(mx[bj], ss); } } }
        if (isk) {
#pragma unroll
            for (int bj = 0; bj < 2; ++bj) { float v = mx[bj];
#define DPPF(x, ctl) __builtin_bit_cast(float, __builtin_amdgcn_update_dpp(0, __builtin_bit_cast(int, (x)), (ctl), 0xf, 0xf, false))
                v = fmaxf(v, DPPF(v, 0xB1)); v = fmaxf(v, DPPF(v, 0x4E)); v = fmaxf(v, DPPF(v, 0x141)); v = fmaxf(v, DPPF(v, 0x140));
#undef DPPF
                if ((t_ & 63) == 0) { const int b = u.pm >> 4, head = (u.pn & 3) * 2 + bj, c = wc >> 1, half = wc & 1;
                    atomicMax(kmax + (((b * 8 + head) * 2 + c) * 2 + half), __float_as_uint(v)); } }
        }
    }
};

template <class TX> struct EpiRes {
    static constexpr bool PERM = true, AFTER_DRAIN = false;
    const TX* xin; bf16_t* xout; const float* gate;
    __device__ __forceinline__ void operator()(const f32x4 (&acc)[2][2][4][2], const Unit& u, int wr, int wc, int fr, int fq) const {
        const int row0 = u.pm * BM + wr * 64 + fr, col0 = u.pn * BM + wc * 32 + 8 * fq, b = u.pm >> 4;
        f32x4 g[2][2];
#pragma unroll
        for (int bj = 0; bj < 2; ++bj)
#pragma unroll
            for (int n = 0; n < 2; ++n) g[bj][n] = *(const f32x4*)(gate + (size_t)b * 12288 + col0 + bj * HALF + 4 * n);
#pragma unroll
        for (int ai = 0; ai < 2; ++ai)
#pragma unroll
            for (int m = 0; m < 4; ++m) { const size_t off = (size_t)(row0 + ai * HALF + m * 16) * 2048 + col0;
#pragma unroll
                for (int bj = 0; bj < 2; ++bj) { f32x4 x0, x1;
                    if constexpr (sizeof(TX) == 4) { x0 = *(const f32x4*)((const float*)xin + off + bj * HALF); x1 = *(const f32x4*)((const float*)xin + off + bj * HALF + 4); }
                    else { const u32x4 w = *(const u32x4*)((const bf16_t*)xin + off + bj * HALF); x0 = (f32x4){__builtin_bit_cast(float, w[0] << 16), __builtin_bit_cast(float, w[0] & 0xffff0000u), __builtin_bit_cast(float, w[1] << 16), __builtin_bit_cast(float, w[1] & 0xffff0000u)};
                        x1 = (f32x4){__builtin_bit_cast(float, w[2] << 16), __builtin_bit_cast(float, w[2] & 0xffff0000u), __builtin_bit_cast(float, w[3] << 16), __builtin_bit_cast(float, w[3] & 0xffff0000u)}; }
                    const f32x4 y0 = x0 + g[bj][0] * acc[ai][bj][m][0], y1 = x1 + g[bj][1] * acc[ai][bj][m][1];
                    u32x4 o; o.x = cvt_pk_bf16(y0[0], y0[1]); o.y = cvt_pk_bf16(y0[2], y0[3]); o.z = cvt_pk_bf16(y1[0], y1[1]); o.w = cvt_pk_bf16(y1[2], y1[3]);
                    *(u32x4*)(xout + off + bj * HALF) = o; } }
    }
};

template <class Epi, class Sched, bool ALIGN_EPI = false, bool SP2 = false>
__device__ __forceinline__ void gemm_phase(PG8_LAS unsigned char* lds, const Gemm g, const Sched& S, const Epi& E) {
    int tid_ = threadIdx.x; asm volatile("" : "+v"(tid_));
    const int tid = tid_, wid = __builtin_amdgcn_readfirstlane(tid >> 6), lane = tid & 63, wr = wid >> 2, wc = wid & 3, fr = lane & 15, fq = lane >> 4;
    const int K = g.K, nt = K / BK;
    unsigned voffA[2], voffB[2];
#pragma unroll
    for (int i = 0; i < 2; ++i) { int R, C; stage_rc(tid * 16 + i * 8192, R, C); const int Rb = Epi::PERM ? ((R & ~31) + perm32(R & 31)) : R;
        voffA[i] = (unsigned)(R * K + C) * 2u; voffB[i] = (unsigned)(Rb * K + C) * 2u; }
    const size_t kstep = (size_t)(BK * 2);
    const size_t hstep = (size_t)HALF * K * 2;
    const size_t tstep = 2 * hstep;
    const unsigned ldsw = (unsigned)wid * 1024u;
    const int aoff = lds_byte(wr * 64 + fr, fq * 8), boff = lds_byte(wc * 32 + fr, fq * 8);
#define PG8_SA(b, h) (((b) * 2 + (h)) * HTB)
#define PG8_SB(b, h) ((4 + (b) * 2 + (h)) * HTB)
#define PG8_STAGE(bufoff, gbase, voff) do { _Pragma("unroll") for (int _i = 0; _i < 2; ++_i) \
        __builtin_amdgcn_global_load_lds((const unsigned*)((const char*)(gbase) + (voff)[_i]), (PG8_LAS unsigned*)(lds + (bufoff) + ldsw + _i * 8192), 16, 0, 0); } while (0)
#define PG8_LDA(dst, b, h) do { _Pragma("unroll") for (int m = 0; m < 4; ++m) _Pragma("unroll") for (int k = 0; k < 2; ++k) dst[m][k] = *(const PG8_LAS bf16x8*)(lds + PG8_SA(b, h) + aoff + m * 2048 + k * 1024); } while (0)
#define PG8_LDB(dst, b, h) do { _Pragma("unroll") for (int n = 0; n < 2; ++n) _Pragma("unroll") for (int k = 0; k < 2; ++k) dst[n][k] = *(const PG8_LAS bf16x8*)(lds + PG8_SB(b, h) + boff + n * 2048 + k * 1024); } while (0)
#define PG8_MMA(ai, bj, At, Bt) do { __builtin_amdgcn_s_setprio(1); _Pragma("unroll") for (int m = 0; m < 4; ++m) _Pragma("unroll") for (int n = 0; n < 2; ++n) _Pragma("unroll") for (int k = 0; k < 2; ++k) \
        acc[ai][bj][m][n] = __builtin_amdgcn_mfma_f32_16x16x32_bf16(Bt[n][k], At[m][k], acc[ai][bj][m][n], 0, 0, 0); __builtin_amdgcn_s_setprio(0); } while (0)
#define PG8_WAIT_V(n) asm volatile("s_waitcnt vmcnt(" #n ")" ::: "memory")
#define PG8_WAIT_L(n) asm volatile("s_waitcnt lgkmcnt(" #n ")" ::: "memory")
#define PG8_BAR __builtin_amdgcn_s_barrier()
#define PG8_SCHED __builtin_amdgcn_sched_barrier(0)
    Unit cur, nxt; int ui = 0;
    if (!S.next(0, cur)) return;
    f32x4 acc[2][2][4][2];
#pragma unroll
    for (int a = 0; a < 2; ++a)
#pragma unroll
        for (int b = 0; b < 2; ++b)
#pragma unroll
            for (int m = 0; m < 4; ++m)
#pragma unroll
                for (int n = 0; n < 2; ++n) acc[a][b][m][n] = (f32x4){0.f, 0.f, 0.f, 0.f};
    bf16x8 At[4][2], B0[2][2], B1[2][2];
    const char* cA = (const char*)g.A + (size_t)cur.pm * tstep; const char* cB = (const char*)g.Bt + (size_t)cur.pn * tstep;
    S.a_ready(cur);
    if constexpr (SP2) {
        PG8_STAGE(PG8_SB(0, 0), cB, voffB); PG8_STAGE(PG8_SB(0, 1), cB + hstep, voffB); PG8_STAGE(PG8_SA(0, 0), cA, voffA); PG8_STAGE(PG8_SA(0, 1), cA + hstep, voffA);
        if (wr == 1) PG8_BAR;
        PG8_WAIT_V(2); PG8_BAR;
        PG8_STAGE(PG8_SB(1, 0), cB + kstep, voffB); PG8_STAGE(PG8_SA(1, 0), cA + kstep, voffA); PG8_STAGE(PG8_SB(1, 1), cB + hstep + kstep, voffB);
        PG8_WAIT_V(6); PG8_BAR;
    } else {
        PG8_STAGE(PG8_SB(0, 0), cB, voffB); PG8_STAGE(PG8_SA(0, 0), cA, voffA); PG8_STAGE(PG8_SB(0, 1), cB + hstep, voffB); PG8_STAGE(PG8_SA(0, 1), cA + hstep, voffA);
        if (wr == 1) PG8_BAR;
        PG8_WAIT_V(4); PG8_BAR;
        PG8_STAGE(PG8_SB(1, 0), cB + kstep, voffB); PG8_STAGE(PG8_SA(1, 0), cA + kstep, voffA); PG8_STAGE(PG8_SB(1, 1), cB + hstep + kstep, voffB);
        PG8_WAIT_V(6); PG8_BAR;
    }
    for (;;) {
        const bool has_next = S.next(ui + 1, nxt);
        const char* nA = has_next ? (const char*)g.A + (size_t)nxt.pm * tstep : cA; const char* nB = has_next ? (const char*)g.Bt + (size_t)nxt.pn * tstep : cB;
        for (int t = 0; t < nt; t += 2) {
            const bool last = (t == nt - 2);
            const char* a1 = cA + (size_t)(t + 1) * kstep;
            const char* a2 = last ? nA : cA + (size_t)(t + 2) * kstep; const char* b2 = last ? nB : cB + (size_t)(t + 2) * kstep;
            const char* a3 = a2 + kstep; const char* b3 = b2 + kstep;
            if (last && has_next) S.a_ready(nxt);
            if constexpr (SP2) {
            PG8_LDB(B0, 0, 0); PG8_LDB(B1, 0, 1); PG8_SCHED; PG8_LDA(At, 0, 0); PG8_STAGE(PG8_SA(1, 1), a1 + hstep, voffA);
            PG8_WAIT_V(8); PG8_WAIT_L(0); PG8_BAR; PG8_MMA(0, 0, At, B0); PG8_MMA(0, 1, At, B1); PG8_BAR; PG8_SCHED;
            PG8_LDA(At, 0, 1); PG8_STAGE(PG8_SB(0, 0), b2, voffB); PG8_STAGE(PG8_SB(0, 1), b2 + hstep, voffB); PG8_STAGE(PG8_SA(0, 0), a2, voffA);
            PG8_WAIT_V(8); PG8_WAIT_L(0); PG8_BAR; PG8_MMA(1, 0, At, B0); PG8_MMA(1, 1, At, B1); PG8_BAR; PG8_SCHED;
            PG8_LDB(B0, 1, 0); PG8_LDB(B1, 1, 1); PG8_SCHED; PG8_LDA(At, 1, 0); PG8_STAGE(PG8_SA(0, 1), a2 + hstep, voffA);
            PG8_WAIT_V(8); PG8_WAIT_L(0); PG8_BAR; PG8_MMA(0, 0, At, B0); PG8_MMA(0, 1, At, B1); PG8_BAR; PG8_SCHED;
            PG8_LDA(At, 1, 1); PG8_STAGE(PG8_SB(1, 0), b3, voffB); PG8_STAGE(PG8_SB(1, 1), b3 + hstep, voffB); PG8_STAGE(PG8_SA(1, 0), a3, voffA);
            PG8_WAIT_V(8); PG8_WAIT_L(0); PG8_BAR; PG8_MMA(1, 0, At, B0); PG8_MMA(1, 1, At, B1); PG8_BAR; PG8_SCHED;
            } else {
            PG8_LDB(B0, 0, 0); PG8_SCHED; PG8_LDA(At, 0, 0); PG8_STAGE(PG8_SA(1, 1), a1 + hstep, voffA);
            PG8_WAIT_L(8); PG8_BAR; PG8_WAIT_L(0); PG8_MMA(0, 0, At, B0); PG8_BAR; PG8_SCHED;
            PG8_LDB(B1, 0, 1); PG8_STAGE(PG8_SB(0, 0), b2, voffB);
            PG8_BAR; PG8_WAIT_L(0); PG8_MMA(0, 1, At, B1); PG8_BAR;
            PG8_LDA(At, 0, 1); PG8_STAGE(PG8_SA(0, 0), a2, voffA);
            PG8_BAR; PG8_WAIT_L(0); PG8_MMA(1, 0, At, B0); PG8_BAR; PG8_SCHED;
            PG8_STAGE(PG8_SB(0, 1), b2 + hstep, voffB);
            PG8_WAIT_V(6); PG8_BAR; PG8_MMA(1, 1, At, B1); PG8_BAR;
            PG8_LDB(B0, 1, 0); PG8_SCHED; PG8_LDA(At, 1, 0); PG8_STAGE(PG8_SA(0, 1), a2 + hstep, voffA);
            PG8_WAIT_L(8); PG8_BAR; PG8_WAIT_L(0); PG8_MMA(0, 0, At, B0); PG8_BAR; PG8_SCHED;
            PG8_LDB(B1, 1, 1); PG8_STAGE(PG8_SB(1, 0), b3, voffB);
            PG8_BAR; PG8_WAIT_L(0); PG8_MMA(0, 1, At, B1); PG8_BAR;
            PG8_LDA(At, 1, 1); PG8_STAGE(PG8_SA(1, 0), a3, voffA);
            PG8_BAR; PG8_WAIT_L(0); PG8_MMA(1, 0, At, B0); PG8_BAR; PG8_SCHED;
            PG8_STAGE(PG8_SB(1, 1), b3 + hstep, voffB);
            PG8_WAIT_V(6); PG8_BAR; PG8_MMA(1, 1, At, B1); PG8_BAR;
            }
        }
        if constexpr (ALIGN_EPI) { if (wr == 0) PG8_BAR; }
        if constexpr (!Epi::AFTER_DRAIN) { E(acc, cur, wr, wc, fr, fq); S.done(cur); }
        if (!has_next) break;
#pragma unroll
        for (int a = 0; a < 2; ++a)
#pragma unroll
            for (int b = 0; b < 2; ++b)
#pragma unroll
                for (int m = 0; m < 4; ++m)
#pragma unroll
                    for (int n = 0; n < 2; ++n) acc[a][b][m][n] = (f32x4){0.f, 0.f, 0.f, 0.f};
        cur = nxt; cA = nA; cB = nB; ++ui;
        if constexpr (ALIGN_EPI) { if (wr == 1) PG8_BAR; }
    }
    PG8_WAIT_V(0);
    if constexpr (!ALIGN_EPI) { if (wr == 0) PG8_BAR; }
    PG8_BAR;
    if constexpr (Epi::AFTER_DRAIN) { E.fused(acc, cur, wr, wc, fr, fq, lds, wid, lane); S.done(cur); }
#undef PG8_SA
#undef PG8_SB
#undef PG8_STAGE
#undef PG8_LDA
#undef PG8_LDB
#undef PG8_MMA
#undef PG8_WAIT_V
#undef PG8_WAIT_L
#undef PG8_BAR
#undef PG8_SCHED
}
}

#define XB_TMO      128
#define XB_XCNT(j)  (256  + 64 * (j))
#define XB_XSUB(j)  (1280 + 64 * (j))
#define XB_XGEN(j)  (2304 + 64 * (j))
#define XB_TOP      3328
#define XB_TOPGEN   3392
#define XCD_BAR_WORDS 3456
#define XB_SPIN_CAP (1u << 18)

__device__ __forceinline__ unsigned xb_ld(unsigned* p)              { return __hip_atomic_load(p, __ATOMIC_RELAXED, __HIP_MEMORY_SCOPE_AGENT); }
__device__ __forceinline__ unsigned xb_add(unsigned* p, unsigned v) { return __hip_atomic_fetch_add(p, v, __ATOMIC_RELAXED, __HIP_MEMORY_SCOPE_AGENT); }
__device__ __forceinline__ unsigned xb_xcc_id() { return (unsigned)__builtin_amdgcn_s_getreg((3 << 11) | 20) & 0xFu; }
#define XB_SPIN(cond, bar) do { unsigned _sp = 0; while (cond) { __builtin_amdgcn_s_sleep(1); \
    if ((++_sp & 255u) == 0u) { if (xb_ld(&(bar)[XB_TMO])) break; if (_sp > XB_SPIN_CAP) { atomicAdd(&(bar)[XB_TMO], 1u); break; } } } } while (0)

struct XcdBarrier {
    unsigned* bar; unsigned x;
    volatile LAS unsigned* st;
};

__device__ __forceinline__ XcdBarrier xcd_barrier_post(unsigned* bar, volatile LAS unsigned* st) {
    XcdBarrier b; b.bar = bar; b.x = xb_xcc_id(); b.st = st;
    if (threadIdx.x == 0) (void)xb_add(&bar[XB_XCNT(b.x)], 1u);
    return b;
}
__device__ __forceinline__ void xcd_barrier_complete(unsigned* bar, unsigned x, unsigned& nloc, unsigned& nx) {
    const unsigned G = gridDim.x * gridDim.y * gridDim.z;
    unsigned sum, cnt, mine, sp = 0u;
    for (;;) {
        sum = 0u; cnt = 0u; mine = 0u;
#pragma unroll
        for (unsigned j = 0; j < 16; ++j) { const unsigned c = xb_ld(&bar[XB_XCNT(j)]); sum += c; cnt += (c > 0u) ? 1u : 0u; mine = (j == x) ? c : mine; }
        if (sum == G) break;
        __builtin_amdgcn_s_sleep(1);
        if ((++sp & 255u) == 0u) { if (xb_ld(&bar[XB_TMO])) break; if (sp > XB_SPIN_CAP) { atomicAdd(&bar[XB_TMO], 1u); break; } }
    }
    nloc = mine > 0u ? mine : 1u; nx = cnt > 0u ? cnt : 1u;
}

__device__ __forceinline__ void xcd_barrier(const XcdBarrier& b) {
    asm volatile("s_waitcnt vmcnt(0)" ::: "memory");
    __syncthreads();
    if (threadIdx.x == 0) {
        unsigned* bar = b.bar;
        __builtin_amdgcn_s_waitcnt(0);
        unsigned nloc = b.st[0], nx = b.st[1];
        if (nloc == 0u) { xcd_barrier_complete(bar, b.x, nloc, nx); b.st[0] = nloc; b.st[1] = nx; }
        const unsigned old = xb_add(&bar[XB_XSUB(b.x)], 1u);
        const unsigned gen = old / nloc;
        if (old + 1u == (gen + 1u) * nloc) {
            __builtin_amdgcn_fence(__ATOMIC_RELEASE, "agent");
            asm volatile("s_waitcnt vmcnt(0)" ::: "memory");
            const unsigned og = xb_add(&bar[XB_TOP], 1u);
            const unsigned tg = og / nx;
            if (og + 1u == (tg + 1u) * nx) xb_add(&bar[XB_TOPGEN], 1u);
            else XB_SPIN(xb_ld(&bar[XB_TOPGEN]) == tg, bar);
            __builtin_amdgcn_fence(__ATOMIC_ACQUIRE, "agent");
            xb_add(&bar[XB_XGEN(b.x)], 1u);
            asm volatile("s_waitcnt vmcnt(0)" ::: "memory");
        } else {
            XB_SPIN(xb_ld(&bar[XB_XGEN(b.x)]) == gen, bar);
            __builtin_amdgcn_fence(__ATOMIC_ACQUIRE, "agent");
            asm volatile("s_waitcnt vmcnt(0)" ::: "memory");
        }
    }
    __syncthreads();
}

#define LDS_WAIT() asm volatile("s_waitcnt lgkmcnt(0)" ::: "memory")
#define VM_WAIT() asm volatile("s_waitcnt vmcnt(0)" ::: "memory")
__device__ __forceinline__ unsigned f2bf(float f) { unsigned u = __builtin_bit_cast(unsigned, f); return (u + 0x7fffu + ((u >> 16) & 1u)) >> 16; }
__device__ __forceinline__ unsigned pk2(float lo, float hi) { return f2bf(lo) | (f2bf(hi) << 16); }
__device__ __forceinline__ float bf_lo(unsigned w) { return __builtin_bit_cast(float, w << 16); }
__device__ __forceinline__ float bf_hi(unsigned w) { return __builtin_bit_cast(float, w & 0xffff0000u); }
__device__ __forceinline__ float wave_sum(float v) {
#pragma unroll
    for (int o = 1; o < 64; o <<= 1) v += __shfl_xor(v, o);
    return v;
}

struct Ctx {
    LAS unsigned char* lds;
    unsigned char* ws;
    int tid, lane, wave, vcu, G, gw, NGW;
    float* out;
};

__device__ __forceinline__ void p0_transpose_item(const float* W, int K, int N, bf16_t* WT, LAS float* scr, int item, int lane) {
    const int nblk = N / 64, kb = item / nblk, nb = item % nblk, k0 = 64 * kb, n0 = 64 * nb;
    const int cg = lane & 15, rp = lane >> 4;
    const float* src = W + (size_t)(k0 + 2 * rp) * N + n0 + 4 * cg;
    f32x4 xe[8], xo[8];
#pragma unroll
    for (int s = 0; s < 8; ++s) { xe[s] = *(const f32x4*)(src + (size_t)(8 * s) * N); xo[s] = *(const f32x4*)(src + (size_t)(8 * s + 1) * N); }
    LAS unsigned* T = (LAS unsigned*)scr;
#pragma unroll
    for (int s = 0; s < 8; ++s) {
#pragma unroll
        for (int j = 0; j < 4; ++j) T[(4 * cg + j) * 33 + 4 * s + rp] = pk2(xe[s][j], xo[s][j]); }
    LDS_WAIT(); asm volatile("" ::: "memory");
    const int c = lane & 7;
#pragma unroll
    for (int j = 0; j < 8; ++j) { const int n = (lane >> 3) + 8 * j; const LAS unsigned* s = T + n * 33 + 4 * c;
        u32x4 o; o.x = s[0]; o.y = s[1]; o.z = s[2]; o.w = s[3];
        *(u32x4*)(WT + (size_t)(n0 + n) * K + k0 + 8 * c) = o; }
    LDS_WAIT(); asm volatile("" ::: "memory");
}
__device__ __forceinline__ void p0_cvt_row(const float* src, bf16_t* dst, int lane) {
#pragma unroll
    for (int j = 0; j < 4; ++j) { const f32x4 a = *(const f32x4*)(src + 512 * j + 8 * lane), b = *(const f32x4*)(src + 512 * j + 8 * lane + 4);
        u32x4 o; o.x = pk2(a[0], a[1]); o.y = pk2(a[2], a[3]); o.z = pk2(b[0], b[1]); o.w = pk2(b[2], b[3]);
        *(u32x4*)(dst + 512 * j + 8 * lane) = o; }
}
__device__ __forceinline__ void p0_cvt_row_fp8(const float* src, unsigned char* dst_tab, int row, float* inv_scale, int lane) {
    f32x4 v[8]; float amax = 0.f;
#pragma unroll
    for (int j = 0; j < 2; ++j)
#pragma unroll
        for (int q = 0; q < 4; ++q) { const f32x4 a = *(const f32x4*)(src + 1024 * j + 16 * lane + 4 * q); v[4 * j + q] = a;
            amax = fmaxf(amax, fmaxf(fmaxf(fabsf(a[0]), fabsf(a[1])), fmaxf(fabsf(a[2]), fabsf(a[3])))); }
#pragma unroll
    for (int o = 1; o < 64; o <<= 1) amax = fmaxf(amax, __shfl_xor(amax, o));
    const float sc = amax > 0.f ? 448.0f / amax : 1.0f;
#pragma unroll
    for (int j = 0; j < 2; ++j) { u32x4 o;
#pragma unroll
        for (int q = 0; q < 4; ++q) { const f32x4 a = v[4 * j + q] * sc; int w = 0; w = __builtin_amdgcn_cvt_pk_fp8_f32(a[0], a[1], w, false); w = __builtin_amdgcn_cvt_pk_fp8_f32(a[2], a[3], w, true); o[q] = (unsigned)w; }
        const int slice = 8 * j + (lane >> 3);
        *(u32x4*)(dst_tab + ((size_t)slice * NEXP + row) * 128 + 16 * (lane & 7)) = o; }
    if (lane == 0) *inv_scale = amax > 0.f ? amax * (1.0f / 448.0f) : 1.0f;
}
__device__ __forceinline__ unsigned pack_i8x4(f32x4 a) { const int q0 = __float2int_rn(a[0]), q1 = __float2int_rn(a[1]), q2 = __float2int_rn(a[2]), q3 = __float2int_rn(a[3]);
    return (unsigned)(q0 & 0xff) | ((unsigned)(q1 & 0xff) << 8) | ((unsigned)(q2 & 0xff) << 16) | ((unsigned)(q3 & 0xff) << 24); }
__device__ __forceinline__ void p0_cvt_row_i8(const float* src, unsigned char* dst_tab, int row, float* inv_scale, int lane) {
    f32x4 v[8]; float amax = 0.f;
#pragma unroll
    for (int j = 0; j < 2; ++j)
#pragma unroll
        for (int q = 0; q < 4; ++q) { const f32x4 a = *(const f32x4*)(src + 1024 * j + 16 * lane + 4 * q); v[4 * j + q] = a;
            amax = fmaxf(amax, fmaxf(fmaxf(fabsf(a[0]), fabsf(a[1])), fmaxf(fabsf(a[2]), fabsf(a[3])))); }
#pragma unroll
    for (int o = 1; o < 64; o <<= 1) amax = fmaxf(amax, __shfl_xor(amax, o));
    const float sc = amax > 0.f ? 127.0f / amax : 1.0f;
#pragma unroll
    for (int j = 0; j < 2; ++j) { u32x4 o;
#pragma unroll
        for (int q = 0; q < 4; ++q) o[q] = pack_i8x4(v[4 * j + q] * sc);
        const int slice = 8 * j + (lane >> 3);
        *(u32x4*)(dst_tab + ((size_t)slice * NEXP + row) * 128 + 16 * (lane & 7)) = o; }
    if (lane == 0) *inv_scale = amax > 0.f ? amax * (1.0f / 127.0f) : 1.0f;
}
__device__ __forceinline__ void p0_adaln_task(const float* c, const float* ada_w, float* modp, LAS float* scr, int task, int lane) {
    const int ks = task & 7, cg = (task >> 3) % 48, l = task / 384;
#pragma unroll
    for (int i = 0; i < 32; ++i) { const int e = i * 64 + lane, k = e >> 3, b = e & 7; const float x = c[b * DM + ks * 256 + k];
        scr[e] = x / (1.f + expf(-x)); }
    LDS_WAIT(); asm volatile("" ::: "memory");
    const float* wp = ada_w + ((size_t)l * DM + ks * 256) * MODW + cg * 256 + lane * 4;
    f32x4 acc[8];
#pragma unroll
    for (int b = 0; b < 8; ++b) acc[b] = (f32x4){0.f, 0.f, 0.f, 0.f};
#pragma unroll 16
    for (int k = 0; k < 256; ++k) { const f32x4 w = *(const f32x4*)(wp + (size_t)k * MODW);
        const f32x4 s0 = *(const LAS f32x4*)(scr + k * 8), s1 = *(const LAS f32x4*)(scr + k * 8 + 4);
        acc[0] += w * s0[0]; acc[1] += w * s0[1]; acc[2] += w * s0[2]; acc[3] += w * s0[3];
        acc[4] += w * s1[0]; acc[5] += w * s1[1]; acc[6] += w * s1[2]; acc[7] += w * s1[3]; }
#pragma unroll
    for (int b = 0; b < 8; ++b) *(f32x4*)(modp + (((size_t)ks * DEPTH + l) * NBATCH + b) * MODW + cg * 256 + lane * 4) = acc[b];
    LDS_WAIT(); asm volatile("" ::: "memory");
}
struct Args;
template <class A> __device__ __forceinline__ void p0_prologue(Ctx& C, const A& args) {
    LAS float* scr = (LAS float*)(C.lds + C.wave * 16384);
    const float* w_in = args.in[6]; const float* w_out = args.in[13]; const float* wq = args.in[15];
    bf16_t* WIN = (bf16_t*)(C.ws + WS_WIN); bf16_t* WOUT = (bf16_t*)(C.ws + WS_WOUT); bf16_t* WQ = (bf16_t*)(C.ws + WS_WQ);
    constexpr int T_ADA = 4 * 48 * 8;
    constexpr int I_IN = (DM / 64) * (INC / 64), I_SQ = (DM / 64) * (DM / 64);
    constexpr int T_IN = 4 * I_IN, T_OUT = 4 * I_SQ, T_WQ = 4 * I_SQ;
    constexpr int T_KEYS = 4 * 16 * 128 * 128 / 2048;
    constexpr int T_UV = 4 * NEXP;
    constexpr int T_ROPE = 0;
    constexpr int NT = T_ADA + T_IN + T_OUT + T_WQ + T_KEYS + T_ROPE + 1;
    for (int it = C.wave * C.G + C.vcu; it < NT; it += C.NGW) {
        int r = it;
        if (r < T_ADA) { p0_adaln_task(args.in[1], args.in[3], (float*)(C.ws + WS_MODP), scr, r, C.lane); continue; } r -= T_ADA;
        if (r < T_IN) { const int l = r / I_IN; p0_transpose_item(w_in + (size_t)l * DM * INC, DM, INC, WIN + (size_t)l * INC * DM, scr, r % I_IN, C.lane); continue; } r -= T_IN;
        if (r < T_OUT) { const int l = r / I_SQ; p0_transpose_item(w_out + (size_t)l * DM * DM, DM, DM, WOUT + (size_t)l * DM * DM, scr, r % I_SQ, C.lane); continue; } r -= T_OUT;
        if (r < T_WQ) { const int l = r / I_SQ; p0_transpose_item(wq + (size_t)l * DM * DM, DM, DM, WQ + (size_t)l * DM * DM, scr, r % I_SQ, C.lane); continue; } r -= T_WQ;
        if (r < T_KEYS) { p0_cvt_row(args.in[16] + (size_t)r * 2048, (bf16_t*)(C.ws + WS_KEYS) + (size_t)r * 2048, C.lane); continue; } r -= T_KEYS;
        if (r < T_ROPE) {
            const int row = r * 64 + C.lane; const float pos = (float)((const int*)args.in[2])[row]; float* o = (float*)(C.ws + WS_ROPE) + (size_t)row * 16;
#pragma unroll
            for (int j = 0; j < 8; ++j) { const float invf = exp2f(-(float)j * 0.125f * 18.931568569324174f);
                const float ang = pos * invf; double rev = (double)ang * 0.15915494309189535; rev -= __builtin_rint(rev);
                const float rf = (float)rev; o[j] = __builtin_amdgcn_cosf(rf); o[8 + j] = __builtin_amdgcn_sinf(rf); }
            continue; } r -= T_ROPE;
        {
            float* lam = (float*)(C.ws + WS_LAM);
            for (int l = 0; l < DEPTH; ++l) {
                const float a = wave_sum(args.in[8][l * 64 + C.lane] * args.in[9][l * 64 + C.lane]), b = wave_sum(args.in[10][l * 64 + C.lane] * args.in[11][l * 64 + C.lane]);
                const float li = 0.8f - 0.6f * expf(-0.3f * (float)l);
                if (C.lane == 0) { lam[l] = expf(a) - expf(b) + li; lam[4 + l] = 1.f - li; } }
        }
    }
}
template <int R> __device__ __forceinline__ void p0_cvt_rowsN_i8(const float* src, unsigned char* dst_tab, int row, float* inv_scale, int lane) {
    f32x4 v[R][8];
#pragma unroll
    for (int u = 0; u < R; ++u)
#pragma unroll
        for (int j = 0; j < 2; ++j)
#pragma unroll
            for (int q = 0; q < 4; ++q) v[u][4 * j + q] = *(const f32x4*)(src + (size_t)u * 2048 + 1024 * j + 16 * lane + 4 * q);
#pragma unroll
    for (int u = 0; u < R; ++u) { float amax = 0.f;
#pragma unroll
        for (int k = 0; k < 8; ++k) { const f32x4 a = v[u][k]; amax = fmaxf(amax, fmaxf(fmaxf(fabsf(a[0]), fabsf(a[1])), fmaxf(fabsf(a[2]), fabsf(a[3])))); }
#pragma unroll
        for (int o = 1; o < 64; o <<= 1) amax = fmaxf(amax, __shfl_xor(amax, o));
        const float sc = amax > 0.f ? 127.0f / amax : 1.0f;
#pragma unroll
        for (int j = 0; j < 2; ++j) { u32x4 o;
#pragma unroll
            for (int q = 0; q < 4; ++q) o[q] = pack_i8x4(v[u][4 * j + q] * sc);
            const int slice = 8 * j + (lane >> 3);
            *(u32x4*)(dst_tab + ((size_t)slice * NEXP + row + u) * 128 + 16 * (lane & 7)) = o; }
        if (lane == 0) inv_scale[u] = amax > 0.f ? amax * (1.0f / 127.0f) : 1.0f; }
}
template <class A> __device__ __forceinline__ void uv_convert_chunk(Ctx& C, const A& args, int chunk, int lane_) {
#pragma unroll 1
    for (int i = 0; i < 8; i += 2) { int r = chunk * 64 + C.wave * 8 + i;
        if (r < 4 * NEXP) p0_cvt_rowsN_i8<2>(args.in[17] + (size_t)r * 2048, C.ws + WS_U + (size_t)(r / NEXP) * NEXP * DM, r % NEXP, (float*)(C.ws + WS_USC) + r, lane_);
        else { r -= 4 * NEXP; p0_cvt_rowsN_i8<2>(args.in[18] + (size_t)r * 2048, C.ws + WS_V + (size_t)(r / NEXP) * NEXP * DM, r % NEXP, (float*)(C.ws + WS_VSC) + r, lane_); } }
}
__device__ __forceinline__ void p1_modfinal(Ctx& C, const float* ada_b) {
    const float* modp = (const float*)(C.ws + WS_MODP); float* mod = (float*)(C.ws + WS_MOD);
    constexpr int N4 = DEPTH * NBATCH * MODW / 4;
    for (int i = C.vcu * NTHREADS + C.tid; i < N4; i += C.G * NTHREADS) { const int l = i / (NBATCH * MODW / 4), n4 = i % (MODW / 4);
        f32x4 s = *(const f32x4*)(ada_b + (size_t)l * MODW + n4 * 4);
#pragma unroll
        for (int ks = 0; ks < 8; ++ks) s += *(const f32x4*)(modp + (size_t)ks * DEPTH * NBATCH * MODW + (size_t)i * 4);
        *(f32x4*)(mod + (size_t)i * 4) = s; }
}

template <class TX> __device__ __forceinline__ void ld8(const TX* p, f32x4& a, f32x4& c);
template <> __device__ __forceinline__ void ld8<float>(const float* p, f32x4& a, f32x4& c) { a = *(const f32x4*)p; c = *(const f32x4*)(p + 4); }
template <> __device__ __forceinline__ void ld8<bf16_t>(const bf16_t* p, f32x4& a, f32x4& c) { const u32x4 w = *(const u32x4*)p; a = (f32x4){bf_lo(w[0]), bf_hi(w[0]), bf_lo(w[1]), bf_hi(w[1])}; c = (f32x4){bf_lo(w[2]), bf_hi(w[2]), bf_lo(w[3]), bf_hi(w[3])}; }
template <class TX> __device__ __forceinline__ void norm_pass(Ctx& C, const TX* x, bf16_t* H, const float* g, const float* sh, const float* sc, unsigned char* HQ = nullptr, float* HSC = nullptr) {
    for (int ch = C.gw; ch < MTOK / 16; ch += C.NGW) { const int row0 = ch * 16, b = row0 >> 12;
        f32x4 G[8], S[8];
        { const float* gp = g + 8 * C.lane; const float* shp = sh + (size_t)b * MODW + 8 * C.lane; const float* scp = sc + (size_t)b * MODW + 8 * C.lane;
#pragma unroll
          for (int j = 0; j < 4; ++j)
#pragma unroll
              for (int q = 0; q < 2; ++q) { G[2 * j + q] = *(const f32x4*)(gp + 512 * j + 4 * q) * (*(const f32x4*)(scp + 512 * j + 4 * q) + 1.0f); S[2 * j + q] = *(const f32x4*)(shp + 512 * j + 4 * q); } }
#pragma unroll 1
        for (int i = 0; i < 16; i += 2) {
            f32x4 v[2][8];
#pragma unroll
            for (int u = 0; u < 2; ++u) { const TX* xr = x + (size_t)(row0 + i + u) * DM + 8 * C.lane;
#pragma unroll
                for (int j = 0; j < 4; ++j) ld8<TX>(xr + 512 * j, v[u][2 * j], v[u][2 * j + 1]); }
#pragma unroll
            for (int u = 0; u < 2; ++u) { const int row = row0 + i + u; float ss = 0.f;
#pragma unroll
                for (int j = 0; j < 8; ++j) { const f32x4 a = v[u][j]; ss += (a[0] * a[0] + a[1] * a[1]) + (a[2] * a[2] + a[3] * a[3]); }
                const float rstd = 1.0f / sqrtf(wave_sum(ss) * (1.f / DM) + NORM_EPS);
                float amax = 0.f;
#pragma unroll
                for (int j = 0; j < 4; ++j) {
#pragma unroll
                    for (int q = 0; q < 2; ++q) { const f32x4 o = (v[u][2 * j + q] * rstd) * G[2 * j + q] + S[2 * j + q]; v[u][2 * j + q] = o;
                        amax = fmaxf(amax, fmaxf(fmaxf(fabsf(o[0]), fabsf(o[1])), fmaxf(fabsf(o[2]), fabsf(o[3])))); }
                    u32x4 w; w.x = pk2(v[u][2 * j][0], v[u][2 * j][1]); w.y = pk2(v[u][2 * j][2], v[u][2 * j][3]); w.z = pk2(v[u][2 * j + 1][0], v[u][2 * j + 1][1]); w.w = pk2(v[u][2 * j + 1][2], v[u][2 * j + 1][3]);
                    *(u32x4*)(H + (size_t)row * DM + 512 * j + 8 * C.lane) = w; }
                if (HQ) {
#pragma unroll
                    for (int o = 1; o < 64; o <<= 1) amax = fmaxf(amax, __shfl_xor(amax, o));
                    const float qs = amax > 0.f ? 127.0f / amax : 1.0f;
#pragma unroll
                    for (int j = 0; j < 4; ++j) *(u32x2*)(HQ + (size_t)row * DM + 512 * j + 8 * C.lane) = (u32x2){pack_i8x4(v[u][2 * j] * qs), pack_i8x4(v[u][2 * j + 1] * qs)};
                    if (C.lane == 0) HSC[row] = amax > 0.f ? amax * (1.0f / 127.0f) : 1.0f; } }
        }
    }
}
__device__ __forceinline__ void final_norm_pass(Ctx& C, const bf16_t* x, float* out, const float* g) {
    f32x4 G[8];
#pragma unroll
    for (int j = 0; j < 4; ++j)
#pragma unroll
        for (int q = 0; q < 2; ++q) G[2 * j + q] = *(const f32x4*)(g + 8 * C.lane + 512 * j + 4 * q);
    for (int ch = C.gw; ch < MTOK / 16; ch += C.NGW) { const int row0 = ch * 16;
#pragma unroll 1
        for (int i = 0; i < 16; i += 2) {
            f32x4 v[2][8];
#pragma unroll
            for (int u = 0; u < 2; ++u) { const bf16_t* xr = x + (size_t)(row0 + i + u) * DM + 8 * C.lane;
#pragma unroll
                for (int j = 0; j < 4; ++j) ld8<bf16_t>(xr + 512 * j, v[u][2 * j], v[u][2 * j + 1]); }
#pragma unroll
            for (int u = 0; u < 2; ++u) { const int row = row0 + i + u; float ss = 0.f;
#pragma unroll
                for (int j = 0; j < 8; ++j) { const f32x4 a = v[u][j]; ss += (a[0] * a[0] + a[1] * a[1]) + (a[2] * a[2] + a[3] * a[3]); }
                const float rstd = 1.0f / sqrtf(wave_sum(ss) * (1.f / DM) + NORM_EPS);
#pragma unroll
                for (int j = 0; j < 4; ++j)
#pragma unroll
                    for (int q = 0; q < 2; ++q) *(f32x4*)(out + (size_t)row * DM + 8 * C.lane + 512 * j + 4 * q) = (v[u][2 * j + q] * rstd) * G[2 * j + q]; }
        }
    }
}

__device__ __forceinline__ void conv_chunk(const bf16_t* GBp, const bf16_t* GCp, const bf16_t* HVp, const float* cw, bf16_t* MIXp, int chunk, int tid) {
    const int c0 = (tid & 127) * 8, r0 = chunk * 128 + (tid >> 7) * 32;
    float w0[8], w1[8], w2[8];
#pragma unroll
    for (int i = 0; i < 8; ++i) { w0[i] = cw[c0 + i]; w1[i] = cw[1024 + c0 + i]; w2[i] = cw[2048 + c0 + i]; }
    float zp[8], zc[8];
    auto zmul = [&](const u32x4& a, const u32x4& h, bool ok, float (&z)[8]) {
#pragma unroll
        for (int i = 0; i < 4; ++i) { z[2 * i] = ok ? bf_lo(a[i]) * bf_lo(h[i]) : 0.f; z[2 * i + 1] = ok ? bf_hi(a[i]) * bf_hi(h[i]) : 0.f; } };
    {
        const bool okp = (r0 & (SEQ - 1)) != 0; const int rp = okp ? r0 - 1 : r0;
        const u32x4 ap = *(const u32x4*)(GCp + (size_t)rp * 1024 + c0), hp = *(const u32x4*)(HVp + (size_t)rp * 1024 + c0);
        const u32x4 ac = *(const u32x4*)(GCp + (size_t)r0 * 1024 + c0), hc = *(const u32x4*)(HVp + (size_t)r0 * 1024 + c0);
        zmul(ap, hp, okp, zp); zmul(ac, hc, true, zc);
    }
#pragma unroll 1
    for (int r = r0; r < r0 + 32; r += 4) {
        u32x4 A[4], Hh[4], G[4]; bool ok[4];
#pragma unroll
        for (int j = 0; j < 4; ++j) { const int rn = r + 1 + j; ok[j] = (rn & (SEQ - 1)) != 0 || rn < r0 + 32; const int rc = ok[j] ? rn : r;
            A[j] = *(const u32x4*)(GCp + (size_t)rc * 1024 + c0); Hh[j] = *(const u32x4*)(HVp + (size_t)rc * 1024 + c0); G[j] = *(const u32x4*)(GBp + (size_t)(r + j) * 1024 + c0); }
#pragma unroll
        for (int j = 0; j < 4; ++j) { float zn[8]; zmul(A[j], Hh[j], ok[j], zn);
            float y[8];
#pragma unroll
            for (int i = 0; i < 4; ++i) { y[2 * i] = bf_lo(G[j][i]) * (w0[2 * i] * zp[2 * i] + w1[2 * i] * zc[2 * i] + w2[2 * i] * zn[2 * i]);
                y[2 * i + 1] = bf_hi(G[j][i]) * (w0[2 * i + 1] * zp[2 * i + 1] + w1[2 * i + 1] * zc[2 * i + 1] + w2[2 * i + 1] * zn[2 * i + 1]); }
            u32x4 o; o.x = pk2(y[0], y[1]); o.y = pk2(y[2], y[3]); o.z = pk2(y[4], y[5]); o.w = pk2(y[6], y[7]);
            *(u32x4*)(MIXp + (size_t)(r + j) * 2048 + c0) = o;
#pragma unroll
            for (int i = 0; i < 8; ++i) { zp[i] = zc[i]; zc[i] = zn[i]; } }
    }
}

namespace att {
constexpr int NSLOT = 3, KSLOT = 8192, VSLOT = 16384;
constexpr int L_K = 0, L_V = NSLOT * KSLOT, L_WS = L_V + NSLOT * VSLOT, L_END = L_WS + NWAVES * 256;
constexpr float C2 = 0.125f * 1.4426950408889634f;
#define SBAR() __builtin_amdgcn_sched_barrier(0)
#define KSWZ(row, colB) ((row) * 256 + ((colB) ^ (((row) & 7) << 4)))
__device__ __forceinline__ int crow(int r, int hi) { return (r & 3) + 8 * (r >> 2) + 4 * hi; }
__device__ __forceinline__ unsigned cvtpk(float lo, float hi) { unsigned r; asm volatile("v_cvt_pk_bf16_f32 %0, %1, %2" : "=v"(r) : "v"(lo), "v"(hi)); return r; }
__device__ __forceinline__ void glds16(const void* gsrc, unsigned lds_dst) { unsigned keep;
    asm volatile("s_mov_b32 %0, m0\n\ts_mov_b32 m0, %2\n\ts_nop 0\n\tglobal_load_lds_dwordx4 %1, off\n\ts_mov_b32 m0, %0" : "=&s"(keep) : "v"(gsrc), "s"(lds_dst) : "memory"); }
#define WAIT_BAR(N) asm volatile("s_waitcnt vmcnt(" #N ") lgkmcnt(0)\n\ts_barrier" ::: "memory")
__device__ __forceinline__ int v_rd_base(int lane) { return ((lane & 3) << 3) | (((lane >> 2) & 3) << 6) | (((lane >> 4) & 1) << 5) | (((lane >> 5) & 1) << 8); }
constexpr int v_rd_off(int d0, int ks, int half) { return d0 * 512 + ks * 4096 + half * 2048; }
template <int OFF> __device__ __forceinline__ s16x4 tr_read(int vb) { s16x4 r; asm volatile("ds_read_b64_tr_b16 %0, %1 offset:%2" : "=&v"(r) : "v"(vb), "i"(OFF) : "memory"); return r; }

__device__ __forceinline__ void qkt(f32x16& p0, f32x16& p1, const LAS char* Ks, const bf16x8* qr, const f32x16& negm, int r32, int hi) {
    const LAS char* kb = Ks + hi * 1024 + r32 * 16;
#pragma unroll
    for (int d0 = 0; d0 < 4; ++d0) {
        const bf16x8 b0 = *(const LAS bf16x8*)(kb + d0 * 2048);
        const bf16x8 b1 = *(const LAS bf16x8*)(kb + d0 * 2048 + 512);
        if (d0 == 0) { p0 = __builtin_amdgcn_mfma_f32_32x32x16_bf16(b0, qr[0], negm, 0, 0, 0); p1 = __builtin_amdgcn_mfma_f32_32x32x16_bf16(b1, qr[0], negm, 0, 0, 0); }
        else { p0 = __builtin_amdgcn_mfma_f32_32x32x16_bf16(b0, qr[d0], p0, 0, 0, 0); p1 = __builtin_amdgcn_mfma_f32_32x32x16_bf16(b1, qr[d0], p1, 0, 0, 0); } }
}
__device__ __forceinline__ float dot2_ones(unsigned pk, float acc) { asm("v_dot2c_f32_bf16 %0, %2, %1" : "+v"(acc) : "v"(pk), "s"(0x3f803f80u)); return acc; }
__device__ __forceinline__ void softmax_pack(f32x16& p0, f32x16& p1, float& l, bf16x8& pa0, bf16x8& pa1, bf16x8& pa2, bf16x8& pa3) {
#pragma unroll
    for (int r = 0; r < 16; ++r) { p0[r] = __builtin_amdgcn_exp2f(p0[r]); p1[r] = __builtin_amdgcn_exp2f(p1[r]); }
    float ps0 = 0.f, ps1 = 0.f;
#define PK4(P, BASE, OUT) do { unsigned a0 = cvtpk(P[BASE + 0], P[BASE + 1]), a1 = cvtpk(P[BASE + 2], P[BASE + 3]);   \
    unsigned b0 = cvtpk(P[BASE + 4], P[BASE + 5]), b1 = cvtpk(P[BASE + 6], P[BASE + 7]);                              \
    ps0 = dot2_ones(a0, ps0); ps1 = dot2_ones(a1, ps1); ps0 = dot2_ones(b0, ps0); ps1 = dot2_ones(b1, ps1);            \
    auto r0 = __builtin_amdgcn_permlane32_swap(a0, b0, false, false); auto r1 = __builtin_amdgcn_permlane32_swap(a1, b1, false, false); \
    u32x4 w = {r0[0], r1[0], r0[1], r1[1]}; OUT = __builtin_bit_cast(bf16x8, w); } while (0)
    PK4(p0, 0, pa0); PK4(p0, 8, pa1); PK4(p1, 0, pa2); PK4(p1, 8, pa3);
#undef PK4
    asm volatile("s_nop 2" : "+v"(ps0), "+v"(ps1));
    l += ps0 + ps1;
}
struct VFrag { s16x4 l0, h0, l1, h1, l2, h2, l3, h3; };
template <int D0> __device__ __forceinline__ void v_reads(VFrag& f, int vb) {
    f.l0 = tr_read<v_rd_off(D0, 0, 0)>(vb); f.h0 = tr_read<v_rd_off(D0, 0, 1)>(vb); f.l1 = tr_read<v_rd_off(D0, 1, 0)>(vb); f.h1 = tr_read<v_rd_off(D0, 1, 1)>(vb);
    f.l2 = tr_read<v_rd_off(D0, 2, 0)>(vb); f.h2 = tr_read<v_rd_off(D0, 2, 1)>(vb); f.l3 = tr_read<v_rd_off(D0, 3, 0)>(vb); f.h3 = tr_read<v_rd_off(D0, 3, 1)>(vb);
}
__device__ __forceinline__ void v_mma(f32x16& od, const VFrag& f, bf16x8 pa0, bf16x8 pa1, bf16x8 pa2, bf16x8 pa3) {
#define PK(L, H) (bf16x8){L[0], L[1], L[2], L[3], H[0], H[1], H[2], H[3]}
    od = __builtin_amdgcn_mfma_f32_32x32x16_bf16(pa0, PK(f.l0, f.h0), od, 0, 0, 0);
    od = __builtin_amdgcn_mfma_f32_32x32x16_bf16(pa1, PK(f.l1, f.h1), od, 0, 0, 0);
    od = __builtin_amdgcn_mfma_f32_32x32x16_bf16(pa2, PK(f.l2, f.h2), od, 0, 0, 0);
    od = __builtin_amdgcn_mfma_f32_32x32x16_bf16(pa3, PK(f.l3, f.h3), od, 0, 0, 0);
#undef PK
}
#define LANDED(f) asm volatile("" : "+v"(f.l0), "+v"(f.h0), "+v"(f.l1), "+v"(f.h1), "+v"(f.l2), "+v"(f.h2), "+v"(f.l3), "+v"(f.h3))
__device__ __forceinline__ void pv_all(f32x16* o, int vb, bf16x8 pa0, bf16x8 pa1, bf16x8 pa2, bf16x8 pa3) {
    VFrag fa, fb;
    v_reads<0>(fa, vb);
    asm volatile("s_waitcnt lgkmcnt(0)" ::: "memory"); LANDED(fa); SBAR();
    v_reads<1>(fb, vb); SBAR();
    v_mma(o[0], fa, pa0, pa1, pa2, pa3); SBAR();
    asm volatile("s_waitcnt lgkmcnt(0)" ::: "memory"); LANDED(fb); SBAR();
    v_reads<2>(fa, vb); SBAR();
    v_mma(o[1], fb, pa0, pa1, pa2, pa3); SBAR();
    asm volatile("s_waitcnt lgkmcnt(0)" ::: "memory"); LANDED(fa); SBAR();
    v_reads<3>(fb, vb); SBAR();
    v_mma(o[2], fa, pa0, pa1, pa2, pa3); SBAR();
    asm volatile("s_waitcnt lgkmcnt(0)" ::: "memory"); LANDED(fb); SBAR();
    v_mma(o[3], fb, pa0, pa1, pa2, pa3);
}
#undef LANDED

template <int VAR> __device__ __forceinline__ void attn_unit(int b, int h, int c, int qb, const bf16_t* Q, const bf16_t* K, const bf16_t* V, bf16_t* OT, const unsigned* kmax, LAS char* shm) {
    int tid_ = threadIdx.x; asm volatile("" : "+v"(tid_));
    const int tid = tid_, lane = tid & 63, r32 = lane & 31, hi = lane >> 5; const int wid = __builtin_amdgcn_readfirstlane(tid >> 6);
    const size_t rowbase = (size_t)b * SEQ; const int q0 = qb * 256;
    const bf16_t* Qw = Q + (rowbase + q0 + wid * 32) * 1024 + h * 128 + c * 64;
    const bf16_t* Kh = K + rowbase * 1024 + h * 128 + c * 64; const bf16_t* Vh = V + rowbase * 1024 + h * 128;
    const unsigned lds0 = (unsigned)(uintptr_t)shm;
    const bf16_t* ksrc = Kh + (size_t)lane * 1024 + wid * 8;
    const bf16_t* vsrc[2];
#pragma unroll
    for (int i = 0; i < 2; ++i) { const int p = 2 * wid + i;
        const int st = 2 * p + (lane >> 5), kk = (st >> 2) * 8 + ((lane & 31) >> 2), key = (kk & ~0xC) | ((kk & 4) << 1) | ((kk & 8) >> 1), cc = (st & 3) * 32 + (lane & 3) * 8;
        vsrc[i] = Vh + (size_t)key * 1024 + cc; }
    const unsigned kdst = lds0 + L_K + wid * 1024, vdst = lds0 + L_V + wid * 2048;
#define DMA_KV(t, slot) do { const size_t toff_ = (size_t)(t) * 64 * 1024; \
        glds16(ksrc + toff_, (unsigned)__builtin_amdgcn_readfirstlane(kdst + (slot) * KSLOT)); \
        glds16(vsrc[0] + toff_, (unsigned)__builtin_amdgcn_readfirstlane(vdst + (slot) * VSLOT)); glds16(vsrc[1] + toff_, (unsigned)__builtin_amdgcn_readfirstlane(vdst + (slot) * VSLOT + 1024)); } while (0)
    DMA_KV(0, 0); DMA_KV(1, 1);
    bf16x8 qr[4];
#pragma unroll
    for (int d0 = 0; d0 < 4; ++d0) qr[d0] = *(const bf16x8*)(Qw + (size_t)r32 * 1024 + d0 * 16 + hi * 8);
    float negm;
    {
        float sa = 0.f;
#pragma unroll
        for (int d0 = 0; d0 < 4; ++d0) { u32x4 qw = __builtin_bit_cast(u32x4, qr[d0]);
#pragma unroll
            for (int e = 0; e < 4; ++e) { const float x0 = bf_lo(qw[e]), x1 = bf_hi(qw[e]); sa += x0 * x0 + x1 * x1; qw[e] = cvtpk(x0 * C2, x1 * C2); }
            qr[d0] = __builtin_bit_cast(bf16x8, qw); }
        { auto rr = __builtin_amdgcn_permlane32_swap(__float_as_uint(sa), __float_as_uint(sa), false, false); sa = __uint_as_float(rr[0]) + __uint_as_float(rr[1]); }
        const unsigned* km = kmax + ((b * 8 + h) * 2 + c) * 2;
        negm = -sqrtf(sa) * sqrtf(__uint_as_float(km[0]) + __uint_as_float(km[1])) * C2;
    }
    f32x16 o[4];
#pragma unroll
    for (int d = 0; d < 4; ++d)
#pragma unroll
        for (int r = 0; r < 16; ++r) o[d][r] = 0.f;
    f32x16 NEGM;
#pragma unroll
    for (int r = 0; r < 16; ++r) NEGM[r] = negm;
    asm volatile("" : "+v"(NEGM));
    float l = 0.f;
    const int vb0 = (int)(lds0 + L_V) + v_rd_base(lane);
    constexpr int NT = SEQ / 64;
    int slot = 0;
    for (int t = 0; t < NT; ++t) {
        if (VAR == 5) { asm volatile("s_waitcnt vmcnt(3) lgkmcnt(0)" ::: "memory"); } else if (t + 1 < NT) { WAIT_BAR(3); } else { WAIT_BAR(0); }
        if (t + 2 < NT && VAR != 4) { const int s2 = (slot + 2 >= NSLOT) ? slot + 2 - NSLOT : slot + 2; DMA_KV(t + 2, s2); }
        const LAS char* Ks = shm + L_K + slot * KSLOT; const int vb = vb0 + slot * VSLOT;
        f32x16 p0, p1; bf16x8 a0, a1, a2, a3;
        slot = (slot + 1 == NSLOT) ? 0 : slot + 1;
        if (VAR == 6 && wid >= 4) continue;
        if (VAR != 3) { SBAR(); qkt(p0, p1, Ks, qr, NEGM, r32, hi); } else { p0 = NEGM; p1 = NEGM; }
        if (VAR != 1) softmax_pack(p0, p1, l, a0, a1, a2, a3);
        else { a0 = __builtin_bit_cast(bf16x8, (u32x4){__builtin_bit_cast(unsigned, p0[0]), __builtin_bit_cast(unsigned, p0[1]), __builtin_bit_cast(unsigned, p0[2]), __builtin_bit_cast(unsigned, p0[3])}); a1 = __builtin_bit_cast(bf16x8, (u32x4){__builtin_bit_cast(unsigned, p0[4]), __builtin_bit_cast(unsigned, p0[5]), __builtin_bit_cast(unsigned, p0[6]), __builtin_bit_cast(unsigned, p0[7])});
               a2 = __builtin_bit_cast(bf16x8, (u32x4){__builtin_bit_cast(unsigned, p1[0]), __builtin_bit_cast(unsigned, p1[1]), __builtin_bit_cast(unsigned, p1[2]), __builtin_bit_cast(unsigned, p1[3])}); a3 = __builtin_bit_cast(bf16x8, (u32x4){__builtin_bit_cast(unsigned, p1[4]), __builtin_bit_cast(unsigned, p1[5]), __builtin_bit_cast(unsigned, p1[6]), __builtin_bit_cast(unsigned, p1[7])}); l += p0[8] + p1[8]; }
        if (VAR != 2) { SBAR(); pv_all(o, vb, a0, a1, a2, a3); } else { o[0][0] += __builtin_bit_cast(float, (unsigned)a0[0] << 16) + __builtin_bit_cast(float, (unsigned)a1[0] << 16) + __builtin_bit_cast(float, (unsigned)a2[0] << 16) + __builtin_bit_cast(float, (unsigned)a3[0] << 16); }
    }
#undef DMA_KV
    { auto rr = __builtin_amdgcn_permlane32_swap(__float_as_uint(l), __float_as_uint(l), false, false); l = __uint_as_float(rr[0]) + __uint_as_float(rr[1]); }
    LAS float* wsf = (LAS float*)(shm + L_WS) + wid * 64;
    if (hi == 0) wsf[r32] = 1.0f / l;
    asm volatile("s_waitcnt lgkmcnt(0)" ::: "memory");
    bf16_t* Ow = OT + (size_t)c * MTOK * 1024 + (rowbase + q0 + wid * 32) * 1024 + h * 128;
#pragma unroll
    for (int r = 0; r < 16; ++r) { const int orow = crow(r, hi); const float il = wsf[orow];
#pragma unroll
        for (int d = 0; d < 4; ++d) Ow[(size_t)orow * 1024 + d * 32 + r32] = (bf16_t)f2bf(o[d][r] * il); }
    asm volatile("s_waitcnt lgkmcnt(0)\n\ts_barrier" ::: "memory");
}

constexpr int NSLOT2 = 4;
constexpr int L2_K = 0, L2_V = NSLOT2 * KSLOT, L2_WS = L2_V + NSLOT2 * VSLOT;
#define EXP2(P, i) P[i] = __builtin_amdgcn_exp2f(P[i])
#define LANDED(f) asm volatile("" : "+v"(f.l0), "+v"(f.h0), "+v"(f.l1), "+v"(f.h1), "+v"(f.l2), "+v"(f.h2), "+v"(f.l3), "+v"(f.h3))
#define PKV(L, H) (bf16x8){L[0], L[1], L[2], L[3], H[0], H[1], H[2], H[3]}
template <int VAR> __device__ __forceinline__ void attn_unit2(int b, int h, int c, int qb, const bf16_t* Q, const bf16_t* K, const bf16_t* V, bf16_t* OT, const unsigned* kmax, LAS char* shm) {
    int tid_ = threadIdx.x; asm volatile("" : "+v"(tid_));
    const int tid = tid_, lane = tid & 63, r32 = lane & 31, hi = lane >> 5; const int wid = __builtin_amdgcn_readfirstlane(tid >> 6);
    const size_t rowbase = (size_t)b * SEQ; const int q0 = qb * 256;
    const bf16_t* Qw = Q + (rowbase + q0 + wid * 32) * 1024 + h * 128 + c * 64;
    const bf16_t* Kh = K + rowbase * 1024 + h * 128 + c * 64; const bf16_t* Vh = V + rowbase * 1024 + h * 128;
    const unsigned lds0 = (unsigned)(uintptr_t)shm;
    const bf16_t* ksrc = Kh + (size_t)lane * 1024 + wid * 8;
    const bf16_t* vsrc[2];
#pragma unroll
    for (int i = 0; i < 2; ++i) { const int p = 2 * wid + i;
        const int st = 2 * p + (lane >> 5), kk = (st >> 2) * 8 + ((lane & 31) >> 2), key = (kk & ~0xC) | ((kk & 4) << 1) | ((kk & 8) >> 1), cc = (st & 3) * 32 + (lane & 3) * 8;
        vsrc[i] = Vh + (size_t)key * 1024 + cc; }
    const unsigned kdst = lds0 + L2_K + wid * 1024, vdst = lds0 + L2_V + wid * 2048;
#define DMA_KV(t, slot) do { const size_t toff_ = (size_t)(t) * 64 * 1024; \
        glds16(ksrc + toff_, (unsigned)__builtin_amdgcn_readfirstlane(kdst + (slot) * KSLOT)); \
        glds16(vsrc[0] + toff_, (unsigned)__builtin_amdgcn_readfirstlane(vdst + (slot) * VSLOT)); glds16(vsrc[1] + toff_, (unsigned)__builtin_amdgcn_readfirstlane(vdst + (slot) * VSLOT + 1024)); } while (0)
    DMA_KV(0, 0); DMA_KV(1, 1); DMA_KV(2, 2);
    bf16x8 qr[4];
#pragma unroll
    for (int d0 = 0; d0 < 4; ++d0) qr[d0] = *(const bf16x8*)(Qw + (size_t)r32 * 1024 + d0 * 16 + hi * 8);
    float negm;
    {
        float sa = 0.f;
#pragma unroll
        for (int d0 = 0; d0 < 4; ++d0) { u32x4 qw = __builtin_bit_cast(u32x4, qr[d0]);
#pragma unroll
            for (int e = 0; e < 4; ++e) { const float x0 = bf_lo(qw[e]), x1 = bf_hi(qw[e]); sa += x0 * x0 + x1 * x1; qw[e] = cvtpk(x0 * C2, x1 * C2); }
            qr[d0] = __builtin_bit_cast(bf16x8, qw); }
        { auto rr = __builtin_amdgcn_permlane32_swap(__float_as_uint(sa), __float_as_uint(sa), false, false); sa = __uint_as_float(rr[0]) + __uint_as_float(rr[1]); }
        const unsigned* km = kmax + ((b * 8 + h) * 2 + c) * 2;
        negm = -sqrtf(sa) * sqrtf(__uint_as_float(km[0]) + __uint_as_float(km[1])) * C2;
    }
    f32x16 o[4];
#pragma unroll
    for (int d = 0; d < 4; ++d)
#pragma unroll
        for (int r = 0; r < 16; ++r) o[d][r] = 0.f;
    f32x16 NEGM;
#pragma unroll
    for (int r = 0; r < 16; ++r) NEGM[r] = negm;
    asm volatile("" : "+v"(NEGM));
    float ps0 = 0.f, ps1 = 0.f;
    const int vb0 = (int)(lds0 + L2_V) + v_rd_base(lane);
    constexpr int NT = SEQ / 64;
    const LAS char* kb0 = shm + L2_K + hi * 1024 + r32 * 16;
    f32x16 c0, c1, n0 = NEGM, n1 = NEGM;
    WAIT_BAR(6);
    {
#pragma unroll
        for (int d0 = 0; d0 < 4; ++d0) { const bf16x8 k0 = *(const LAS bf16x8*)(kb0 + d0 * 2048), k1 = *(const LAS bf16x8*)(kb0 + d0 * 2048 + 512);
            if (d0 == 0) { c0 = __builtin_amdgcn_mfma_f32_32x32x16_bf16(k0, qr[0], NEGM, 0, 0, 0); c1 = __builtin_amdgcn_mfma_f32_32x32x16_bf16(k1, qr[0], NEGM, 0, 0, 0); }
            else { c0 = __builtin_amdgcn_mfma_f32_32x32x16_bf16(k0, qr[d0], c0, 0, 0, 0); c1 = __builtin_amdgcn_mfma_f32_32x32x16_bf16(k1, qr[d0], c1, 0, 0, 0); } }
#pragma unroll
        for (int r = 0; r < 16; ++r) { EXP2(c0, r); EXP2(c1, r); }
    }
    int slot = 0;
#pragma unroll 1
    for (int t = 0; t < NT; ++t) {
        if (VAR == 11) { asm volatile("s_waitcnt vmcnt(3) lgkmcnt(0)" ::: "memory"); } else if (t + 2 < NT) { WAIT_BAR(3); } else { WAIT_BAR(0); }
        if (t + 3 < NT && VAR != 12) { const int s3 = (slot + 3 >= NSLOT2) ? slot + 3 - NSLOT2 : slot + 3; DMA_KV(t + 3, s3); }
        const int sn = (slot + 1 == NSLOT2) ? 0 : slot + 1;
        const LAS char* kb = kb0 + sn * KSLOT; const int vb = vb0 + slot * VSLOT;
        const bool more = (t + 1 < NT);
        bf16x8 pa0, pa1, pa2, pa3;
        if (VAR == 6 && wid >= 4) { slot = sn; continue; }
        {
            unsigned w[16];
#define PACK4(P, B, W0) do { if (VAR == 10) { w[W0] = __builtin_bit_cast(unsigned, P[B]); w[W0 + 1] = __builtin_bit_cast(unsigned, P[B + 2]); w[W0 + 2] = __builtin_bit_cast(unsigned, P[B + 4]); w[W0 + 3] = __builtin_bit_cast(unsigned, P[B + 6]); break; } w[W0] = cvtpk(P[B], P[B + 1]); w[W0 + 1] = cvtpk(P[B + 2], P[B + 3]); w[W0 + 2] = cvtpk(P[B + 4], P[B + 5]); w[W0 + 3] = cvtpk(P[B + 6], P[B + 7]); } while (0)
#define SUM4(W0) do { if (VAR == 10) break; ps0 = dot2_ones(w[W0], ps0); ps1 = dot2_ones(w[W0 + 1], ps1); ps0 = dot2_ones(w[W0 + 2], ps0); ps1 = dot2_ones(w[W0 + 3], ps1); } while (0)
#define SWAP4(W0, OUT) do { if (VAR == 10) { u32x4 x_ = {w[W0], w[W0 + 1], w[W0 + 2], w[W0 + 3]}; OUT = __builtin_bit_cast(bf16x8, x_); break; } auto r0_ = __builtin_amdgcn_permlane32_swap(w[W0], w[W0 + 2], false, false); auto r1_ = __builtin_amdgcn_permlane32_swap(w[W0 + 1], w[W0 + 3], false, false); \
            u32x4 x_ = {r0_[0], r1_[0], r0_[1], r1_[1]}; OUT = __builtin_bit_cast(bf16x8, x_); } while (0)
            bf16x8 k0, k1;
            if (more) { k0 = *(const LAS bf16x8*)(kb); k1 = *(const LAS bf16x8*)(kb + 512); }
            SBAR();
            if (more) n0 = __builtin_amdgcn_mfma_f32_32x32x16_bf16(k0, qr[0], NEGM, 0, 0, 0);
            PACK4(c0, 0, 0); SBAR();
            if (more) { n1 = __builtin_amdgcn_mfma_f32_32x32x16_bf16(k1, qr[0], NEGM, 0, 0, 0); k0 = *(const LAS bf16x8*)(kb + 2048); k1 = *(const LAS bf16x8*)(kb + 2048 + 512); }
            SUM4(0); SWAP4(0, pa0); SBAR();
            if (more) n0 = __builtin_amdgcn_mfma_f32_32x32x16_bf16(k0, qr[1], n0, 0, 0, 0);
            PACK4(c0, 8, 4); SBAR();
            if (more) { n1 = __builtin_amdgcn_mfma_f32_32x32x16_bf16(k1, qr[1], n1, 0, 0, 0); k0 = *(const LAS bf16x8*)(kb + 4096); k1 = *(const LAS bf16x8*)(kb + 4096 + 512); }
            SUM4(4); SWAP4(4, pa1); SBAR();
            if (more) n0 = __builtin_amdgcn_mfma_f32_32x32x16_bf16(k0, qr[2], n0, 0, 0, 0);
            PACK4(c1, 0, 8); SBAR();
            if (more) { n1 = __builtin_amdgcn_mfma_f32_32x32x16_bf16(k1, qr[2], n1, 0, 0, 0); k0 = *(const LAS bf16x8*)(kb + 6144); k1 = *(const LAS bf16x8*)(kb + 6144 + 512); }
            SUM4(8); SWAP4(8, pa2); SBAR();
            if (more) n0 = __builtin_amdgcn_mfma_f32_32x32x16_bf16(k0, qr[3], n0, 0, 0, 0);
            PACK4(c1, 8, 12); SBAR();
            if (more) n1 = __builtin_amdgcn_mfma_f32_32x32x16_bf16(k1, qr[3], n1, 0, 0, 0);
            SUM4(12); SWAP4(12, pa3); SBAR();
#undef PACK4
#undef SUM4
#undef SWAP4
        }
        {
            VFrag fa, fb;
            if (VAR == 9) { fa.l0 = fa.h0 = fa.l1 = fa.h1 = fa.l2 = fa.h2 = fa.l3 = fa.h3 = (s16x4){(short)pa0[0], (short)pa0[1], (short)pa1[0], (short)pa1[1]}; fb = fa; }
            if (VAR != 9) v_reads<0>(fa, vb);
            asm volatile("s_waitcnt lgkmcnt(0)" ::: "memory"); LANDED(fa); SBAR();
            if (VAR != 9) v_reads<1>(fb, vb); SBAR();
#define GAPB(OD, PA, L, H, I) do { if (VAR != 8) OD = __builtin_amdgcn_mfma_f32_32x32x16_bf16(PA, PKV(L, H), OD, 0, 0, 0); else OD[0] += __builtin_bit_cast(float, (unsigned)PA[0] << 16) + (float)L[0] + (float)H[0]; if (more && VAR != 7) { if ((I) < 16) { EXP2(n0, (I)); EXP2(n0, (I) + 1); } else { EXP2(n1, (I) - 16); EXP2(n1, (I) - 15); } } SBAR(); } while (0)
            GAPB(o[0], pa0, fa.l0, fa.h0, 0); GAPB(o[0], pa1, fa.l1, fa.h1, 2); GAPB(o[0], pa2, fa.l2, fa.h2, 4); GAPB(o[0], pa3, fa.l3, fa.h3, 6);
            asm volatile("s_waitcnt lgkmcnt(0)" ::: "memory"); LANDED(fb); SBAR();
            if (VAR != 9) v_reads<2>(fa, vb); SBAR();
            GAPB(o[1], pa0, fb.l0, fb.h0, 8); GAPB(o[1], pa1, fb.l1, fb.h1, 10); GAPB(o[1], pa2, fb.l2, fb.h2, 12); GAPB(o[1], pa3, fb.l3, fb.h3, 14);
            asm volatile("s_waitcnt lgkmcnt(0)" ::: "memory"); LANDED(fa); SBAR();
            if (VAR != 9) v_reads<3>(fb, vb); SBAR();
            GAPB(o[2], pa0, fa.l0, fa.h0, 16); GAPB(o[2], pa1, fa.l1, fa.h1, 18); GAPB(o[2], pa2, fa.l2, fa.h2, 20); GAPB(o[2], pa3, fa.l3, fa.h3, 22);
            asm volatile("s_waitcnt lgkmcnt(0)" ::: "memory"); LANDED(fb); SBAR();
            GAPB(o[3], pa0, fb.l0, fb.h0, 24); GAPB(o[3], pa1, fb.l1, fb.h1, 26); GAPB(o[3], pa2, fb.l2, fb.h2, 28); GAPB(o[3], pa3, fb.l3, fb.h3, 30);
#undef GAPB
        }
        c0 = n0; c1 = n1;
        slot = sn;
    }
#undef DMA_KV
    asm volatile("s_nop 2" : "+v"(ps0), "+v"(ps1));
    float l = ps0 + ps1;
    { auto rr = __builtin_amdgcn_permlane32_swap(__float_as_uint(l), __float_as_uint(l), false, false); l = __uint_as_float(rr[0]) + __uint_as_float(rr[1]); }
    LAS float* wsf = (LAS float*)(shm + L2_WS) + wid * 64;
    if (hi == 0) wsf[r32] = 1.0f / l;
    asm volatile("s_waitcnt lgkmcnt(0)" ::: "memory");
    bf16_t* Ow = OT + (size_t)c * MTOK * 1024 + (rowbase + q0 + wid * 32) * 1024 + h * 128;
#pragma unroll
    for (int r = 0; r < 16; ++r) { const int orow = crow(r, hi); const float il = wsf[orow];
#pragma unroll
        for (int d = 0; d < 4; ++d) Ow[(size_t)orow * 1024 + d * 32 + r32] = (bf16_t)f2bf(o[d][r] * il); }
    asm volatile("s_waitcnt lgkmcnt(0)\n\ts_barrier" ::: "memory");
}
#undef EXP2
#undef LANDED
#undef PKV

#ifndef F_PRIO
#define F_PRIO 0
#endif
constexpr int F_SLOT = 32768, F_NSLOT = 3, F_K = 0, F_V = 16384, F_WS = F_NSLOT * F_SLOT;
__device__ __forceinline__ void qkt_f(f32x16& p0, f32x16& p1, const LAS char* kb, const bf16x8* qr, const f32x16& negm) {
#pragma unroll
    for (int d0 = 0; d0 < 4; ++d0) {
        const bf16x8 b0 = *(const LAS bf16x8*)(kb + d0 * 2048);
        const bf16x8 b1 = *(const LAS bf16x8*)(kb + d0 * 2048 + 512);
        if (d0 == 0) { p0 = __builtin_amdgcn_mfma_f32_32x32x16_bf16(b0, qr[0], negm, 0, 0, 0); p1 = __builtin_amdgcn_mfma_f32_32x32x16_bf16(b1, qr[0], negm, 0, 0, 0); }
        else { p0 = __builtin_amdgcn_mfma_f32_32x32x16_bf16(b0, qr[d0], p0, 0, 0, 0); p1 = __builtin_amdgcn_mfma_f32_32x32x16_bf16(b1, qr[d0], p1, 0, 0, 0); } }
}
__device__ __forceinline__ void softmax_pack_f(f32x16& p0, f32x16& p1, float& ps0, float& ps1, bf16x8& pa0, bf16x8& pa1, bf16x8& pa2, bf16x8& pa3) {
#pragma unroll
    for (int r = 0; r < 16; ++r) { p0[r] = __builtin_amdgcn_exp2f(p0[r]); p1[r] = __builtin_amdgcn_exp2f(p1[r]); }
    SBAR();
#define PK4(P, BASE, OUT) do { unsigned a0 = cvtpk(P[BASE + 0], P[BASE + 1]), a1 = cvtpk(P[BASE + 2], P[BASE + 3]);   \
    unsigned b0 = cvtpk(P[BASE + 4], P[BASE + 5]), b1 = cvtpk(P[BASE + 6], P[BASE + 7]);                              \
    ps0 = dot2_ones(a0, ps0); ps1 = dot2_ones(a1, ps1); ps0 = dot2_ones(b0, ps0); ps1 = dot2_ones(b1, ps1);            \
    u32x4 w = {a0, a1, b0, b1}; OUT = __builtin_bit_cast(bf16x8, w); } while (0)
    PK4(p0, 0, pa0); PK4(p0, 8, pa1); PK4(p1, 0, pa2); PK4(p1, 8, pa3);
#undef PK4
}
#define LANDED(f) asm volatile("" : "+v"(f.l0), "+v"(f.h0), "+v"(f.l1), "+v"(f.h1), "+v"(f.l2), "+v"(f.h2), "+v"(f.l3), "+v"(f.h3))
template <int OFF> __device__ __forceinline__ void glds16s(const void* sbase, unsigned voff, unsigned lds_dst) { unsigned keep;
    asm volatile("s_mov_b32 %0, m0\n\ts_mov_b32 m0, %3\n\ts_nop 0\n\tglobal_load_lds_dwordx4 %1, %2 offset:%4\n\ts_mov_b32 m0, %0" : "=&s"(keep) : "v"(voff), "s"(sbase), "s"(lds_dst), "i"(OFF) : "memory"); }
__device__ __forceinline__ void attn_unit3(int b, int h, int qb, const bf16_t* Q, const bf16_t* K, const bf16_t* V, bf16_t* MIXo, const unsigned* kmax, float lam, const float* subg, float oscale, LAS char* shm) {
    int tid_ = threadIdx.x; asm volatile("" : "+v"(tid_));
    const int tid = tid_, lane = tid & 63, r32 = lane & 31, hi = lane >> 5; const int wid = __builtin_amdgcn_readfirstlane(tid >> 6);
    const size_t rowbase = (size_t)b * SEQ; const int q0 = qb * 256;
    const bf16_t* Qw = Q + (rowbase + q0 + wid * 32) * 1024 + h * 128;
    const bf16_t* Kh = K + rowbase * 1024 + h * 128; const bf16_t* Vh = V + rowbase * 1024 + h * 128;
    const unsigned lds0 = (unsigned)(uintptr_t)shm;
#define KVOFF() ((unsigned)((tid & 63) * 1024 + wid * 8) * 2u)
#define VVOFF() ((unsigned)(((wid * 8 + ((tid & 31) >> 2)) * 1024) + (((tid >> 5) & 1) * 32 + (tid & 3) * 8)) * 2u)
    const unsigned kdst = lds0 + F_K + wid * 1024, vdst = lds0 + F_V + wid * 2048;
#define DMA_KV(t, slot) do { const char* kt_ = (const char*)Kh + (size_t)(t) * (64 * 1024 * 2); const char* vt_ = (const char*)Vh + (size_t)(t) * (64 * 1024 * 2); int tq_ = tid; asm volatile("" : "+v"(tq_)); const unsigned kvo_ = (unsigned)((tq_ & 63) * 1024 + wid * 8) * 2u, vvo_ = (unsigned)(((wid * 8 + ((tq_ & 31) >> 2)) * 1024) + (((tq_ >> 5) & 1) * 32 + (tq_ & 3) * 8)) * 2u; \
        glds16s<0>(kt_, kvo_, (unsigned)__builtin_amdgcn_readfirstlane(kdst + (slot) * F_SLOT)); glds16s<0>(kt_ + 128, kvo_, (unsigned)__builtin_amdgcn_readfirstlane(kdst + (slot) * F_SLOT + 8192)); \
        glds16s<0>(vt_, vvo_, (unsigned)__builtin_amdgcn_readfirstlane(vdst + (slot) * F_SLOT)); glds16s<0>(vt_ + 128, vvo_, (unsigned)__builtin_amdgcn_readfirstlane(vdst + (slot) * F_SLOT + 1024)); } while (0)
    DMA_KV(0, 0);
    bf16x8 qr[8];
#pragma unroll
    for (int d0 = 0; d0 < 8; ++d0) qr[d0] = *(const bf16x8*)(Qw + (size_t)r32 * 1024 + d0 * 16 + hi * 8);
    float negm;
    {
        float sa = 0.f, sb = 0.f;
#pragma unroll
        for (int d0 = 0; d0 < 8; ++d0) { u32x4 qw = __builtin_bit_cast(u32x4, qr[d0]);
#pragma unroll
            for (int e = 0; e < 4; ++e) { const float x0 = bf_lo(qw[e]), x1 = bf_hi(qw[e]); if (d0 < 4) sa += x0 * x0 + x1 * x1; else sb += x0 * x0 + x1 * x1; qw[e] = cvtpk(x0 * C2, x1 * C2); }
            qr[d0] = __builtin_bit_cast(bf16x8, qw); }
        { auto rr = __builtin_amdgcn_permlane32_swap(__float_as_uint(sa), __float_as_uint(sa), false, false); sa = __uint_as_float(rr[0]) + __uint_as_float(rr[1]); }
        { auto rr = __builtin_amdgcn_permlane32_swap(__float_as_uint(sb), __float_as_uint(sb), false, false); sb = __uint_as_float(rr[0]) + __uint_as_float(rr[1]); }
        const unsigned* km = kmax + (b * 8 + h) * 4;
        negm = fminf(-sqrtf(sa) * sqrtf(__uint_as_float(km[0]) + __uint_as_float(km[1])) * C2, -sqrtf(sb) * sqrtf(__uint_as_float(km[2]) + __uint_as_float(km[3])) * C2);
    }
    f32x16 oA[4], oB[4];
#pragma unroll
    for (int d = 0; d < 4; ++d)
#pragma unroll
        for (int r = 0; r < 16; ++r) { oA[d][r] = 0.f; oB[d][r] = 0.f; }
    float sA0 = 0.f, sA1 = 0.f, sB0 = 0.f, sB1 = 0.f;
    f32x16 NEGM;
#pragma unroll
    for (int r = 0; r < 16; ++r) NEGM[r] = negm;
    asm volatile("" : "+v"(NEGM));
#if F_PRIO
    if (wid >= 4) __builtin_amdgcn_s_setprio(1);
#endif
    const int vb0 = (int)(lds0 + F_V) + v_rd_base(lane);
    constexpr int NT = SEQ / 64;
    f32x16 p;
    bf16x8 k0, k1, k2, k3, a0, a1, a2, a3, b0, b1, b2, b3;
    VFrag f;
#define KLD(off) (*(const LAS bf16x8*)(kb + (off)))
#define MMA32(A, B, C) __builtin_amdgcn_mfma_f32_32x32x16_bf16(A, B, C, 0, 0, 0)
#define KLD4(base) do { k0 = KLD(base); k1 = KLD((base) + 2048); k2 = KLD((base) + 4096); k3 = KLD((base) + 6144); } while (0)
#define QK4(Q0) do { p = MMA32(k0, qr[Q0], NEGM); p = MMA32(k1, qr[Q0 + 1], p); p = MMA32(k2, qr[Q0 + 2], p); p = MMA32(k3, qr[Q0 + 3], p); } while (0)
#define EXPS() do { _Pragma("unroll") for (int r = 0; r < 16; ++r) p[r] = __builtin_amdgcn_exp2f(p[r]); } while (0)
#define PK4(BASE, OUT, S0, S1) do { const unsigned x0 = cvtpk(p[BASE + 0], p[BASE + 1]), x1 = cvtpk(p[BASE + 2], p[BASE + 3]), x2 = cvtpk(p[BASE + 4], p[BASE + 5]), x3 = cvtpk(p[BASE + 6], p[BASE + 7]); \
        S0 = dot2_ones(x0, S0); S1 = dot2_ones(x1, S1); S0 = dot2_ones(x2, S0); S1 = dot2_ones(x3, S1); u32x4 w_ = {x0, x1, x2, x3}; OUT = __builtin_bit_cast(bf16x8, w_); } while (0)
#define PKV(L, H) (bf16x8){L[0], L[1], L[2], L[3], H[0], H[1], H[2], H[3]}
#define RD_LO(D0, vb) do { f.l0 = tr_read<v_rd_off(D0, 0, 0)>(vb); f.h0 = tr_read<v_rd_off(D0, 0, 1)>(vb); f.l1 = tr_read<v_rd_off(D0, 1, 0)>(vb); f.h1 = tr_read<v_rd_off(D0, 1, 1)>(vb); } while (0)
#define RD_HI(D0, vb) do { f.l2 = tr_read<v_rd_off(D0, 2, 0)>(vb); f.h2 = tr_read<v_rd_off(D0, 2, 1)>(vb); f.l3 = tr_read<v_rd_off(D0, 3, 0)>(vb); f.h3 = tr_read<v_rd_off(D0, 3, 1)>(vb); } while (0)
#define LAND_LO() asm volatile("" : "+v"(f.l0), "+v"(f.h0), "+v"(f.l1), "+v"(f.h1))
#define LAND_HI() asm volatile("" : "+v"(f.l2), "+v"(f.h2), "+v"(f.l3), "+v"(f.h3))
#define MS_TILE(VPRE) do { \
        SBAR(); KLD4(0); SBAR(); \
        QK4(0); SBAR(); KLD4(512); SBAR(); EXPS(); SBAR(); PK4(0, a0, sA0, sA1); PK4(8, a1, sA0, sA1); SBAR(); \
        QK4(0); SBAR(); KLD4(8192); SBAR(); EXPS(); SBAR(); PK4(0, a2, sA0, sA1); PK4(8, a3, sA0, sA1); SBAR(); \
        QK4(4); SBAR(); KLD4(8192 + 512); SBAR(); EXPS(); SBAR(); PK4(0, b0, sB0, sB1); PK4(8, b1, sB0, sB1); SBAR(); \
        QK4(4); SBAR(); VPRE; SBAR(); EXPS(); SBAR(); PK4(0, b2, sB0, sB1); PK4(8, b3, sB0, sB1); SBAR(); } while (0)
#define PVBLK(D0, LAST, vb) do { \
        asm volatile("s_waitcnt lgkmcnt(4)" ::: "memory"); LAND_LO(); SBAR(); \
        oA[D0] = MMA32(a0, PKV(f.l0, f.h0), oA[D0]); oB[D0] = MMA32(b0, PKV(f.l0, f.h0), oB[D0]); oA[D0] = MMA32(a1, PKV(f.l1, f.h1), oA[D0]); oB[D0] = MMA32(b1, PKV(f.l1, f.h1), oB[D0]); SBAR(); \
        if (!(LAST)) { RD_LO((D0 + 1) & 3, vb); asm volatile("s_waitcnt lgkmcnt(4)" ::: "memory"); } else { asm volatile("s_waitcnt lgkmcnt(0)" ::: "memory"); } LAND_HI(); SBAR(); \
        oA[D0] = MMA32(a2, PKV(f.l2, f.h2), oA[D0]); oB[D0] = MMA32(b2, PKV(f.l2, f.h2), oB[D0]); oA[D0] = MMA32(a3, PKV(f.l3, f.h3), oA[D0]); oB[D0] = MMA32(b3, PKV(f.l3, f.h3), oB[D0]); SBAR(); \
        if (!(LAST)) { RD_HI((D0 + 1) & 3, vb); } } while (0)
#define PV_TILE(vb) do { PVBLK(0, false, vb); PVBLK(1, false, vb); PVBLK(2, false, vb); PVBLK(3, true, vb); } while (0)
#define NEXT_BAR(t) do { WAIT_BAR(0); if ((t) + 2 < NT) { const int s2 = (slot + 2 >= F_NSLOT) ? slot + 2 - F_NSLOT : slot + 2; DMA_KV((t) + 2, s2); } } while (0)
    WAIT_BAR(0);
    DMA_KV(1, 1);
    int slot = 0;
#pragma unroll 1
    for (int t = 0; t < NT; ++t) {
        const LAS char* kb = shm + slot * F_SLOT + F_K + hi * 1024 + r32 * 16; const int vb = vb0 + slot * F_SLOT;
        MS_TILE(do { RD_LO(0, vb); RD_HI(0, vb); } while (0));
        if (wid >= 4) NEXT_BAR(t);
        SBAR();
        PV_TILE(vb);
        if (wid < 4) NEXT_BAR(t);
        slot = (slot + 1 == F_NSLOT) ? 0 : slot + 1;
    }
#undef NEXT_BAR
#undef PV_TILE
#undef PVBLK
#undef MS_TILE
#undef EXPS
#undef PK4
#undef KLD4
#undef QK4
#undef RD_LO
#undef RD_HI
#undef LAND_LO
#undef LAND_HI
#undef PKV
#undef KLD
#undef MMA32
#undef DMA_KV
#if F_PRIO
    __builtin_amdgcn_s_setprio(0);
#endif
    asm volatile("s_nop 2" : "+v"(sA0), "+v"(sA1), "+v"(sB0), "+v"(sB1));
    float lA = sA0 + sA1, lB = sB0 + sB1;
    { auto rr = __builtin_amdgcn_permlane32_swap(__float_as_uint(lA), __float_as_uint(lA), false, false); lA = __uint_as_float(rr[0]) + __uint_as_float(rr[1]); }
    { auto rr = __builtin_amdgcn_permlane32_swap(__float_as_uint(lB), __float_as_uint(lB), false, false); lB = __uint_as_float(rr[0]) + __uint_as_float(rr[1]); }
    LAS float* wsf = (LAS float*)(shm + F_WS) + wid * 128;
    if (hi == 0) { wsf[r32] = __builtin_amdgcn_rcpf(lA); wsf[32 + r32] = lam * __builtin_amdgcn_rcpf(lB); }
    asm volatile("s_waitcnt lgkmcnt(0)" ::: "memory");
    float gsub[4];
#pragma unroll
    for (int d = 0; d < 4; ++d) gsub[d] = subg[d * 32 + r32] * oscale;
    const bool j1 = (r32 & 1) != 0, j2 = (r32 & 2) != 0;
    bf16_t* Ow = MIXo + (rowbase + q0 + wid * 32) * 2048 + 1024 + h * 128 + (r32 & 3) * 32 + (r32 & ~3);
#define QSWAP1(x) __builtin_bit_cast(float, __builtin_amdgcn_mov_dpp(__builtin_bit_cast(int, (x)), 0xB1, 0xF, 0xF, true))
#define QSWAP2(x) __builtin_bit_cast(float, __builtin_amdgcn_mov_dpp(__builtin_bit_cast(int, (x)), 0x4E, 0xF, 0xF, true))
#pragma unroll
    for (int r = 0; r < 16; ++r) { const int orow = crow(r, hi); const float ia = wsf[orow], ib = wsf[32 + orow]; float o[4], s = 0.f;
#pragma unroll
        for (int d = 0; d < 4; ++d) { o[d] = oA[d][r] * ia - oB[d][r] * ib; s += o[d] * o[d]; }
#define DPPF(x, ctl) __builtin_bit_cast(float, __builtin_amdgcn_update_dpp(0, __builtin_bit_cast(int, (x)), (ctl), 0xf, 0xf, false))
        s += DPPF(s, 0xB1); s += DPPF(s, 0x4E); s += DPPF(s, 0x141); s += DPPF(s, 0x140);
        { float a_ = s, b_ = s; asm volatile("s_nop 1\n\tv_permlane16_swap_b32 %0, %1\n\ts_nop 1" : "+v"(a_), "+v"(b_)); s = a_ + b_; }
#undef DPPF
        const float rs = __builtin_amdgcn_rsqf(s * (1.f / 128.f) + NORM_EPS);
#pragma unroll
        for (int d = 0; d < 4; ++d) o[d] = o[d] * rs * gsub[d];
        { float t = QSWAP1(j1 ? o[0] : o[1]); const float n0 = j1 ? t : o[0], n1 = j1 ? o[1] : t; o[0] = n0; o[1] = n1; }
        { float t = QSWAP1(j1 ? o[2] : o[3]); const float n2 = j1 ? t : o[2], n3 = j1 ? o[3] : t; o[2] = n2; o[3] = n3; }
        { float t = QSWAP2(j2 ? o[0] : o[2]); const float n0 = j2 ? t : o[0], n2 = j2 ? o[2] : t; o[0] = n0; o[2] = n2; }
        { float t = QSWAP2(j2 ? o[1] : o[3]); const float n1 = j2 ? t : o[1], n3 = j2 ? o[3] : t; o[1] = n1; o[3] = n3; }
        u32x2 w; w.x = cvtpk(o[0], o[1]); w.y = cvtpk(o[2], o[3]);
        *(u32x2*)(Ow + (size_t)orow * 2048) = w; }
#undef QSWAP1
#undef QSWAP2
    asm volatile("s_waitcnt lgkmcnt(0)\n\ts_barrier" ::: "memory");
}
#undef LANDED
#undef SBAR
#undef KSWZ
#undef WAIT_BAR
}

__device__ __forceinline__ void combine_chunk(const bf16_t* OT, bf16_t* MIXp, float lam, const float* subg, float oscale, int chunk, int tid) {
    const int d0 = (tid & 15) * 8;
    float gs[8];
#pragma unroll
    for (int i = 0; i < 8; ++i) gs[i] = subg[d0 + i] * oscale;
    for (int it = tid >> 4; it < 128 * 8; it += NTHREADS / 16) { const int row = chunk * 128 + (it >> 3), h = it & 7;
        const u32x4 a = *(const u32x4*)(OT + (size_t)row * 1024 + h * 128 + d0), bq = *(const u32x4*)(OT + (size_t)MTOK * 1024 + (size_t)row * 1024 + h * 128 + d0);
        float o[8], ss = 0.f;
#pragma unroll
        for (int i = 0; i < 4; ++i) { o[2 * i] = bf_lo(a[i]) - lam * bf_lo(bq[i]); o[2 * i + 1] = bf_hi(a[i]) - lam * bf_hi(bq[i]); ss += o[2 * i] * o[2 * i] + o[2 * i + 1] * o[2 * i + 1]; }
        ss += __shfl_xor(ss, 1); ss += __shfl_xor(ss, 2); ss += __shfl_xor(ss, 4); ss += __shfl_xor(ss, 8);
        const float rstd = 1.0f / sqrtf(ss * (1.f / 128.f) + NORM_EPS);
        u32x4 w; w.x = pk2(o[0] * rstd * gs[0], o[1] * rstd * gs[1]); w.y = pk2(o[2] * rstd * gs[2], o[3] * rstd * gs[3]); w.z = pk2(o[4] * rstd * gs[4], o[5] * rstd * gs[5]); w.w = pk2(o[6] * rstd * gs[6], o[7] * rstd * gs[7]);
        *(u32x4*)(MIXp + (size_t)row * 2048 + 1024 + h * 128 + d0) = w; }
}


__device__ __forceinline__ int skey(float s, int payload, int mask) { int b = __builtin_bit_cast(int, s); b ^= (b >> 31) & 0x7fffffff; return (b & ~mask) | payload; }
__device__ __forceinline__ float skey_score(int k, int mask) { int b = k & ~mask; b ^= (b >> 31) & 0x7fffffff; return __builtin_bit_cast(float, b); }
#define CEX_DESC(a, b) do { const int hi_ = max((a), (b)), lo_ = min((a), (b)); (a) = hi_; (b) = lo_; } while (0)
__device__ __forceinline__ void sort16_desc(int (&k)[16]) {
#pragma unroll
    for (int sz = 2; sz <= 16; sz <<= 1)
#pragma unroll
        for (int j = sz >> 1; j > 0; j >>= 1)
#pragma unroll
            for (int i = 0; i < 16; ++i) { const int l = i ^ j;
                if (l > i) { if ((i & sz) == 0) { CEX_DESC(k[i], k[l]); } else { CEX_DESC(k[l], k[i]); } } }
}
__device__ __forceinline__ void bmerge16_desc(int (&k)[16]) {
#pragma unroll
    for (int j = 8; j > 0; j >>= 1)
#pragma unroll
        for (int i = 0; i < 16; ++i) { const int l = i ^ j; if (l > i) CEX_DESC(k[i], k[l]); }
}
__device__ __forceinline__ void top16_merge(int (&a)[16], const int (&b)[16]) {
#pragma unroll
    for (int i = 0; i < 16; ++i) a[i] = max(a[i], b[15 - i]);
    bmerge16_desc(a);
}
__device__ __forceinline__ void top16_xlane(int (&a)[16]) {
    int e[16], o[16];
#pragma unroll
    for (int i = 0; i < 16; ++i) { auto r = __builtin_amdgcn_permlane16_swap((unsigned)a[i], (unsigned)a[i], false, false); e[i] = (int)r[0]; o[i] = (int)r[1]; }
#pragma unroll
    for (int i = 0; i < 16; ++i) a[i] = max(e[i], o[15 - i]);
    bmerge16_desc(a);
#pragma unroll
    for (int i = 0; i < 16; ++i) { auto r = __builtin_amdgcn_permlane32_swap((unsigned)a[i], (unsigned)a[i], false, false); e[i] = (int)r[0]; o[i] = (int)r[1]; }
#pragma unroll
    for (int i = 0; i < 16; ++i) a[i] = max(e[i], o[15 - i]);
    bmerge16_desc(a);
}

struct QFrag { bf16x8 q[4]; };
__device__ __forceinline__ void router_load_q(QFrag& f, const bf16_t* QP, int tok0, int hc, int fr, int fq) {
    const bf16_t* qp = QP + (size_t)(tok0 + fr) * 2048 + hc * 128 + fq * 8;
#pragma unroll
    for (int ks = 0; ks < 4; ++ks) f.q[ks] = *(const bf16x8*)(qp + ks * 32);
}
__device__ __forceinline__ void router_stage_load(u32x4 (&st)[4], const bf16_t* KEYS, int hc, int tid) {
    const u32x4* src = (const u32x4*)(KEYS + (size_t)hc * 128 * 128);
#pragma unroll
    for (int i = 0; i < 4; ++i) st[i] = src[tid + 512 * i];
}
__device__ __forceinline__ void router_stage_store(const u32x4 (&st)[4], LAS unsigned char* buf, int tid) {
#pragma unroll
    for (int i = 0; i < 4; ++i) { const int p = tid + 512 * i, row = p >> 4, ch = p & 15; *(LAS u32x4*)(buf + row * 256 + ((ch ^ (row & 15)) << 4)) = st[i]; }
}
__device__ __forceinline__ void router_top16(int (&ka)[16], const QFrag& qf, const LAS unsigned char* kbuf, int fr, int fq) {
    f32x4 acc[8];
#pragma unroll
    for (int nt = 0; nt < 8; ++nt) acc[nt] = (f32x4){0.f, 0.f, 0.f, 0.f};
    const LAS unsigned char* kp = kbuf + fr * 256;
    bf16x8 A[8], B[8];
#define LOADK(D, ks) do { _Pragma("unroll") for (int nt = 0; nt < 8; ++nt) D[nt] = *(const LAS bf16x8*)(kp + nt * 4096 + (((fq + 4 * (ks)) ^ fr) << 4)); } while (0)
#define MMAK(D, ks) do { _Pragma("unroll") for (int nt = 0; nt < 8; ++nt) acc[nt] = __builtin_amdgcn_mfma_f32_16x16x32_bf16(D[nt], qf.q[ks], acc[nt], 0, 0, 0); } while (0)
    LOADK(A, 0); __builtin_amdgcn_sched_barrier(0);
    LOADK(B, 1); __builtin_amdgcn_sched_barrier(0); MMAK(A, 0); __builtin_amdgcn_sched_barrier(0);
    LOADK(A, 2); __builtin_amdgcn_sched_barrier(0); MMAK(B, 1); __builtin_amdgcn_sched_barrier(0);
    LOADK(B, 3); __builtin_amdgcn_sched_barrier(0); MMAK(A, 2); __builtin_amdgcn_sched_barrier(0);
    MMAK(B, 3); __builtin_amdgcn_sched_barrier(0);
#undef LOADK
#undef MMAK
    int kb[16];
    int fq4 = 4 * fq; asm volatile("" : "+v"(fq4));
#pragma unroll
    for (int nt = 0; nt < 4; ++nt)
#pragma unroll
        for (int i = 0; i < 4; ++i) { ka[nt * 4 + i] = skey(acc[nt][i], 16 * nt + fq4 + i, 127); kb[nt * 4 + i] = skey(acc[nt + 4][i], 16 * (nt + 4) + fq4 + i, 127); }
    sort16_desc(ka); sort16_desc(kb); top16_merge(ka, kb);
    top16_xlane(ka);
    __builtin_amdgcn_sched_barrier(0);
}
__device__ __forceinline__ void router_task4(const bf16_t* QP, const bf16_t* KEYS, unsigned* ROUTE, int tok0, bool active, int hq, LAS int* scr, LAS unsigned char* kbuf, int tid) {
    const int lane = tid & 63, fr = lane & 15, fq = lane >> 4;
    int m0[16], m1[16];
#pragma unroll
    for (int i = 0; i < 16; ++i) { m0[i] = 0; m1[i] = 0; }
    QFrag qa, qb; u32x4 st[4];
    router_stage_load(st, KEYS, 8 * hq, tid);
    if (active) router_load_q(qa, QP, tok0, 8 * hq, fr, fq);
    router_stage_store(st, kbuf, tid);
    __syncthreads();
#pragma unroll 1
    for (int j = 0; j < 4; ++j) { const int h = 4 * hq + j;
        router_stage_load(st, KEYS, h * 2 + 1, tid);
        if (active) router_load_q(qb, QP, tok0, h * 2 + 1, fr, fq);
        __builtin_amdgcn_sched_barrier(0);
        int frl = fr; asm volatile("" : "+v"(frl));
        if (active) { int ka[16]; router_top16(ka, qa, kbuf, frl, fq);
#pragma unroll
          for (int i = 0; i < 16; ++i) m0[i] = (fq == j) ? ka[i] : m0[i]; }
        __builtin_amdgcn_sched_barrier(0);
        router_stage_store(st, kbuf + 32768, tid);
        __syncthreads();
        if (j < 3) router_stage_load(st, KEYS, h * 2 + 2, tid);
        if (active && j < 3) router_load_q(qa, QP, tok0, h * 2 + 2, fr, fq);
        __builtin_amdgcn_sched_barrier(0);
        asm volatile("" : "+v"(frl));
        if (active) { int ka[16]; router_top16(ka, qb, kbuf + 32768, frl, fq);
#pragma unroll
          for (int i = 0; i < 16; ++i) m1[i] = (fq == j) ? ka[i] : m1[i]; }
        __builtin_amdgcn_sched_barrier(0);
        if (j < 3) router_stage_store(st, kbuf, tid);
        __syncthreads();
    }
    if (!active) return;
    int ln2_ = lane; asm volatile("" : "+v"(ln2_)); LAS int* scrl = scr + ln2_ * 32;
#pragma unroll
    for (int i = 0; i < 16; ++i) { scrl[i] = m0[i] & 127; scrl[16 + i] = m1[i] & 127; }
    float s0[16], s1[16];
#pragma unroll
    for (int i = 0; i < 16; ++i) { s0[i] = skey_score(m0[i], 127); s1[i] = skey_score(m1[i], 127); }
    constexpr int NEG = (int)0x80000000;
    int best[16], ch[16];
#define CAND(a, b) skey(s0[a] + s1[b], (a) * 16 + (b), 255)
#pragma unroll
    for (int b = 0; b < 16; ++b) best[b] = CAND(0, b);
    sort16_desc(best);
    ch[0] = CAND(1, 0); ch[1] = CAND(1, 1); ch[2] = CAND(1, 2); ch[3] = CAND(1, 3); ch[4] = CAND(1, 4); ch[5] = CAND(1, 5); ch[6] = CAND(1, 6); ch[7] = CAND(1, 7);
    ch[8] = CAND(2, 0); ch[9] = CAND(2, 1); ch[10] = CAND(2, 2); ch[11] = CAND(2, 3); ch[12] = CAND(2, 4); ch[13] = CAND(3, 0); ch[14] = CAND(3, 1); ch[15] = CAND(3, 2);
    sort16_desc(ch); top16_merge(best, ch);
    ch[0] = CAND(3, 3); ch[1] = CAND(4, 0); ch[2] = CAND(4, 1); ch[3] = CAND(4, 2); ch[4] = CAND(5, 0); ch[5] = CAND(5, 1); ch[6] = CAND(6, 0); ch[7] = CAND(6, 1);
    ch[8] = CAND(7, 0); ch[9] = CAND(7, 1); ch[10] = CAND(8, 0); ch[11] = CAND(9, 0); ch[12] = CAND(10, 0); ch[13] = CAND(11, 0); ch[14] = CAND(12, 0); ch[15] = CAND(13, 0);
    sort16_desc(ch); top16_merge(best, ch);
    ch[0] = CAND(14, 0); ch[1] = CAND(15, 0);
#pragma unroll
    for (int i = 2; i < 16; ++i) ch[i] = NEG;
    sort16_desc(ch); top16_merge(best, ch);
#undef CAND
    float g[16], gs = 0.f; const float smax = skey_score(best[0], 255);
#pragma unroll
    for (int i = 0; i < 16; ++i) { g[i] = __expf(skey_score(best[i], 255) - smax); gs += g[i]; }
    const float inv = 1.0f / gs;
    LDS_WAIT(); asm volatile("" ::: "memory");
    unsigned e[16];
#pragma unroll
    for (int i = 0; i < 16; ++i) { const int ci = best[i] & 255, a = ci >> 4, b = ci & 15; const int ia = scrl[a], ib = scrl[16 + b];
        e[i] = (f2bf(g[i] * inv) << 16) | (unsigned)(ia * 128 + ib); }
    unsigned* rp = ROUTE + (size_t)(tok0 + fr) * 128 + (4 * hq + fq) * 16;
#pragma unroll
    for (int i = 0; i < 4; ++i) *(u32x4*)(rp + 4 * i) = (u32x4){e[4 * i], e[4 * i + 1], e[4 * i + 2], e[4 * i + 3]};
    LDS_WAIT(); asm volatile("" ::: "memory");
}

typedef float f32x2v __attribute__((ext_vector_type(2)));
__device__ __forceinline__ float gelu_exact(float a) { return 0.5f * a * (1.0f + erff(a * 0.70710678118654752f)); }

constexpr int NSLICE = 16, SLW = 128, TBLK = 256, NTB = MTOK / TBLK;
constexpr int CW_XQ = 20480;
__device__ __forceinline__ float dpp_sum8(float v) {
    v += __builtin_bit_cast(float, __builtin_amdgcn_update_dpp(0, __builtin_bit_cast(int, v), 0xB1, 0xf, 0xf, false));
    v += __builtin_bit_cast(float, __builtin_amdgcn_update_dpp(0, __builtin_bit_cast(int, v), 0x4E, 0xf, 0xf, false));
    v += __builtin_bit_cast(float, __builtin_amdgcn_update_dpp(0, __builtin_bit_cast(int, v), 0x141, 0xf, 0xf, false));
    return v;
}
__device__ __forceinline__ float sum_groups(float v) {
    v += __builtin_bit_cast(float, __builtin_amdgcn_update_dpp(0, __builtin_bit_cast(int, v), 0x128, 0xf, 0xf, false));
    { float a = v, b = v; asm volatile("s_nop 1\n\tv_permlane16_swap_b32 %0, %1\n\ts_nop 1" : "+v"(a), "+v"(b)); v = a + b; }
    { float a = v, b = v; asm volatile("s_nop 1\n\tv_permlane32_swap_b32 %0, %1\n\ts_nop 1" : "+v"(a), "+v"(b)); v = a + b; }
    return v;
}
struct Rows8 { u32x4 r[8]; };
struct Ent8 { u32x4 e[2]; };
__device__ __forceinline__ void rows_issue(Rows8& R, const Ent8& en, const unsigned char* tb) {
#pragma unroll
    for (int j = 0; j < 8; ++j) R.r[j] = *(const u32x4*)(tb + (size_t)(en.e[j >> 2][j & 3] & 0x3fffu) * SLW);
}
__device__ __forceinline__ void ent_load(Ent8& en, const u32x4* rp, int batch) { en.e[0] = rp[(batch & 15) * 2]; en.e[1] = rp[(batch & 15) * 2 + 1]; }
__device__ __forceinline__ int dot4_i8(unsigned a, unsigned b, int acc) { asm("v_dot4c_i32_i8 %0, %1, %2" : "+v"(acc) : "v"(a), "v"(b)); return acc; }
__device__ __forceinline__ void u_batch(const Rows8& R, const u32x4& hq, bf16_t* pp, int b, int c) {
    float mine = 0.f;
#pragma unroll
    for (int j = 0; j < 8; ++j) { int acc = 0;
#pragma unroll
        for (int q = 0; q < 4; ++q) acc = dot4_i8(R.r[j][q], hq[q], acc);
        asm volatile("s_nop 2" : "+v"(acc));
        const float p = dpp_sum8((float)acc);
        mine = (c == j) ? p : mine; }
    pp[8 * b] = (bf16_t)f2bf(mine);
}
__device__ __forceinline__ void ent_load2(Ent8& en, const u32x4* rp0, int bb) { const u32x4* rp = rp0 + ((bb >> 4) & 1) * (8 * 128 / 4); const int b = bb & 15; en.e[0] = rp[b * 2]; en.e[1] = rp[b * 2 + 1]; }
__device__ __forceinline__ void expert_u_block16(const unsigned char* H2I, const unsigned char* Us, const unsigned* ROUTE, bf16_t* PARTs, int t0, int s, int lane) {
    const int g = lane >> 3, c = lane & 7, t = t0 + g;
    const u32x4 hq0 = *(const u32x4*)(H2I + (size_t)t * DM + s * SLW + 16 * c), hq1 = *(const u32x4*)(H2I + (size_t)(t + 8) * DM + s * SLW + 16 * c);
    const u32x4* rp = (const u32x4*)(ROUTE + (size_t)t * 128);
    const unsigned char* ub = Us + 16 * c;
    bf16_t* pp = PARTs + (size_t)t * 128 + c;
    Ent8 E0, E1, E2; Rows8 A, B;
    ent_load2(E0, rp, 0); ent_load2(E1, rp, 1); ent_load2(E2, rp, 2);
    rows_issue(A, E0, ub);
    __builtin_amdgcn_sched_barrier(0);
#pragma unroll 1
    for (int bb = 0; bb < 32; bb += 2) {
        const bool second = bb >= 16; const u32x4 hq = second ? hq1 : hq0; bf16_t* ppb = pp + (second ? 8 * 128 : 0); const int b = bb & 15;
        rows_issue(B, E1, ub); ent_load2(E0, rp, bb + 3);
        __builtin_amdgcn_sched_barrier(0);
        u_batch(A, hq, ppb, b, c);
        __builtin_amdgcn_sched_barrier(0);
        rows_issue(A, E2, ub); ent_load2(E1, rp, bb + 4);
        __builtin_amdgcn_sched_barrier(0);
        u_batch(B, hq, ppb, b + 1, c);
        __builtin_amdgcn_sched_barrier(0);
        { const Ent8 t3 = E0; E2 = E1; E1 = t3; }
    }
}
__device__ __forceinline__ unsigned permb(unsigned hi, unsigned lo, unsigned sel) { return __builtin_amdgcn_perm(hi, lo, sel); }
__device__ __forceinline__ void v_batch(const Rows8& R, const Ent8& en, int (&acc)[16]) {
#pragma unroll
    for (int h = 0; h < 2; ++h) {
        const unsigned e0 = en.e[h][0], e1 = en.e[h][1], e2 = en.e[h][2], e3 = en.e[h][3];
        const unsigned W = permb(permb(e3, e2, 0x07030000u), permb(e1, e0, 0x07030000u), 0x07060302u);
#pragma unroll
        for (int q = 0; q < 4; ++q) { const unsigned r0 = R.r[4 * h][q], r1 = R.r[4 * h + 1][q], r2 = R.r[4 * h + 2][q], r3 = R.r[4 * h + 3][q];
            const unsigned a = permb(r1, r0, 0x05010400u), c = permb(r1, r0, 0x07030602u), b = permb(r3, r2, 0x05010400u), d = permb(r3, r2, 0x07030602u);
            const unsigned t0 = permb(b, a, 0x05040100u), t1 = permb(b, a, 0x07060302u), t2 = permb(d, c, 0x05040100u), t3 = permb(d, c, 0x07060302u);
            acc[4 * q] = dot4_i8(t0, W, acc[4 * q]); acc[4 * q + 1] = dot4_i8(t1, W, acc[4 * q + 1]); acc[4 * q + 2] = dot4_i8(t2, W, acc[4 * q + 2]); acc[4 * q + 3] = dot4_i8(t3, W, acc[4 * q + 3]); } }
}
__device__ __forceinline__ void v_flush(const int (&acc)[16], const u32x4& xa, const u32x4& xb, const f32x4 (&gv)[4], bf16_t* xout, size_t off, float ws) {
    float y[16];
#pragma unroll
    for (int k = 0; k < 16; ++k) { const unsigned w = (k < 8) ? xa[k >> 1] : xb[(k - 8) >> 1]; const float x = (k & 1) ? bf_hi(w) : bf_lo(w); y[k] = x + gv[k >> 2][k & 3] * ((float)acc[k] * ws); }
    u32x4 oa, ob;
#pragma unroll
    for (int q = 0; q < 4; ++q) { oa[q] = pk2(y[2 * q], y[2 * q + 1]); ob[q] = pk2(y[8 + 2 * q], y[8 + 2 * q + 1]); }
    *(u32x4*)(xout + off) = oa; *(u32x4*)(xout + off + 8) = ob;
}
__device__ __forceinline__ void expert_v_block16(const bf16_t* xin, bf16_t* xout, const float* gate, const unsigned char* Vs, const unsigned* WR, const float* WSC, int t0, int s, int lane) {
    const int g = lane >> 3, c = lane & 7, t = t0 + g, b_ = t >> 12;
    const size_t off = (size_t)t * DM + s * SLW + 16 * c; const float* gp = gate + (size_t)b_ * MODW + s * SLW + 16 * c;
    const u32x4* rp = (const u32x4*)(WR + (size_t)t * 128);
    const unsigned char* vb = Vs + 16 * c;
    const float ws0 = WSC[t], ws1 = WSC[t + 8];
    int acc[16];
#pragma unroll
    for (int k = 0; k < 16; ++k) acc[k] = 0;
    Ent8 EA, E1, E2, E3; Rows8 A, B;
    ent_load2(EA, rp, 0); ent_load2(E1, rp, 1); ent_load2(E2, rp, 2);
    rows_issue(A, EA, vb);
    const u32x4 xa0 = *(const u32x4*)(xin + off), xb0 = *(const u32x4*)(xin + off + 8), xa1 = *(const u32x4*)(xin + off + (size_t)8 * DM), xb1 = *(const u32x4*)(xin + off + (size_t)8 * DM + 8);
    f32x4 gv[4];
#pragma unroll
    for (int q = 0; q < 4; ++q) gv[q] = *(const f32x4*)(gp + 4 * q);
    __builtin_amdgcn_sched_barrier(0);
#pragma unroll 1
    for (int bb = 0; bb < 32; bb += 2) {
        if (bb == 16) {
            asm volatile("s_nop 2" : "+v"(acc[0]), "+v"(acc[1]), "+v"(acc[2]), "+v"(acc[3]), "+v"(acc[4]), "+v"(acc[5]), "+v"(acc[6]), "+v"(acc[7]), "+v"(acc[8]), "+v"(acc[9]), "+v"(acc[10]), "+v"(acc[11]), "+v"(acc[12]), "+v"(acc[13]), "+v"(acc[14]), "+v"(acc[15]));
            v_flush(acc, xa0, xb0, gv, xout, off, ws0);
#pragma unroll
            for (int k = 0; k < 16; ++k) acc[k] = 0;
            __builtin_amdgcn_sched_barrier(0); }
        rows_issue(B, E1, vb); ent_load2(E3, rp, bb + 3);
        __builtin_amdgcn_sched_barrier(0);
        v_batch(A, EA, acc);
        __builtin_amdgcn_sched_barrier(0);
        rows_issue(A, E2, vb); ent_load2(EA, rp, bb + 4);
        __builtin_amdgcn_sched_barrier(0);
        v_batch(B, E1, acc);
        __builtin_amdgcn_sched_barrier(0);
        { const Ent8 t4 = EA; EA = E2; E1 = E3; E2 = t4; }
    }
    asm volatile("s_nop 2" : "+v"(acc[0]), "+v"(acc[1]), "+v"(acc[2]), "+v"(acc[3]), "+v"(acc[4]), "+v"(acc[5]), "+v"(acc[6]), "+v"(acc[7]), "+v"(acc[8]), "+v"(acc[9]), "+v"(acc[10]), "+v"(acc[11]), "+v"(acc[12]), "+v"(acc[13]), "+v"(acc[14]), "+v"(acc[15]));
    v_flush(acc, xa1, xb1, gv, xout, off + (size_t)8 * DM, ws1);
}
__device__ __forceinline__ void expert_f_phase(Ctx& C, const bf16_t* PART, const unsigned* ROUTE, const float* US, const float* VS, const float* HSC, unsigned* WR, float* WSC) {
    const unsigned* PW = (const unsigned*)PART;
    for (int g = C.gw; g < MTOK / 4; g += C.NGW) {
        unsigned pw[4][NSLICE]; u32x2 rt[4]; float hs[4];
#pragma unroll
        for (int j = 0; j < 4; ++j) { const int t = 4 * g + j;
#pragma unroll
            for (int s = 0; s < NSLICE; ++s) pw[j][s] = PW[((size_t)s * MTOK + t) * 64 + C.lane];
            rt[j] = *(const u32x2*)(ROUTE + (size_t)t * 128 + 2 * C.lane); hs[j] = HSC[t]; }
        __builtin_amdgcn_sched_barrier(0);
        float us[4][2], vs[4][2];
#pragma unroll
        for (int j = 0; j < 4; ++j) { us[j][0] = US[rt[j].x & 0x3fffu]; us[j][1] = US[rt[j].y & 0x3fffu]; vs[j][0] = VS[rt[j].x & 0x3fffu]; vs[j][1] = VS[rt[j].y & 0x3fffu]; }
        __builtin_amdgcn_sched_barrier(0);
#pragma unroll
        for (int j = 0; j < 4; ++j) { const int t = 4 * g + j; float a0 = 0.f, a1 = 0.f;
#pragma unroll
            for (int s = 0; s < NSLICE; ++s) { a0 += __builtin_bit_cast(float, pw[j][s] << 16); a1 += __builtin_bit_cast(float, pw[j][s] & 0xffff0000u); }
            const float w0 = gelu_exact(a0 * us[j][0] * hs[j]) * __builtin_bit_cast(float, rt[j].x & 0xffff0000u) * vs[j][0];
            const float w1 = gelu_exact(a1 * us[j][1] * hs[j]) * __builtin_bit_cast(float, rt[j].y & 0xffff0000u) * vs[j][1];
            float m = fmaxf(fabsf(w0), fabsf(w1));
#pragma unroll
            for (int o = 1; o < 64; o <<= 1) m = fmaxf(m, __shfl_xor(m, o));
            const float qs = m > 0.f ? 127.0f / m : 0.f;
            u32x2 o2; o2.x = ((unsigned)(__float2int_rn(w0 * qs) & 0xff) << 24) | (rt[j].x & 0x3fffu); o2.y = ((unsigned)(__float2int_rn(w1 * qs) & 0xff) << 24) | (rt[j].y & 0x3fffu);
            *(u32x2*)(WR + (size_t)t * 128 + 2 * C.lane) = o2;
            if (C.lane == 0) WSC[t] = m * (1.0f / 127.0f); }
    }
}

constexpr int NPHASE = 47;
#ifndef MK_SPLIT
#define MK_SPLIT 0
#endif
struct Args { const float* in[20]; float* out; unsigned char* ws; int ph_lo, ph_hi; };
static_assert(sizeof(Args) == 20 * 8 + 8 + 8 + 8, "Args has no padding");

__device__ __forceinline__ bool in_range(int lo, int hi, int k) { asm volatile("" : "+s"(lo), "+s"(hi)); return lo <= k && k < hi; }
__device__ __forceinline__ int opaque_idx(int k) { asm volatile("" : "+s"(k)); return k; }
#define ARG(k) (args.in[opaque_idx(k)])
__global__ void __launch_bounds__(NTHREADS, 2) fwd_kernel(Args args) {
    extern __shared__ __attribute__((aligned(16))) unsigned char lds_raw[];
    Ctx C;
    C.lds = (LAS unsigned char*)lds_raw; C.ws = args.ws;
    C.tid = threadIdx.x; C.lane = C.tid & 63; C.wave = __builtin_amdgcn_readfirstlane(C.tid >> 6);
    C.G = gridDim.x; { const int bx = blockIdx.x; C.vcu = (C.G % 8 == 0) ? (bx % 8) * (C.G / 8) + bx / 8 : bx; }
    C.gw = C.vcu * NWAVES + C.wave; C.NGW = C.G * NWAVES;
    C.out = args.out;
    unsigned* ctl = (unsigned*)(C.ws + WS_CTL);
    volatile LAS unsigned* MISC = (volatile LAS unsigned*)(C.lds + LDS_MISC);
    for (int u = C.tid; u < (LDS_BYTES - LDS_MISC) / 4; u += NTHREADS) ((LAS unsigned*)(C.lds + LDS_MISC))[u] = 0u;
    __syncthreads();
    const int lo = args.ph_lo, hi = args.ph_hi;
    int nstamp = 0; (void)nstamp;
    XcdBarrier bar; bar.bar = ctl + CW_BAR; bar.x = 0; bar.st = nullptr;
    if (hi - lo > 1) bar = xcd_barrier_post(ctl + CW_BAR, MISC + 8);
#ifndef ONLYP
#define ONLYP -1
#endif
#define PEN(c) (ONLYP < 0 || ONLYP == (c))
#ifndef GEMM_ALIGN
#define GEMM_ALIGN true
#endif
#ifndef GEMM_SP2
#define GEMM_SP2 true
#endif
#ifndef ATTN_VARIANT
#define ATTN_VARIANT 0
#endif
#ifndef DUP_CLASS
#define DUP_CLASS -1
#endif
#define IN(k) in_range(lo, hi, (k))
#if defined(TIMING) && TIMING
#define STAMP_PHASE() do { if (blockIdx.x == 0 && threadIdx.x == 0) { unsigned long long* ts_ = (unsigned long long*)(args.ws + WS_DIAG); ts_[nstamp] = __builtin_amdgcn_s_memrealtime(); } ++nstamp; } while (0)
#else
#define STAMP_PHASE() do { } while (0)
#endif
#define FRESH(k) do { STAMP_PHASE(); C.tid = threadIdx.x; uintptr_t w_ = (uintptr_t)args.ws, o_ = (uintptr_t)args.out; asm volatile("; PHASE_MARK " #k : "+v"(C.tid), "+s"(C.gw), "+s"(C.vcu), "+s"(w_), "+s"(o_)); \
    C.ws = (unsigned char*)(GAS unsigned char*)w_; C.out = (float*)(GAS float*)o_; C.lane = C.tid & 63; } while (0)
#ifndef PROBE_BAR
#define PROBE_BAR 0
#endif
#define SEAM(k) do { if (IN(k) && IN((k) + 1)) { xcd_barrier(bar); if (PROBE_BAR) xcd_barrier(bar); } } while (0)

    float* MOD = (float*)(C.ws + WS_MOD);
    bf16_t* H = (bf16_t*)(C.ws + WS_H); bf16_t* SEG = (bf16_t*)(C.ws + WS_SEG); bf16_t* MIX = (bf16_t*)(C.ws + WS_MIX); bf16_t* QP = (bf16_t*)(C.ws + WS_QP); bf16_t* H2 = (bf16_t*)(C.ws + WS_H2); bf16_t* OT = (bf16_t*)(C.ws + WS_OT); bf16_t* XB = (bf16_t*)(C.ws + WS_XB);
    unsigned* ROUTE = (unsigned*)(C.ws + WS_ROUTE);

    if (PEN(0) && IN(0)) for (int rep_ = 0; rep_ < ((DUP_CLASS == 0) ? 2 : 1); ++rep_) { if (rep_) xcd_barrier(bar); FRESH(0); p0_prologue(C, args); } SEAM(0);
    if (PEN(1) && IN(1)) for (int rep_ = 0; rep_ < ((DUP_CLASS == 1) ? 2 : 1); ++rep_) { if (rep_) xcd_barrier(bar); FRESH(1); p1_modfinal(C, ARG(4)); } SEAM(1);

    for (int l = 0; l < DEPTH; ++l) {
        const int pb = 2 + 11 * l;
        const float* modl = MOD + (size_t)l * NBATCH * MODW;
        unsigned* kmax = ctl + CW_KMAX + l * 256;
        if (PEN(2) && IN(pb + 0)) for (int rep_ = 0; rep_ < ((DUP_CLASS == 2) ? 2 : 1); ++rep_) { if (rep_) xcd_barrier(bar); FRESH(2); bf16_t* XB_ = (bf16_t*)(C.ws + WS_XB); if (l == 0) norm_pass<float>(C, ARG(0), H, ARG(5) + (size_t)l * DM, modl + 0 * DM, modl + 1 * DM); else norm_pass<bf16_t>(C, XB_, H, ARG(5) + (size_t)l * DM, modl + 0 * DM, modl + 1 * DM); } SEAM(pb + 0);
        if (PEN(3) && IN(pb + 1)) for (int rep_ = 0; rep_ < ((DUP_CLASS == 3) ? 2 : 1); ++rep_) { if (rep_) xcd_barrier(bar); FRESH(3);
            pg8::Gemm g{H, (const bf16_t*)(C.ws + WS_WIN) + (size_t)l * INC * DM, MTOK, INC, DM}; pg8::StaticOrder S; S.init(MTOK, INC, C.G, (int)blockIdx.x);
            pg8::EpiIn E{SEG, SEG_ELEMS, (const int*)ARG(2), kmax};
            pg8::gemm_phase<pg8::EpiIn, pg8::StaticOrder, GEMM_ALIGN, GEMM_SP2>(C.lds, g, S, E);
        } SEAM(pb + 1);
        if (PEN(4) && IN(pb + 2)) for (int rep_ = 0; rep_ < ((DUP_CLASS == 4) ? 2 : 1); ++rep_) { if (rep_) xcd_barrier(bar); FRESH(4);
            bf16_t* otdst = (DUP_CLASS == 4 && rep_ == 0) ? (bf16_t*)(C.ws + WS_PART) : OT;
            const float lam = __uint_as_float(__builtin_amdgcn_readfirstlane(((const unsigned*)(C.ws + WS_LAM))[l])), osc = __uint_as_float(__builtin_amdgcn_readfirstlane(((const unsigned*)(C.ws + WS_LAM))[4 + l]));
            int kun = 0; bool convdone = false, uvdone = false; (void)uvdone;
            for (int u = C.vcu; u < NBATCH * AHEADS * (SEQ / 256); u += C.G, ++kun) { const int bh = u >> 4, qb = u & 15;
                att::attn_unit3(bh >> 3, bh & 7, qb, SEG + 3 * SEG_ELEMS, SEG + 4 * SEG_ELEMS, SEG + 5 * SEG_ELEMS, MIX, kmax, lam, ARG(12) + (size_t)l * VDIM, osc, (LAS char*)C.lds);
                if (l == 0 && rep_ == 0) { int tu_ = threadIdx.x; asm volatile("" : "+v"(tu_)); const int lu_ = tu_ & 63;
                    uv_convert_chunk(C, args, 2 * u, lu_); uv_convert_chunk(C, args, 2 * u + 1, lu_); }
                if (kun == (C.vcu & 3)) { convdone = true; int tc_ = threadIdx.x; asm volatile("" : "+v"(tc_));
                    for (int ch = C.vcu; ch < MTOK / 128; ch += C.G) conv_chunk(SEG + 0 * SEG_ELEMS, SEG + 1 * SEG_ELEMS, SEG + 2 * SEG_ELEMS, ARG(7) + (size_t)l * 3 * CONVW, MIX, ch, tc_); } }
            if (!convdone) { int tc_ = threadIdx.x; asm volatile("" : "+v"(tc_));
                for (int ch = C.vcu; ch < MTOK / 128; ch += C.G) conv_chunk(SEG + 0 * SEG_ELEMS, SEG + 1 * SEG_ELEMS, SEG + 2 * SEG_ELEMS, ARG(7) + (size_t)l * 3 * CONVW, MIX, ch, tc_); }
        } SEAM(pb + 2);
        if (PEN(5) && IN(pb + 4)) for (int rep_ = 0; rep_ < ((DUP_CLASS == 5) ? 2 : 1); ++rep_) { if (rep_) xcd_barrier(bar); FRESH(5);
            pg8::Gemm g{MIX, (const bf16_t*)(C.ws + WS_WOUT) + (size_t)l * DM * DM, MTOK, DM, DM}; pg8::StaticOrder S; S.init(MTOK, DM, C.G, (int)blockIdx.x);
            bf16_t* XB_ = (bf16_t*)(C.ws + WS_XB);
            bf16_t* XO_ = (DUP_CLASS == 5 && rep_ == 0) ? (bf16_t*)(C.ws + WS_PART) : XB_;
            if (l == 0) { pg8::EpiRes<float> E{ARG(0), XO_, modl + 2 * DM}; pg8::gemm_phase<pg8::EpiRes<float>, pg8::StaticOrder, GEMM_ALIGN, GEMM_SP2>(C.lds, g, S, E); }
            else { pg8::EpiRes<bf16_t> E{XB_, XO_, modl + 2 * DM}; pg8::gemm_phase<pg8::EpiRes<bf16_t>, pg8::StaticOrder, GEMM_ALIGN, GEMM_SP2>(C.lds, g, S, E); }
        } SEAM(pb + 4);
        if (PEN(6) && IN(pb + 5)) for (int rep_ = 0; rep_ < ((DUP_CLASS == 6) ? 2 : 1); ++rep_) { if (rep_) xcd_barrier(bar); FRESH(6); norm_pass<bf16_t>(C, (const bf16_t*)(C.ws + WS_XB), H2, ARG(14) + (size_t)l * DM, modl + 3 * DM, modl + 4 * DM, C.ws + WS_H2I, (float*)(C.ws + WS_HSC)); } SEAM(pb + 5);
        if (PEN(7) && IN(pb + 6)) for (int rep_ = 0; rep_ < ((DUP_CLASS == 7) ? 2 : 1); ++rep_) { if (rep_) xcd_barrier(bar); FRESH(7);
            pg8::Gemm g{H2, (const bf16_t*)(C.ws + WS_WQ) + (size_t)l * DM * DM, MTOK, DM, DM}; pg8::StaticOrder S; S.init(MTOK, DM, C.G, (int)blockIdx.x);
            pg8::EpiBf16 E{QP, DM};
            pg8::gemm_phase<pg8::EpiBf16, pg8::StaticOrder, GEMM_ALIGN, GEMM_SP2>(C.lds, g, S, E);
        } SEAM(pb + 6);
        if (PEN(8) && IN(pb + 7)) for (int rep_ = 0; rep_ < ((DUP_CLASS == 8) ? 2 : 1); ++rep_) { if (rep_) xcd_barrier(bar); FRESH(8);
            const bf16_t* keys = (const bf16_t*)(C.ws + WS_KEYS) + (size_t)l * 16 * 128 * 128;
            LAS int* scr = (LAS int*)(C.lds + 65536 + C.wave * 8192);
            for (int base = C.vcu * NWAVES; base < MTOK / 16; base += C.NGW) { const int tg = base + C.wave;
#pragma unroll 1
                for (int hq = 0; hq < 2; ++hq) router_task4(QP, keys, ROUTE, tg * 16, tg < MTOK / 16, hq, scr, (LAS unsigned char*)C.lds, C.tid); }
        } SEAM(pb + 7);
        const unsigned char* U8 = C.ws + WS_U + (size_t)l * NEXP * DM; const unsigned char* V8 = C.ws + WS_V + (size_t)l * NEXP * DM;
        if (PEN(9) && IN(pb + 8)) for (int rep_ = 0; rep_ < ((DUP_CLASS == 9) ? 2 : 1); ++rep_) { if (rep_) xcd_barrier(bar); FRESH(9);
            const unsigned xcd = xb_xcc_id() & 7u; unsigned* cnt = ctl + CW_XQ + ((l * 2 + 0) * 2 + rep_) * 16; volatile LAS int* bc = (volatile LAS int*)(C.lds + LDS_MISC + 64);
            bf16_t* PART = (bf16_t*)(C.ws + WS_PART); const unsigned char* H2I = C.ws + WS_H2I;
            for (int k = 0; k < NSLICE; ++k) { const int s = (int)((xcd + (unsigned)(k >> 1)) & 7u) + 8 * (k & 1);
                if (k == 2) { __syncthreads(); if (C.tid < NSLICE) bc[8 + C.tid] = (int)__hip_atomic_load(cnt + C.tid, __ATOMIC_RELAXED, __HIP_MEMORY_SCOPE_AGENT); __syncthreads(); }
                if (k >= 2 && bc[8 + s] >= NTB) continue;
                const unsigned char* Us = U8 + (size_t)s * NEXP * SLW; bf16_t* PARTs = PART + (size_t)s * MTOK * 128;
                __syncthreads(); if (C.tid == 0) bc[0] = (int)__hip_atomic_fetch_add(cnt + s, 1u, __ATOMIC_RELAXED, __HIP_MEMORY_SCOPE_AGENT); __syncthreads();
                int blk = bc[0], par = 0;
                while (blk < NTB) { int nxt = 0; if (C.tid == 0) nxt = (int)__hip_atomic_fetch_add(cnt + s, 1u, __ATOMIC_RELAXED, __HIP_MEMORY_SCOPE_AGENT);
#pragma unroll 1
                    for (int h2 = 0; h2 < 2; ++h2) expert_u_block16(H2I, Us, ROUTE, PARTs, blk * TBLK + C.wave * 32 + h2 * 16, s, C.lane);
                    if (C.tid == 0) bc[par ^ 1] = nxt;
                    __syncthreads(); par ^= 1; blk = bc[par]; } }
        } SEAM(pb + 8);
        if (PEN(12) && IN(pb + 9)) { FRESH(12);
            if (DUP_CLASS == 12) { expert_f_phase(C, (const bf16_t*)(C.ws + WS_PART), ROUTE, (const float*)(C.ws + WS_USC) + (size_t)l * NEXP, (const float*)(C.ws + WS_VSC) + (size_t)l * NEXP, (const float*)(C.ws + WS_HSC), (unsigned*)(C.ws + WS_WR), (float*)(C.ws + WS_WSC)); FRESH(12); }
            expert_f_phase(C, (const bf16_t*)(C.ws + WS_PART), ROUTE, (const float*)(C.ws + WS_USC) + (size_t)l * NEXP, (const float*)(C.ws + WS_VSC) + (size_t)l * NEXP, (const float*)(C.ws + WS_HSC), (unsigned*)(C.ws + WS_WR), (float*)(C.ws + WS_WSC));
        } SEAM(pb + 9);
        if (PEN(13) && IN(pb + 10)) for (int rep_ = 0; rep_ < ((DUP_CLASS == 13) ? 2 : 1); ++rep_) { if (rep_) xcd_barrier(bar); FRESH(13);
            bf16_t* XB_ = (bf16_t*)(C.ws + WS_XB); bf16_t* xdst = (DUP_CLASS == 13 && rep_ == 0) ? (bf16_t*)(C.ws + WS_PART) + (size_t)64 * 1024 * 1024 : XB_;
            const unsigned xcd = xb_xcc_id() & 7u; unsigned* cnt = ctl + CW_XQ + ((l * 2 + 1) * 2 + rep_) * 16; volatile LAS int* bc = (volatile LAS int*)(C.lds + LDS_MISC + 64);
            const unsigned* WR = (const unsigned*)(C.ws + WS_WR); const float* WSC = (const float*)(C.ws + WS_WSC);
            for (int k = 0; k < NSLICE; ++k) { const int s = (int)((xcd + (unsigned)(k >> 1)) & 7u) + 8 * (k & 1);
                if (k == 2) { __syncthreads(); if (C.tid < NSLICE) bc[8 + C.tid] = (int)__hip_atomic_load(cnt + C.tid, __ATOMIC_RELAXED, __HIP_MEMORY_SCOPE_AGENT); __syncthreads(); }
                if (k >= 2 && bc[8 + s] >= NTB) continue;
                const unsigned char* Vs = V8 + (size_t)s * NEXP * SLW;
                __syncthreads(); if (C.tid == 0) bc[0] = (int)__hip_atomic_fetch_add(cnt + s, 1u, __ATOMIC_RELAXED, __HIP_MEMORY_SCOPE_AGENT); __syncthreads();
                int blk = bc[0], par = 0;
                while (blk < NTB) { int nxt = 0; if (C.tid == 0) nxt = (int)__hip_atomic_fetch_add(cnt + s, 1u, __ATOMIC_RELAXED, __HIP_MEMORY_SCOPE_AGENT);
#pragma unroll 1
                    for (int h2 = 0; h2 < 2; ++h2) expert_v_block16(XB_, xdst, modl + 5 * DM, Vs, WR, WSC, blk * TBLK + C.wave * 32 + h2 * 16, s, C.lane);
                    if (C.tid == 0) bc[par ^ 1] = nxt;
                    __syncthreads(); par ^= 1; blk = bc[par]; } }
        } SEAM(pb + 10);
    }
    if (PEN(10) && IN(46)) for (int rep_ = 0; rep_ < ((DUP_CLASS == 10) ? 2 : 1); ++rep_) { if (rep_) xcd_barrier(bar); FRESH(10); final_norm_pass(C, (const bf16_t*)(C.ws + WS_XB), C.out, ARG(19)); }
#if defined(UBENCH)
    { float a0 = (float)C.lane, a1 = a0 + 1.f, a2 = a0 + 2.f, a3 = a0 + 3.f, a4 = 1.f, a5 = 2.f, a6 = 3.f, a7 = 4.f; f32x2 p0 = {0.f, 0.f}, p1 = p0, p2 = p0, p3 = p0; unsigned w0 = C.tid * 2654435761u, w1 = w0 ^ 0x55aa55aau;
#pragma unroll 1
      for (int it = 0; it < 16384; ++it) {
#if UBENCH == 1
        asm volatile("v_cvt_pk_f32_fp8_e32 %0, %4\n\tv_cvt_pk_f32_fp8_e32 %1, %5\n\tv_cvt_pk_f32_fp8_e32 %2, %4\n\tv_cvt_pk_f32_fp8_e32 %3, %5\n\tv_cvt_pk_f32_fp8_e32 %0, %5\n\tv_cvt_pk_f32_fp8_e32 %1, %4\n\tv_cvt_pk_f32_fp8_e32 %2, %5\n\tv_cvt_pk_f32_fp8_e32 %3, %4" : "+v"(p0), "+v"(p1), "+v"(p2), "+v"(p3) : "v"(w0), "v"(w1));
#elif UBENCH == 2
        asm volatile("v_cvt_pk_f32_fp8_sdwa %0, %4 src0_sel:WORD_1\n\tv_cvt_pk_f32_fp8_sdwa %1, %5 src0_sel:WORD_1\n\tv_cvt_pk_f32_fp8_sdwa %2, %4 src0_sel:WORD_1\n\tv_cvt_pk_f32_fp8_sdwa %3, %5 src0_sel:WORD_1\n\tv_cvt_pk_f32_fp8_sdwa %0, %5 src0_sel:WORD_1\n\tv_cvt_pk_f32_fp8_sdwa %1, %4 src0_sel:WORD_1\n\tv_cvt_pk_f32_fp8_sdwa %2, %5 src0_sel:WORD_1\n\tv_cvt_pk_f32_fp8_sdwa %3, %4 src0_sel:WORD_1" : "+v"(p0), "+v"(p1), "+v"(p2), "+v"(p3) : "v"(w0), "v"(w1));
#elif UBENCH == 3
        asm volatile("v_fma_f32 %0, %4, %5, %0\n\tv_fma_f32 %1, %4, %5, %1\n\tv_fma_f32 %2, %4, %5, %2\n\tv_fma_f32 %3, %4, %5, %3\n\tv_fma_f32 %0, %5, %4, %0\n\tv_fma_f32 %1, %5, %4, %1\n\tv_fma_f32 %2, %5, %4, %2\n\tv_fma_f32 %3, %5, %4, %3" : "+v"(a0), "+v"(a1), "+v"(a2), "+v"(a3) : "v"(a4), "v"(a5));
#elif UBENCH == 5
        { int i0 = (int)w0, i1 = (int)w1, i2 = 3, i3 = 4; asm volatile("v_dot4c_i32_i8 %0, %4, %5\n\tv_dot4c_i32_i8 %1, %4, %5\n\tv_dot4c_i32_i8 %2, %4, %5\n\tv_dot4c_i32_i8 %3, %4, %5\n\tv_dot4c_i32_i8 %0, %5, %4\n\tv_dot4c_i32_i8 %1, %5, %4\n\tv_dot4c_i32_i8 %2, %5, %4\n\tv_dot4c_i32_i8 %3, %5, %4" : "+v"(i0), "+v"(i1), "+v"(i2), "+v"(i3) : "v"(w0), "v"(w1)); a0 += (float)(i0 + i1 + i2 + i3); }
#elif UBENCH == 7
        asm volatile("v_perm_b32 %0, %4, %5, %6\n\tv_perm_b32 %1, %4, %5, %6\n\tv_perm_b32 %2, %4, %5, %6\n\tv_perm_b32 %3, %4, %5, %6\n\tv_perm_b32 %0, %5, %4, %6\n\tv_perm_b32 %1, %5, %4, %6\n\tv_perm_b32 %2, %5, %4, %6\n\tv_perm_b32 %3, %5, %4, %6" : "+v"(a0), "+v"(a1), "+v"(a2), "+v"(a3) : "v"(w0), "v"(w1), "v"(0x05010400u));
#elif UBENCH == 8
        asm volatile("v_pack_b32_f16 %0, %4, %5\n\tv_pack_b32_f16 %1, %4, %5\n\tv_and_or_b32 %2, %4, %5, %2\n\tv_and_or_b32 %3, %4, %5, %3\n\tv_pack_b32_f16 %0, %5, %4\n\tv_pack_b32_f16 %1, %5, %4\n\tv_lshl_or_b32 %2, %5, 8, %2\n\tv_lshl_or_b32 %3, %5, 8, %3" : "+v"(a0), "+v"(a1), "+v"(a2), "+v"(a3) : "v"(w0), "v"(w1));
#elif UBENCH == 6
        asm volatile("v_pk_fma_f32 %0, %4, %5, %0\n\tv_pk_fma_f32 %1, %4, %5, %1\n\tv_pk_fma_f32 %2, %4, %5, %2\n\tv_pk_fma_f32 %3, %4, %5, %3\n\tv_pk_fma_f32 %0, %5, %4, %0\n\tv_pk_fma_f32 %1, %5, %4, %1\n\tv_pk_fma_f32 %2, %5, %4, %2\n\tv_pk_fma_f32 %3, %5, %4, %3" : "+v"(p0), "+v"(p1), "+v"(p2), "+v"(p3) : "v"(p0), "v"(p1));
#else
        asm volatile("v_pk_fma_f16 %0, %4, %5, %0\n\tv_pk_fma_f16 %1, %4, %5, %1\n\tv_pk_fma_f16 %2, %4, %5, %2\n\tv_pk_fma_f16 %3, %4, %5, %3\n\tv_pk_fma_f16 %0, %5, %4, %0\n\tv_pk_fma_f16 %1, %5, %4, %1\n\tv_pk_fma_f16 %2, %5, %4, %2\n\tv_pk_fma_f16 %3, %5, %4, %3" : "+v"(a0), "+v"(a1), "+v"(a2), "+v"(a3) : "v"(w0), "v"(w1));
#endif
      }
      if (a0 + a1 + a2 + a3 + p0.x + p1.x + p2.x + p3.x + p0.y + p1.y + p2.y + p3.y == 1.2345e-30f) ((float*)(C.ws + WS_DIAG))[C.tid] = a0; }
#endif
#undef IN
#undef SEAM
}


#if defined(CHECK) && CHECK
constexpr size_t WS_XSAVE = 1776 * MiB;
constexpr int NSTAGE = 16, NSAMP = 96;
__device__ __forceinline__ unsigned hash32(unsigned x) { x ^= x >> 16; x *= 0x7feb352du; x ^= x >> 15; x *= 0x846ca68bu; x ^= x >> 16; return x; }
__device__ __forceinline__ float bf2f(bf16_t v) { return __builtin_bit_cast(float, ((unsigned)v) << 16); }
__device__ __forceinline__ double wsumd(double v) {
#pragma unroll
    for (int o = 1; o < 64; o <<= 1) v += __shfl_xor(v, o);
    return v; }
__device__ __forceinline__ float wmaxf(float v) {
#pragma unroll
    for (int o = 1; o < 64; o <<= 1) v = fmaxf(v, __shfl_xor(v, o));
    return v; }
__device__ __forceinline__ void diag_add(float* diag, int stage, double num, double den, int lane) { if (lane == 0) { atomicAdd(diag + 2 * stage, (float)num); atomicAdd(diag + 2 * stage + 1, (float)den); } }
__device__ __forceinline__ float chk_silu(float x) { return x / (1.f + expf(-x)); }
__device__ __forceinline__ float chk_rstd(const float* x, int row, int lane) { double ss = 0; for (int k = lane; k < DM; k += 64) { const double v = x[(size_t)row * DM + k]; ss += v * v; } ss = wsumd(ss); return 1.0f / sqrtf((float)(ss / DM) + NORM_EPS); }
__device__ __forceinline__ float chk_norm_elem(const float* x, int row, int col, float rstd, const float* g, const float* sh, const float* sc) { const int b = row >> 12;
    return x[(size_t)row * DM + col] * rstd * g[col] * (1.0f + sc[(size_t)b * MODW + col]) + sh[(size_t)b * MODW + col]; }
__global__ void __launch_bounds__(64) check_kernel(Args args) {
    __shared__ float sq_[64]; __shared__ float ssc[256]; __shared__ int sused[256]; __shared__ int sti[32]; __shared__ float sts[32]; __shared__ int sce[16]; __shared__ float scs[16];
    const int stage = blockIdx.x / NSAMP, s = blockIdx.x % NSAMP, lane = threadIdx.x;
    unsigned char* ws = args.ws; float* diag = (float*)(ws + WS_DIAG);
    const float* MOD = (const float*)(ws + WS_MOD); const bf16_t* H = (const bf16_t*)(ws + WS_H); const bf16_t* SEG = (const bf16_t*)(ws + WS_SEG);
    const bf16_t* MIX = (const bf16_t*)(ws + WS_MIX); const bf16_t* OT = (const bf16_t*)(ws + WS_OT); const bf16_t* H2 = (const bf16_t*)(ws + WS_H2); const bf16_t* QP = (const bf16_t*)(ws + WS_QP); const unsigned* ROUTE = (const unsigned*)(ws + WS_ROUTE);
    const float* XS = (const float*)(ws + WS_XSAVE); const unsigned* kmax = (const unsigned*)(ws + WS_CTL) + CW_KMAX;
    const unsigned hsh = hash32(stage * 7919u + s * 104729u + 12345u);
    const int row = hsh % MTOK; const unsigned h2 = hash32(hsh + 1u);
    if (stage == 1) {
        const int b = h2 % 8, n = (h2 >> 3) % MODW; double a = 0;
        for (int k = lane; k < DM; k += 64) a += (double)chk_silu(args.in[1][b * DM + k]) * args.in[3][(size_t)k * MODW + n];
        a = wsumd(a) + args.in[4][n]; const double d = MOD[(size_t)b * MODW + n] - a; diag_add(diag, stage, d * d, a * a, lane);
    } else if (stage == 2) {
        const int col = h2 % DM; const float rstd = chk_rstd(args.in[0], row, lane); const float r = chk_norm_elem(args.in[0], row, col, rstd, args.in[5], MOD + 0 * DM, MOD + 1 * DM);
        const double d = bf2f(H[(size_t)row * DM + col]) - r; diag_add(diag, stage, d * d, (double)r * r, lane);
    } else if (stage == 3 || stage == 4) {
        int col;
        if (stage == 3) { const int t = h2 % 4; col = (t == 3 ? 5 : t) * 1024 + (h2 >> 2) % 1024; } else { col = 3072 + (h2 % 2048); if (s < NSAMP / 2) col = (col & ~63) | ((h2 >> 11) % 16); }
        auto dotc = [&](int c) { double a = 0; for (int k = lane; k < DM; k += 64) a += (double)bf2f(H[(size_t)row * DM + k]) * args.in[6][(size_t)k * INC + c]; return (float)wsumd(a); };
        float r = dotc(col);
        if (stage == 4) { const int dd = col & 63; if (dd < 16) { const int j = dd & 7; const float invf = powf(500000.f, -(float)(2 * j) / 16.f); const float ang = (float)((const int*)args.in[2])[row] * invf;
                const float cs = cosf(ang), sn = sinf(ang); const float o = (dd < 8) ? dotc(col + 8) : dotc(col - 8); r = (dd < 8) ? r * cs - o * sn : r * cs + o * sn; } }
        const float got = bf2f(SEG[(size_t)(col >> 10) * SEG_ELEMS + (size_t)row * 1024 + (col & 1023)]);
        const double d = got - r; diag_add(diag, stage, d * d, (double)r * r, lane);
    } else if (stage == 5) {
        const int b = h2 % 8, hh = (h2 >> 3) % 8, c = (h2 >> 6) % 2; const bf16_t* K = SEG + 4 * SEG_ELEMS; float mx = 0.f;
        for (int sq = lane; sq < SEQ; sq += 64) { float a = 0; for (int d = 0; d < 64; ++d) { const float v = bf2f(K[((size_t)b * SEQ + sq) * 1024 + hh * 128 + c * 64 + d]); a += v * v; } mx = fmaxf(mx, a); }
        mx = wmaxf(mx);
        const unsigned* km = kmax + ((b * 8 + hh) * 2 + c) * 2; const float bound = __uint_as_float(km[0]) + __uint_as_float(km[1]);
        const bool ok = bound >= mx * 0.98f && bound <= mx * 2.2f; diag_add(diag, stage, ok ? 0.0 : 1.0, 1.0, lane);
    } else if (stage == 6) {
        const int hh = h2 % 8, c = (h2 >> 3) % 2, d = (h2 >> 4) % 128, b = row >> 12;
        const bf16_t* Q = SEG + 3 * SEG_ELEMS; const bf16_t* K = SEG + 4 * SEG_ELEMS; const bf16_t* V = SEG + 5 * SEG_ELEMS;
        sq_[lane] = bf2f(Q[(size_t)row * 1024 + hh * 128 + c * 64 + lane]); __syncthreads();
        float mx = -1e30f;
        for (int sq = lane; sq < SEQ; sq += 64) { float a = 0; const bf16_t* kr = K + ((size_t)b * SEQ + sq) * 1024 + hh * 128 + c * 64; for (int e = 0; e < 64; ++e) a += sq_[e] * bf2f(kr[e]); mx = fmaxf(mx, a * 0.125f); }
        mx = wmaxf(mx);
        double num = 0, den = 0;
        for (int sq = lane; sq < SEQ; sq += 64) { float a = 0; const bf16_t* kr = K + ((size_t)b * SEQ + sq) * 1024 + hh * 128 + c * 64; for (int e = 0; e < 64; ++e) a += sq_[e] * bf2f(kr[e]);
            const double p = exp((double)(a * 0.125f - mx)); den += p; num += p * bf2f(V[((size_t)b * SEQ + sq) * 1024 + hh * 128 + d]); }
        num = wsumd(num); den = wsumd(den);
        const double r = num / den; const double dd = bf2f(OT[(size_t)c * MTOK * 1024 + (size_t)row * 1024 + hh * 128 + d]) - r; diag_add(diag, stage, dd * dd, r * r, lane);
    } else if (stage == 7) {
        if ((s & 1) == 0) { const int col = h2 % 1024, sq = row & (SEQ - 1); const bf16_t* GB = SEG; const bf16_t* GC = SEG + SEG_ELEMS; const bf16_t* HV = SEG + 2 * SEG_ELEMS;
            auto z = [&](int r) { return bf2f(GC[(size_t)r * 1024 + col]) * bf2f(HV[(size_t)r * 1024 + col]); };
            const float zm = (sq > 0) ? z(row - 1) : 0.f, zc = z(row), zp = (sq < SEQ - 1) ? z(row + 1) : 0.f;
            const float r = bf2f(GB[(size_t)row * 1024 + col]) * (args.in[7][col] * zm + args.in[7][1024 + col] * zc + args.in[7][2048 + col] * zp);
            const double d = bf2f(MIX[(size_t)row * 2048 + col]) - r; diag_add(diag, stage, d * d, (double)r * r, lane);
        } else { const int hh = h2 % 8, d = (h2 >> 3) % 128;
            const double a1 = wsumd((double)args.in[8][lane] * args.in[9][lane]), a2 = wsumd((double)args.in[10][lane] * args.in[11][lane]);
            const float lam_init = 0.8f - 0.6f * expf(-0.3f * 0.f), lam = (float)(exp(a1) - exp(a2)) + lam_init;
            double ss = 0; float od = 0;
            for (int e = lane; e < 128; e += 64) { const float o = bf2f(OT[(size_t)row * 1024 + hh * 128 + e]) - lam * bf2f(OT[(size_t)MTOK * 1024 + (size_t)row * 1024 + hh * 128 + e]); ss += (double)o * o; if (e == d) od = o; }
            ss = wsumd(ss); od = (float)wsumd((double)od);
            const float r = od / sqrtf((float)(ss / 128.0) + NORM_EPS) * args.in[12][d] * (1.f - lam_init);
            const double dd = bf2f(MIX[(size_t)row * 2048 + 1024 + hh * 128 + d]) - r; diag_add(diag, stage, dd * dd, (double)r * r, lane); }
    } else if (stage == 8) {
        const int col = h2 % DM, b = row >> 12; double a = 0; for (int k = lane; k < DM; k += 64) a += (double)bf2f(MIX[(size_t)row * DM + k]) * args.in[13][(size_t)k * DM + col];
        a = wsumd(a); const double delta = (double)MOD[(size_t)b * MODW + 2 * DM + col] * a;
        const double r = args.in[0][(size_t)row * DM + col] + delta; const double d = XS[(size_t)row * DM + col] - r; diag_add(diag, stage, d * d, delta * delta, lane);
    } else if (stage == 9) {
        const int col = h2 % DM; const float rstd = chk_rstd(XS, row, lane); const float r = chk_norm_elem(XS, row, col, rstd, args.in[14], MOD + 3 * DM, MOD + 4 * DM);
        const double d = bf2f(H2[(size_t)row * DM + col]) - r; diag_add(diag, stage, d * d, (double)r * r, lane);
    } else if (stage == 10) {
        const int col = h2 % DM; double a = 0; for (int k = lane; k < DM; k += 64) a += (double)bf2f(H2[(size_t)row * DM + k]) * args.in[15][(size_t)k * DM + col];
        a = wsumd(a); const double d = bf2f(QP[(size_t)row * DM + col]) - a; diag_add(diag, stage, d * d, a * a, lane);
    } else if (stage == 11) {
        const int hh = h2 % 8;
        for (int i = lane; i < 256; i += 64) { const int c = i >> 7, n = i & 127; double a = 0; for (int d = 0; d < 128; ++d) a += (double)bf2f(QP[(size_t)row * DM + (hh * 2 + c) * 128 + d]) * args.in[16][(((size_t)hh * 2 + c) * 128 + n) * 128 + d]; ssc[i] = (float)a; sused[i] = 0; }
        __syncthreads();
        if (lane == 0) {
            for (int c = 0; c < 2; ++c) for (int j = 0; j < 16; ++j) { int bi = -1; float bv = -1e30f; for (int n = 0; n < 128; ++n) if (!sused[c * 128 + n] && ssc[c * 128 + n] > bv) { bv = ssc[c * 128 + n]; bi = n; }
                sti[c * 16 + j] = bi; sts[c * 16 + j] = bv; sused[c * 128 + bi] = 1; }
            for (int q = 0; q < 256; ++q) sused[q] = 0;
            for (int j = 0; j < 16; ++j) { int bi = -1; float bv = -1e30f; for (int q = 0; q < 256; ++q) { if (sused[q]) continue; const float v = sts[q >> 4] + sts[16 + (q & 15)]; if (v > bv) { bv = v; bi = q; } }
                sused[bi] = 1; sce[j] = sti[bi >> 4] * 128 + sti[16 + (bi & 15)]; scs[j] = bv; }
            double gsum = 0; for (int j = 0; j < 16; ++j) gsum += exp((double)(scs[j] - scs[0]));
            double err = 0;
            for (int j = 0; j < 16; ++j) { const double gr = exp((double)(scs[j] - scs[0])) / gsum; double gm = 0;
                for (int q = 0; q < 16; ++q) { const unsigned e = ROUTE[(size_t)row * 128 + hh * 16 + q]; if ((int)(e & 0x3fffu) == sce[j]) gm = __builtin_bit_cast(float, e & 0xffff0000u); }
                err += fabs(gr - gm); }
            diag_add(diag, stage, err * err, 1.0, lane); }
    } else if (stage == 13) {
        const int pair = h2 % 128; const unsigned ent = ROUTE[(size_t)row * 128 + pair]; const int eid = ent & 0x3fffu; double a = 0;
        for (int k = lane; k < DM; k += 64) a += (double)bf2f(H2[(size_t)row * DM + k]) * args.in[17][(size_t)eid * DM + k];
        a = wsumd(a); double got = 0; const bf16_t* PART = (const bf16_t*)(ws + WS_PART);
        for (int sl = 0; sl < 16; ++sl) got += bf2f(PART[(size_t)sl * MTOK * 128 + (size_t)row * 128 + pair]);
        got *= (double)((const float*)(ws + WS_USC))[eid] * ((const float*)(ws + WS_HSC))[row]; const double d = got - a; diag_add(diag, stage, d * d, a * a, lane);
    } else if (stage == 14) {
        const int pair = h2 % 128; const unsigned ent = ROUTE[(size_t)row * 128 + pair]; const int eid = ent & 0x3fffu; const float gate = __builtin_bit_cast(float, ent & 0xffff0000u); double a = 0;
        for (int k = lane; k < DM; k += 64) a += (double)bf2f(H2[(size_t)row * DM + k]) * args.in[17][(size_t)eid * DM + k];
        a = wsumd(a); const double w = 0.5 * a * (1.0 + erf(a * 0.7071067811865476)) * gate;
        const unsigned wr = ((const unsigned*)(ws + WS_WR))[(size_t)row * 128 + pair]; const double got = (double)((int)wr >> 24) * ((const float*)(ws + WS_WSC))[row] * (1.0 / ((const float*)(ws + WS_VSC))[eid]);
        const double d = got - w + (((int)(wr & 0x3fffu) == eid) ? 0.0 : 100.0); diag_add(diag, stage, d * d, w * w, lane);
    } else if (stage == 12) {
        const int col = h2 % DM, b = row >> 12; const float rstd = chk_rstd(XS, row, lane); double out = 0;
        for (int e = 0; e < 128; ++e) { const unsigned ent = ROUTE[(size_t)row * 128 + e]; const int eid = ent & 0x3fffu; const float gate = __builtin_bit_cast(float, ent & 0xffff0000u); double a = 0;
            for (int k = lane; k < DM; k += 64) { const float hk = chk_norm_elem(XS, row, k, rstd, args.in[14], MOD + 3 * DM, MOD + 4 * DM); a += (double)hk * args.in[17][(size_t)eid * DM + k]; }
            a = wsumd(a); const double ge = 0.5 * a * (1.0 + erf(a * 0.7071067811865476)); out += ge * gate * args.in[18][(size_t)eid * DM + col]; }
        const double delta = (double)MOD[(size_t)b * MODW + 5 * DM + col] * out; const double r = XS[(size_t)row * DM + col] + delta; const double d = args.out[(size_t)row * DM + col] - r; diag_add(diag, stage, d * d, delta * delta, lane);
    }
}
#ifndef CHECK_FROM
#define CHECK_FROM 1
#endif
__global__ void encode_kernel(Args args) {
    const float* diag = (const float*)(args.ws + WS_DIAG);
    int k = 14; float m = 1.f;
    for (int st = NSTAGE - 1; st >= CHECK_FROM; --st) { const float num = diag[2 * st], den = diag[2 * st + 1]; float rel = sqrtf(num / fmaxf(den, 1e-30f)); if (!(rel == rel)) rel = 1e4f;
        const float tol = (st == 11 || st == 12 || st == 13 || st == 14) ? 0.08f : (st == 5 ? 0.01f : 0.03f);
        if (rel > tol) { k = st; m = fminf(9.9f, fmaxf(1.f, 1.f + 2.f * (log10f(rel) + 4.f))); } }
    const float c = sqrtf(m * powf(10.f, (float)k));
    for (size_t i = (size_t)blockIdx.x * blockDim.x + threadIdx.x; i < (size_t)MTOK * DM; i += (size_t)gridDim.x * blockDim.x) args.out[i] = c;
}
#endif
extern "C" void kernel_launch(void* const* d_in, const int* in_sizes, int n_in, void* d_out, int out_size, void* d_ws, size_t ws_size, hipStream_t stream) {
    static int grid = 0;
    if (grid == 0) {
        if (n_in != 20 || out_size != MTOK * DM || ws_size < WS_END) { fprintf(stderr, "kernel_launch: unexpected shapes: n_in %d out %d ws %zu (need %zu)\n", n_in, out_size, ws_size, (size_t)WS_END); grid = -1; return; }
        int dev = 0, cus = 0;
        if (hipGetDevice(&dev) != hipSuccess || hipDeviceGetAttribute(&cus, hipDeviceAttributeMultiprocessorCount, dev) != hipSuccess) { grid = -1; return; }
        if (hipFuncSetAttribute((const void*)fwd_kernel, hipFuncAttributeMaxDynamicSharedMemorySize, LDS_BYTES) != hipSuccess) { fprintf(stderr, "kernel_launch: hipFuncSetAttribute failed\n"); grid = -1; return; }
        int per_cu = 0;
        if (hipOccupancyMaxActiveBlocksPerMultiprocessor(&per_cu, (const void*)fwd_kernel, NTHREADS, LDS_BYTES) != hipSuccess || per_cu < 1) { fprintf(stderr, "kernel_launch: occupancy query says %d\n", per_cu); }
        (void)hipGetLastError();
        grid = cus;
    }
    if (grid < 0) return;
    (void)hipMemsetAsync((char*)d_ws + WS_CTL, 0, CTL_ZERO_BYTES, stream);
    Args a{};
    for (int i = 0; i < 20; ++i) a.in[i] = (const float*)d_in[i];
    a.out = (float*)d_out; a.ws = (unsigned char*)d_ws;
#if defined(CHECK) && CHECK
    if (ws_size < WS_XSAVE + (size_t)MTOK * DM * 4) { fprintf(stderr, "check build: workspace too small\n"); return; }
    (void)hipMemsetAsync((char*)d_ws + WS_DIAG, 0, 4096, stream);
    for (int p = 0; p < 2 + 11; ++p) { a.ph_lo = p; a.ph_hi = p + 1; hipLaunchKernelGGL(fwd_kernel, dim3(grid), dim3(NTHREADS), LDS_BYTES, stream, a);
        if (p == 2 + 4) (void)hipMemcpyAsync((char*)d_ws + WS_XSAVE, d_out, (size_t)MTOK * DM * 4, hipMemcpyDeviceToDevice, stream); }
    hipLaunchKernelGGL(check_kernel, dim3(NSTAGE * NSAMP), dim3(64), 0, stream, a);
    hipLaunchKernelGGL(encode_kernel, dim3(1024), dim3(256), 0, stream, a);
#elif MK_SPLIT
    for (int p = 0; p < NPHASE; ++p) { a.ph_lo = p; a.ph_hi = p + 1; hipLaunchKernelGGL(fwd_kernel, dim3(grid), dim3(NTHREADS), LDS_BYTES, stream, a); }
#else
    a.ph_lo = 0; a.ph_hi = NPHASE; hipLaunchKernelGGL(fwd_kernel, dim3(grid), dim3(NTHREADS), LDS_BYTES, stream, a);
#endif
    const hipError_t le = hipPeekAtLastError();
    if (le != hipSuccess) fprintf(stderr, "kernel_launch: launch failed: %s\n", hipGetErrorName(le));
}
```
